# Optimizing an MI355X kernel written in HIP

```python
import jax, jax.numpy as jnp
from jax import lax
import numpy as np

D_MODEL = 1024
BATCH = 8
SEQ = 2048
DEPTH = 2
DEC_BATCH = 16
DEC_SEQ = 64
PAST_LEN = 4096

CHUNK = 64
N_META = 16
N_MIXERS = 2
HEAD_DIM = 64
N_HEADS = D_MODEL // HEAD_DIM
D_FF = 2752
LORA_DECAY = 64
LORA_AAA = 64
LORA_GATE = 128
Q_BLOCK = 128
RMS_EPS = 1e-6
GN_EPS = 64e-5

kernel_name = "rwkv7_stickbreaking_macaron_stream"


def rms_norm(x, g):
    xf = x.astype(jnp.float32)
    y = xf * lax.rsqrt(jnp.mean(xf * xf, axis=-1, keepdims=True) + RMS_EPS)
    return (y * g.astype(jnp.float32)).astype(x.dtype)


def swiglu(x, w_in, w_out):
    gate, up = jnp.split(x @ w_in, 2, axis=-1)
    return (jax.nn.silu(gate) * up) @ w_out


def rwkv7_time_mix(h, shift_prev, S0, mu, w_rkv, w0, w1, w2, a0, a1, a2, g1, g2,
                   k_k, k_a, r_k, gn_w, gn_b, w_o):
    B, T, D = h.shape
    H, N = N_HEADS, HEAD_DIM
    f32 = jnp.float32
    h_prev = jnp.concatenate([shift_prev[:, None, :].astype(h.dtype), h[:, :-1]], axis=1)
    dx = h_prev - h
    xr, xw, xk, xv, xa, xg = (h + dx * mu[i] for i in range(6))
    r = xr @ w_rkv[0]
    k = xk @ w_rkv[1]
    v = xv @ w_rkv[2]
    log_rate = -jax.nn.softplus(-(w0 + jnp.tanh(xw @ w1) @ w2)) - 0.5
    decay = jnp.exp(-jnp.exp(log_rate.astype(f32)))
    a = jax.nn.sigmoid((a0 + (xa @ a1) @ a2).astype(f32))
    g = jax.nn.sigmoid(xg @ g1) @ g2
    heads = lambda t: t.astype(f32).reshape(B, T, H, N)
    r, k, v, decay, a = map(heads, (r, k, v, decay, a))
    kk = k * k_k.astype(f32).reshape(H, N)
    kk = kk / jnp.maximum(jnp.sqrt(jnp.sum(kk * kk, axis=-1, keepdims=True)), 1e-12)
    k = k * (1.0 + (a - 1.0) * k_a.astype(f32).reshape(H, N))

    def step(S, inp):
        r_t, w_t, k_t, v_t, kk_t, a_t = inp
        sa = jnp.einsum('bhvk,bhk->bhv', S, -kk_t)
        S = (S * w_t[:, :, None, :]
             + sa[..., None] * (kk_t * a_t)[:, :, None, :]
             + v_t[..., None] * k_t[:, :, None, :])
        return S, jnp.einsum('bhvk,bhk->bhv', S, r_t)

    seq = tuple(jnp.swapaxes(t, 0, 1) for t in (r, decay, k, v, kk, a))
    S_fin, o = lax.scan(step, S0.astype(f32), seq)
    o = jnp.swapaxes(o, 0, 1)
    mean = jnp.mean(o, axis=-1, keepdims=True)
    var = jnp.mean(jnp.square(o - mean), axis=-1, keepdims=True)
    o = ((o - mean) * lax.rsqrt(var + GN_EPS) * gn_w.astype(f32).reshape(H, N)
         + gn_b.astype(f32).reshape(H, N))
    o = o + jnp.sum(r * k * r_k.astype(f32), axis=-1, keepdims=True) * v
    out = (o.reshape(B, T, D).astype(h.dtype) * g) @ w_o
    return out, S_fin.astype(S0.dtype), h[:, -1]


def sb_block(q, q_pos, k, v, k_pos):
    z = jnp.einsum('bhqd,bhkd->bhqk', q, k, preferred_element_type=jnp.float32) * (HEAD_DIM ** -0.5)
    vis = k_pos[None, :] < q_pos[:, None]
    log_beta = jax.nn.log_sigmoid(z)
    log_1m = jnp.where(vis, jax.nn.log_sigmoid(-z), 0.0)
    later = lax.cumsum(log_1m, axis=3, reverse=True) - log_1m
    A = jnp.where(vis, jnp.exp(log_beta + later), 0.0)
    return jnp.einsum('bhqk,bhkd->bhqd', A.astype(v.dtype), v)


def stick_breaking_mix(h, k_past, v_past, w_qkv, q_norm_g, k_norm_g, w_o):
    B, T, D = h.shape
    qkv = (h @ w_qkv).reshape(B, T, 3, N_HEADS, HEAD_DIM)
    q = rms_norm(qkv[:, :, 0], q_norm_g).transpose(0, 2, 1, 3)
    k = rms_norm(qkv[:, :, 1], k_norm_g).transpose(0, 2, 1, 3)
    v = qkv[:, :, 2].transpose(0, 2, 1, 3)
    if k_past is None:
        n_blk = -(-T // Q_BLOCK)
        Lp = n_blk * Q_BLOCK
        pad = ((0, 0), (0, 0), (0, Lp - T), (0, 0))
        qp, kp, vp = jnp.pad(q, pad), jnp.pad(k, pad), jnp.pad(v, pad)
        pos = jnp.arange(Lp)
        q_blocks = qp.reshape(B, N_HEADS, n_blk, Q_BLOCK, HEAD_DIM).transpose(2, 0, 1, 3, 4)
        pos_blocks = pos.reshape(n_blk, Q_BLOCK)
        o = lax.map(lambda args: sb_block(args[0], args[1], kp, vp, pos), (q_blocks, pos_blocks))
        o = o.transpose(1, 2, 0, 3, 4).reshape(B, N_HEADS, Lp, HEAD_DIM)[:, :, :T]
    else:
        P = k_past.shape[2]
        k_all = jnp.concatenate([k_past.astype(k.dtype), k], axis=2)
        v_all = jnp.concatenate([v_past.astype(v.dtype), v], axis=2)
        o = sb_block(q, P + jnp.arange(T), k_all, v_all, jnp.arange(P + T))
    out = o.transpose(0, 2, 1, 3).reshape(B, T, D) @ w_o
    return out, k, v


def layer_stack(x, rwkv_S0, rwkv_shift0, k_past, v_past, ffn_norm_g, ffn_w_in, ffn_w_out,
                mix_norm_g, rwkv_params, sb_params):
    mu, w_rkv, w0, w1, w2, a0, a1, a2, g1, g2, k_k, k_a, r_k, gn_w, gn_b, rw_o = rwkv_params
    w_qkv, q_norm_g, k_norm_g, sb_o = sb_params
    rwkv_S, rwkv_shift, k_new, v_new = rwkv_S0, rwkv_shift0, None, None
    for i in range(DEPTH):
        x = x + 0.5 * swiglu(rms_norm(x, ffn_norm_g[i, 0]), ffn_w_in[i, 0], ffn_w_out[i, 0])
        h = rms_norm(x, mix_norm_g[i])
        if i % N_MIXERS == 0:
            y, rwkv_S, rwkv_shift = rwkv7_time_mix(h, rwkv_shift0, rwkv_S0, mu, w_rkv, w0, w1, w2,
                                                   a0, a1, a2, g1, g2, k_k, k_a, r_k, gn_w, gn_b, rw_o)
        else:
            y, k_new, v_new = stick_breaking_mix(h, k_past, v_past, w_qkv, q_norm_g, k_norm_g, sb_o)
        x = x + y
        x = x + 0.5 * swiglu(rms_norm(x, ffn_norm_g[i, 1]), ffn_w_in[i, 1], ffn_w_out[i, 1])
    return x, rwkv_S, rwkv_shift, k_new, v_new


def setup_inputs(seed: int = 0) -> dict:
    key = jax.random.key(seed)
    ks = jax.random.split(key, 32)
    f32 = jnp.float32
    D, H, N = D_MODEL, N_HEADS, HEAD_DIM
    nrm = lambda k, shape, s: jax.random.normal(k, shape, f32) * s
    return {
        "x_prompt": nrm(ks[0], (BATCH, SEQ, D), 1.0),
        "x_sample": nrm(ks[1], (DEC_BATCH, DEC_SEQ, D), 1.0),
        "state_rwkv_wkv": nrm(ks[2], (DEC_BATCH, H, N, N), 0.5),
        "state_rwkv_shift": nrm(ks[3], (DEC_BATCH, D), 1.0),
        "cache_sb_k": nrm(ks[4], (DEC_BATCH, H, PAST_LEN, N), 1.0),
        "cache_sb_v": nrm(ks[5], (DEC_BATCH, H, PAST_LEN, N), 1.0),
        "meta_tokens": nrm(ks[6], (N_META, D), 1.0),
        "ffn_norm_g": 1.0 + nrm(ks[7], (DEPTH, 2, D), 0.02),
        "ffn_w_in": nrm(ks[8], (DEPTH, 2, D, 2 * D_FF), D ** -0.5),
        "ffn_w_out": nrm(ks[9], (DEPTH, 2, D_FF, D), D_FF ** -0.5),
        "mix_norm_g": 1.0 + nrm(ks[10], (DEPTH, D), 0.02),
        "rwkv_mu": jax.random.uniform(ks[11], (6, D), f32),
        "rwkv_w_rkv": nrm(ks[12], (3, D, D), D ** -0.5),
        "rwkv_w0": jnp.linspace(-6.0, -1.0, D, dtype=f32) + nrm(ks[13], (D,), 0.1),
        "rwkv_w1": nrm(ks[14], (D, LORA_DECAY), D ** -0.5),
        "rwkv_w2": nrm(ks[15], (LORA_DECAY, D), 0.1 * LORA_DECAY ** -0.5),
        "rwkv_a0": nrm(ks[16], (D,), 0.1),
        "rwkv_a1": nrm(ks[17], (D, LORA_AAA), D ** -0.5),
        "rwkv_a2": nrm(ks[18], (LORA_AAA, D), 0.1 * LORA_AAA ** -0.5),
        "rwkv_g1": nrm(ks[19], (D, LORA_GATE), D ** -0.5),
        "rwkv_g2": nrm(ks[20], (LORA_GATE, D), LORA_GATE ** -0.5),
        "rwkv_k_k": 0.85 + nrm(ks[21], (D,), 0.02),
        "rwkv_k_a": 1.0 + nrm(ks[22], (D,), 0.02),
        "rwkv_r_k": nrm(ks[23], (H, N), 0.1),
        "rwkv_gn_w": 1.0 + nrm(ks[24], (D,), 0.02),
        "rwkv_gn_b": nrm(ks[25], (D,), 0.02),
        "rwkv_w_o": nrm(ks[26], (D, D), D ** -0.5),
        "sb_w_qkv": nrm(ks[27], (D, 3 * D), D ** -0.5),
        "sb_q_norm_g": 1.0 + nrm(ks[28], (N,), 0.02),
        "sb_k_norm_g": 1.0 + nrm(ks[29], (N,), 0.02),
        "sb_w_o": nrm(ks[30], (D, D), D ** -0.5),
    }


def reference(x_prompt, x_sample, state_rwkv_wkv, state_rwkv_shift, cache_sb_k, cache_sb_v,
              meta_tokens, ffn_norm_g, ffn_w_in, ffn_w_out, mix_norm_g,
              rwkv_mu, rwkv_w_rkv, rwkv_w0, rwkv_w1, rwkv_w2, rwkv_a0, rwkv_a1, rwkv_a2,
              rwkv_g1, rwkv_g2, rwkv_k_k, rwkv_k_a, rwkv_r_k, rwkv_gn_w, rwkv_gn_b, rwkv_w_o,
              sb_w_qkv, sb_q_norm_g, sb_k_norm_g, sb_w_o):
    rwkv_params = (rwkv_mu, rwkv_w_rkv, rwkv_w0, rwkv_w1, rwkv_w2, rwkv_a0, rwkv_a1, rwkv_a2,
                   rwkv_g1, rwkv_g2, rwkv_k_k, rwkv_k_a, rwkv_r_k, rwkv_gn_w, rwkv_gn_b, rwkv_w_o)
    sb_params = (sb_w_qkv, sb_q_norm_g, sb_k_norm_g, sb_w_o)

    B = x_prompt.shape[0]
    meta = jnp.broadcast_to(meta_tokens.astype(x_prompt.dtype)[None], (B, N_META, D_MODEL))
    xp = jnp.concatenate([meta, x_prompt], axis=1)
    S0_p = jnp.zeros((B, N_HEADS, HEAD_DIM, HEAD_DIM), x_prompt.dtype)
    shift0_p = jnp.zeros((B, D_MODEL), x_prompt.dtype)
    yp, S_p, shift_p, k_p, v_p = layer_stack(xp, S0_p, shift0_p, None, None, ffn_norm_g, ffn_w_in,
                                             ffn_w_out, mix_norm_g, rwkv_params, sb_params)
    y_prompt = yp[:, N_META:]

    ys, S_s, shift_s, k_s, v_s = layer_stack(x_sample, state_rwkv_wkv, state_rwkv_shift, cache_sb_k,
                                             cache_sb_v, ffn_norm_g, ffn_w_in, ffn_w_out, mix_norm_g,
                                             rwkv_params, sb_params)
    return (y_prompt, ys, S_p, shift_p, k_p, v_p, S_s, shift_s, k_s, v_s)
```

```cpp
#include <hip/hip_runtime.h>
#include <hip/hip_cooperative_groups.h>
#include <cstdio>
#include <cstdint>
namespace cg = cooperative_groups;
namespace pg8 {
#define PG8_LAS __attribute__((address_space(3)))
typedef unsigned short bf16_t;
typedef short bf16x8 __attribute__((ext_vector_type(8)));
typedef float f32x4 __attribute__((ext_vector_type(4)));
typedef unsigned u32x4 __attribute__((ext_vector_type(4)));
constexpr int BM = 256, BK = 64, HALF = 128, HTB = HALF * BK * 2  , STAGE_BYTES = 8 * HTB, NXCD = 8, WGM = 8;

__host__ __device__ __forceinline__ int lds_byte(int r, int c) { const int st = (r >> 4) * 2 + (c >> 5), rr = r & 15, cc = c & 31, ob = rr * 64 + cc * 2; return st * 1024 + (ob ^ (((ob >> 9) & 1) << 5)); }
__host__ __device__ __forceinline__ void stage_rc(int b, int& R, int& C) { const int st = b / 1024, sb = b % 1024, swz = sb ^ (((sb >> 9) & 1) << 5); R = (st >> 1) * 16 + swz / 64; C = (st & 1) * 32 + (swz % 64) / 2; }
__host__ __device__ __forceinline__ int perm32(int rho) { const int n = rho >> 4, i = rho & 15; return 8 * (i >> 2) + 4 * n + (i & 3); }

struct Unit { int pm, pn; };
struct Gemm { const bf16_t* A; const bf16_t* Bt; int M, N, K; };

struct StaticOrder {
    int nM, nN, nwg, G, c;
    __host__ __device__ void init(int M, int N, int G_, int c_) { nM = M / BM; nN = N / BM; nwg = nM * nN; G = G_; c = c_; }
    __host__ __device__ bool next(int i, Unit& u) const {
        const long L = (long)i * G + c; if (L >= nwg) return false;
        int wgid = (int)L; { const int q = nwg / NXCD, r = nwg % NXCD, xcd = wgid % NXCD, off = wgid / NXCD; wgid = (xcd < r ? xcd * (q + 1) : r * (q + 1) + (xcd - r) * q) + off; }
        const int nig = WGM * nN, gid = wgid / nig, fm = gid * WGM, gsz = (nM - fm) < WGM ? (nM - fm) : WGM;
        u.pm = fm + ((wgid % nig) % gsz); u.pn = (wgid % nig) / gsz; return true;
    }
    __device__ __forceinline__ void a_ready(const Unit&) const {}
    __device__ __forceinline__ void done(const Unit&) const {}
};
template <class Epi, class Sched, bool ALIGN_EPI = false, bool SP2 = false>
__device__ __forceinline__ void gemm_phase(PG8_LAS unsigned char* lds, const Gemm g, const Sched& S, const Epi& E) {
    int tid = threadIdx.x; asm volatile("" : "+v"(tid)); const int wid = __builtin_amdgcn_readfirstlane(tid >> 6), lane = tid & 63, wr = wid >> 2, wc = wid & 3, fr = lane & 15, fq = lane >> 4;
    const int K = g.K, nt = K / BK;
    unsigned voffA[2], voffB[2];
#pragma unroll
    for (int i = 0; i < 2; ++i) { int R, C; stage_rc(tid * 16 + i * 8192, R, C); const int Rb = Epi::PERM ? ((R & ~31) + perm32(R & 31)) : R;
        voffA[i] = (unsigned)(R * K + C) * 2u; voffB[i] = (unsigned)(Rb * K + C) * 2u; }
    const size_t kstep = (size_t)(BK * 2);
    const size_t hstep = (size_t)HALF * K * 2;
    const size_t tstep = 2 * hstep;
    const unsigned ldsw = (unsigned)wid * 1024u;
    const int aoff = lds_byte(wr * 64 + fr, fq * 8), boff = lds_byte(wc * 32 + fr, fq * 8);
#define PG8_SA(b, h) (((b) * 2 + (h)) * HTB)
#define PG8_SB(b, h) ((4 + (b) * 2 + (h)) * HTB)
#define PG8_STAGE(bufoff, gbase, voff) do { _Pragma("unroll") for (int _i = 0; _i < 2; ++_i) \
        __builtin_amdgcn_global_load_lds((const unsigned*)((const char*)(gbase) + (voff)[_i]), (PG8_LAS unsigned*)(lds + (bufoff) + ldsw + _i * 8192), 16, 0, 0); } while (0)
#define PG8_LDA(dst, b, h) do { _Pragma("unroll") for (int m = 0; m < 4; ++m) _Pragma("unroll") for (int k = 0; k < 2; ++k) dst[m][k] = *(const PG8_LAS bf16x8*)(lds + PG8_SA(b, h) + aoff + m * 2048 + k * 1024); } while (0)
#define PG8_LDB(dst, b, h) do { _Pragma("unroll") for (int n = 0; n < 2; ++n) _Pragma("unroll") for (int k = 0; k < 2; ++k) dst[n][k] = *(const PG8_LAS bf16x8*)(lds + PG8_SB(b, h) + boff + n * 2048 + k * 1024); } while (0)
#define PG8_MMA(ai, bj, At, Bt) do { __builtin_amdgcn_s_setprio(1); _Pragma("unroll") for (int m = 0; m < 4; ++m) _Pragma("unroll") for (int n = 0; n < 2; ++n) _Pragma("unroll") for (int k = 0; k < 2; ++k) \
        acc[ai][bj][m][n] = __builtin_amdgcn_mfma_f32_16x16x32_bf16(Bt[n][k], At[m][k], acc[ai][bj][m][n], 0, 0, 0); __builtin_amdgcn_s_setprio(0); } while (0)
#define PG8_WAIT_V(n) asm volatile("s_waitcnt vmcnt(" #n ")" ::: "memory")
#define PG8_WAIT_L(n) asm volatile("s_waitcnt lgkmcnt(" #n ")" ::: "memory")
#define PG8_BAR __builtin_amdgcn_s_barrier()
#define PG8_SCHED __builtin_amdgcn_sched_barrier(0)
    Unit cur, nxt; int ui = 0;
    if (!S.next(0, cur)) return;
    f32x4 acc[2][2][4][2];
#pragma unroll
    for (int a = 0; a < 2; ++a)
#pragma unroll
        for (int b = 0; b < 2; ++b)
#pragma unroll
            for (int m = 0; m < 4; ++m)
#pragma unroll
                for (int n = 0; n < 2; ++n) acc[a][b][m][n] = (f32x4){0.f, 0.f, 0.f, 0.f};
    bf16x8 At[4][2], B0[2][2], B1[2][2];
    const char* cA = (const char*)g.A + (size_t)cur.pm * tstep; const char* cB = (const char*)g.Bt + (size_t)cur.pn * tstep;
    S.a_ready(cur);
    if constexpr (SP2) {
        PG8_STAGE(PG8_SB(0, 0), cB, voffB); PG8_STAGE(PG8_SB(0, 1), cB + hstep, voffB); PG8_STAGE(PG8_SA(0, 0), cA, voffA); PG8_STAGE(PG8_SA(0, 1), cA + hstep, voffA);
        if (wr == 1) PG8_BAR;
        PG8_WAIT_V(2); PG8_BAR;
        PG8_STAGE(PG8_SB(1, 0), cB + kstep, voffB); PG8_STAGE(PG8_SA(1, 0), cA + kstep, voffA); PG8_STAGE(PG8_SB(1, 1), cB + hstep + kstep, voffB);
        PG8_WAIT_V(6); PG8_BAR;
    } else {
        PG8_STAGE(PG8_SB(0, 0), cB, voffB); PG8_STAGE(PG8_SA(0, 0), cA, voffA); PG8_STAGE(PG8_SB(0, 1), cB + hstep, voffB); PG8_STAGE(PG8_SA(0, 1), cA + hstep, voffA);
        if (wr == 1) PG8_BAR;
        PG8_WAIT_V(4); PG8_BAR;
        PG8_STAGE(PG8_SB(1, 0), cB + kstep, voffB); PG8_STAGE(PG8_SA(1, 0), cA + kstep, voffA); PG8_STAGE(PG8_SB(1, 1), cB + hstep + kstep, voffB);
        PG8_WAIT_V(6); PG8_BAR;
    }
    for (;;) {
        const bool has_next = S.next(ui + 1, nxt);
        const char* nA = has_next ? (const char*)g.A + (size_t)nxt.pm * tstep : cA; const char* nB = has_next ? (const char*)g.Bt + (size_t)nxt.pn * tstep : cB;
        for (int t = 0; t < nt; t += 2) {
            const bool last = (t == nt - 2);
            const char* a1 = cA + (size_t)(t + 1) * kstep;
            const char* a2 = last ? nA : cA + (size_t)(t + 2) * kstep; const char* b2 = last ? nB : cB + (size_t)(t + 2) * kstep;
            const char* a3 = a2 + kstep; const char* b3 = b2 + kstep;
            if (last && has_next) S.a_ready(nxt);
            if constexpr (SP2) {
            PG8_LDB(B0, 0, 0); PG8_LDB(B1, 0, 1); PG8_SCHED; PG8_LDA(At, 0, 0); PG8_STAGE(PG8_SA(1, 1), a1 + hstep, voffA);
            PG8_WAIT_V(8); PG8_WAIT_L(0); PG8_BAR; PG8_MMA(0, 0, At, B0); PG8_MMA(0, 1, At, B1); PG8_BAR; PG8_SCHED;
            PG8_LDA(At, 0, 1); PG8_STAGE(PG8_SB(0, 0), b2, voffB); PG8_STAGE(PG8_SB(0, 1), b2 + hstep, voffB); PG8_STAGE(PG8_SA(0, 0), a2, voffA);
            PG8_WAIT_V(8); PG8_WAIT_L(0); PG8_BAR; PG8_MMA(1, 0, At, B0); PG8_MMA(1, 1, At, B1); PG8_BAR; PG8_SCHED;
            PG8_LDB(B0, 1, 0); PG8_LDB(B1, 1, 1); PG8_SCHED; PG8_LDA(At, 1, 0); PG8_STAGE(PG8_SA(0, 1), a2 + hstep, voffA);
            PG8_WAIT_V(8); PG8_WAIT_L(0); PG8_BAR; PG8_MMA(0, 0, At, B0); PG8_MMA(0, 1, At, B1); PG8_BAR; PG8_SCHED;
            PG8_LDA(At, 1, 1); PG8_STAGE(PG8_SB(1, 0), b3, voffB); PG8_STAGE(PG8_SB(1, 1), b3 + hstep, voffB); PG8_STAGE(PG8_SA(1, 0), a3, voffA);
            PG8_WAIT_V(8); PG8_WAIT_L(0); PG8_BAR; PG8_MMA(1, 0, At, B0); PG8_MMA(1, 1, At, B1); PG8_BAR; PG8_SCHED;
            } else {
            PG8_LDB(B0, 0, 0); PG8_SCHED; PG8_LDA(At, 0, 0); PG8_STAGE(PG8_SA(1, 1), a1 + hstep, voffA);
            PG8_WAIT_L(8); PG8_BAR; PG8_WAIT_L(0); PG8_MMA(0, 0, At, B0); PG8_BAR; PG8_SCHED;
            PG8_LDB(B1, 0, 1); PG8_STAGE(PG8_SB(0, 0), b2, voffB);
            PG8_BAR; PG8_WAIT_L(0); PG8_MMA(0, 1, At, B1); PG8_BAR;
            PG8_LDA(At, 0, 1); PG8_STAGE(PG8_SA(0, 0), a2, voffA);
            PG8_BAR; PG8_WAIT_L(0); PG8_MMA(1, 0, At, B0); PG8_BAR; PG8_SCHED;
            PG8_STAGE(PG8_SB(0, 1), b2 + hstep, voffB);
            PG8_WAIT_V(6); PG8_BAR; PG8_MMA(1, 1, At, B1); PG8_BAR;
            PG8_LDB(B0, 1, 0); PG8_SCHED; PG8_LDA(At, 1, 0); PG8_STAGE(PG8_SA(0, 1), a2 + hstep, voffA);
            PG8_WAIT_L(8); PG8_BAR; PG8_WAIT_L(0); PG8_MMA(0, 0, At, B0); PG8_BAR; PG8_SCHED;
            PG8_LDB(B1, 1, 1); PG8_STAGE(PG8_SB(1, 0), b3, voffB);
            PG8_BAR; PG8_WAIT_L(0); PG8_MMA(0, 1, At, B1); PG8_BAR;
            PG8_LDA(At, 1, 1); PG8_STAGE(PG8_SA(1, 0), a3, voffA);
            PG8_BAR; PG8_WAIT_L(0); PG8_MMA(1, 0, At, B0); PG8_BAR; PG8_SCHED;
            PG8_STAGE(PG8_SB(1, 1), b3 + hstep, voffB);
            PG8_WAIT_V(6); PG8_BAR; PG8_MMA(1, 1, At, B1); PG8_BAR;
            }
        }
        if constexpr (ALIGN_EPI) { if (wr == 0) PG8_BAR; }
        if constexpr (!Epi::AFTER_DRAIN) { E(acc, cur, wr, wc, fr, fq); S.done(cur); }
        if (!has_next) break;
#pragma unroll
        for (int a = 0; a < 2; ++a)
#pragma unroll
            for (int b = 0; b < 2; ++b)
#pragma unroll
                for (int m = 0; m < 4; ++m)
#pragma unroll
                    for (int n = 0; n < 2; ++n) acc[a][b][m][n] = (f32x4){0.f, 0.f, 0.f, 0.f};
        cur = nxt; cA = nA; cB = nB; ++ui;
        if constexpr (ALIGN_EPI) { if (wr == 1) PG8_BAR; }
    }
    PG8_WAIT_V(0);
    if constexpr (!ALIGN_EPI) { if (wr == 0) PG8_BAR; }
    PG8_BAR;
    if constexpr (Epi::AFTER_DRAIN) { E.fused(acc, cur, wr, wc, fr, fq, lds, wid, lane); S.done(cur); }
#undef PG8_SA
#undef PG8_SB
#undef PG8_STAGE
#undef PG8_LDA
#undef PG8_LDB
#undef PG8_MMA
#undef PG8_WAIT_V
#undef PG8_WAIT_L
#undef PG8_BAR
#undef PG8_SCHED
}
}

#define LAS __attribute__((address_space(3)))
typedef unsigned short bf16_t;
typedef short bf16x8 __attribute__((ext_vector_type(8)));
typedef float f32x4 __attribute__((ext_vector_type(4)));
typedef float f32x2 __attribute__((ext_vector_type(2)));
typedef float f32x16 __attribute__((ext_vector_type(16)));
typedef unsigned u32x4 __attribute__((ext_vector_type(4)));
typedef unsigned u32x2 __attribute__((ext_vector_type(2)));

constexpr int D = 1024, NH = 16, HD = 64;
constexpr int BP = 8, TP = 2064, SEQP = 2048, NMETA = 16, BS = 16, TS = 64, PAST = 4096;
constexpr int MPR = BP * TP;
constexpr int MR = MPR + BS * TS;
constexpr int MP = 17664;
constexpr int NTM = 69;
constexpr int DFF = 2752, DFFP = 2816, NIN = 5632;
constexpr float RMS_EPS = 1e-6f, GN_EPS = 64e-5f;
constexpr float LOG2E = 1.4426950408889634f;

constexpr size_t O_YP = 0, O_YS = 16777216, O_SP = 17825792, O_SHP = 18350080, O_KP = 18358272, O_VP = 35266560,
                 O_SS = 52174848, O_SHS = 53223424, O_KS = 53239808, O_VS = 54288384, O_END = 55336960;

constexpr size_t SZ_ROWBF = (size_t)MP * D * 2, SZ_ROWF = (size_t)MP * D * 4;
constexpr size_t W_X = 0;
constexpr size_t W_XN = W_X + SZ_ROWF;
constexpr size_t W_HB = W_XN + SZ_ROWBF;
constexpr size_t W_WIN = W_HB + (size_t)MP * DFFP * 2;
constexpr size_t SZ_WIN1 = (size_t)NIN * D * 2, SZ_WOUT1 = (size_t)D * DFFP * 2;
constexpr size_t W_WOUT = W_WIN + 4 * SZ_WIN1;
constexpr size_t W_WG1 = W_WOUT + 4 * SZ_WOUT1;
constexpr size_t W_WL2 = W_WG1 + (size_t)3584 * D * 2;
constexpr size_t W_WO1 = W_WL2 + (size_t)3072 * 256 * 2;
constexpr size_t W_WQKV = W_WO1 + (size_t)D * D * 2;
constexpr size_t W_WO2 = W_WQKV + (size_t)3 * D * D * 2;
constexpr size_t W_AALL = W_WO2 + (size_t)D * D * 2;
constexpr size_t W_RKV = W_AALL + 5 * SZ_ROWBF;
constexpr size_t W_L1 = W_RKV + 3 * SZ_ROWBF;
constexpr size_t W_A2 = W_L1 + (size_t)2 * MP * 256 * 4;
constexpr size_t W_DEC = W_A2 + (size_t)MP * 256 * 2;
constexpr size_t W_AA = W_DEC + SZ_ROWF;
constexpr size_t W_GG = W_AA + SZ_ROWBF;
constexpr size_t W_SO = W_GG + SZ_ROWBF;
constexpr size_t W_OG = W_SO + SZ_ROWF;
constexpr size_t W_QB = W_OG + SZ_ROWBF;
constexpr size_t W_END = W_QB + SZ_ROWBF;

struct Params { const float* in[31]; float* out; unsigned char* ws; int ph_lo, ph_hi; };
typedef const Params __attribute__((address_space(4)))* KP;

__device__ __forceinline__ unsigned cvt_pk(float lo, float hi) { unsigned r; asm("v_cvt_pk_bf16_f32 %0, %1, %2" : "=v"(r) : "v"(lo), "v"(hi)); return r; }
__device__ __forceinline__ void store_bf4(bf16_t* p, f32x4 v) { u32x2 w; w.x = cvt_pk(v[0], v[1]); w.y = cvt_pk(v[2], v[3]); *(u32x2*)p = w; }
__device__ __forceinline__ float bf_lo(unsigned w) { return __uint_as_float(w << 16); }
__device__ __forceinline__ float bf_hi(unsigned w) { return __uint_as_float(w & 0xffff0000u); }
__device__ __forceinline__ float sigmoidf_(float x) { return __builtin_amdgcn_rcpf(1.f + __expf(-x)); }
__device__ __forceinline__ float softplusf_(float x) { return fmaxf(x, 0.f) + __logf(1.f + __expf(-fabsf(x))); }
__device__ __forceinline__ float shx(float v, int o, int lane) { return __builtin_bit_cast(float, __builtin_amdgcn_ds_bpermute((lane ^ o) << 2, __builtin_bit_cast(int, v))); }
__device__ __forceinline__ float wave_sum(float v, int lane) {
#pragma unroll
    for (int o = 1; o < 64; o <<= 1) v += shx(v, o, lane);
    return v;
}
__device__ __forceinline__ void row_bt(int row, int& grp, int& b, int& t) { if (row < MPR) { grp = 0; b = row / TP; t = row - b * TP; } else { grp = 1; const int r = row - MPR; b = r >> 6; t = r & 63; } }

using pg8::Unit;
struct EpiSwiGLU {
    static constexpr bool PERM = true, AFTER_DRAIN = false;
    bf16_t* HB;
    __device__ __forceinline__ void operator()(const f32x4 (&acc)[2][2][4][2], const Unit& u, int wr, int wc, int fr, int fq) const {
        const int row0 = u.pm * 256 + wr * 64 + fr, col0 = u.pn * 128 + wc * 32 + 8 * fq;
#pragma unroll
        for (int ai = 0; ai < 2; ++ai)
#pragma unroll
            for (int m = 0; m < 4; ++m) {
                bf16_t* rowp = HB + (size_t)(row0 + ai * 128 + m * 16) * DFFP + col0;
                float hv[8];
#pragma unroll
                for (int n = 0; n < 2; ++n)
#pragma unroll
                    for (int j = 0; j < 4; ++j) { const float g = acc[ai][0][m][n][j], up = acc[ai][1][m][n][j]; hv[n * 4 + j] = g * sigmoidf_(g) * up; }
                u32x4 w; w.x = cvt_pk(hv[0], hv[1]); w.y = cvt_pk(hv[2], hv[3]); w.z = cvt_pk(hv[4], hv[5]); w.w = cvt_pk(hv[6], hv[7]);
                *(u32x4*)rowp = w;
            }
    }
};
struct EpiRes {
    static constexpr bool PERM = false, AFTER_DRAIN = false;
    float* X; float scale; float* out;
    __device__ __forceinline__ void operator()(const f32x4 (&acc)[2][2][4][2], const Unit& u, int wr, int wc, int fr, int fq) const {
        const int row0 = u.pm * 256 + wr * 64 + fr, col0 = u.pn * 256 + wc * 32 + 4 * fq;
#pragma unroll
        for (int ai = 0; ai < 2; ++ai)
#pragma unroll
            for (int m = 0; m < 4; ++m) {
                const int row = row0 + ai * 128 + m * 16;
                float* xp = X + (size_t)row * D + col0;
                if (out == nullptr) {
#pragma unroll
                    for (int bj = 0; bj < 2; ++bj)
#pragma unroll
                        for (int n = 0; n < 2; ++n) { f32x4* q = (f32x4*)(xp + bj * 128 + n * 16); *q = *q + acc[ai][bj][m][n] * scale; }
                } else if (row < MR) {
                    float* dp = nullptr;
                    if (row < MPR) { const int b = row / TP, t = row - b * TP; if (t >= NMETA) dp = out + O_YP + ((size_t)b * SEQP + (t - NMETA)) * D; }
                    else dp = out + O_YS + (size_t)(row - MPR) * D;
                    if (dp) {
                        dp += col0;
#pragma unroll
                        for (int bj = 0; bj < 2; ++bj)
#pragma unroll
                            for (int n = 0; n < 2; ++n) { *(f32x4*)(dp + bj * 128 + n * 16) = *(const f32x4*)(xp + bj * 128 + n * 16) + acc[ai][bj][m][n] * scale; }
                    }
                }
                asm volatile("" ::: "memory");
            }
    }
};
struct EpiG1 {
    static constexpr bool PERM = true, AFTER_DRAIN = false;
    bf16_t* RKV; float* L1;
    __device__ __forceinline__ void operator()(const f32x4 (&acc)[2][2][4][2], const Unit& u, int wr, int wc, int fr, int fq) const {
        const unsigned row0 = (unsigned)((u.pm % NTM) * 256 + wr * 64 + fr), cw = wc * 32 + 8 * fq;
        if (u.pn < 12) {
            bf16_t* base = RKV + (size_t)(u.pn >> 2) * MP * D;
            const unsigned off0 = row0 * D + (u.pn & 3) * 256 + cw;
#pragma unroll
            for (int ai = 0; ai < 2; ++ai)
#pragma unroll
                for (int m = 0; m < 4; ++m)
#pragma unroll
                    for (int bj = 0; bj < 2; ++bj) { const f32x4 v0 = acc[ai][bj][m][0], v1 = acc[ai][bj][m][1];
                        u32x4 w; w.x = cvt_pk(v0[0], v0[1]); w.y = cvt_pk(v0[2], v0[3]); w.z = cvt_pk(v1[0], v1[1]); w.w = cvt_pk(v1[2], v1[3]);
                        *(u32x4*)(base + (off0 + (unsigned)((ai * 128 + m * 16) * D + bj * 128))) = w; }
        } else {
            float* base = L1 + (size_t)(u.pn - 12) * MP * 256;
            const unsigned off0 = row0 * 256 + cw;
#pragma unroll
            for (int ai = 0; ai < 2; ++ai)
#pragma unroll
                for (int m = 0; m < 4; ++m)
#pragma unroll
                    for (int bj = 0; bj < 2; ++bj)
#pragma unroll
                        for (int n = 0; n < 2; ++n) *(f32x4*)(base + (off0 + (unsigned)((ai * 128 + m * 16) * 256 + bj * 128 + n * 4))) = acc[ai][bj][m][n];
        }
    }
};
struct EpiG2 {
    static constexpr bool PERM = true, AFTER_DRAIN = false;
    float* DEC; bf16_t* AA; bf16_t* GG;
    __device__ __forceinline__ void operator()(const f32x4 (&acc)[2][2][4][2], const Unit& u, int wr, int wc, int fr, int fq) const {
        const int sec = u.pn >> 2;
        const unsigned off0 = (unsigned)(u.pm * 256 + wr * 64 + fr) * D + (u.pn & 3) * 256 + wc * 32 + 8 * fq;
        bf16_t* ob = sec == 1 ? AA : GG;
#pragma unroll
        for (int ai = 0; ai < 2; ++ai)
#pragma unroll
            for (int m = 0; m < 4; ++m)
#pragma unroll
                for (int bj = 0; bj < 2; ++bj) {
                    const unsigned off = off0 + (unsigned)((ai * 128 + m * 16) * D + bj * 128);
                    const f32x4 v0 = acc[ai][bj][m][0], v1 = acc[ai][bj][m][1];
                    if (sec == 0) { *(f32x4*)(DEC + off) = v0; *(f32x4*)(DEC + off + 4) = v1; }
                    else { u32x4 w; w.x = cvt_pk(v0[0], v0[1]); w.y = cvt_pk(v0[2], v0[3]); w.z = cvt_pk(v1[0], v1[1]); w.w = cvt_pk(v1[2], v1[3]); *(u32x4*)(ob + off) = w; }
                }
    }
};
struct EpiQKV {
    static constexpr bool PERM = false, AFTER_DRAIN = false;
    bf16_t* QB; float* out; const float* qg; const float* kg;
    __device__ __forceinline__ void operator()(const f32x4 (&acc)[2][2][4][2], const Unit& u, int wr, int wc, int fr, int fq) const {
        const int sec = u.pn >> 2, head = (u.pn & 3) * 4 + wc, row0 = u.pm * 256 + wr * 64 + fr;
        f32x4 gn[2][2];
#pragma unroll
        for (int bj = 0; bj < 2; ++bj)
#pragma unroll
            for (int n = 0; n < 2; ++n) { const int d = 32 * bj + 16 * n + 4 * fq;
                gn[bj][n] = sec == 0 ? *(const f32x4*)(qg + d) * 0.125f : (sec == 1 ? *(const f32x4*)(kg + d) : (f32x4){1.f, 1.f, 1.f, 1.f}); }
#pragma unroll
        for (int ai = 0; ai < 2; ++ai)
#pragma unroll
            for (int m = 0; m < 4; ++m) {
                const int row = row0 + ai * 128 + m * 16;
                float ss = 0.f;
#pragma unroll
                for (int bj = 0; bj < 2; ++bj)
#pragma unroll
                    for (int n = 0; n < 2; ++n) { const f32x4 x = acc[ai][bj][m][n]; ss += (x[0] * x[0] + x[1] * x[1]) + (x[2] * x[2] + x[3] * x[3]); }
                { const int ln = fq * 16 + fr; ss += shx(ss, 16, ln); ss += shx(ss, 32, ln); }
                const float rs = sec == 2 ? 1.f : __builtin_amdgcn_rsqf(ss * (1.f / 64.f) + RMS_EPS);
                if (row < MR) {
                    if (sec == 0) {
                        bf16_t* qp = QB + (size_t)row * D + head * 64 + 4 * fq;
#pragma unroll
                        for (int bj = 0; bj < 2; ++bj)
#pragma unroll
                            for (int n = 0; n < 2; ++n) { const f32x4 x = acc[ai][bj][m][n] * rs * gn[bj][n]; u32x2 w; w.x = cvt_pk(x[0], x[1]); w.y = cvt_pk(x[2], x[3]); *(u32x2*)(qp + 32 * bj + 16 * n) = w; }
                    } else {
                        int grp, b, t; row_bt(row, grp, b, t);
                        float* dp = grp == 0 ? out + (sec == 1 ? O_KP : O_VP) + (((size_t)b * NH + head) * TP + t) * HD
                                             : out + (sec == 1 ? O_KS : O_VS) + (((size_t)b * NH + head) * TS + t) * HD;
                        dp += 4 * fq;
#pragma unroll
                        for (int bj = 0; bj < 2; ++bj)
#pragma unroll
                            for (int n = 0; n < 2; ++n) *(f32x4*)(dp + 32 * bj + 16 * n) = acc[ai][bj][m][n] * rs * gn[bj][n];
                    }
                }
            }
    }
};
struct G1Order {
    int G, c;
    __device__ bool next(int i, Unit& u) const {
        const long L = (long)i * G + c; if (L >= 966) return false;
        int w = (int)L; { const int q = 966 / 8, r = 966 % 8, xcd = w % 8, off = w / 8; w = (xcd < r ? xcd * (q + 1) : r * (q + 1) + (xcd - r) * q) + off; }
        const int pm = w / 14, q = w % 14;
        if (q < 12) { u.pm = (q >> 2) * NTM + pm; u.pn = q; } else { u.pm = (q - 9) * NTM + pm; u.pn = q; }
        return true;
    }
    __device__ __forceinline__ void a_ready(const Unit&) const {}
    __device__ __forceinline__ void done(const Unit&) const {}
};

struct Job { const float* src; bf16_t* dst; const float* mu; int ld, Ksrc, koff, Kdst, rows, map, smode; };
__device__ __forceinline__ int srccol(int map, int n, int ld) {
    if (map == 0) return n < ld ? n : -1;
    if (map == 1) { const int pn = n >> 8, c = n & 255, bj = c >> 7, j = c & 127, hc = pn * 128 + j; return hc < DFF ? (bj ? DFF + hc : hc) : -1; }
    { const int t = n >> 8, c = n & 255, bj = c >> 7, wc = (c & 127) >> 5, i = c & 31; return t * 256 + 64 * wc + 32 * bj + i; }
}
__device__ __forceinline__ Job get_job(KP p, int j) {
    Job J; J.mu = nullptr; J.koff = 0; J.map = 0; J.smode = 0;
    unsigned char* ws = p->ws;
    if (j < 4) { J.src = p->in[8] + (size_t)j * D * 2 * DFF; J.dst = (bf16_t*)(ws + W_WIN + j * SZ_WIN1); J.ld = 2 * DFF; J.Ksrc = D; J.Kdst = D; J.rows = NIN; J.map = 1; }
    else if (j < 8) { const int i = j - 4; J.src = p->in[9] + (size_t)i * DFF * D; J.dst = (bf16_t*)(ws + W_WOUT + i * SZ_WOUT1); J.ld = D; J.Ksrc = DFF; J.Kdst = DFFP; J.rows = D; }
    else if (j < 11) { const int g = j - 8; J.src = p->in[12] + (size_t)g * D * D; J.dst = (bf16_t*)(ws + W_WG1) + (size_t)g * D * D; J.ld = D; J.Ksrc = D; J.Kdst = D; J.rows = D; }
    else if (j < 17) { const int idx = j - 11, part = idx / 3, which = idx % 3;
        J.src = which == 0 ? p->in[14] : (which == 1 ? p->in[17] : p->in[19]); J.ld = which == 2 ? 128 : 64; J.rows = J.ld;
        J.mu = p->in[11] + (which == 0 ? 1 : (which == 1 ? 4 : 5)) * D; J.smode = part + 1;
        J.dst = (bf16_t*)(ws + W_WG1) + (size_t)(3072 + part * 256 + which * 64) * D; J.Ksrc = D; J.Kdst = D; }
    else if (j < 20) { const int which = j - 17; J.src = which == 0 ? p->in[15] : (which == 1 ? p->in[18] : p->in[20]); J.ld = D; J.rows = D;
        J.Ksrc = which == 2 ? 128 : 64; J.koff = which * 64; J.Kdst = 256; J.dst = (bf16_t*)(ws + W_WL2) + (size_t)which * D * 256; }
    else if (j == 20) { J.src = p->in[26]; J.dst = (bf16_t*)(ws + W_WO1); J.ld = D; J.Ksrc = D; J.Kdst = D; J.rows = D; }
    else if (j == 21) { J.src = p->in[27]; J.dst = (bf16_t*)(ws + W_WQKV); J.ld = 3 * D; J.Ksrc = D; J.Kdst = D; J.rows = 3 * D; J.map = 2; }
    else { J.src = p->in[30]; J.dst = (bf16_t*)(ws + W_WO2); J.ld = D; J.Ksrc = D; J.Kdst = D; J.rows = D; }
    return J;
}
__device__ __forceinline__ void convert_weights(KP p, LAS float* tl, int tid, int bid, int G) {
    int rot = 0;
    for (int j = 0; j < 23; ++j) {
        const Job J = get_job(p, j);
        const int nkt = J.Kdst >> 6, ntile = (J.rows >> 6) * nkt;
        int first = bid - rot; if (first < 0) first += G;
        for (int t = first; t < ntile; t += G) {
            const int n0 = (t / nkt) << 6, k0 = (t % nkt) << 6;
            const bool inside = k0 >= J.koff && k0 < J.koff + J.Ksrc;
            if (inside) {
                const int nn = tid & 63, sc = srccol(J.map, n0 + nn, J.ld);
#pragma unroll
                for (int it = 0; it < 8; ++it) {
                    const int kk = (tid >> 6) + 8 * it, ks = k0 - J.koff + kk;
                    float v = sc >= 0 ? J.src[(size_t)ks * J.ld + sc] : 0.f;
                    if (J.smode == 1) v *= 1.f - J.mu[ks]; else if (J.smode == 2) v *= J.mu[ks];
                    tl[kk * 65 + nn] = v;
                }
            }
            __syncthreads();
            {
                const int nn = tid >> 3, kq = tid & 7;
                u32x4 w = (u32x4){0u, 0u, 0u, 0u};
                if (inside) { float v[8];
#pragma unroll
                    for (int e = 0; e < 8; ++e) v[e] = tl[(kq * 8 + e) * 65 + nn];
                    w.x = cvt_pk(v[0], v[1]); w.y = cvt_pk(v[2], v[3]); w.z = cvt_pk(v[4], v[5]); w.w = cvt_pk(v[6], v[7]); }
                *(u32x4*)(J.dst + (size_t)(n0 + nn) * J.Kdst + k0 + kq * 8) = w;
            }
            __syncthreads();
        }
        rot = (rot + ntile) % G;
    }
}
__device__ __forceinline__ float row_rstd(const f32x4 (&v)[4], int lane) {
    float s = 0.f;
#pragma unroll
    for (int i = 0; i < 4; ++i) s += (v[i][0] * v[i][0] + v[i][1] * v[i][1]) + (v[i][2] * v[i][2] + v[i][3] * v[i][3]);
    s = wave_sum(s, lane);
    return __builtin_amdgcn_rsqf(s * (1.f / D) + RMS_EPS);
}

__device__ __forceinline__ void assemble_x(KP p, int tid, int bid, int G) {
    const int lane = tid & 63, gw = bid * 8 + (tid >> 6), nw = G * 8;
    float* X = (float*)(p->ws + W_X); bf16_t* XN = (bf16_t*)(p->ws + W_XN); const float* g = p->in[7];
    for (int row = gw; row < MP; row += nw) {
        f32x4 v[4];
        const float* src = nullptr;
        if (row < MPR) { const int b = row / TP, t = row - b * TP; src = t < NMETA ? p->in[6] + (size_t)t * D : p->in[0] + ((size_t)b * SEQP + (t - NMETA)) * D; }
        else if (row < MR) src = p->in[1] + (size_t)(row - MPR) * D;
#pragma unroll
        for (int i = 0; i < 4; ++i) v[i] = src ? *(const f32x4*)(src + lane * 4 + 256 * i) : (f32x4){0.f, 0.f, 0.f, 0.f};
        const float rs = row_rstd(v, lane);
#pragma unroll
        for (int i = 0; i < 4; ++i) { const int c = lane * 4 + 256 * i; *(f32x4*)(X + (size_t)row * D + c) = v[i]; store_bf4(XN + (size_t)row * D + c, v[i] * rs * *(const f32x4*)(g + c)); }
    }
}
__device__ __forceinline__ void norm_phase(KP p, const float* g, int tid, int bid, int G) {
    const int lane = tid & 63, gw = bid * 8 + (tid >> 6), nw = G * 8;
    const float* X = (const float*)(p->ws + W_X); bf16_t* XN = (bf16_t*)(p->ws + W_XN);
    for (int row = gw; row < MP; row += nw) {
        f32x4 v[4];
#pragma unroll
        for (int i = 0; i < 4; ++i) v[i] = *(const f32x4*)(X + (size_t)row * D + lane * 4 + 256 * i);
        const float rs = row_rstd(v, lane);
#pragma unroll
        for (int i = 0; i < 4; ++i) { const int c = lane * 4 + 256 * i; store_bf4(XN + (size_t)row * D + c, v[i] * rs * *(const f32x4*)(g + c)); }
    }
}
__device__ __forceinline__ void mixprep_phase(KP p, int tid, int bid, int G) {
    const int lane = tid & 63, gw = bid * 8 + (tid >> 6), nw = G * 8;
    const float* X = (const float*)(p->ws + W_X); bf16_t* A = (bf16_t*)(p->ws + W_AALL);
    const float* g = p->in[10]; const float* mu = p->in[11];
    for (int row = gw; row < MR; row += nw) {
        int grp, b, t; row_bt(row, grp, b, t);
        f32x4 v[4], pv[4];
#pragma unroll
        for (int i = 0; i < 4; ++i) v[i] = *(const f32x4*)(X + (size_t)row * D + lane * 4 + 256 * i);
        const float rs = row_rstd(v, lane);
        if (t > 0) {
#pragma unroll
            for (int i = 0; i < 4; ++i) pv[i] = *(const f32x4*)(X + (size_t)(row - 1) * D + lane * 4 + 256 * i);
            const float rp = row_rstd(pv, lane);
#pragma unroll
            for (int i = 0; i < 4; ++i) pv[i] = pv[i] * rp * *(const f32x4*)(g + lane * 4 + 256 * i);
        } else {
#pragma unroll
            for (int i = 0; i < 4; ++i) pv[i] = grp == 0 ? (f32x4){0.f, 0.f, 0.f, 0.f} : *(const f32x4*)(p->in[3] + (size_t)b * D + lane * 4 + 256 * i);
        }
        const bool last = t == (grp == 0 ? TP - 1 : TS - 1);
        float* sh = grp == 0 ? p->out + O_SHP + (size_t)b * D : p->out + O_SHS + (size_t)b * D;
#pragma unroll
        for (int i = 0; i < 4; ++i) {
            const int c = lane * 4 + 256 * i; const size_t o = (size_t)row * D + c;
            const f32x4 h = v[i] * rs * *(const f32x4*)(g + c), dx = pv[i] - h;
            store_bf4(A + o, h + dx * *(const f32x4*)(mu + c));
            store_bf4(A + (size_t)MP * D + o, h + dx * *(const f32x4*)(mu + 2 * D + c));
            store_bf4(A + (size_t)2 * MP * D + o, h + dx * *(const f32x4*)(mu + 3 * D + c));
            store_bf4(A + (size_t)3 * MP * D + o, h);
            store_bf4(A + (size_t)4 * MP * D + o, pv[i]);
            if (last) *(f32x4*)(sh + c) = h;
        }
    }
}
__device__ __forceinline__ void act_phase(KP p, int gtid, int nthr) {
    const float* L1 = (const float*)(p->ws + W_L1); bf16_t* A2 = (bf16_t*)(p->ws + W_A2);
    for (int i = gtid; i < MP * 64; i += nthr) {
        const int c = (i & 63) * 4;
        f32x4 v = *(const f32x4*)(L1 + (size_t)i * 4) + *(const f32x4*)(L1 + (size_t)MP * 256 + (size_t)i * 4);
        if (c < 64) {
#pragma unroll
            for (int j = 0; j < 4; ++j) v[j] = 1.f - 2.f * __builtin_amdgcn_rcpf(1.f + __expf(2.f * v[j]));
        } else if (c >= 128) {
#pragma unroll
            for (int j = 0; j < 4; ++j) v[j] = sigmoidf_(v[j]);
        }
        store_bf4(A2 + (size_t)i * 4, v);
    }
}

__device__ __forceinline__ float dpp_sum16(float x) {
    x += __builtin_bit_cast(float, __builtin_amdgcn_update_dpp(0, __builtin_bit_cast(int, x), 0xB1, 0xF, 0xF, true));
    x += __builtin_bit_cast(float, __builtin_amdgcn_update_dpp(0, __builtin_bit_cast(int, x), 0x4E, 0xF, 0xF, true));
    x += __builtin_bit_cast(float, __builtin_amdgcn_update_dpp(0, __builtin_bit_cast(int, x), 0x141, 0xF, 0xF, true));
    x += __builtin_bit_cast(float, __builtin_amdgcn_update_dpp(0, __builtin_bit_cast(int, x), 0x140, 0xF, 0xF, true));
    return x;
}
constexpr int SC_CH = 16, SC_STR = 400;
__device__ __forceinline__ void scan_phase(KP p, LAS float* buf, int tid, int bid, int G) {
    const int wid = tid >> 6, lane = tid & 63, rl = lane >> 4, kq = lane & 15;
    const bf16_t* RKV = (const bf16_t*)(p->ws + W_RKV); const float* DEC = (const float*)(p->ws + W_DEC); const bf16_t* AA = (const bf16_t*)(p->ws + W_AA);
    float* SO = (float*)(p->ws + W_SO);
    const int pi = tid >> 5, pj = tid & 31;
    for (int u = bid; u < 768; u += G) {
        int bh, half, T, row0; const float* S0; float* Sout;
        if (u < 256) { bh = u >> 1; half = u & 1; T = TP; row0 = (bh >> 4) * TP; S0 = nullptr; Sout = p->out + O_SP + (size_t)bh * 4096; }
        else { const int v = u - 256; bh = v >> 1; half = v & 1; T = TS; row0 = MPR + (bh >> 4) * TS; S0 = p->in[2] + (size_t)bh * 4096; Sout = p->out + O_SS + (size_t)bh * 4096; }
        const int h = bh & 15, vrow = half * 32 + wid * 4 + rl;
        f32x4 s = (f32x4){0.f, 0.f, 0.f, 0.f};
        if (S0) s = *(const f32x4*)(S0 + vrow * 64 + kq * 4);
        const int nchunk = T / SC_CH;
        const int kc = h * 64 + 2 * pj;
        const f32x2 kkv = *(const f32x2*)(p->in[21] + kc), kav = *(const f32x2*)(p->in[22] + kc), w0v = *(const f32x2*)(p->in[13] + kc), a0v = *(const f32x2*)(p->in[16] + kc);
        unsigned pr, pk, pvv, pa; f32x2 pd;
#define SC_LOAD(c) do { const size_t o = (size_t)(row0 + (c) * SC_CH + pi) * D + kc; pr = *(const unsigned*)(RKV + o); pk = *(const unsigned*)(RKV + (size_t)MP * D + o); \
        pvv = *(const unsigned*)(RKV + (size_t)2 * MP * D + o); pa = *(const unsigned*)(AA + o); pd = *(const f32x2*)(DEC + o); } while (0)
#define SC_STORE(bi) do { LAS float* rec = buf + (bi) * (SC_CH * SC_STR) + pi * SC_STR; \
        const float r0 = bf_lo(pr), r1 = bf_hi(pr), k0 = bf_lo(pk), k1 = bf_hi(pk), v0 = bf_lo(pvv), v1 = bf_hi(pvv), a0 = sigmoidf_(a0v.x + bf_lo(pa)), a1 = sigmoidf_(a0v.y + bf_hi(pa)); \
        const float w0 = __expf(-__expf(-softplusf_(-(w0v.x + pd.x)) - 0.5f)), w1 = __expf(-__expf(-softplusf_(-(w0v.y + pd.y)) - 0.5f)); \
        const float q0 = k0 * kkv.x, q1 = k1 * kkv.y; float ss = q0 * q0 + q1 * q1; \
        _Pragma("unroll") for (int o_ = 1; o_ < 32; o_ <<= 1) ss += shx(ss, o_, lane); \
        const float inv = 1.f / fmaxf(sqrtf(ss), 1e-12f); const float n0 = q0 * inv, n1 = q1 * inv; \
        const float kp0 = k0 * (1.f + (a0 - 1.f) * kav.x), kp1 = k1 * (1.f + (a1 - 1.f) * kav.y); \
        const float b0 = n0 * a0, b1 = n1 * a1; \
        float br = b0 * r0 + b1 * r1, kr = kp0 * r0 + kp1 * r1; \
        _Pragma("unroll") for (int o_ = 1; o_ < 32; o_ <<= 1) { br += shx(br, o_, lane); kr += shx(kr, o_, lane); } \
        *(LAS f32x2*)(rec + 2 * pj) = (f32x2){w0, w1}; *(LAS f32x2*)(rec + 64 + 2 * pj) = (f32x2){n0, n1}; *(LAS f32x2*)(rec + 128 + 2 * pj) = (f32x2){b0, b1}; \
        *(LAS f32x2*)(rec + 192 + 2 * pj) = (f32x2){kp0, kp1}; *(LAS f32x2*)(rec + 256 + 2 * pj) = (f32x2){w0 * r0, w1 * r1}; *(LAS f32x2*)(rec + 320 + 2 * pj) = (f32x2){v0, v1}; \
        if (pj == 0) { rec[384] = br; rec[385] = kr; } } while (0)
        SC_LOAD(0); SC_STORE(0);
        __syncthreads();
        float* op = SO + (size_t)row0 * D + h * 64 + vrow;
        for (int c = 0; c < nchunk; ++c) {
            const bool more = c + 1 < nchunk;
            if (more) SC_LOAD(c + 1);
            const LAS float* cb = buf + (c & 1) * (SC_CH * SC_STR);
#pragma unroll 4
            for (int i = 0; i < SC_CH; ++i) {
                const LAS float* rec = cb + i * SC_STR;
                const f32x4 wd = *(const LAS f32x4*)(rec + kq * 4), kk = *(const LAS f32x4*)(rec + 64 + kq * 4), bb = *(const LAS f32x4*)(rec + 128 + kq * 4),
                            kp = *(const LAS f32x4*)(rec + 192 + kq * 4), wr = *(const LAS f32x4*)(rec + 256 + kq * 4);
                const float vv = rec[320 + vrow], br = rec[384], kr = rec[385];
                float d1 = (s[0] * kk[0] + s[1] * kk[1]) + (s[2] * kk[2] + s[3] * kk[3]);
                float d2 = (s[0] * wr[0] + s[1] * wr[1]) + (s[2] * wr[2] + s[3] * wr[3]);
                d1 = dpp_sum16(d1); d2 = dpp_sum16(d2);
                const float sa = -d1;
                const float o = d2 + sa * br + vv * kr;
                s = s * wd + bb * sa + kp * vv;
                if (kq == 0) op[(size_t)(c * SC_CH + i) * D] = o;
            }
            if (more) SC_STORE((c + 1) & 1);
            __syncthreads();
        }
        *(f32x4*)(Sout + vrow * 64 + kq * 4) = s;
#undef SC_LOAD
#undef SC_STORE
    }
}
__device__ __forceinline__ void post_phase(KP p, int tid, int bid, int G) {
    const int lane = tid & 63, gw = bid * 8 + (tid >> 6), nw = G * 8;
    const bf16_t* RKV = (const bf16_t*)(p->ws + W_RKV); const bf16_t* AA = (const bf16_t*)(p->ws + W_AA); const bf16_t* GG = (const bf16_t*)(p->ws + W_GG);
    const float* SO = (const float*)(p->ws + W_SO); bf16_t* OG = (bf16_t*)(p->ws + W_OG);
    const float* k_a = p->in[22]; const float* a0p = p->in[16]; const float* r_k = p->in[23]; const float* gnw = p->in[24]; const float* gnb = p->in[25];
    const int c0 = lane * 16;
    for (int row = gw; row < MR; row += nw) {
        const size_t o = (size_t)row * D + c0;
        float ov[16], rv[16], kv[16], vv[16], av[16], gv[16];
#pragma unroll
        for (int q = 0; q < 4; ++q) { const f32x4 x = *(const f32x4*)(SO + o + 4 * q); ov[4 * q] = x[0]; ov[4 * q + 1] = x[1]; ov[4 * q + 2] = x[2]; ov[4 * q + 3] = x[3]; }
#define LD16(dst, ptr) do { const u32x4 a_ = *(const u32x4*)(ptr), b_ = *(const u32x4*)((ptr) + 8); \
        dst[0] = bf_lo(a_.x); dst[1] = bf_hi(a_.x); dst[2] = bf_lo(a_.y); dst[3] = bf_hi(a_.y); dst[4] = bf_lo(a_.z); dst[5] = bf_hi(a_.z); dst[6] = bf_lo(a_.w); dst[7] = bf_hi(a_.w); \
        dst[8] = bf_lo(b_.x); dst[9] = bf_hi(b_.x); dst[10] = bf_lo(b_.y); dst[11] = bf_hi(b_.y); dst[12] = bf_lo(b_.z); dst[13] = bf_hi(b_.z); dst[14] = bf_lo(b_.w); dst[15] = bf_hi(b_.w); } while (0)
        LD16(rv, RKV + o); LD16(kv, RKV + (size_t)MP * D + o); LD16(vv, RKV + (size_t)2 * MP * D + o); LD16(av, AA + o); LD16(gv, GG + o);
#undef LD16
        float sm = 0.f, rk = 0.f;
#pragma unroll
        for (int e = 0; e < 16; ++e) { sm += ov[e]; const float kp = kv[e] * (1.f + (sigmoidf_(a0p[c0 + e] + av[e]) - 1.f) * k_a[c0 + e]); rk += rv[e] * kp * r_k[c0 + e]; }
        sm += shx(sm, 1, lane); sm += shx(sm, 2, lane); rk += shx(rk, 1, lane); rk += shx(rk, 2, lane);
        const float mean = sm * (1.f / 64.f);
        float vs = 0.f;
#pragma unroll
        for (int e = 0; e < 16; ++e) { const float d = ov[e] - mean; vs += d * d; }
        vs += shx(vs, 1, lane); vs += shx(vs, 2, lane);
        const float rstd = __builtin_amdgcn_rsqf(vs * (1.f / 64.f) + GN_EPS);
        unsigned w[8];
#pragma unroll
        for (int e = 0; e < 16; e += 2) {
            const float y0 = ((ov[e] - mean) * rstd * gnw[c0 + e] + gnb[c0 + e] + rk * vv[e]) * gv[e];
            const float y1 = ((ov[e + 1] - mean) * rstd * gnw[c0 + e + 1] + gnb[c0 + e + 1] + rk * vv[e + 1]) * gv[e + 1];
            w[e >> 1] = cvt_pk(y0, y1);
        }
        *(u32x4*)(OG + o) = (u32x4){w[0], w[1], w[2], w[3]}; *(u32x4*)(OG + o + 8) = (u32x4){w[4], w[5], w[6], w[7]};
    }
}

__device__ __forceinline__ int crow(int r, int hi) { return (r & 3) + 8 * (r >> 2) + 4 * hi; }
__device__ __forceinline__ bf16x8 pack8(f32x4 a, f32x4 b) {
    u32x4 w; w.x = cvt_pk(a[0], a[1]); w.y = cvt_pk(a[2], a[3]); w.z = cvt_pk(b[0], b[1]); w.w = cvt_pk(b[2], b[3]);
    return __builtin_bit_cast(bf16x8, w);
}
__device__ __forceinline__ void attn_phase(KP p, int tid, int bid, int G) {
    const int lane = tid & 63, gw = bid * 8 + (tid >> 6), nw = G * 8;
    const bf16_t* QB = (const bf16_t*)(p->ws + W_QB); bf16_t* AO = (bf16_t*)(p->ws + W_OG);
    const int ql = lane & 31, hi = lane >> 5;
    constexpr int NU_P = BP * NH * 65;
    for (int u = gw; u < NU_P + BS * NH * 2; u += nw) {
        int bh, Q0, nq, npast, row_base, Tn; const float *kc, *vc, *kn, *vn;
        if (u < NU_P) { bh = u / 65; Q0 = (u - bh * 65) * 32; nq = min(32, TP - Q0); npast = 0; row_base = (bh >> 4) * TP; Tn = TP;
            kc = nullptr; vc = nullptr; kn = p->out + O_KP + (size_t)bh * TP * HD; vn = p->out + O_VP + (size_t)bh * TP * HD; }
        else { const int v = u - NU_P; bh = v >> 1; Q0 = (v & 1) * 32; nq = 32; npast = PAST; row_base = MPR + (bh >> 4) * TS; Tn = TS;
            kc = p->in[4] + (size_t)bh * PAST * HD; vc = p->in[5] + (size_t)bh * PAST * HD; kn = p->out + O_KS + (size_t)bh * TS * HD; vn = p->out + O_VS + (size_t)bh * TS * HD; }
        const int h = bh & 15, qpos0 = npast + Q0;
        bf16x8 qf[4];
        { const bf16_t* qp = QB + (size_t)(row_base + Q0 + min(ql, nq - 1)) * D + h * 64 + hi * 8;
#pragma unroll
          for (int s = 0; s < 4; ++s) qf[s] = *(const bf16x8*)(qp + 16 * s); }
        f32x16 o0, o1;
#pragma unroll
        for (int r = 0; r < 16; ++r) { o0[r] = 0.f; o1[r] = 0.f; }
        float carry = ql < nq ? 0.f : -1e30f;
        const int qpos = qpos0 + ql;
        for (int kt = qpos0 >> 5; kt >= 0; --kt) {
            const int P0 = kt * 32;
            const bool inpast = P0 < npast;
            const float* kb = inpast ? kc + (size_t)P0 * HD : kn + (size_t)(P0 - npast) * HD;
            const float* vb = inpast ? vc + (size_t)P0 * HD : vn + (size_t)(P0 - npast) * HD;
            const int lim = inpast ? 31 : min(31, Tn - 1 - (P0 - npast));
            f32x16 st;
#pragma unroll
            for (int r = 0; r < 16; ++r) st[r] = 0.f;
            { const float* kp = kb + (size_t)min(ql, lim) * HD + hi * 8;
#pragma unroll
              for (int s = 0; s < 4; ++s) { const f32x4 a = *(const f32x4*)(kp + 16 * s), b = *(const f32x4*)(kp + 16 * s + 4);
                  st = __builtin_amdgcn_mfma_f32_32x32x16_bf16(pack8(a, b), qf[s], st, 0, 0, 0); } }
            float L[16];
            float own[4];
#pragma unroll
            for (int g = 0; g < 4; ++g) { float sg = 0.f;
#pragma unroll
                for (int i = 0; i < 4; ++i) { const int r = 4 * g + i; const bool vis = (P0 + crow(r, hi)) < qpos; L[r] = vis ? -softplusf_(st[r]) : 0.f; sg += L[r]; }
                own[g] = sg; }
            float oth[4];
#pragma unroll
            for (int g = 0; g < 4; ++g) oth[g] = shx(own[g], 32, lane);
            float suf = carry;
            float A[16];
#pragma unroll
            for (int g = 3; g >= 0; --g) {
                float c = suf + (hi == 0 ? oth[g] : 0.f);
#pragma unroll
                for (int i = 3; i >= 0; --i) { const int r = 4 * g + i; c += L[r]; const bool vis = (P0 + crow(r, hi)) < qpos; A[r] = vis ? __expf(st[r] + c) : 0.f; }
                suf += own[g] + oth[g];
            }
            carry = suf;
            const bf16x8 pa0 = pack8((f32x4){A[0], A[1], A[2], A[3]}, (f32x4){A[4], A[5], A[6], A[7]});
            const bf16x8 pa1 = pack8((f32x4){A[8], A[9], A[10], A[11]}, (f32x4){A[12], A[13], A[14], A[15]});
#pragma unroll
            for (int jj = 0; jj < 2; ++jj) {
                float x0[8], x1[8];
#pragma unroll
                for (int i = 0; i < 8; ++i) { const float* vp = vb + (size_t)min(crow(8 * jj + i, hi), lim) * HD + ql; x0[i] = vp[0]; x1[i] = vp[32]; }
                const bf16x8 vf0 = pack8((f32x4){x0[0], x0[1], x0[2], x0[3]}, (f32x4){x0[4], x0[5], x0[6], x0[7]});
                const bf16x8 vf1 = pack8((f32x4){x1[0], x1[1], x1[2], x1[3]}, (f32x4){x1[4], x1[5], x1[6], x1[7]});
                o0 = __builtin_amdgcn_mfma_f32_32x32x16_bf16(jj == 0 ? pa0 : pa1, vf0, o0, 0, 0, 0);
                o1 = __builtin_amdgcn_mfma_f32_32x32x16_bf16(jj == 0 ? pa0 : pa1, vf1, o1, 0, 0, 0);
            }
            if (!__any(carry >= -104.f)) break;
        }
        bf16_t* op = AO + (size_t)(row_base + Q0) * D + h * 64 + ql;
#pragma unroll
        for (int r = 0; r < 16; ++r) { const int qr = crow(r, hi); if (qr < nq) { op[(size_t)qr * D] = (bf16_t)(cvt_pk(o0[r], 0.f) & 0xffffu); op[(size_t)qr * D + 32] = (bf16_t)(cvt_pk(o1[r], 0.f) & 0xffffu); } }
    }
}

constexpr int NPHASE = 23;
#ifndef PHM
#define PHM 0xffff
#endif
#define EN(k) (((PHM) >> (k)) & 1)
constexpr int LDS_BYTES = 147456;
template <class Epi, class Sched>
__device__ __forceinline__ void run_gemm(LAS unsigned char* lds, const bf16_t* A, const bf16_t* Bt, int M, int N, int K, const Sched& S, const Epi& E) {
    pg8::Gemm g{A, Bt, M, N, K};
    pg8::gemm_phase<Epi, Sched, true, true>(lds, g, S, E);
}
__global__ void __launch_bounds__(512, 2) mega(Params p_unused) {
    extern __shared__ __attribute__((aligned(16))) unsigned char lds_raw[];
    LAS unsigned char* lds = (LAS unsigned char*)lds_raw;
    cg::grid_group grid = cg::this_grid();
    KP p = (KP)__builtin_amdgcn_kernarg_segment_ptr();
    const int ph_lo = p->ph_lo, ph_hi = p->ph_hi;
    for (int ph = ph_lo; ph < ph_hi; ++ph) {
        asm volatile("" : "+s"(p));
        int tid = threadIdx.x, bid = blockIdx.x, G = gridDim.x;
        asm volatile("" : "+v"(tid), "+s"(bid), "+s"(G));
        int ffn = -1; bool ffn_in = false;
        if (ph == 1 || ph == 2) { ffn = 0; ffn_in = ph == 1; } else if (ph == 11 || ph == 12) { ffn = 1; ffn_in = ph == 11; }
        else if (ph == 14 || ph == 15) { ffn = 2; ffn_in = ph == 14; } else if (ph == 21 || ph == 22) { ffn = 3; ffn_in = ph == 21; }
        if (EN(0) && ph == 0) { convert_weights(p, (LAS float*)lds, tid, bid, G); assemble_x(p, tid, bid, G); }
        else if (EN(1) && ffn >= 0 && ffn_in) {
            pg8::StaticOrder S; S.init(MP, NIN, G, bid);
            unsigned char* ws = p->ws; EpiSwiGLU E{(bf16_t*)(ws + W_HB)};
            run_gemm(lds, (const bf16_t*)(ws + W_XN), (const bf16_t*)(ws + W_WIN + ffn * SZ_WIN1), MP, NIN, D, S, E);
        } else if (EN(2) && ffn >= 0) {
            pg8::StaticOrder S; S.init(MP, D, G, bid);
            unsigned char* ws = p->ws; EpiRes E{(float*)(ws + W_X), 0.5f, ffn == 3 ? p->out : nullptr};
            run_gemm(lds, (const bf16_t*)(ws + W_HB), (const bf16_t*)(ws + W_WOUT + ffn * SZ_WOUT1), MP, D, DFFP, S, E);
        }
        else if (EN(3) && ph == 3) mixprep_phase(p, tid, bid, G);
        else if (EN(4) && ph == 4) {
            G1Order S{G, bid};
            unsigned char* ws = p->ws; EpiG1 E{(bf16_t*)(ws + W_RKV), (float*)(ws + W_L1)};
            run_gemm(lds, (const bf16_t*)(ws + W_AALL), (const bf16_t*)(ws + W_WG1), 5 * MP, 3584, D, S, E);
        }
        else if (EN(5) && ph == 5) act_phase(p, bid * 512 + tid, G * 512);
        else if (EN(6) && ph == 6) {
            pg8::StaticOrder S; S.init(MP, 3072, G, bid);
            unsigned char* ws = p->ws; EpiG2 E{(float*)(ws + W_DEC), (bf16_t*)(ws + W_AA), (bf16_t*)(ws + W_GG)};
            run_gemm(lds, (const bf16_t*)(ws + W_A2), (const bf16_t*)(ws + W_WL2), MP, 3072, 256, S, E);
        }
        else if (EN(7) && ph == 7) scan_phase(p, (LAS float*)lds, tid, bid, G);
        else if (EN(8) && ph == 8) post_phase(p, tid, bid, G);
        else if (EN(9) && (ph == 9 || ph == 19)) {
            pg8::StaticOrder S; S.init(MP, D, G, bid);
            unsigned char* ws = p->ws; EpiRes E{(float*)(ws + W_X), 1.0f, nullptr};
            run_gemm(lds, (const bf16_t*)(ws + W_OG), (const bf16_t*)(ws + (ph == 9 ? W_WO1 : W_WO2)), MP, D, D, S, E);
        }
        else if (EN(10) && ph == 10) norm_phase(p, p->in[7] + D, tid, bid, G);
        else if (EN(10) && ph == 13) norm_phase(p, p->in[7] + 2 * D, tid, bid, G);
        else if (EN(10) && ph == 16) norm_phase(p, p->in[10] + D, tid, bid, G);
        else if (EN(11) && ph == 17) {
            pg8::StaticOrder S; S.init(MP, 3 * D, G, bid);
            unsigned char* ws = p->ws; EpiQKV E{(bf16_t*)(ws + W_QB), p->out, p->in[28], p->in[29]};
            run_gemm(lds, (const bf16_t*)(ws + W_XN), (const bf16_t*)(ws + W_WQKV), MP, 3 * D, D, S, E);
        }
        else if (EN(12) && ph == 18) attn_phase(p, tid, bid, G);
        else if (EN(10) && ph == 20) norm_phase(p, p->in[7] + 3 * D, tid, bid, G);
        if (ph + 1 < ph_hi) grid.sync();
    }
}

#ifndef ONE_LAUNCH
#define ONE_LAUNCH 1
#endif
extern "C" void kernel_launch(void* const* d_in, const int* in_sizes, int n_in, void* d_out, int out_size, void* d_ws, size_t ws_size, hipStream_t stream) {
    static int grid = 0;
    if (grid == 0) {
        if (n_in != 31 || (size_t)out_size != O_END || ws_size < W_END) { fprintf(stderr, "kernel_launch: unexpected sizes (n_in %d out %d ws %zu need %zu)\n", n_in, out_size, ws_size, (size_t)W_END); grid = -1; return; }
        int dev = 0, cus = 0, per_cu = 0;
        hipGetDevice(&dev); hipDeviceGetAttribute(&cus, hipDeviceAttributeMultiprocessorCount, dev);
        if (hipFuncSetAttribute((const void*)mega, hipFuncAttributeMaxDynamicSharedMemorySize, LDS_BYTES) != hipSuccess) { fprintf(stderr, "kernel_launch: hipFuncSetAttribute failed\n"); grid = -1; return; }
        hipOccupancyMaxActiveBlocksPerMultiprocessor(&per_cu, (const void*)mega, 512, LDS_BYTES);
        (void)hipGetLastError();
        if (per_cu < 1) per_cu = 1;
        grid = cus * per_cu;
    }
    if (grid < 0) return;
    Params p{};
    for (int i = 0; i < 31; ++i) p.in[i] = (const float*)d_in[i];
    p.out = (float*)d_out; p.ws = (unsigned char*)d_ws;
#if ONE_LAUNCH
    p.ph_lo = 0; p.ph_hi = NPHASE;
    void* args[] = {&p};
    hipError_t e = hipLaunchCooperativeKernel((const void*)mega, dim3(grid), dim3(512), args, LDS_BYTES, stream);
    if (e != hipSuccess) fprintf(stderr, "cooperative launch failed: %s (grid %d)\n", hipGetErrorString(e), grid);
#else
    for (int ph = 0; ph < NPHASE; ++ph) { p.ph_lo = ph; p.ph_hi = ph + 1; hipLaunchKernelGGL(mega, dim3(grid), dim3(512), LDS_BYTES, stream, p); }
#endif
}
```

```cpp
#include <hip/hip_runtime.h>
#include <hip/hip_cooperative_groups.h>
#include <cstdio>
#include <cstdint>
namespace cg = cooperative_groups;
__device__ __forceinline__ int lane_now() { int l; asm volatile("v_mbcnt_lo_u32_b32 %0, -1, 0\n\tv_mbcnt_hi_u32_b32 %0, -1, %0" : "=v"(l)); return l; }
namespace pg8 {
#define PG8_LAS __attribute__((address_space(3)))
typedef unsigned short bf16_t;
typedef short bf16x8 __attribute__((ext_vector_type(8)));
typedef float f32x4 __attribute__((ext_vector_type(4)));
typedef unsigned u32x4 __attribute__((ext_vector_type(4)));
constexpr int BM = 256, BK = 64, HALF = 128, HTB = HALF * BK * 2  , STAGE_BYTES = 8 * HTB, NXCD = 8, WGM = 8;

__host__ __device__ __forceinline__ int lds_byte(int r, int c) { const int st = (r >> 4) * 2 + (c >> 5), rr = r & 15, cc = c & 31, ob = rr * 64 + cc * 2; return st * 1024 + (ob ^ (((ob >> 9) & 1) << 5)); }
__host__ __device__ __forceinline__ void stage_rc(int b, int& R, int& C) { const int st = b / 1024, sb = b % 1024, swz = sb ^ (((sb >> 9) & 1) << 5); R = (st >> 1) * 16 + swz / 64; C = (st & 1) * 32 + (swz % 64) / 2; }
__host__ __device__ __forceinline__ int perm32(int rho) { const int n = rho >> 4, i = rho & 15; return 8 * (i >> 2) + 4 * n + (i & 3); }

struct Unit { int pm, pn, kb, nt, fl; };
struct Gemm { const bf16_t* A; const bf16_t* Bt; int M, N, K, wb; };

struct StaticOrder {
    int nM, nN, nwg, G, c, nt0;
    __host__ __device__ void init(int M, int N, int G_, int c_) { nM = M / BM; nN = N / BM; nwg = nM * nN; G = G_; c = c_; }
    __host__ __device__ bool next(int i, Unit& u) const {
        const long L = (long)i * G + c; if (L >= nwg) return false;
        int wgid = (int)L; { const int q = nwg / NXCD, r = nwg % NXCD, xcd = wgid % NXCD, off = wgid / NXCD; wgid = (xcd < r ? xcd * (q + 1) : r * (q + 1) + (xcd - r) * q) + off; }
        const int nig = WGM * nN, gid = wgid / nig, fm = gid * WGM, gsz = (nM - fm) < WGM ? (nM - fm) : WGM;
        u.pm = fm + ((wgid % nig) % gsz); u.pn = (wgid % nig) / gsz; u.kb = 0; u.nt = nt0; u.fl = 0; return true;
    }
    __device__ __forceinline__ void a_ready(const Unit&) const {}
    __device__ __forceinline__ void done(const Unit&) const {}
};
template <class Epi, class Sched, bool ALIGN_EPI = false, bool SP2 = false>
__device__ __forceinline__ void gemm_phase(PG8_LAS unsigned char* lds, const Gemm g, const Sched S, const Epi E) {
    int tid = g.wb + lane_now(); asm volatile("" : "+v"(tid)); const int wid = __builtin_amdgcn_readfirstlane(tid >> 6), lane = tid & 63, wr = wid >> 2, wc = wid & 3, fr = lane & 15, fq = lane >> 4;
    const int K = g.K, nt = K / BK;
    unsigned voffA[2], voffB[2];
#pragma unroll
    for (int i = 0; i < 2; ++i) { int R, C; stage_rc(tid * 16 + i * 8192, R, C); const int Rb = Epi::PERM ? ((R & ~31) + perm32(R & 31)) : R;
        voffA[i] = (unsigned)(R * K + C) * 2u; voffB[i] = (unsigned)(Rb * K + C) * 2u; }
    const size_t kstep = (size_t)(BK * 2);
    const size_t hstep = (size_t)HALF * K * 2;
    const size_t tstep = 2 * hstep;
    const unsigned ldsw = (unsigned)wid * 1024u;
    const int aoff = lds_byte(wr * 64 + fr, fq * 8), boff = lds_byte(wc * 32 + fr, fq * 8);
#define PG8_SA(b, h) (((b) * 2 + (h)) * HTB)
#define PG8_SB(b, h) ((4 + (b) * 2 + (h)) * HTB)
#define PG8_STAGE(bufoff, gbase, voff) do { _Pragma("unroll") for (int _i = 0; _i < 2; ++_i) \
        __builtin_amdgcn_global_load_lds((const unsigned*)((const char*)(gbase) + (voff)[_i]), (PG8_LAS unsigned*)(lds + (bufoff) + ldsw + _i * 8192), 16, 0, 0); } while (0)
#define PG8_LDA(dst, b, h) do { _Pragma("unroll") for (int m = 0; m < 4; ++m) _Pragma("unroll") for (int k = 0; k < 2; ++k) dst[m][k] = *(const PG8_LAS bf16x8*)(lds + PG8_SA(b, h) + aoff + m * 2048 + k * 1024); } while (0)
#define PG8_LDB(dst, b, h) do { _Pragma("unroll") for (int n = 0; n < 2; ++n) _Pragma("unroll") for (int k = 0; k < 2; ++k) dst[n][k] = *(const PG8_LAS bf16x8*)(lds + PG8_SB(b, h) + boff + n * 2048 + k * 1024); } while (0)
#define PG8_MMA(ai, bj, At, Bt) do { __builtin_amdgcn_s_setprio(1); _Pragma("unroll") for (int m = 0; m < 4; ++m) _Pragma("unroll") for (int n = 0; n < 2; ++n) _Pragma("unroll") for (int k = 0; k < 2; ++k) \
        acc[ai][bj][m][n] = __builtin_amdgcn_mfma_f32_16x16x32_bf16(Bt[n][k], At[m][k], acc[ai][bj][m][n], 0, 0, 0); __builtin_amdgcn_s_setprio(0); } while (0)
#define PG8_WAIT_V(n) asm volatile("s_waitcnt vmcnt(" #n ")" ::: "memory")
#define PG8_WAIT_L(n) asm volatile("s_waitcnt lgkmcnt(" #n ")" ::: "memory")
#define PG8_BAR __builtin_amdgcn_s_barrier()
#define PG8_SCHED __builtin_amdgcn_sched_barrier(0)
    Unit cur, nxt; int ui = 0;
    if (!S.next(0, cur)) return;
    f32x4 acc[2][2][4][2];
#pragma unroll
    for (int a = 0; a < 2; ++a)
#pragma unroll
        for (int b = 0; b < 2; ++b)
#pragma unroll
            for (int m = 0; m < 4; ++m)
#pragma unroll
                for (int n = 0; n < 2; ++n) acc[a][b][m][n] = (f32x4){0.f, 0.f, 0.f, 0.f};
    bf16x8 At[4][2], B0[2][2], B1[2][2];
    const char* cA = (const char*)g.A + (size_t)cur.pm * tstep + cur.kb; const char* cB = (const char*)g.Bt + (size_t)cur.pn * tstep + cur.kb;
    S.a_ready(cur);
    if constexpr (SP2) {
        PG8_STAGE(PG8_SB(0, 0), cB, voffB); PG8_STAGE(PG8_SB(0, 1), cB + hstep, voffB); PG8_STAGE(PG8_SA(0, 0), cA, voffA); PG8_STAGE(PG8_SA(0, 1), cA + hstep, voffA);
        if (wr == 1) PG8_BAR;
        PG8_WAIT_V(2); PG8_BAR;
        PG8_STAGE(PG8_SB(1, 0), cB + kstep, voffB); PG8_STAGE(PG8_SA(1, 0), cA + kstep, voffA); PG8_STAGE(PG8_SB(1, 1), cB + hstep + kstep, voffB);
        PG8_WAIT_V(6); PG8_BAR;
    } else {
        PG8_STAGE(PG8_SB(0, 0), cB, voffB); PG8_STAGE(PG8_SA(0, 0), cA, voffA); PG8_STAGE(PG8_SB(0, 1), cB + hstep, voffB); PG8_STAGE(PG8_SA(0, 1), cA + hstep, voffA);
        if (wr == 1) PG8_BAR;
        PG8_WAIT_V(4); PG8_BAR;
        PG8_STAGE(PG8_SB(1, 0), cB + kstep, voffB); PG8_STAGE(PG8_SA(1, 0), cA + kstep, voffA); PG8_STAGE(PG8_SB(1, 1), cB + hstep + kstep, voffB);
        PG8_WAIT_V(6); PG8_BAR;
    }
    for (;;) {
        const bool has_next = S.next(ui + 1, nxt);
        const char* nA = has_next ? (const char*)g.A + (size_t)nxt.pm * tstep + nxt.kb : cA; const char* nB = has_next ? (const char*)g.Bt + (size_t)nxt.pn * tstep + nxt.kb : cB;
        const int ntu = cur.nt;
        for (int t = 0; t < ntu; t += 2) {
            const bool last = (t == ntu - 2);
            const char* a1 = cA + (size_t)(t + 1) * kstep;
            const char* a2 = last ? nA : cA + (size_t)(t + 2) * kstep; const char* b2 = last ? nB : cB + (size_t)(t + 2) * kstep;
            const char* a3 = a2 + kstep; const char* b3 = b2 + kstep;
            if (last && has_next) S.a_ready(nxt);
            if constexpr (SP2) {
            PG8_LDB(B0, 0, 0); PG8_LDB(B1, 0, 1); PG8_SCHED; PG8_LDA(At, 0, 0); PG8_STAGE(PG8_SA(1, 1), a1 + hstep, voffA);
            PG8_WAIT_V(8); PG8_WAIT_L(0); PG8_BAR; PG8_MMA(0, 0, At, B0); PG8_MMA(0, 1, At, B1); PG8_BAR; PG8_SCHED;
            PG8_LDA(At, 0, 1); PG8_STAGE(PG8_SB(0, 0), b2, voffB); PG8_STAGE(PG8_SB(0, 1), b2 + hstep, voffB); PG8_STAGE(PG8_SA(0, 0), a2, voffA);
            PG8_WAIT_V(8); PG8_WAIT_L(0); PG8_BAR; PG8_MMA(1, 0, At, B0); PG8_MMA(1, 1, At, B1); PG8_BAR; PG8_SCHED;
            PG8_LDB(B0, 1, 0); PG8_LDB(B1, 1, 1); PG8_SCHED; PG8_LDA(At, 1, 0); PG8_STAGE(PG8_SA(0, 1), a2 + hstep, voffA);
            PG8_WAIT_V(8); PG8_WAIT_L(0); PG8_BAR; PG8_MMA(0, 0, At, B0); PG8_MMA(0, 1, At, B1); PG8_BAR; PG8_SCHED;
            PG8_LDA(At, 1, 1); PG8_STAGE(PG8_SB(1, 0), b3, voffB); PG8_STAGE(PG8_SB(1, 1), b3 + hstep, voffB); PG8_STAGE(PG8_SA(1, 0), a3, voffA);
            PG8_WAIT_V(8); PG8_WAIT_L(0); PG8_BAR; PG8_MMA(1, 0, At, B0); PG8_MMA(1, 1, At, B1); PG8_BAR; PG8_SCHED;
            } else {
            PG8_LDB(B0, 0, 0); PG8_SCHED; PG8_LDA(At, 0, 0); PG8_STAGE(PG8_SA(1, 1), a1 + hstep, voffA);
            PG8_WAIT_L(8); PG8_BAR; PG8_WAIT_L(0); PG8_MMA(0, 0, At, B0); PG8_BAR; PG8_SCHED;
            PG8_LDB(B1, 0, 1); PG8_STAGE(PG8_SB(0, 0), b2, voffB);
            PG8_BAR; PG8_WAIT_L(0); PG8_MMA(0, 1, At, B1); PG8_BAR;
            PG8_LDA(At, 0, 1); PG8_STAGE(PG8_SA(0, 0), a2, voffA);
            PG8_BAR; PG8_WAIT_L(0); PG8_MMA(1, 0, At, B0); PG8_BAR; PG8_SCHED;
            PG8_STAGE(PG8_SB(0, 1), b2 + hstep, voffB);
            PG8_WAIT_V(6); PG8_BAR; PG8_MMA(1, 1, At, B1); PG8_BAR;
            PG8_LDB(B0, 1, 0); PG8_SCHED; PG8_LDA(At, 1, 0); PG8_STAGE(PG8_SA(0, 1), a2 + hstep, voffA);
            PG8_WAIT_L(8); PG8_BAR; PG8_WAIT_L(0); PG8_MMA(0, 0, At, B0); PG8_BAR; PG8_SCHED;
            PG8_LDB(B1, 1, 1); PG8_STAGE(PG8_SB(1, 0), b3, voffB);
            PG8_BAR; PG8_WAIT_L(0); PG8_MMA(0, 1, At, B1); PG8_BAR;
            PG8_LDA(At, 1, 1); PG8_STAGE(PG8_SA(1, 0), a3, voffA);
            PG8_BAR; PG8_WAIT_L(0); PG8_MMA(1, 0, At, B0); PG8_BAR; PG8_SCHED;
            PG8_STAGE(PG8_SB(1, 1), b3 + hstep, voffB);
            PG8_WAIT_V(6); PG8_BAR; PG8_MMA(1, 1, At, B1); PG8_BAR;
            }
        }
        if constexpr (ALIGN_EPI) { if (wr == 0) PG8_BAR; }
        if constexpr (!Epi::AFTER_DRAIN) { int t_ = g.wb + lane_now(); asm volatile("" : "+v"(t_)); const int fr_ = t_ & 15, fq_ = (t_ >> 4) & 3; E(acc, cur, wr, wc, fr_, fq_); S.done(cur); }
        if (!has_next) break;
#pragma unroll
        for (int a = 0; a < 2; ++a)
#pragma unroll
            for (int b = 0; b < 2; ++b)
#pragma unroll
                for (int m = 0; m < 4; ++m)
#pragma unroll
                    for (int n = 0; n < 2; ++n) acc[a][b][m][n] = (f32x4){0.f, 0.f, 0.f, 0.f};
        cur = nxt; cA = nA; cB = nB; ++ui;
        if constexpr (ALIGN_EPI) { if (wr == 1) PG8_BAR; }
    }
    PG8_WAIT_V(0);
    if constexpr (!ALIGN_EPI) { if (wr == 0) PG8_BAR; }
    PG8_BAR;
    if constexpr (Epi::AFTER_DRAIN) { E.fused(acc, cur, wr, wc, fr, fq, lds, wid, lane); S.done(cur); }
#undef PG8_SA
#undef PG8_SB
#undef PG8_STAGE
#undef PG8_LDA
#undef PG8_LDB
#undef PG8_MMA
#undef PG8_WAIT_V
#undef PG8_WAIT_L
#undef PG8_BAR
#undef PG8_SCHED
}
}

#define LAS __attribute__((address_space(3)))
typedef unsigned short bf16_t;
typedef short bf16x8 __attribute__((ext_vector_type(8)));
typedef float f32x4 __attribute__((ext_vector_type(4)));
typedef float f32x2 __attribute__((ext_vector_type(2)));
typedef float f32x16 __attribute__((ext_vector_type(16)));
typedef unsigned u32x4 __attribute__((ext_vector_type(4)));
typedef unsigned u32x2 __attribute__((ext_vector_type(2)));

constexpr int D = 1024, NH = 16, HD = 64;
constexpr int BP = 8, TP = 2064, SEQP = 2048, NMETA = 16, BS = 16, TS = 64, PAST = 4096;
constexpr int MPR = BP * TP;
constexpr int MR = MPR + BS * TS;
constexpr int MP = 17664;
constexpr int NTM = 69;
constexpr int DFF = 2752, DFFP = 2816, NIN = 5632;
constexpr float RMS_EPS = 1e-6f, GN_EPS = 64e-5f;
constexpr float LOG2E = 1.4426950408889634f;

constexpr size_t O_YP = 0, O_YS = 16777216, O_SP = 17825792, O_SHP = 18350080, O_KP = 18358272, O_VP = 35266560,
                 O_SS = 52174848, O_SHS = 53223424, O_KS = 53239808, O_VS = 54288384, O_END = 55336960;

constexpr size_t SZ_ROWBF = (size_t)MP * D * 2, SZ_ROWF = (size_t)MP * D * 4;
constexpr size_t W_X = 0;
constexpr size_t W_XN = W_X + SZ_ROWF;
constexpr size_t W_HB = W_XN + SZ_ROWBF;
constexpr size_t W_WIN = W_HB + (size_t)MP * DFFP * 2;
constexpr size_t SZ_WIN1 = (size_t)NIN * D * 2, SZ_WOUT1 = (size_t)D * DFFP * 2;
constexpr size_t W_WOUT = W_WIN + 4 * SZ_WIN1;
constexpr size_t W_WG1 = W_WOUT + 4 * SZ_WOUT1;
constexpr size_t W_WL2 = W_WG1 + (size_t)3584 * D * 2;
constexpr size_t W_WO1 = W_WL2 + (size_t)3072 * 256 * 2;
constexpr size_t W_WQKV = W_WO1 + (size_t)D * D * 2;
constexpr size_t W_WO2 = W_WQKV + (size_t)3 * D * D * 2;
constexpr size_t W_AALL = W_WO2 + (size_t)D * D * 2;
constexpr size_t W_RKV = W_AALL + 5 * SZ_ROWBF;
constexpr size_t W_L1 = W_RKV + 3 * SZ_ROWBF;
constexpr size_t W_A2 = W_L1 + (size_t)2 * MP * 256 * 4;
constexpr size_t W_DEC = W_A2 + (size_t)MP * 256 * 2;
constexpr size_t W_AA = W_DEC + SZ_ROWBF;
constexpr size_t W_GG = W_AA + SZ_ROWBF;
constexpr size_t W_SO = W_GG + SZ_ROWBF;
constexpr size_t W_OG = W_SO + SZ_ROWF;
constexpr size_t W_QB = W_OG + SZ_ROWBF;
constexpr size_t W_END = W_QB + SZ_ROWBF;

struct Params { const float* in[31]; float* out; unsigned char* ws; int ph_lo, ph_hi; int seq[64]; };
typedef const Params __attribute__((address_space(4)))* KP;

__device__ __forceinline__ unsigned cvt_pk(float lo, float hi) { unsigned r; asm("v_cvt_pk_bf16_f32 %0, %1, %2" : "=v"(r) : "v"(lo), "v"(hi)); return r; }
__device__ __forceinline__ void store_bf4(bf16_t* p, f32x4 v) { u32x2 w; w.x = cvt_pk(v[0], v[1]); w.y = cvt_pk(v[2], v[3]); *(u32x2*)p = w; }
__device__ __forceinline__ float bf_lo(unsigned w) { return __uint_as_float(w << 16); }
__device__ __forceinline__ float bf_hi(unsigned w) { return __uint_as_float(w & 0xffff0000u); }
__device__ __forceinline__ float sigmoidf_(float x) { return __builtin_amdgcn_rcpf(1.f + __expf(-x)); }
__device__ __forceinline__ float softplusf_(float x) { return fmaxf(x, 0.f) + __logf(1.f + __expf(-fabsf(x))); }
__device__ __forceinline__ float shx(float v, int o, int lane) { return __builtin_bit_cast(float, __builtin_amdgcn_ds_bpermute((lane ^ o) << 2, __builtin_bit_cast(int, v))); }
__device__ __forceinline__ float wave_sum(float v, int lane) {
#pragma unroll
    for (int o = 1; o < 64; o <<= 1) v += shx(v, o, lane);
    return v;
}
__device__ __forceinline__ void row_bt(int row, int& grp, int& b, int& t) { if (row < MPR) { grp = 0; b = row / TP; t = row - b * TP; } else { grp = 1; const int r = row - MPR; b = r >> 6; t = r & 63; } }

using pg8::Unit;
extern __shared__ __attribute__((aligned(16))) unsigned char lds_raw[];
struct EpiSwiGLU {
    static constexpr bool PERM = true, AFTER_DRAIN = false;
    bf16_t* HB;
    __device__ __forceinline__ void operator()(const f32x4 (&acc)[2][2][4][2], const Unit& u, int wr, int wc, int fr, int fq) const {
        const int row0 = u.pm * 256 + wr * 64 + fr, col0 = u.pn * 128 + wc * 32 + 8 * fq;
#pragma unroll
        for (int ai = 0; ai < 2; ++ai)
#pragma unroll
            for (int m = 0; m < 4; ++m) {
                bf16_t* rowp = HB + (size_t)(row0 + ai * 128 + m * 16) * DFFP + col0;
                float hv[8];
#pragma unroll
                for (int n = 0; n < 2; ++n)
#pragma unroll
                    for (int j = 0; j < 4; ++j) { const float g = acc[ai][0][m][n][j], up = acc[ai][1][m][n][j]; hv[n * 4 + j] = g * sigmoidf_(g) * up; }
                u32x4 w; w.x = cvt_pk(hv[0], hv[1]); w.y = cvt_pk(hv[2], hv[3]); w.z = cvt_pk(hv[4], hv[5]); w.w = cvt_pk(hv[6], hv[7]);
                *(u32x4*)rowp = w;
            }
    }
};
struct EpiRes {
    static constexpr bool PERM = false, AFTER_DRAIN = false;
    float* X; float scale; float* out;
    __device__ __forceinline__ void operator()(const f32x4 (&acc)[2][2][4][2], const Unit& u, int wr, int wc, int fr, int fq) const {
        float* const X_ = X; float* const out_ = out; const float sc_ = scale;
        const int row0 = u.pm * 256 + wr * 64 + fr, col0 = u.pn * 256 + wc * 32 + 4 * fq;
#pragma unroll
        for (int ai = 0; ai < 2; ++ai)
#pragma unroll
            for (int m = 0; m < 4; ++m) {
                const int row = row0 + ai * 128 + m * 16;
                float* xp = X_ + (size_t)row * D + col0;
                if (out_ != nullptr) {
                    xp = nullptr;
                    if (row < MPR) { const int b = row / TP, t = row - b * TP; if (t >= NMETA) xp = out_ + O_YP + ((size_t)b * SEQP + (t - NMETA)) * D + col0; }
                    else if (row < MR) xp = out_ + O_YS + (size_t)(row - MPR) * D + col0;
                }
                if (u.fl & 1) {
                    const int ln = fq * 16 + fr, rr = ln >> 5, cc = ln & 31;
                    LAS float* sl = (LAS float*)((LAS unsigned char*)lds_raw + 131072) + (wr * 4 + wc) * 576;
#pragma unroll
                    for (int bj = 0; bj < 2; ++bj) {
#pragma unroll
                        for (int n = 0; n < 2; ++n) *(LAS f32x4*)(sl + fr * 36 + n * 16 + fq * 4) = acc[ai][bj][m][n] * sc_;
#pragma unroll 1
                        for (int k = 0; k < 8; ++k) {
                            const int rw = row - fr + 2 * k + rr;
                            float* tp = X_ + (size_t)rw * D;
                            if (out_ != nullptr) {
                                tp = nullptr;
                                if (rw < MPR) { const int b = rw / TP, t = rw - b * TP; if (t >= NMETA) tp = out_ + O_YP + ((size_t)b * SEQP + (t - NMETA)) * D; }
                                else if (rw < MR) tp = out_ + O_YS + (size_t)(rw - MPR) * D;
                            }
                            const float v = sl[(2 * k + rr) * 36 + cc];
                            if (tp) __hip_atomic_fetch_add(tp + u.pn * 256 + wc * 32 + bj * 128 + cc, v, __ATOMIC_RELAXED, __HIP_MEMORY_SCOPE_AGENT);
                        }
                    }
                } else if (xp) {
                    {
#pragma unroll
                        for (int bj = 0; bj < 2; ++bj)
#pragma unroll
                            for (int n = 0; n < 2; ++n) { f32x4* q = (f32x4*)(xp + bj * 128 + n * 16); *q = *q + acc[ai][bj][m][n] * sc_; }
                    }
                }
                asm volatile("" ::: "memory");
            }
    }
};
struct TailOrder {
    pg8::StaticOrder so; int nfull, nsplit, ntsplit;
    __device__ void init(int M, int N, int K, int G, int c, bool split) {
        so.init(M, N, G, c); so.nt0 = K / 64;
        nfull = so.nwg; nsplit = 1; ntsplit = so.nt0;
        const int rest = so.nwg % G;
        if (split && rest > 0 && so.nwg > G) {
            const int cap = G / rest; int best = 1;
            for (int s = 2; s <= cap && s * 2 <= so.nt0; ++s) if (so.nt0 % s == 0 && ((so.nt0 / s) & 1) == 0) best = s;
            if (best > 1) { nfull = so.nwg - rest; nsplit = best; ntsplit = so.nt0 / best; }
        }
    }
    __device__ bool next(int i, Unit& u) const {
        const long L = (long)i * so.G + so.c;
        if (L < nfull) { pg8::StaticOrder t = so; t.G = 1; t.c = 0; return t.next((int)L, u); }
        const long L2 = L - nfull; if (L2 >= (long)(so.nwg - nfull) * nsplit) return false;
        const int tile = nfull + (int)(L2 / nsplit), ch = (int)(L2 % nsplit);
        pg8::StaticOrder t = so; t.G = 1; t.c = 0; t.next(tile, u);
        u.kb = ch * ntsplit * 128; u.nt = ntsplit; u.fl = 1; return true;
    }
    __device__ __forceinline__ void a_ready(const Unit&) const {}
    __device__ __forceinline__ void done(const Unit&) const {}
};
struct EpiG1 {
    static constexpr bool PERM = true, AFTER_DRAIN = false;
    bf16_t* RKV; float* L1;
    __device__ __forceinline__ void operator()(const f32x4 (&acc)[2][2][4][2], const Unit& u, int wr, int wc, int fr, int fq) const {
        const unsigned row0 = (unsigned)((u.pm % NTM) * 256 + wr * 64 + fr), cw = wc * 32 + 8 * fq;
        if (u.pn < 12) {
            bf16_t* base = RKV + (size_t)(u.pn >> 2) * MP * D;
            const unsigned off0 = row0 * D + (u.pn & 3) * 256 + cw;
#pragma unroll
            for (int ai = 0; ai < 2; ++ai)
#pragma unroll
                for (int m = 0; m < 4; ++m)
#pragma unroll
                    for (int bj = 0; bj < 2; ++bj) { const f32x4 v0 = acc[ai][bj][m][0], v1 = acc[ai][bj][m][1];
                        u32x4 w; w.x = cvt_pk(v0[0], v0[1]); w.y = cvt_pk(v0[2], v0[3]); w.z = cvt_pk(v1[0], v1[1]); w.w = cvt_pk(v1[2], v1[3]);
                        *(u32x4*)(base + (off0 + (unsigned)((ai * 128 + m * 16) * D + bj * 128))) = w; }
        } else {
            float* base = L1 + (size_t)(u.pn - 12) * MP * 256;
            const unsigned off0 = row0 * 256 + cw;
#pragma unroll
            for (int ai = 0; ai < 2; ++ai)
#pragma unroll
                for (int m = 0; m < 4; ++m)
#pragma unroll
                    for (int bj = 0; bj < 2; ++bj)
#pragma unroll
                        for (int n = 0; n < 2; ++n) *(f32x4*)(base + (off0 + (unsigned)((ai * 128 + m * 16) * 256 + bj * 128 + n * 4))) = acc[ai][bj][m][n];
        }
    }
};
struct EpiG2 {
    static constexpr bool PERM = true, AFTER_DRAIN = false;
    bf16_t* LW;
    __device__ __forceinline__ void operator()(const f32x4 (&acc)[2][2][4][2], const Unit& u, int wr, int wc, int fr, int fq) const {
        bf16_t* base = LW + (size_t)(u.pn >> 2) * MP * D;
        const unsigned off0 = (unsigned)(u.pm * 256 + wr * 64 + fr) * D + (u.pn & 3) * 256 + wc * 32 + 8 * fq;
#pragma unroll
        for (int ai = 0; ai < 2; ++ai)
#pragma unroll
            for (int m = 0; m < 4; ++m)
#pragma unroll
                for (int bj = 0; bj < 2; ++bj) { const f32x4 v0 = acc[ai][bj][m][0], v1 = acc[ai][bj][m][1];
                    u32x4 w; w.x = cvt_pk(v0[0], v0[1]); w.y = cvt_pk(v0[2], v0[3]); w.z = cvt_pk(v1[0], v1[1]); w.w = cvt_pk(v1[2], v1[3]);
                    *(u32x4*)(base + (off0 + (unsigned)((ai * 128 + m * 16) * D + bj * 128))) = w; }
    }
};
struct EpiQKV {
    static constexpr bool PERM = false, AFTER_DRAIN = false;
    bf16_t* QB; float* out; const float* qg; const float* kg;
    __device__ __forceinline__ void operator()(const f32x4 (&acc)[2][2][4][2], const Unit& u, int wr, int wc, int fr, int fq) const {
        const int sec = u.pn >> 2, head = (u.pn & 3) * 4 + wc, row0 = u.pm * 256 + wr * 64 + fr;
        f32x4 gn[2][2];
#pragma unroll
        for (int bj = 0; bj < 2; ++bj)
#pragma unroll
            for (int n = 0; n < 2; ++n) { const int d = 32 * bj + 16 * n + 4 * fq;
                gn[bj][n] = sec == 0 ? *(const f32x4*)(qg + d) * 0.125f : (sec == 1 ? *(const f32x4*)(kg + d) : (f32x4){1.f, 1.f, 1.f, 1.f}); }
#pragma unroll
        for (int ai = 0; ai < 2; ++ai)
#pragma unroll
            for (int m = 0; m < 4; ++m) {
                const int row = row0 + ai * 128 + m * 16;
                float ss = 0.f;
#pragma unroll
                for (int bj = 0; bj < 2; ++bj)
#pragma unroll
                    for (int n = 0; n < 2; ++n) { const f32x4 x = acc[ai][bj][m][n]; ss += (x[0] * x[0] + x[1] * x[1]) + (x[2] * x[2] + x[3] * x[3]); }
                { const int ln = fq * 16 + fr; ss += shx(ss, 16, ln); ss += shx(ss, 32, ln); }
                const float rs = sec == 2 ? 1.f : __builtin_amdgcn_rsqf(ss * (1.f / 64.f) + RMS_EPS);
                if (row < MR) {
                    if (sec == 0) {
                        bf16_t* qp = QB + (size_t)row * D + head * 64 + 4 * fq;
#pragma unroll
                        for (int bj = 0; bj < 2; ++bj)
#pragma unroll
                            for (int n = 0; n < 2; ++n) { const f32x4 x = acc[ai][bj][m][n] * rs * gn[bj][n]; u32x2 w; w.x = cvt_pk(x[0], x[1]); w.y = cvt_pk(x[2], x[3]); *(u32x2*)(qp + 32 * bj + 16 * n) = w; }
                    } else {
                        int grp, b, t; row_bt(row, grp, b, t);
                        float* dp = grp == 0 ? out + (sec == 1 ? O_KP : O_VP) + (((size_t)b * NH + head) * TP + t) * HD
                                             : out + (sec == 1 ? O_KS : O_VS) + (((size_t)b * NH + head) * TS + t) * HD;
                        dp += 4 * fq;
#pragma unroll
                        for (int bj = 0; bj < 2; ++bj)
#pragma unroll
                            for (int n = 0; n < 2; ++n) *(f32x4*)(dp + 32 * bj + 16 * n) = acc[ai][bj][m][n] * rs * gn[bj][n];
                    }
                }
            }
    }
};
struct G1Order {
    int G, c;
    __device__ bool next(int i, Unit& u) const {
        const long L = (long)i * G + c; if (L >= 966) return false;
        int w = (int)L; { const int q = 966 / 8, r = 966 % 8, xcd = w % 8, off = w / 8; w = (xcd < r ? xcd * (q + 1) : r * (q + 1) + (xcd - r) * q) + off; }
        const int pm = w / 14, q = w % 14;
        if (q < 12) { u.pm = (q >> 2) * NTM + pm; u.pn = q; } else { u.pm = (q - 9) * NTM + pm; u.pn = q; }
        u.kb = 0; u.nt = 16; u.fl = 0;
        return true;
    }
    __device__ __forceinline__ void a_ready(const Unit&) const {}
    __device__ __forceinline__ void done(const Unit&) const {}
};

struct Job { const float* src; bf16_t* dst; const float* mu; int ld, Ksrc, koff, Kdst, rows, map, smode; };
__device__ __forceinline__ int srccol(int map, int n, int ld) {
    if (map == 0) return n < ld ? n : -1;
    if (map == 1) { const int pn = n >> 8, c = n & 255, bj = c >> 7, j = c & 127, hc = pn * 128 + j; return hc < DFF ? (bj ? DFF + hc : hc) : -1; }
    { const int t = n >> 8, c = n & 255, bj = c >> 7, wc = (c & 127) >> 5, i = c & 31; return t * 256 + 64 * wc + 32 * bj + i; }
}
__device__ __forceinline__ Job get_job(KP p, int j) {
    Job J; J.mu = nullptr; J.koff = 0; J.map = 0; J.smode = 0;
    unsigned char* ws = p->ws;
    if (j < 4) { J.src = p->in[8] + (size_t)j * D * 2 * DFF; J.dst = (bf16_t*)(ws + W_WIN + j * SZ_WIN1); J.ld = 2 * DFF; J.Ksrc = D; J.Kdst = D; J.rows = NIN; J.map = 1; }
    else if (j < 8) { const int i = j - 4; J.src = p->in[9] + (size_t)i * DFF * D; J.dst = (bf16_t*)(ws + W_WOUT + i * SZ_WOUT1); J.ld = D; J.Ksrc = DFF; J.Kdst = DFFP; J.rows = D; }
    else if (j < 11) { const int g = j - 8; J.src = p->in[12] + (size_t)g * D * D; J.dst = (bf16_t*)(ws + W_WG1) + (size_t)g * D * D; J.ld = D; J.Ksrc = D; J.Kdst = D; J.rows = D; }
    else if (j < 17) { const int idx = j - 11, part = idx / 3, which = idx % 3;
        J.src = which == 0 ? p->in[14] : (which == 1 ? p->in[17] : p->in[19]); J.ld = which == 2 ? 128 : 64; J.rows = J.ld;
        J.mu = p->in[11] + (which == 0 ? 1 : (which == 1 ? 4 : 5)) * D; J.smode = part + 1;
        J.dst = (bf16_t*)(ws + W_WG1) + (size_t)(3072 + part * 256 + which * 64) * D; J.Ksrc = D; J.Kdst = D; }
    else if (j < 20) { const int which = j - 17; J.src = which == 0 ? p->in[15] : (which == 1 ? p->in[18] : p->in[20]); J.ld = D; J.rows = D;
        J.Ksrc = which == 2 ? 128 : 64; J.koff = which * 64; J.Kdst = 256; J.dst = (bf16_t*)(ws + W_WL2) + (size_t)which * D * 256; }
    else if (j == 20) { J.src = p->in[26]; J.dst = (bf16_t*)(ws + W_WO1); J.ld = D; J.Ksrc = D; J.Kdst = D; J.rows = D; }
    else if (j == 21) { J.src = p->in[27]; J.dst = (bf16_t*)(ws + W_WQKV); J.ld = 3 * D; J.Ksrc = D; J.Kdst = D; J.rows = 3 * D; J.map = 2; }
    else { J.src = p->in[30]; J.dst = (bf16_t*)(ws + W_WO2); J.ld = D; J.Ksrc = D; J.Kdst = D; J.rows = D; }
    return J;
}
__device__ __forceinline__ void convert_weights(KP p, LAS float* tl, int tid, int bid, int G) {
    int rot = 0;
    for (int j = 0; j < 23; ++j) {
        const Job J = get_job(p, j);
        const int nkt = J.Kdst >> 6, nnt = (J.rows + 255) >> 8, ntile = nnt * nkt;
        int first = bid - rot; if (first < 0) first += G;
        for (int t = first; t < ntile; t += G) {
            const int n0 = (t / nkt) << 8, k0 = (t % nkt) << 6;
            const bool inside = k0 >= J.koff && k0 < J.koff + J.Ksrc;
            if (inside) {
                const int nn = tid & 255, kh = tid >> 8;
                const int sc = (n0 + nn) < J.rows ? srccol(J.map, n0 + nn, J.ld) : -1;
                const float* sp = J.src + (size_t)(k0 - J.koff + kh) * J.ld + (sc >= 0 ? sc : 0);
                float v[32];
#pragma unroll
                for (int it = 0; it < 32; ++it) v[it] = sc >= 0 ? sp[(size_t)(2 * it) * J.ld] : 0.f;
                if (J.smode) {
#pragma unroll
                    for (int it = 0; it < 32; ++it) { const float m = J.mu[k0 - J.koff + kh + 2 * it]; v[it] *= J.smode == 1 ? 1.f - m : m; }
                }
#pragma unroll
                for (int it = 0; it < 32; ++it) tl[(kh + 2 * it) * 257 + nn] = v[it];
            }
            __syncthreads();
            {
                const int nn = tid >> 1, kh = (tid & 1) * 32;
                if (n0 + nn < J.rows) {
                    bf16_t* dp = J.dst + (size_t)(n0 + nn) * J.Kdst + k0 + kh;
#pragma unroll
                    for (int q = 0; q < 4; ++q) {
                        const unsigned z_ = (unsigned)tid >> 31;
                        u32x4 w = (u32x4){z_, z_, z_, z_};
                        if (inside) { float v[8];
#pragma unroll
                            for (int e = 0; e < 8; ++e) v[e] = tl[(kh + q * 8 + e) * 257 + nn];
                            w.x = cvt_pk(v[0], v[1]); w.y = cvt_pk(v[2], v[3]); w.z = cvt_pk(v[4], v[5]); w.w = cvt_pk(v[6], v[7]); }
                        *(u32x4*)(dp + q * 8) = w;
                    }
                }
            }
            __syncthreads();
        }
        rot = (rot + ntile) % G;
    }
}
__device__ __forceinline__ float row_rstd(const f32x4 (&v)[4], int lane) {
    float s = 0.f;
#pragma unroll
    for (int i = 0; i < 4; ++i) s += (v[i][0] * v[i][0] + v[i][1] * v[i][1]) + (v[i][2] * v[i][2] + v[i][3] * v[i][3]);
    s = wave_sum(s, lane);
    return __builtin_amdgcn_rsqf(s * (1.f / D) + RMS_EPS);
}

__device__ __forceinline__ void assemble_x(KP p, int tid, int bid, int G) {
    const int lane = tid & 63, gw = bid * 8 + (tid >> 6), nw = G * 8;
    float* X = (float*)(p->ws + W_X); bf16_t* XN = (bf16_t*)(p->ws + W_XN); const float* g = p->in[7];
    for (int row = gw; row < MP; row += nw) {
        f32x4 v[4];
        const float* src = nullptr;
        if (row < MPR) { const int b = row / TP, t = row - b * TP; src = t < NMETA ? p->in[6] + (size_t)t * D : p->in[0] + ((size_t)b * SEQP + (t - NMETA)) * D; }
        else if (row < MR) src = p->in[1] + (size_t)(row - MPR) * D;
#pragma unroll
        for (int i = 0; i < 4; ++i) { const float zf = __uint_as_float((unsigned)tid >> 31); v[i] = src ? *(const f32x4*)(src + lane * 4 + 256 * i) : (f32x4){zf, zf, zf, zf}; }
        const float rs = row_rstd(v, lane);
#pragma unroll
        for (int i = 0; i < 4; ++i) { const int c = lane * 4 + 256 * i; *(f32x4*)(X + (size_t)row * D + c) = v[i]; store_bf4(XN + (size_t)row * D + c, v[i] * rs * *(const f32x4*)(g + c)); }
    }
}
__device__ __forceinline__ void norm_phase(KP p, const float* g, int tid, int bid, int G, bool copy_y = false) {
    const int lane = tid & 63, gw = bid * 8 + (tid >> 6), nw = G * 8;
    const float* X = (const float*)(p->ws + W_X); bf16_t* XN = (bf16_t*)(p->ws + W_XN);
    for (int row = gw; row < MP; row += nw) {
        f32x4 v[4];
#pragma unroll
        for (int i = 0; i < 4; ++i) v[i] = *(const f32x4*)(X + (size_t)row * D + lane * 4 + 256 * i);
        const float rs = row_rstd(v, lane);
#pragma unroll
        for (int i = 0; i < 4; ++i) { const int c = lane * 4 + 256 * i; store_bf4(XN + (size_t)row * D + c, v[i] * rs * *(const f32x4*)(g + c)); }
        if (copy_y && row < MR) {
            float* dp = nullptr;
            if (row < MPR) { const int b = row / TP, t = row - b * TP; if (t >= NMETA) dp = p->out + O_YP + ((size_t)b * SEQP + (t - NMETA)) * D; }
            else dp = p->out + O_YS + (size_t)(row - MPR) * D;
            if (dp) {
#pragma unroll
                for (int i = 0; i < 4; ++i) *(f32x4*)(dp + lane * 4 + 256 * i) = v[i];
            }
        }
    }
}
__device__ __forceinline__ void mixprep_phase(KP p, int tid, int bid, int G) {
    const int lane = tid & 63, gw = bid * 8 + (tid >> 6), nw = G * 8;
    const float* X = (const float*)(p->ws + W_X); bf16_t* A = (bf16_t*)(p->ws + W_AALL);
    const float* g = p->in[10]; const float* mu = p->in[11];
    for (int row = gw; row < MR; row += nw) {
        int grp, b, t; row_bt(row, grp, b, t);
        f32x4 v[4], pv[4];
#pragma unroll
        for (int i = 0; i < 4; ++i) v[i] = *(const f32x4*)(X + (size_t)row * D + lane * 4 + 256 * i);
        const float rs = row_rstd(v, lane);
        if (t > 0) {
#pragma unroll
            for (int i = 0; i < 4; ++i) pv[i] = *(const f32x4*)(X + (size_t)(row - 1) * D + lane * 4 + 256 * i);
            const float rp = row_rstd(pv, lane);
#pragma unroll
            for (int i = 0; i < 4; ++i) pv[i] = pv[i] * rp * *(const f32x4*)(g + lane * 4 + 256 * i);
        } else {
#pragma unroll
            for (int i = 0; i < 4; ++i) { const float zf = __uint_as_float((unsigned)tid >> 31); pv[i] = grp == 0 ? (f32x4){zf, zf, zf, zf} : *(const f32x4*)(p->in[3] + (size_t)b * D + lane * 4 + 256 * i); }
        }
        const bool last = t == (grp == 0 ? TP - 1 : TS - 1);
        float* sh = grp == 0 ? p->out + O_SHP + (size_t)b * D : p->out + O_SHS + (size_t)b * D;
#pragma unroll
        for (int i = 0; i < 4; ++i) {
            const int c = lane * 4 + 256 * i; const size_t o = (size_t)row * D + c;
            const f32x4 h = v[i] * rs * *(const f32x4*)(g + c), dx = pv[i] - h;
            store_bf4(A + o, h + dx * *(const f32x4*)(mu + c));
            store_bf4(A + (size_t)MP * D + o, h + dx * *(const f32x4*)(mu + 2 * D + c));
            store_bf4(A + (size_t)2 * MP * D + o, h + dx * *(const f32x4*)(mu + 3 * D + c));
            store_bf4(A + (size_t)3 * MP * D + o, h);
            store_bf4(A + (size_t)4 * MP * D + o, pv[i]);
            if (last) *(f32x4*)(sh + c) = h;
        }
    }
}
__device__ __forceinline__ void act_phase(KP p, int gtid, int nthr) {
    const float* L1 = (const float*)(p->ws + W_L1); bf16_t* A2 = (bf16_t*)(p->ws + W_A2);
    for (int i = gtid; i < MP * 64; i += nthr) {
        const int c = (i & 63) * 4;
        f32x4 v = *(const f32x4*)(L1 + (size_t)i * 4) + *(const f32x4*)(L1 + (size_t)MP * 256 + (size_t)i * 4);
        if (c < 64) {
#pragma unroll
            for (int j = 0; j < 4; ++j) v[j] = 1.f - 2.f * __builtin_amdgcn_rcpf(1.f + __expf(2.f * v[j]));
        } else if (c >= 128) {
#pragma unroll
            for (int j = 0; j < 4; ++j) v[j] = sigmoidf_(v[j]);
        }
        store_bf4(A2 + (size_t)i * 4, v);
    }
}

__device__ __forceinline__ float dpp_sum16(float x) {
    x += __builtin_bit_cast(float, __builtin_amdgcn_update_dpp(0, __builtin_bit_cast(int, x), 0xB1, 0xF, 0xF, true));
    x += __builtin_bit_cast(float, __builtin_amdgcn_update_dpp(0, __builtin_bit_cast(int, x), 0x4E, 0xF, 0xF, true));
    x += __builtin_bit_cast(float, __builtin_amdgcn_update_dpp(0, __builtin_bit_cast(int, x), 0x141, 0xF, 0xF, true));
    x += __builtin_bit_cast(float, __builtin_amdgcn_update_dpp(0, __builtin_bit_cast(int, x), 0x140, 0xF, 0xF, true));
    return x;
}
constexpr int SC_CH = 16, SC_STR = 400;
__device__ __forceinline__ void scan_phase(KP p, LAS float* buf, int tid, int bid, int G) {
    const int wid = tid >> 6, lane = tid & 63;
    const bf16_t* RKV = (const bf16_t*)(p->ws + W_RKV); const bf16_t* DEC = (const bf16_t*)(p->ws + W_DEC); const bf16_t* AA = (const bf16_t*)(p->ws + W_AA);
    float* SO = (float*)(p->ws + W_SO);
    const bool producer = wid >= 4;
    for (int u = bid; u < 768; u += G) {
        int bh, half, T, row0; const float* S0; float* Sout;
        if (u < 256) { bh = u >> 1; half = u & 1; T = TP; row0 = (bh >> 4) * TP; S0 = nullptr; Sout = p->out + O_SP + (size_t)bh * 4096; }
        else { const int v = u - 256; bh = v >> 1; half = v & 1; T = TS; row0 = MPR + (bh >> 4) * TS; S0 = p->in[2] + (size_t)bh * 4096; Sout = p->out + O_SS + (size_t)bh * 4096; }
        const int h = bh & 15, nchunk = T / SC_CH;
        if (producer) {
            const int t2 = tid - 256, pi = t2 >> 4, pj = t2 & 15, kc = h * 64 + 4 * pj;
            const f32x4 kkv = *(const f32x4*)(p->in[21] + kc), kav = *(const f32x4*)(p->in[22] + kc), w0v = *(const f32x4*)(p->in[13] + kc), a0v = *(const f32x4*)(p->in[16] + kc);
            u32x2 pr, pk, pvv, pa, pd;
#define SC_LOAD(c) do { const size_t o = (size_t)(row0 + (c) * SC_CH + pi) * D + kc; pr = *(const u32x2*)(RKV + o); pk = *(const u32x2*)(RKV + (size_t)MP * D + o); \
            pvv = *(const u32x2*)(RKV + (size_t)2 * MP * D + o); pa = *(const u32x2*)(AA + o); pd = *(const u32x2*)(DEC + o); } while (0)
#define SC_STORE(bi) do { LAS float* rec = buf + (bi) * (SC_CH * SC_STR) + pi * SC_STR; \
            const f32x4 r = (f32x4){bf_lo(pr.x), bf_hi(pr.x), bf_lo(pr.y), bf_hi(pr.y)}, k = (f32x4){bf_lo(pk.x), bf_hi(pk.x), bf_lo(pk.y), bf_hi(pk.y)}; \
            const f32x4 v = (f32x4){bf_lo(pvv.x), bf_hi(pvv.x), bf_lo(pvv.y), bf_hi(pvv.y)}; \
            f32x4 a = (f32x4){bf_lo(pa.x), bf_hi(pa.x), bf_lo(pa.y), bf_hi(pa.y)} + a0v; f32x4 w = (f32x4){bf_lo(pd.x), bf_hi(pd.x), bf_lo(pd.y), bf_hi(pd.y)} + w0v; \
            _Pragma("unroll") for (int j = 0; j < 4; ++j) { a[j] = sigmoidf_(a[j]); w[j] = __expf(-__expf(-softplusf_(-w[j]) - 0.5f)); } \
            const f32x4 q = k * kkv; float ss = (q[0] * q[0] + q[1] * q[1]) + (q[2] * q[2] + q[3] * q[3]); ss = dpp_sum16(ss); \
            const float inv = 1.f / fmaxf(sqrtf(ss), 1e-12f); const f32x4 nk = q * inv; \
            const f32x4 kp = k * (1.f + (a - 1.f) * kav), bb = nk * a; \
            float br = (bb[0] * r[0] + bb[1] * r[1]) + (bb[2] * r[2] + bb[3] * r[3]), kr = (kp[0] * r[0] + kp[1] * r[1]) + (kp[2] * r[2] + kp[3] * r[3]); \
            br = dpp_sum16(br); kr = dpp_sum16(kr); \
            *(LAS f32x4*)(rec + 4 * pj) = w; *(LAS f32x4*)(rec + 64 + 4 * pj) = nk; *(LAS f32x4*)(rec + 128 + 4 * pj) = bb; \
            *(LAS f32x4*)(rec + 192 + 4 * pj) = kp; *(LAS f32x4*)(rec + 256 + 4 * pj) = w * r; *(LAS f32x4*)(rec + 320 + 4 * pj) = v; \
            if (pj == 0) *(LAS f32x2*)(rec + 384) = (f32x2){br, kr}; } while (0)
            SC_LOAD(0); SC_STORE(0);
            if (nchunk > 1) SC_LOAD(1);
            __syncthreads();
            for (int c = 0; c < nchunk; ++c) {
                if (c + 1 < nchunk) { SC_STORE((c + 1) & 1); if (c + 2 < nchunk) SC_LOAD(c + 2); }
                __syncthreads();
            }
#undef SC_LOAD
#undef SC_STORE
        } else {
            const int rp = lane >> 4, kq = lane & 15, vA = half * 32 + wid * 8 + rp * 2;
            f32x4 sA = (f32x4){0.f, 0.f, 0.f, 0.f}, sB = sA;
            if (S0) { sA = *(const f32x4*)(S0 + vA * 64 + kq * 4); sB = *(const f32x4*)(S0 + (vA + 1) * 64 + kq * 4); }
            float* op = SO + (size_t)(row0 + kq) * D + h * 64 + vA;
            __syncthreads();
            for (int c = 0; c < nchunk; ++c) {
                const LAS float* cb = buf + (c & 1) * (SC_CH * SC_STR);
                float oA = 0.f, oB = 0.f;
#pragma unroll
                for (int i = 0; i < SC_CH; ++i) {
                    const LAS float* rec = cb + i * SC_STR;
                    const f32x4 wd = *(const LAS f32x4*)(rec + kq * 4), kk = *(const LAS f32x4*)(rec + 64 + kq * 4), bb = *(const LAS f32x4*)(rec + 128 + kq * 4),
                                kp = *(const LAS f32x4*)(rec + 192 + kq * 4), wr = *(const LAS f32x4*)(rec + 256 + kq * 4);
                    const f32x2 vv = *(const LAS f32x2*)(rec + 320 + vA), sc = *(const LAS f32x2*)(rec + 384);
                    float d1A = (sA[0] * kk[0] + sA[1] * kk[1]) + (sA[2] * kk[2] + sA[3] * kk[3]);
                    float d1B = (sB[0] * kk[0] + sB[1] * kk[1]) + (sB[2] * kk[2] + sB[3] * kk[3]);
                    float d2A = (sA[0] * wr[0] + sA[1] * wr[1]) + (sA[2] * wr[2] + sA[3] * wr[3]);
                    float d2B = (sB[0] * wr[0] + sB[1] * wr[1]) + (sB[2] * wr[2] + sB[3] * wr[3]);
                    d1A = dpp_sum16(d1A); d1B = dpp_sum16(d1B); d2A = dpp_sum16(d2A); d2B = dpp_sum16(d2B);
                    const float saA = -d1A, saB = -d1B;
                    const float tA = d2A + saA * sc.x + vv.x * sc.y, tB = d2B + saB * sc.x + vv.y * sc.y;
                    sA = sA * wd + bb * saA + kp * vv.x;
                    sB = sB * wd + bb * saB + kp * vv.y;
                    oA = kq == i ? tA : oA; oB = kq == i ? tB : oB;
                }
                *(f32x2*)(op + (size_t)c * SC_CH * D) = (f32x2){oA, oB};
                __syncthreads();
            }
            *(f32x4*)(Sout + vA * 64 + kq * 4) = sA; *(f32x4*)(Sout + (vA + 1) * 64 + kq * 4) = sB;
        }
    }
}
__device__ __forceinline__ void post_phase(KP p, int tid, int bid, int G) {
    const int lane = tid & 63, gw = bid * 8 + (tid >> 6), nw = G * 8;
    const bf16_t* RKV = (const bf16_t*)(p->ws + W_RKV); const bf16_t* AA = (const bf16_t*)(p->ws + W_AA); const bf16_t* GG = (const bf16_t*)(p->ws + W_GG);
    const float* SO = (const float*)(p->ws + W_SO); bf16_t* OG = (bf16_t*)(p->ws + W_OG);
    const float* k_a = p->in[22]; const float* a0p = p->in[16]; const float* r_k = p->in[23]; const float* gnw = p->in[24]; const float* gnb = p->in[25];
    const int c0 = lane * 16;
    for (int row = gw; row < MR; row += nw) {
        const size_t o = (size_t)row * D + c0;
        float ov[16], rv[16], kv[16], vv[16], av[16], gv[16];
#pragma unroll
        for (int q = 0; q < 4; ++q) { const f32x4 x = *(const f32x4*)(SO + o + 4 * q); ov[4 * q] = x[0]; ov[4 * q + 1] = x[1]; ov[4 * q + 2] = x[2]; ov[4 * q + 3] = x[3]; }
#define LD16(dst, ptr) do { const u32x4 a_ = *(const u32x4*)(ptr), b_ = *(const u32x4*)((ptr) + 8); \
        dst[0] = bf_lo(a_.x); dst[1] = bf_hi(a_.x); dst[2] = bf_lo(a_.y); dst[3] = bf_hi(a_.y); dst[4] = bf_lo(a_.z); dst[5] = bf_hi(a_.z); dst[6] = bf_lo(a_.w); dst[7] = bf_hi(a_.w); \
        dst[8] = bf_lo(b_.x); dst[9] = bf_hi(b_.x); dst[10] = bf_lo(b_.y); dst[11] = bf_hi(b_.y); dst[12] = bf_lo(b_.z); dst[13] = bf_hi(b_.z); dst[14] = bf_lo(b_.w); dst[15] = bf_hi(b_.w); } while (0)
        LD16(rv, RKV + o); LD16(kv, RKV + (size_t)MP * D + o); LD16(vv, RKV + (size_t)2 * MP * D + o); LD16(av, AA + o); LD16(gv, GG + o);
#undef LD16
        float sm = 0.f, rk = 0.f;
#pragma unroll
        for (int e = 0; e < 16; ++e) { sm += ov[e]; const float kp = kv[e] * (1.f + (sigmoidf_(a0p[c0 + e] + av[e]) - 1.f) * k_a[c0 + e]); rk += rv[e] * kp * r_k[c0 + e]; }
        sm += shx(sm, 1, lane); sm += shx(sm, 2, lane); rk += shx(rk, 1, lane); rk += shx(rk, 2, lane);
        const float mean = sm * (1.f / 64.f);
        float vs = 0.f;
#pragma unroll
        for (int e = 0; e < 16; ++e) { const float d = ov[e] - mean; vs += d * d; }
        vs += shx(vs, 1, lane); vs += shx(vs, 2, lane);
        const float rstd = __builtin_amdgcn_rsqf(vs * (1.f / 64.f) + GN_EPS);
        unsigned w[8];
#pragma unroll
        for (int e = 0; e < 16; e += 2) {
            const float y0 = ((ov[e] - mean) * rstd * gnw[c0 + e] + gnb[c0 + e] + rk * vv[e]) * gv[e];
            const float y1 = ((ov[e + 1] - mean) * rstd * gnw[c0 + e + 1] + gnb[c0 + e + 1] + rk * vv[e + 1]) * gv[e + 1];
            w[e >> 1] = cvt_pk(y0, y1);
        }
        *(u32x4*)(OG + o) = (u32x4){w[0], w[1], w[2], w[3]}; *(u32x4*)(OG + o + 8) = (u32x4){w[4], w[5], w[6], w[7]};
    }
}

__device__ __forceinline__ int crow(int r, int hi) { return (r & 3) + 8 * (r >> 2) + 4 * hi; }
__device__ __forceinline__ bf16x8 pack8(f32x4 a, f32x4 b) {
    u32x4 w; w.x = cvt_pk(a[0], a[1]); w.y = cvt_pk(a[2], a[3]); w.z = cvt_pk(b[0], b[1]); w.w = cvt_pk(b[2], b[3]);
    return __builtin_bit_cast(bf16x8, w);
}
__device__ __forceinline__ void attn_phase(KP p, int tid, int bid, int G) {
    const int lane = tid & 63, gw = bid * 8 + (tid >> 6), nw = G * 8;
    const bf16_t* QB = (const bf16_t*)(p->ws + W_QB); bf16_t* AO = (bf16_t*)(p->ws + W_OG);
    const int ql = lane & 31, hi = lane >> 5;
    constexpr int NU_P = BP * NH * 65;
    for (int u = gw; u < NU_P + BS * NH * 2; u += nw) {
        int bh, Q0, nq, npast, row_base, Tn; const float *kc, *vc, *kn, *vn;
        if (u < NU_P) { bh = u / 65; Q0 = (u - bh * 65) * 32; nq = min(32, TP - Q0); npast = 0; row_base = (bh >> 4) * TP; Tn = TP;
            kc = nullptr; vc = nullptr; kn = p->out + O_KP + (size_t)bh * TP * HD; vn = p->out + O_VP + (size_t)bh * TP * HD; }
        else { const int v = u - NU_P; bh = v >> 1; Q0 = (v & 1) * 32; nq = 32; npast = PAST; row_base = MPR + (bh >> 4) * TS; Tn = TS;
            kc = p->in[4] + (size_t)bh * PAST * HD; vc = p->in[5] + (size_t)bh * PAST * HD; kn = p->out + O_KS + (size_t)bh * TS * HD; vn = p->out + O_VS + (size_t)bh * TS * HD; }
        const int h = bh & 15, qpos0 = npast + Q0;
        bf16x8 qf[4];
        { const bf16_t* qp = QB + (size_t)(row_base + Q0 + min(ql, nq - 1)) * D + h * 64 + hi * 8;
#pragma unroll
          for (int s = 0; s < 4; ++s) qf[s] = *(const bf16x8*)(qp + 16 * s); }
        f32x16 o0, o1;
#pragma unroll
        for (int r = 0; r < 16; ++r) { o0[r] = 0.f; o1[r] = 0.f; }
        float carry = ql < nq ? 0.f : -1e30f;
        const int qpos = qpos0 + ql;
        for (int kt = qpos0 >> 5; kt >= 0; --kt) {
            const int P0 = kt * 32;
            const bool inpast = P0 < npast;
            const float* kb = inpast ? kc + (size_t)P0 * HD : kn + (size_t)(P0 - npast) * HD;
            const float* vb = inpast ? vc + (size_t)P0 * HD : vn + (size_t)(P0 - npast) * HD;
            const int lim = inpast ? 31 : min(31, Tn - 1 - (P0 - npast));
            f32x16 st;
#pragma unroll
            for (int r = 0; r < 16; ++r) st[r] = 0.f;
            { const float* kp = kb + (size_t)min(ql, lim) * HD + hi * 8;
#pragma unroll
              for (int s = 0; s < 4; ++s) { const f32x4 a = *(const f32x4*)(kp + 16 * s), b = *(const f32x4*)(kp + 16 * s + 4);
                  st = __builtin_amdgcn_mfma_f32_32x32x16_bf16(pack8(a, b), qf[s], st, 0, 0, 0); } }
            float L[16];
            float own[4];
#pragma unroll
            for (int g = 0; g < 4; ++g) { float sg = 0.f;
#pragma unroll
                for (int i = 0; i < 4; ++i) { const int r = 4 * g + i; const bool vis = (P0 + crow(r, hi)) < qpos; L[r] = vis ? -softplusf_(st[r]) : 0.f; sg += L[r]; }
                own[g] = sg; }
            float oth[4];
#pragma unroll
            for (int g = 0; g < 4; ++g) oth[g] = shx(own[g], 32, lane);
            float suf = carry;
            float A[16];
#pragma unroll
            for (int g = 3; g >= 0; --g) {
                float c = suf + (hi == 0 ? oth[g] : 0.f);
#pragma unroll
                for (int i = 3; i >= 0; --i) { const int r = 4 * g + i; c += L[r]; const bool vis = (P0 + crow(r, hi)) < qpos; A[r] = vis ? __expf(st[r] + c) : 0.f; }
                suf += own[g] + oth[g];
            }
            carry = suf;
            const bf16x8 pa0 = pack8((f32x4){A[0], A[1], A[2], A[3]}, (f32x4){A[4], A[5], A[6], A[7]});
            const bf16x8 pa1 = pack8((f32x4){A[8], A[9], A[10], A[11]}, (f32x4){A[12], A[13], A[14], A[15]});
#pragma unroll
            for (int jj = 0; jj < 2; ++jj) {
                float x0[8], x1[8];
#pragma unroll
                for (int i = 0; i < 8; ++i) { const float* vp = vb + (size_t)min(crow(8 * jj + i, hi), lim) * HD + ql; x0[i] = vp[0]; x1[i] = vp[32]; }
                const bf16x8 vf0 = pack8((f32x4){x0[0], x0[1], x0[2], x0[3]}, (f32x4){x0[4], x0[5], x0[6], x0[7]});
                const bf16x8 vf1 = pack8((f32x4){x1[0], x1[1], x1[2], x1[3]}, (f32x4){x1[4], x1[5], x1[6], x1[7]});
                o0 = __builtin_amdgcn_mfma_f32_32x32x16_bf16(jj == 0 ? pa0 : pa1, vf0, o0, 0, 0, 0);
                o1 = __builtin_amdgcn_mfma_f32_32x32x16_bf16(jj == 0 ? pa0 : pa1, vf1, o1, 0, 0, 0);
            }
            if (!__any(carry >= -104.f)) break;
        }
        bf16_t* op = AO + (size_t)(row_base + Q0) * D + h * 64 + ql;
#pragma unroll
        for (int r = 0; r < 16; ++r) { const int qr = crow(r, hi); if (qr < nq) { op[(size_t)qr * D] = (bf16_t)(cvt_pk(o0[r], 0.f) & 0xffffu); op[(size_t)qr * D + 32] = (bf16_t)(cvt_pk(o1[r], 0.f) & 0xffffu); } }
    }
}

constexpr int NPHASE = 23;
#ifndef PHM
#define PHM 0xffff
#endif
#define EN(k) (((PHM) >> (k)) & 1)
constexpr int LDS_BYTES = 131072 + 8 * 576 * 4;
template <class Epi, class Sched>
__device__ __forceinline__ void run_gemm(LAS unsigned char* lds, int wb, const bf16_t* A, const bf16_t* Bt, int M, int N, int K, const Sched S, const Epi E) {
    pg8::Gemm g{A, Bt, M, N, K, wb};
    pg8::gemm_phase<Epi, Sched, true, true>(lds, g, S, E);
}
__global__ void __launch_bounds__(512, 2) mega(Params p_unused) {
    LAS unsigned char* lds = (LAS unsigned char*)lds_raw;
    cg::grid_group grid = cg::this_grid();
    KP p = (KP)__builtin_amdgcn_kernarg_segment_ptr();
    const int ph_lo = p->ph_lo, ph_hi = p->ph_hi;
    const int wb = __builtin_amdgcn_readfirstlane((int)threadIdx.x) & ~63;
    for (int pi_ = ph_lo; pi_ < ph_hi; ++pi_) {
        asm volatile("" ::: "v1","v2","v3","v4","v5","v6","v7","v8","v9","v10","v11","v12","v13","v14","v15","v16","v17","v18","v19","v20","v21","v22","v23","v24","v25","v26","v27","v28","v29","v30","v31","v32","v33","v34","v35","v36","v37","v38","v39","v40","v41","v42","v43","v44","v45","v46","v47","v48","v49","v50","v51","v52","v53","v54","v55","v56","v57","v58","v59","v60","v61","v62","v63","v64","v65","v66","v67","v68","v69","v70","v71","v72","v73","v74","v75","v76","v77","v78","v79","v80","v81","v82","v83","v84","v85","v86","v87","v88","v89","v90","v91","v92","v93","v94","v95","v96","v97","v98","v99","v100","v101","v102","v103","v104","v105","v106","v107","v108","v109","v110","v111","v112","v113","v114","v115","v116","v117","v118","v119","v120","v121","v122","v123","v124","v125","v126","v127","v128","v129","v130","v131","v132","v133","v134","v135","v136","v137","v138","v139","v140","v141","v142","v143","v144","v145","v146","v147","v148","v149","v150","v151","v152","v153","v154","v155","v156","v157","v158","v159","v160","v161","v162","v163","v164","v165","v166","v167","v168","v169","v170","v171","v172","v173","v174","v175","v176","v177","v178","v179","v180","v181","v182","v183","v184","v185","v186","v187","v188","v189","v190","v191","v192","v193","v194","v195","v196","v197","v198","v199","v200","v201","v202","v203","v204","v205","v206","v207","v208","v209","v210","v211","v212","v213","v214","v215","v216","v217","v218","v219","v220","v221","v222","v223","v224","v225","v226","v227","v228","v229","v230","v231","v232","v233","v234","v235","v236","v237","v238","v239","v240","v241","v242","v243","v244","v245","v246","v247","v248","v249");
        asm volatile("" : "+s"(p));
        const int phc = p->seq[pi_], ph = phc & 63; const bool dry = (phc & 64) != 0;
        int bid = blockIdx.x, G = gridDim.x;
        asm volatile("" : "+s"(bid), "+s"(G));
#define TID_HERE (wb + lane_now())
        int ffn = -1; bool ffn_in = false;
        if (ph == 1 || ph == 2) { ffn = 0; ffn_in = ph == 1; } else if (ph == 11 || ph == 12) { ffn = 1; ffn_in = ph == 11; }
        else if (ph == 14 || ph == 15) { ffn = 2; ffn_in = ph == 14; } else if (ph == 21 || ph == 22) { ffn = 3; ffn_in = ph == 21; }
        if (EN(0) && ph == 0) { { const int tid = TID_HERE; convert_weights(p, (LAS float*)lds, tid, bid, G); assemble_x(p, tid, bid, G); } }
        else if (EN(1) && ffn >= 0 && ffn_in) {
            pg8::StaticOrder S; S.init(MP, NIN, G, bid); S.nt0 = D / 64;
            unsigned char* ws = p->ws; EpiSwiGLU E{(bf16_t*)(ws + W_HB)};
            run_gemm(lds, wb, (const bf16_t*)(ws + W_XN), (const bf16_t*)(ws + W_WIN + ffn * SZ_WIN1), MP, NIN, D, S, E);
        } else if (EN(2) && ffn >= 0) {
            TailOrder S; S.init(MP, D, DFFP, G, bid, true);
            unsigned char* ws = p->ws; EpiRes E{(float*)(ws + W_X), dry ? 0.f : 0.5f, (ffn == 3 && !dry) ? p->out : nullptr};
            run_gemm(lds, wb, (const bf16_t*)(ws + W_HB), (const bf16_t*)(ws + W_WOUT + ffn * SZ_WOUT1), MP, D, DFFP, S, E);
        }
        else if (EN(3) && ph == 3) mixprep_phase(p, TID_HERE, bid, G);
        else if (EN(4) && ph == 4) {
            G1Order S{G, bid};
            unsigned char* ws = p->ws; EpiG1 E{(bf16_t*)(ws + W_RKV), (float*)(ws + W_L1)};
            run_gemm(lds, wb, (const bf16_t*)(ws + W_AALL), (const bf16_t*)(ws + W_WG1), 5 * MP, 3584, D, S, E);
        }
        else if (EN(5) && ph == 5) act_phase(p, bid * 512 + TID_HERE, G * 512);
        else if (EN(6) && ph == 6) {
            pg8::StaticOrder S; S.init(MP, 3072, G, bid); S.nt0 = 4;
            unsigned char* ws = p->ws; EpiG2 E{(bf16_t*)(ws + W_DEC)};
            run_gemm(lds, wb, (const bf16_t*)(ws + W_A2), (const bf16_t*)(ws + W_WL2), MP, 3072, 256, S, E);
        }
        else if (EN(7) && ph == 7) scan_phase(p, (LAS float*)lds, TID_HERE, bid, G);
        else if (EN(8) && ph == 8) post_phase(p, TID_HERE, bid, G);
        else if (EN(9) && (ph == 9 || ph == 19)) {
            TailOrder S; S.init(MP, D, D, G, bid, true);
            unsigned char* ws = p->ws; EpiRes E{(float*)(ws + W_X), dry ? 0.f : 1.0f, nullptr};
            run_gemm(lds, wb, (const bf16_t*)(ws + W_OG), (const bf16_t*)(ws + (ph == 9 ? W_WO1 : W_WO2)), MP, D, D, S, E);
        }
        else if (EN(10) && ph == 10) norm_phase(p, p->in[7] + D, TID_HERE, bid, G);
        else if (EN(10) && ph == 13) norm_phase(p, p->in[7] + 2 * D, TID_HERE, bid, G);
        else if (EN(10) && ph == 16) norm_phase(p, p->in[10] + D, TID_HERE, bid, G);
        else if (EN(11) && ph == 17) {
            pg8::StaticOrder S; S.init(MP, 3 * D, G, bid); S.nt0 = D / 64;
            unsigned char* ws = p->ws; EpiQKV E{(bf16_t*)(ws + W_QB), p->out, p->in[28], p->in[29]};
            run_gemm(lds, wb, (const bf16_t*)(ws + W_XN), (const bf16_t*)(ws + W_WQKV), MP, 3 * D, D, S, E);
        }
        else if (EN(12) && ph == 18) attn_phase(p, TID_HERE, bid, G);
        else if (EN(10) && ph == 20) norm_phase(p, p->in[7] + 3 * D, TID_HERE, bid, G, true);
        if (pi_ + 1 < ph_hi) grid.sync();
    }
}

#ifndef ONE_LAUNCH
#define ONE_LAUNCH 1
#endif
extern "C" void kernel_launch(void* const* d_in, const int* in_sizes, int n_in, void* d_out, int out_size, void* d_ws, size_t ws_size, hipStream_t stream) {
    static int grid = 0;
    if (grid == 0) {
        if (n_in != 31 || (size_t)out_size != O_END || ws_size < W_END) { fprintf(stderr, "kernel_launch: unexpected sizes (n_in %d out %d ws %zu need %zu)\n", n_in, out_size, ws_size, (size_t)W_END); grid = -1; return; }
        int dev = 0, cus = 0, per_cu = 0;
        hipGetDevice(&dev); hipDeviceGetAttribute(&cus, hipDeviceAttributeMultiprocessorCount, dev);
        if (hipFuncSetAttribute((const void*)mega, hipFuncAttributeMaxDynamicSharedMemorySize, LDS_BYTES) != hipSuccess) { fprintf(stderr, "kernel_launch: hipFuncSetAttribute failed\n"); grid = -1; return; }
        hipOccupancyMaxActiveBlocksPerMultiprocessor(&per_cu, (const void*)mega, 512, LDS_BYTES);
        (void)hipGetLastError();
        if (per_cu < 1) per_cu = 1;
        grid = cus * per_cu;
    }
    if (grid < 0) return;
    Params p{};
    for (int i = 0; i < 31; ++i) p.in[i] = (const float*)d_in[i];
    p.out = (float*)d_out; p.ws = (unsigned char*)d_ws;
    int nseq = 0;
    for (int ph = 0; ph < NPHASE; ++ph) {
        p.seq[nseq++] = ph;
#ifdef REP_OF
        for (int r = 0; r < (REP_OF(ph)); ++r) p.seq[nseq++] = (ph | ((ph == 2 || ph == 9) ? 64 : 0));
#endif
    }
#if ONE_LAUNCH
    p.ph_lo = 0; p.ph_hi = nseq;
    void* args[] = {&p};
    hipError_t e = hipLaunchCooperativeKernel((const void*)mega, dim3(grid), dim3(512), args, LDS_BYTES, stream);
    if (e != hipSuccess) fprintf(stderr, "cooperative launch failed: %s (grid %d)\n", hipGetErrorString(e), grid);
#else
    for (int ph = 0; ph < nseq; ++ph) { p.ph_lo = ph; p.ph_hi = ph + 1; hipLaunchKernelGGL(mega, dim3(grid), dim3(512), LDS_BYTES, stream, p); }
#endif
}
```

```cpp
#include <hip/hip_runtime.h>
#include <hip/hip_cooperative_groups.h>
#include <cstdio>
#include <cstdint>
namespace cg = cooperative_groups;
__device__ __forceinline__ int lane_now() { int l; asm volatile("v_mbcnt_lo_u32_b32 %0, -1, 0\n\tv_mbcnt_hi_u32_b32 %0, -1, %0" : "=v"(l)); return l; }
namespace pg8 {
#define PG8_LAS __attribute__((address_space(3)))
typedef unsigned short bf16_t;
typedef short bf16x8 __attribute__((ext_vector_type(8)));
typedef float f32x4 __attribute__((ext_vector_type(4)));
typedef unsigned u32x4 __attribute__((ext_vector_type(4)));
constexpr int BM = 256, BK = 64, HALF = 128, HTB = HALF * BK * 2  , STAGE_BYTES = 8 * HTB, NXCD = 8, WGM = 8;

__host__ __device__ __forceinline__ int lds_byte(int r, int c) { const int st = (r >> 4) * 2 + (c >> 5), rr = r & 15, cc = c & 31, ob = rr * 64 + cc * 2; return st * 1024 + (ob ^ (((ob >> 9) & 1) << 5)); }
__host__ __device__ __forceinline__ void stage_rc(int b, int& R, int& C) { const int st = b / 1024, sb = b % 1024, swz = sb ^ (((sb >> 9) & 1) << 5); R = (st >> 1) * 16 + swz / 64; C = (st & 1) * 32 + (swz % 64) / 2; }
__host__ __device__ __forceinline__ int perm32(int rho) { const int n = rho >> 4, i = rho & 15; return 8 * (i >> 2) + 4 * n + (i & 3); }

struct Unit { int pm, pn, kb, nt, fl; };
struct Gemm { const bf16_t* A; const bf16_t* Bt; int M, N, K, wb; };

struct StaticOrder {
    int nM, nN, nwg, G, c, nt0;
    __host__ __device__ void init(int M, int N, int G_, int c_) { nM = M / BM; nN = N / BM; nwg = nM * nN; G = G_; c = c_; }
    __host__ __device__ bool next(int i, Unit& u) const {
        const long L = (long)i * G + c; if (L >= nwg) return false;
        int wgid = (int)L; { const int q = nwg / NXCD, r = nwg % NXCD, xcd = wgid % NXCD, off = wgid / NXCD; wgid = (xcd < r ? xcd * (q + 1) : r * (q + 1) + (xcd - r) * q) + off; }
        const int nig = WGM * nN, gid = wgid / nig, fm = gid * WGM, gsz = (nM - fm) < WGM ? (nM - fm) : WGM;
        u.pm = fm + ((wgid % nig) % gsz); u.pn = (wgid % nig) / gsz; u.kb = 0; u.nt = nt0; u.fl = 0; return true;
    }
    __device__ __forceinline__ void a_ready(const Unit&) const {}
    __device__ __forceinline__ void done(const Unit&) const {}
};
template <class Epi, class Sched, bool ALIGN_EPI = false, bool SP2 = false>
__device__ __forceinline__ void gemm_phase(PG8_LAS unsigned char* lds, const Gemm g, const Sched S, const Epi E) {
    int tid = g.wb + lane_now(); asm volatile("" : "+v"(tid)); const int wid = __builtin_amdgcn_readfirstlane(tid >> 6), lane = tid & 63, wr = wid >> 2, wc = wid & 3, fr = lane & 15, fq = lane >> 4;
    const int K = g.K, nt = K / BK;
    unsigned voffA[2], voffB[2];
#pragma unroll
    for (int i = 0; i < 2; ++i) { int R, C; stage_rc(tid * 16 + i * 8192, R, C); const int Rb = Epi::PERM ? ((R & ~31) + perm32(R & 31)) : R;
        voffA[i] = (unsigned)(R * K + C) * 2u; voffB[i] = (unsigned)(Rb * K + C) * 2u; }
    const size_t kstep = (size_t)(BK * 2);
    const size_t hstep = (size_t)HALF * K * 2;
    const size_t tstep = 2 * hstep;
    const unsigned ldsw = (unsigned)wid * 1024u;
    const int aoff = lds_byte(wr * 64 + fr, fq * 8), boff = lds_byte(wc * 32 + fr, fq * 8);
#define PG8_SA(b, h) (((b) * 2 + (h)) * HTB)
#define PG8_SB(b, h) ((4 + (b) * 2 + (h)) * HTB)
#define PG8_STAGE(bufoff, gbase, voff) do { _Pragma("unroll") for (int _i = 0; _i < 2; ++_i) \
        __builtin_amdgcn_global_load_lds((const unsigned*)((const char*)(gbase) + (voff)[_i]), (PG8_LAS unsigned*)(lds + (bufoff) + ldsw + _i * 8192), 16, 0, 0); } while (0)
#define PG8_LDA(dst, b, h) do { _Pragma("unroll") for (int m = 0; m < 4; ++m) _Pragma("unroll") for (int k = 0; k < 2; ++k) dst[m][k] = *(const PG8_LAS bf16x8*)(lds + PG8_SA(b, h) + aoff + m * 2048 + k * 1024); } while (0)
#define PG8_LDB(dst, b, h) do { _Pragma("unroll") for (int n = 0; n < 2; ++n) _Pragma("unroll") for (int k = 0; k < 2; ++k) dst[n][k] = *(const PG8_LAS bf16x8*)(lds + PG8_SB(b, h) + boff + n * 2048 + k * 1024); } while (0)
#define PG8_MMA(ai, bj, At, Bt) do { __builtin_amdgcn_s_setprio(1); _Pragma("unroll") for (int m = 0; m < 4; ++m) _Pragma("unroll") for (int n = 0; n < 2; ++n) _Pragma("unroll") for (int k = 0; k < 2; ++k) \
        acc[ai][bj][m][n] = __builtin_amdgcn_mfma_f32_16x16x32_bf16(Bt[n][k], At[m][k], acc[ai][bj][m][n], 0, 0, 0); __builtin_amdgcn_s_setprio(0); } while (0)
#define PG8_WAIT_V(n) asm volatile("s_waitcnt vmcnt(" #n ")" ::: "memory")
#define PG8_WAIT_L(n) asm volatile("s_waitcnt lgkmcnt(" #n ")" ::: "memory")
#define PG8_BAR __builtin_amdgcn_s_barrier()
#define PG8_SCHED __builtin_amdgcn_sched_barrier(0)
    Unit cur, nxt; int ui = 0;
    if (!S.next(0, cur)) return;
    f32x4 acc[2][2][4][2];
#pragma unroll
    for (int a = 0; a < 2; ++a)
#pragma unroll
        for (int b = 0; b < 2; ++b)
#pragma unroll
            for (int m = 0; m < 4; ++m)
#pragma unroll
                for (int n = 0; n < 2; ++n) acc[a][b][m][n] = (f32x4){0.f, 0.f, 0.f, 0.f};
    bf16x8 At[4][2], B0[2][2], B1[2][2];
    const char* cA = (const char*)g.A + (size_t)cur.pm * tstep + cur.kb; const char* cB = (const char*)g.Bt + (size_t)cur.pn * tstep + cur.kb;
    S.a_ready(cur);
    if constexpr (SP2) {
        PG8_STAGE(PG8_SB(0, 0), cB, voffB); PG8_STAGE(PG8_SB(0, 1), cB + hstep, voffB); PG8_STAGE(PG8_SA(0, 0), cA, voffA); PG8_STAGE(PG8_SA(0, 1), cA + hstep, voffA);
        if (wr == 1) PG8_BAR;
        PG8_WAIT_V(2); PG8_BAR;
        PG8_STAGE(PG8_SB(1, 0), cB + kstep, voffB); PG8_STAGE(PG8_SA(1, 0), cA + kstep, voffA); PG8_STAGE(PG8_SB(1, 1), cB + hstep + kstep, voffB);
        PG8_WAIT_V(6); PG8_BAR;
    } else {
        PG8_STAGE(PG8_SB(0, 0), cB, voffB); PG8_STAGE(PG8_SA(0, 0), cA, voffA); PG8_STAGE(PG8_SB(0, 1), cB + hstep, voffB); PG8_STAGE(PG8_SA(0, 1), cA + hstep, voffA);
        if (wr == 1) PG8_BAR;
        PG8_WAIT_V(4); PG8_BAR;
        PG8_STAGE(PG8_SB(1, 0), cB + kstep, voffB); PG8_STAGE(PG8_SA(1, 0), cA + kstep, voffA); PG8_STAGE(PG8_SB(1, 1), cB + hstep + kstep, voffB);
        PG8_WAIT_V(6); PG8_BAR;
    }
    for (;;) {
        const bool has_next = S.next(ui + 1, nxt);
        const char* nA = has_next ? (const char*)g.A + (size_t)nxt.pm * tstep + nxt.kb : cA; const char* nB = has_next ? (const char*)g.Bt + (size_t)nxt.pn * tstep + nxt.kb : cB;
        const int ntu = cur.nt;
        for (int t = 0; t < ntu; t += 2) {
            const bool last = (t == ntu - 2);
            const char* a1 = cA + (size_t)(t + 1) * kstep;
            const char* a2 = last ? nA : cA + (size_t)(t + 2) * kstep; const char* b2 = last ? nB : cB + (size_t)(t + 2) * kstep;
            const char* a3 = a2 + kstep; const char* b3 = b2 + kstep;
            if (last && has_next) S.a_ready(nxt);
            if constexpr (SP2) {
            PG8_LDB(B0, 0, 0); PG8_LDB(B1, 0, 1); PG8_SCHED; PG8_LDA(At, 0, 0); PG8_STAGE(PG8_SA(1, 1), a1 + hstep, voffA);
            PG8_WAIT_V(8); PG8_WAIT_L(0); PG8_BAR; PG8_MMA(0, 0, At, B0); PG8_MMA(0, 1, At, B1); PG8_BAR; PG8_SCHED;
            PG8_LDA(At, 0, 1); PG8_STAGE(PG8_SB(0, 0), b2, voffB); PG8_STAGE(PG8_SB(0, 1), b2 + hstep, voffB); PG8_STAGE(PG8_SA(0, 0), a2, voffA);
            PG8_WAIT_V(8); PG8_WAIT_L(0); PG8_BAR; PG8_MMA(1, 0, At, B0); PG8_MMA(1, 1, At, B1); PG8_BAR; PG8_SCHED;
            PG8_LDB(B0, 1, 0); PG8_LDB(B1, 1, 1); PG8_SCHED; PG8_LDA(At, 1, 0); PG8_STAGE(PG8_SA(0, 1), a2 + hstep, voffA);
            PG8_WAIT_V(8); PG8_WAIT_L(0); PG8_BAR; PG8_MMA(0, 0, At, B0); PG8_MMA(0, 1, At, B1); PG8_BAR; PG8_SCHED;
            PG8_LDA(At, 1, 1); PG8_STAGE(PG8_SB(1, 0), b3, voffB); PG8_STAGE(PG8_SB(1, 1), b3 + hstep, voffB); PG8_STAGE(PG8_SA(1, 0), a3, voffA);
            PG8_WAIT_V(8); PG8_WAIT_L(0); PG8_BAR; PG8_MMA(1, 0, At, B0); PG8_MMA(1, 1, At, B1); PG8_BAR; PG8_SCHED;
            } else {
            PG8_LDB(B0, 0, 0); PG8_SCHED; PG8_LDA(At, 0, 0); PG8_STAGE(PG8_SA(1, 1), a1 + hstep, voffA);
            PG8_WAIT_L(8); PG8_BAR; PG8_WAIT_L(0); PG8_MMA(0, 0, At, B0); PG8_BAR; PG8_SCHED;
            PG8_LDB(B1, 0, 1); PG8_STAGE(PG8_SB(0, 0), b2, voffB);
            PG8_BAR; PG8_WAIT_L(0); PG8_MMA(0, 1, At, B1); PG8_BAR;
            PG8_LDA(At, 0, 1); PG8_STAGE(PG8_SA(0, 0), a2, voffA);
            PG8_BAR; PG8_WAIT_L(0); PG8_MMA(1, 0, At, B0); PG8_BAR; PG8_SCHED;
            PG8_STAGE(PG8_SB(0, 1), b2 + hstep, voffB);
            PG8_WAIT_V(6); PG8_BAR; PG8_MMA(1, 1, At, B1); PG8_BAR;
            PG8_LDB(B0, 1, 0); PG8_SCHED; PG8_LDA(At, 1, 0); PG8_STAGE(PG8_SA(0, 1), a2 + hstep, voffA);
            PG8_WAIT_L(8); PG8_BAR; PG8_WAIT_L(0); PG8_MMA(0, 0, At, B0); PG8_BAR; PG8_SCHED;
            PG8_LDB(B1, 1, 1); PG8_STAGE(PG8_SB(1, 0), b3, voffB);
            PG8_BAR; PG8_WAIT_L(0); PG8_MMA(0, 1, At, B1); PG8_BAR;
            PG8_LDA(At, 1, 1); PG8_STAGE(PG8_SA(1, 0), a3, voffA);
            PG8_BAR; PG8_WAIT_L(0); PG8_MMA(1, 0, At, B0); PG8_BAR; PG8_SCHED;
            PG8_STAGE(PG8_SB(1, 1), b3 + hstep, voffB);
            PG8_WAIT_V(6); PG8_BAR; PG8_MMA(1, 1, At, B1); PG8_BAR;
            }
        }
        if constexpr (ALIGN_EPI) { if (wr == 0) PG8_BAR; }
        if constexpr (!Epi::AFTER_DRAIN) { int t_ = g.wb + lane_now(); asm volatile("" : "+v"(t_)); const int fr_ = t_ & 15, fq_ = (t_ >> 4) & 3; E(acc, cur, wr, wc, fr_, fq_); S.done(cur); }
        if (!has_next) break;
#pragma unroll
        for (int a = 0; a < 2; ++a)
#pragma unroll
            for (int b = 0; b < 2; ++b)
#pragma unroll
                for (int m = 0; m < 4; ++m)
#pragma unroll
                    for (int n = 0; n < 2; ++n) acc[a][b][m][n] = (f32x4){0.f, 0.f, 0.f, 0.f};
        cur = nxt; cA = nA; cB = nB; ++ui;
        if constexpr (ALIGN_EPI) { if (wr == 1) PG8_BAR; }
    }
    PG8_WAIT_V(0);
    if constexpr (!ALIGN_EPI) { if (wr == 0) PG8_BAR; }
    PG8_BAR;
    if constexpr (Epi::AFTER_DRAIN) { E.fused(acc, cur, wr, wc, fr, fq, lds, wid, lane); S.done(cur); }
#undef PG8_SA
#undef PG8_SB
#undef PG8_STAGE
#undef PG8_LDA
#undef PG8_LDB
#undef PG8_MMA
#undef PG8_WAIT_V
#undef PG8_WAIT_L
#undef PG8_BAR
#undef PG8_SCHED
}
}

#define LAS __attribute__((address_space(3)))
typedef unsigned short bf16_t;
typedef short bf16x8 __attribute__((ext_vector_type(8)));
typedef float f32x4 __attribute__((ext_vector_type(4)));
typedef float f32x2 __attribute__((ext_vector_type(2)));
typedef float f32x16 __attribute__((ext_vector_type(16)));
typedef unsigned u32x4 __attribute__((ext_vector_type(4)));
typedef unsigned u32x2 __attribute__((ext_vector_type(2)));

constexpr int D = 1024, NH = 16, HD = 64;
constexpr int BP = 8, TP = 2064, SEQP = 2048, NMETA = 16, BS = 16, TS = 64, PAST = 4096;
constexpr int MPR = BP * TP;
constexpr int MR = MPR + BS * TS;
constexpr int MP = 17664;
constexpr int NTM = 69;
constexpr int DFF = 2752, DFFP = 2816, NIN = 5632;
constexpr float RMS_EPS = 1e-6f, GN_EPS = 64e-5f;
constexpr float LOG2E = 1.4426950408889634f;

constexpr size_t O_YP = 0, O_YS = 16777216, O_SP = 17825792, O_SHP = 18350080, O_KP = 18358272, O_VP = 35266560,
                 O_SS = 52174848, O_SHS = 53223424, O_KS = 53239808, O_VS = 54288384, O_END = 55336960;

constexpr size_t SZ_ROWBF = (size_t)MP * D * 2, SZ_ROWF = (size_t)MP * D * 4;
constexpr size_t W_X = 0;
constexpr size_t W_XN = W_X + SZ_ROWF;
constexpr size_t W_HB = W_XN + SZ_ROWBF;
constexpr size_t W_WIN = W_HB + (size_t)MP * DFFP * 2;
constexpr size_t SZ_WIN1 = (size_t)NIN * D * 2, SZ_WOUT1 = (size_t)D * DFFP * 2;
constexpr size_t W_WOUT = W_WIN + 4 * SZ_WIN1;
constexpr size_t W_WG1 = W_WOUT + 4 * SZ_WOUT1;
constexpr size_t W_WL2 = W_WG1 + (size_t)3584 * D * 2;
constexpr size_t W_WO1 = W_WL2 + (size_t)3072 * 256 * 2;
constexpr size_t W_WQKV = W_WO1 + (size_t)D * D * 2;
constexpr size_t W_WO2 = W_WQKV + (size_t)3 * D * D * 2;
constexpr size_t W_AALL = W_WO2 + (size_t)D * D * 2;
constexpr size_t W_RKV = W_AALL + 5 * SZ_ROWBF;
constexpr size_t W_L1 = W_RKV + 3 * SZ_ROWBF;
constexpr size_t W_A2 = W_L1 + (size_t)2 * MP * 256 * 4;
constexpr size_t W_DEC = W_A2 + (size_t)MP * 256 * 2;
constexpr size_t W_AA = W_DEC + SZ_ROWBF;
constexpr size_t W_GG = W_AA + SZ_ROWBF;
constexpr size_t W_SO = W_GG + SZ_ROWBF;
constexpr size_t W_OG = W_SO + SZ_ROWF;
constexpr size_t W_QB = W_OG + SZ_ROWBF;
constexpr size_t W_END = W_QB + SZ_ROWBF;

struct Params { const float* in[31]; float* out; unsigned char* ws; int ph_lo, ph_hi; int seq[64]; };
typedef const Params __attribute__((address_space(4)))* KP;

__device__ __forceinline__ unsigned cvt_pk(float lo, float hi) { unsigned r; asm("v_cvt_pk_bf16_f32 %0, %1, %2" : "=v"(r) : "v"(lo), "v"(hi)); return r; }
__device__ __forceinline__ void store_bf4(bf16_t* p, f32x4 v) { u32x2 w; w.x = cvt_pk(v[0], v[1]); w.y = cvt_pk(v[2], v[3]); *(u32x2*)p = w; }
__device__ __forceinline__ float bf_lo(unsigned w) { return __uint_as_float(w << 16); }
__device__ __forceinline__ float bf_hi(unsigned w) { return __uint_as_float(w & 0xffff0000u); }
__device__ __forceinline__ float sigmoidf_(float x) { return __builtin_amdgcn_rcpf(1.f + __expf(-x)); }
__device__ __forceinline__ float softplusf_(float x) { return fmaxf(x, 0.f) + __logf(1.f + __expf(-fabsf(x))); }
__device__ __forceinline__ float shx(float v, int o, int lane) { return __builtin_bit_cast(float, __builtin_amdgcn_ds_bpermute((lane ^ o) << 2, __builtin_bit_cast(int, v))); }
__device__ __forceinline__ float wave_sum(float v, int lane) {
#pragma unroll
    for (int o = 1; o < 64; o <<= 1) v += shx(v, o, lane);
    return v;
}
__device__ __forceinline__ void row_bt(int row, int& grp, int& b, int& t) { if (row < MPR) { grp = 0; b = row / TP; t = row - b * TP; } else { grp = 1; const int r = row - MPR; b = r >> 6; t = r & 63; } }

using pg8::Unit;
extern __shared__ __attribute__((aligned(16))) unsigned char lds_raw[];
struct EpiSwiGLU {
    static constexpr bool PERM = true, AFTER_DRAIN = false;
    bf16_t* HB;
    __device__ __forceinline__ void operator()(const f32x4 (&acc)[2][2][4][2], const Unit& u, int wr, int wc, int fr, int fq) const {
        const int row0 = u.pm * 256 + wr * 64 + fr, col0 = u.pn * 128 + wc * 32 + 8 * fq;
#pragma unroll
        for (int ai = 0; ai < 2; ++ai)
#pragma unroll
            for (int m = 0; m < 4; ++m) {
                bf16_t* rowp = HB + (size_t)(row0 + ai * 128 + m * 16) * DFFP + col0;
                float hv[8];
#pragma unroll
                for (int n = 0; n < 2; ++n)
#pragma unroll
                    for (int j = 0; j < 4; ++j) { const float g = acc[ai][0][m][n][j], up = acc[ai][1][m][n][j]; hv[n * 4 + j] = g * sigmoidf_(g) * up; }
                u32x4 w; w.x = cvt_pk(hv[0], hv[1]); w.y = cvt_pk(hv[2], hv[3]); w.z = cvt_pk(hv[4], hv[5]); w.w = cvt_pk(hv[6], hv[7]);
                *(u32x4*)rowp = w;
            }
    }
};
struct EpiRes {
    static constexpr bool PERM = false, AFTER_DRAIN = false;
    float* X; float scale; float* out;
    __device__ __forceinline__ void operator()(const f32x4 (&acc)[2][2][4][2], const Unit& u, int wr, int wc, int fr, int fq) const {
        float* const X_ = X; float* const out_ = out; const float sc_ = scale;
        const int row0 = u.pm * 256 + wr * 64 + fr, col0 = u.pn * 256 + wc * 32 + 4 * fq;
#pragma unroll
        for (int ai = 0; ai < 2; ++ai)
#pragma unroll
            for (int m = 0; m < 4; ++m) {
                const int row = row0 + ai * 128 + m * 16;
                float* xp = X_ + (size_t)row * D + col0;
                if (out_ != nullptr) {
                    xp = nullptr;
                    if (row < MPR) { const int b = row / TP, t = row - b * TP; if (t >= NMETA) xp = out_ + O_YP + ((size_t)b * SEQP + (t - NMETA)) * D + col0; }
                    else if (row < MR) xp = out_ + O_YS + (size_t)(row - MPR) * D + col0;
                }
                if (u.fl & 1) {
                    const int ln = fq * 16 + fr, rr = ln >> 5, cc = ln & 31;
                    LAS float* sl = (LAS float*)((LAS unsigned char*)lds_raw + 131072) + (wr * 4 + wc) * 576;
#pragma unroll
                    for (int bj = 0; bj < 2; ++bj) {
#pragma unroll
                        for (int n = 0; n < 2; ++n) *(LAS f32x4*)(sl + fr * 36 + n * 16 + fq * 4) = acc[ai][bj][m][n] * sc_;
#pragma unroll 1
                        for (int k = 0; k < 8; ++k) {
                            const int rw = row - fr + 2 * k + rr;
                            float* tp = X_ + (size_t)rw * D;
                            if (out_ != nullptr) {
                                tp = nullptr;
                                if (rw < MPR) { const int b = rw / TP, t = rw - b * TP; if (t >= NMETA) tp = out_ + O_YP + ((size_t)b * SEQP + (t - NMETA)) * D; }
                                else if (rw < MR) tp = out_ + O_YS + (size_t)(rw - MPR) * D;
                            }
                            const float v = sl[(2 * k + rr) * 36 + cc];
                            if (tp) __hip_atomic_fetch_add(tp + u.pn * 256 + wc * 32 + bj * 128 + cc, v, __ATOMIC_RELAXED, __HIP_MEMORY_SCOPE_AGENT);
                        }
                    }
                } else if (xp) {
                    {
#pragma unroll
                        for (int bj = 0; bj < 2; ++bj)
#pragma unroll
                            for (int n = 0; n < 2; ++n) { f32x4* q = (f32x4*)(xp + bj * 128 + n * 16); *q = *q + acc[ai][bj][m][n] * sc_; }
                    }
                }
                asm volatile("" ::: "memory");
            }
    }
};
struct TailOrder {
    pg8::StaticOrder so; int nfull, nsplit, ntsplit;
    __device__ void init(int M, int N, int K, int G, int c, bool split) {
        so.init(M, N, G, c); so.nt0 = K / 64;
        nfull = so.nwg; nsplit = 1; ntsplit = so.nt0;
        const int rest = so.nwg % G;
        if (split && rest > 0 && so.nwg > G) {
            const int cap = G / rest; int best = 1;
            for (int s = 2; s <= cap && s * 2 <= so.nt0; ++s) if (so.nt0 % s == 0 && ((so.nt0 / s) & 1) == 0) best = s;
            if (best > 1) { nfull = so.nwg - rest; nsplit = best; ntsplit = so.nt0 / best; }
        }
    }
    __device__ bool next(int i, Unit& u) const {
        const long L = (long)i * so.G + so.c;
        if (L < nfull) { pg8::StaticOrder t = so; t.G = 1; t.c = 0; return t.next((int)L, u); }
        const long L2 = L - nfull; if (L2 >= (long)(so.nwg - nfull) * nsplit) return false;
        const int tile = nfull + (int)(L2 / nsplit), ch = (int)(L2 % nsplit);
        pg8::StaticOrder t = so; t.G = 1; t.c = 0; t.next(tile, u);
        u.kb = ch * ntsplit * 128; u.nt = ntsplit; u.fl = 1; return true;
    }
    __device__ __forceinline__ void a_ready(const Unit&) const {}
    __device__ __forceinline__ void done(const Unit&) const {}
};
struct EpiG1 {
    static constexpr bool PERM = true, AFTER_DRAIN = false;
    bf16_t* RKV; float* L1;
    __device__ __forceinline__ void operator()(const f32x4 (&acc)[2][2][4][2], const Unit& u, int wr, int wc, int fr, int fq) const {
        const unsigned row0 = (unsigned)((u.pm % NTM) * 256 + wr * 64 + fr), cw = wc * 32 + 8 * fq;
        if (u.pn < 12) {
            bf16_t* base = RKV + (size_t)(u.pn >> 2) * MP * D;
            const unsigned off0 = row0 * D + (u.pn & 3) * 256 + cw;
#pragma unroll
            for (int ai = 0; ai < 2; ++ai)
#pragma unroll
                for (int m = 0; m < 4; ++m)
#pragma unroll
                    for (int bj = 0; bj < 2; ++bj) { const f32x4 v0 = acc[ai][bj][m][0], v1 = acc[ai][bj][m][1];
                        u32x4 w; w.x = cvt_pk(v0[0], v0[1]); w.y = cvt_pk(v0[2], v0[3]); w.z = cvt_pk(v1[0], v1[1]); w.w = cvt_pk(v1[2], v1[3]);
                        *(u32x4*)(base + (off0 + (unsigned)((ai * 128 + m * 16) * D + bj * 128))) = w; }
        } else {
            float* base = L1 + (size_t)(u.pn - 12) * MP * 256;
            const unsigned off0 = row0 * 256 + cw;
#pragma unroll
            for (int ai = 0; ai < 2; ++ai)
#pragma unroll
                for (int m = 0; m < 4; ++m)
#pragma unroll
                    for (int bj = 0; bj < 2; ++bj)
#pragma unroll
                        for (int n = 0; n < 2; ++n) *(f32x4*)(base + (off0 + (unsigned)((ai * 128 + m * 16) * 256 + bj * 128 + n * 4))) = acc[ai][bj][m][n];
        }
    }
};
struct EpiG2 {
    static constexpr bool PERM = true, AFTER_DRAIN = false;
    bf16_t* LW;
    __device__ __forceinline__ void operator()(const f32x4 (&acc)[2][2][4][2], const Unit& u, int wr, int wc, int fr, int fq) const {
        bf16_t* base = LW + (size_t)(u.pn >> 2) * MP * D;
        const unsigned off0 = (unsigned)(u.pm * 256 + wr * 64 + fr) * D + (u.pn & 3) * 256 + wc * 32 + 8 * fq;
#pragma unroll
        for (int ai = 0; ai < 2; ++ai)
#pragma unroll
            for (int m = 0; m < 4; ++m)
#pragma unroll
                for (int bj = 0; bj < 2; ++bj) { const f32x4 v0 = acc[ai][bj][m][0], v1 = acc[ai][bj][m][1];
                    u32x4 w; w.x = cvt_pk(v0[0], v0[1]); w.y = cvt_pk(v0[2], v0[3]); w.z = cvt_pk(v1[0], v1[1]); w.w = cvt_pk(v1[2], v1[3]);
                    *(u32x4*)(base + (off0 + (unsigned)((ai * 128 + m * 16) * D + bj * 128))) = w; }
    }
};
struct EpiQKV {
    static constexpr bool PERM = false, AFTER_DRAIN = false;
    bf16_t* QB; float* out; const float* qg; const float* kg;
    __device__ __forceinline__ void operator()(const f32x4 (&acc)[2][2][4][2], const Unit& u, int wr, int wc, int fr, int fq) const {
        const int sec = u.pn >> 2, head = (u.pn & 3) * 4 + wc, row0 = u.pm * 256 + wr * 64 + fr;
        f32x4 gn[2][2];
#pragma unroll
        for (int bj = 0; bj < 2; ++bj)
#pragma unroll
            for (int n = 0; n < 2; ++n) { const int d = 32 * bj + 16 * n + 4 * fq;
                gn[bj][n] = sec == 0 ? *(const f32x4*)(qg + d) * 0.125f : (sec == 1 ? *(const f32x4*)(kg + d) : (f32x4){1.f, 1.f, 1.f, 1.f}); }
#pragma unroll
        for (int ai = 0; ai < 2; ++ai)
#pragma unroll
            for (int m = 0; m < 4; ++m) {
                const int row = row0 + ai * 128 + m * 16;
                float ss = 0.f;
#pragma unroll
                for (int bj = 0; bj < 2; ++bj)
#pragma unroll
                    for (int n = 0; n < 2; ++n) { const f32x4 x = acc[ai][bj][m][n]; ss += (x[0] * x[0] + x[1] * x[1]) + (x[2] * x[2] + x[3] * x[3]); }
                { const int ln = fq * 16 + fr; ss += shx(ss, 16, ln); ss += shx(ss, 32, ln); }
                const float rs = sec == 2 ? 1.f : __builtin_amdgcn_rsqf(ss * (1.f / 64.f) + RMS_EPS);
                if (row < MR) {
                    if (sec == 0) {
                        bf16_t* qp = QB + (size_t)row * D + head * 64 + 4 * fq;
#pragma unroll
                        for (int bj = 0; bj < 2; ++bj)
#pragma unroll
                            for (int n = 0; n < 2; ++n) { const f32x4 x = acc[ai][bj][m][n] * rs * gn[bj][n]; u32x2 w; w.x = cvt_pk(x[0], x[1]); w.y = cvt_pk(x[2], x[3]); *(u32x2*)(qp + 32 * bj + 16 * n) = w; }
                    } else {
                        int grp, b, t; row_bt(row, grp, b, t);
                        float* dp = grp == 0 ? out + (sec == 1 ? O_KP : O_VP) + (((size_t)b * NH + head) * TP + t) * HD
                                             : out + (sec == 1 ? O_KS : O_VS) + (((size_t)b * NH + head) * TS + t) * HD;
                        dp += 4 * fq;
#pragma unroll
                        for (int bj = 0; bj < 2; ++bj)
#pragma unroll
                            for (int n = 0; n < 2; ++n) *(f32x4*)(dp + 32 * bj + 16 * n) = acc[ai][bj][m][n] * rs * gn[bj][n];
                    }
                }
            }
    }
};
struct G1Order {
    int G, c;
    __device__ bool next(int i, Unit& u) const {
        const long L = (long)i * G + c; if (L >= 966) return false;
        int w = (int)L; { const int q = 966 / 8, r = 966 % 8, xcd = w % 8, off = w / 8; w = (xcd < r ? xcd * (q + 1) : r * (q + 1) + (xcd - r) * q) + off; }
        const int pm = w / 14, q = w % 14;
        if (q < 12) { u.pm = (q >> 2) * NTM + pm; u.pn = q; } else { u.pm = (q - 9) * NTM + pm; u.pn = q; }
        u.kb = 0; u.nt = 16; u.fl = 0;
        return true;
    }
    __device__ __forceinline__ void a_ready(const Unit&) const {}
    __device__ __forceinline__ void done(const Unit&) const {}
};

struct Job { const float* src; bf16_t* dst; const float* mu; int ld, Ksrc, koff, Kdst, rows, map, smode; };
__device__ __forceinline__ int srccol(int map, int n, int ld) {
    if (map == 0) return n < ld ? n : -1;
    if (map == 1) { const int pn = n >> 8, c = n & 255, bj = c >> 7, j = c & 127, hc = pn * 128 + j; return hc < DFF ? (bj ? DFF + hc : hc) : -1; }
    { const int t = n >> 8, c = n & 255, bj = c >> 7, wc = (c & 127) >> 5, i = c & 31; return t * 256 + 64 * wc + 32 * bj + i; }
}
__device__ __forceinline__ Job get_job(KP p, int j) {
    Job J; J.mu = nullptr; J.koff = 0; J.map = 0; J.smode = 0;
    unsigned char* ws = p->ws;
    if (j < 4) { J.src = p->in[8] + (size_t)j * D * 2 * DFF; J.dst = (bf16_t*)(ws + W_WIN + j * SZ_WIN1); J.ld = 2 * DFF; J.Ksrc = D; J.Kdst = D; J.rows = NIN; J.map = 1; }
    else if (j < 8) { const int i = j - 4; J.src = p->in[9] + (size_t)i * DFF * D; J.dst = (bf16_t*)(ws + W_WOUT + i * SZ_WOUT1); J.ld = D; J.Ksrc = DFF; J.Kdst = DFFP; J.rows = D; }
    else if (j < 11) { const int g = j - 8; J.src = p->in[12] + (size_t)g * D * D; J.dst = (bf16_t*)(ws + W_WG1) + (size_t)g * D * D; J.ld = D; J.Ksrc = D; J.Kdst = D; J.rows = D; }
    else if (j < 17) { const int idx = j - 11, part = idx / 3, which = idx % 3;
        J.src = which == 0 ? p->in[14] : (which == 1 ? p->in[17] : p->in[19]); J.ld = which == 2 ? 128 : 64; J.rows = J.ld;
        J.mu = p->in[11] + (which == 0 ? 1 : (which == 1 ? 4 : 5)) * D; J.smode = part + 1;
        J.dst = (bf16_t*)(ws + W_WG1) + (size_t)(3072 + part * 256 + which * 64) * D; J.Ksrc = D; J.Kdst = D; }
    else if (j < 20) { const int which = j - 17; J.src = which == 0 ? p->in[15] : (which == 1 ? p->in[18] : p->in[20]); J.ld = D; J.rows = D;
        J.Ksrc = which == 2 ? 128 : 64; J.koff = which * 64; J.Kdst = 256; J.dst = (bf16_t*)(ws + W_WL2) + (size_t)which * D * 256; }
    else if (j == 20) { J.src = p->in[26]; J.dst = (bf16_t*)(ws + W_WO1); J.ld = D; J.Ksrc = D; J.Kdst = D; J.rows = D; }
    else if (j == 21) { J.src = p->in[27]; J.dst = (bf16_t*)(ws + W_WQKV); J.ld = 3 * D; J.Ksrc = D; J.Kdst = D; J.rows = 3 * D; J.map = 2; }
    else { J.src = p->in[30]; J.dst = (bf16_t*)(ws + W_WO2); J.ld = D; J.Ksrc = D; J.Kdst = D; J.rows = D; }
    return J;
}
__device__ __forceinline__ void convert_weights(KP p, LAS float* tl, int tid, int bid, int G) {
    int rot = 0;
    for (int j = 0; j < 23; ++j) {
        const Job J = get_job(p, j);
        const int nkt = J.Kdst >> 6, nnt = (J.rows + 255) >> 8, ntile = nnt * nkt;
        int first = bid - rot; if (first < 0) first += G;
        for (int t = first; t < ntile; t += G) {
            const int n0 = (t / nkt) << 8, k0 = (t % nkt) << 6;
            const bool inside = k0 >= J.koff && k0 < J.koff + J.Ksrc;
            if (inside) {
                const int nn = tid & 255, kh = tid >> 8;
                const int sc = (n0 + nn) < J.rows ? srccol(J.map, n0 + nn, J.ld) : -1;
                const float* sp = J.src + (size_t)(k0 - J.koff + kh) * J.ld + (sc >= 0 ? sc : 0);
                float v[32];
#pragma unroll
                for (int it = 0; it < 32; ++it) v[it] = sc >= 0 ? sp[(size_t)(2 * it) * J.ld] : 0.f;
                if (J.smode) {
#pragma unroll
                    for (int it = 0; it < 32; ++it) { const float m = J.mu[k0 - J.koff + kh + 2 * it]; v[it] *= J.smode == 1 ? 1.f - m : m; }
                }
#pragma unroll
                for (int it = 0; it < 32; ++it) tl[(kh + 2 * it) * 257 + nn] = v[it];
            }
            __syncthreads();
            {
                const int nn = tid >> 1, kh = (tid & 1) * 32;
                if (n0 + nn < J.rows) {
                    bf16_t* dp = J.dst + (size_t)(n0 + nn) * J.Kdst + k0 + kh;
#pragma unroll
                    for (int q = 0; q < 4; ++q) {
                        const unsigned z_ = (unsigned)tid >> 31;
                        u32x4 w = (u32x4){z_, z_, z_, z_};
                        if (inside) { float v[8];
#pragma unroll
                            for (int e = 0; e < 8; ++e) v[e] = tl[(kh + q * 8 + e) * 257 + nn];
                            w.x = cvt_pk(v[0], v[1]); w.y = cvt_pk(v[2], v[3]); w.z = cvt_pk(v[4], v[5]); w.w = cvt_pk(v[6], v[7]); }
                        *(u32x4*)(dp + q * 8) = w;
                    }
                }
            }
            __syncthreads();
        }
        rot = (rot + ntile) % G;
    }
}
__device__ __forceinline__ float row_rstd(const f32x4 (&v)[4], int lane) {
    float s = 0.f;
#pragma unroll
    for (int i = 0; i < 4; ++i) s += (v[i][0] * v[i][0] + v[i][1] * v[i][1]) + (v[i][2] * v[i][2] + v[i][3] * v[i][3]);
    s = wave_sum(s, lane);
    return __builtin_amdgcn_rsqf(s * (1.f / D) + RMS_EPS);
}

__device__ __forceinline__ void assemble_x(KP p, int tid, int bid, int G) {
    const int lane = tid & 63, gw = bid * 8 + (tid >> 6), nw = G * 8;
    float* X = (float*)(p->ws + W_X); bf16_t* XN = (bf16_t*)(p->ws + W_XN); const float* g = p->in[7];
    for (int row = gw; row < MP; row += nw) {
        f32x4 v[4];
        const float* src = nullptr;
        if (row < MPR) { const int b = row / TP, t = row - b * TP; src = t < NMETA ? p->in[6] + (size_t)t * D : p->in[0] + ((size_t)b * SEQP + (t - NMETA)) * D; }
        else if (row < MR) src = p->in[1] + (size_t)(row - MPR) * D;
#pragma unroll
        for (int i = 0; i < 4; ++i) { const float zf = __uint_as_float((unsigned)tid >> 31); v[i] = src ? *(const f32x4*)(src + lane * 4 + 256 * i) : (f32x4){zf, zf, zf, zf}; }
        const float rs = row_rstd(v, lane);
#pragma unroll
        for (int i = 0; i < 4; ++i) { const int c = lane * 4 + 256 * i; *(f32x4*)(X + (size_t)row * D + c) = v[i]; store_bf4(XN + (size_t)row * D + c, v[i] * rs * *(const f32x4*)(g + c)); }
    }
}
__device__ __forceinline__ void norm_phase(KP p, const float* g, int tid, int bid, int G, bool copy_y = false) {
    const int lane = tid & 63, gw = bid * 8 + (tid >> 6), nw = G * 8;
    const float* X = (const float*)(p->ws + W_X); bf16_t* XN = (bf16_t*)(p->ws + W_XN);
    for (int row = gw; row < MP; row += nw) {
        f32x4 v[4];
#pragma unroll
        for (int i = 0; i < 4; ++i) v[i] = *(const f32x4*)(X + (size_t)row * D + lane * 4 + 256 * i);
        const float rs = row_rstd(v, lane);
#pragma unroll
        for (int i = 0; i < 4; ++i) { const int c = lane * 4 + 256 * i; store_bf4(XN + (size_t)row * D + c, v[i] * rs * *(const f32x4*)(g + c)); }
        if (copy_y && row < MR) {
            float* dp = nullptr;
            if (row < MPR) { const int b = row / TP, t = row - b * TP; if (t >= NMETA) dp = p->out + O_YP + ((size_t)b * SEQP + (t - NMETA)) * D; }
            else dp = p->out + O_YS + (size_t)(row - MPR) * D;
            if (dp) {
#pragma unroll
                for (int i = 0; i < 4; ++i) *(f32x4*)(dp + lane * 4 + 256 * i) = v[i];
            }
        }
    }
}
__device__ __forceinline__ void mixprep_phase(KP p, int tid, int bid, int G) {
    const int lane = tid & 63, gw = bid * 8 + (tid >> 6), nw = G * 8;
    const float* X = (const float*)(p->ws + W_X); bf16_t* A = (bf16_t*)(p->ws + W_AALL);
    const float* g = p->in[10]; const float* mu = p->in[11];
    for (int row = gw; row < MR; row += nw) {
        int grp, b, t; row_bt(row, grp, b, t);
        f32x4 v[4], pv[4];
#pragma unroll
        for (int i = 0; i < 4; ++i) v[i] = *(const f32x4*)(X + (size_t)row * D + lane * 4 + 256 * i);
        const float rs = row_rstd(v, lane);
        if (t > 0) {
#pragma unroll
            for (int i = 0; i < 4; ++i) pv[i] = *(const f32x4*)(X + (size_t)(row - 1) * D + lane * 4 + 256 * i);
            const float rp = row_rstd(pv, lane);
#pragma unroll
            for (int i = 0; i < 4; ++i) pv[i] = pv[i] * rp * *(const f32x4*)(g + lane * 4 + 256 * i);
        } else {
#pragma unroll
            for (int i = 0; i < 4; ++i) { const float zf = __uint_as_float((unsigned)tid >> 31); pv[i] = grp == 0 ? (f32x4){zf, zf, zf, zf} : *(const f32x4*)(p->in[3] + (size_t)b * D + lane * 4 + 256 * i); }
        }
        const bool last = t == (grp == 0 ? TP - 1 : TS - 1);
        float* sh = grp == 0 ? p->out + O_SHP + (size_t)b * D : p->out + O_SHS + (size_t)b * D;
#pragma unroll
        for (int i = 0; i < 4; ++i) {
            const int c = lane * 4 + 256 * i; const size_t o = (size_t)row * D + c;
            const f32x4 h = v[i] * rs * *(const f32x4*)(g + c), dx = pv[i] - h;
            store_bf4(A + o, h + dx * *(const f32x4*)(mu + c));
            store_bf4(A + (size_t)MP * D + o, h + dx * *(const f32x4*)(mu + 2 * D + c));
            store_bf4(A + (size_t)2 * MP * D + o, h + dx * *(const f32x4*)(mu + 3 * D + c));
            store_bf4(A + (size_t)3 * MP * D + o, h);
            store_bf4(A + (size_t)4 * MP * D + o, pv[i]);
            if (last) *(f32x4*)(sh + c) = h;
        }
    }
}
__device__ __forceinline__ void act_phase(KP p, int gtid, int nthr) {
    const float* L1 = (const float*)(p->ws + W_L1); bf16_t* A2 = (bf16_t*)(p->ws + W_A2);
    for (int i = gtid; i < MP * 64; i += nthr) {
        const int c = (i & 63) * 4;
        f32x4 v = *(const f32x4*)(L1 + (size_t)i * 4) + *(const f32x4*)(L1 + (size_t)MP * 256 + (size_t)i * 4);
        if (c < 64) {
#pragma unroll
            for (int j = 0; j < 4; ++j) v[j] = 1.f - 2.f * __builtin_amdgcn_rcpf(1.f + __expf(2.f * v[j]));
        } else if (c >= 128) {
#pragma unroll
            for (int j = 0; j < 4; ++j) v[j] = sigmoidf_(v[j]);
        }
        store_bf4(A2 + (size_t)i * 4, v);
    }
}

__device__ __forceinline__ float dpp_sum16(float x) {
    x += __builtin_bit_cast(float, __builtin_amdgcn_update_dpp(0, __builtin_bit_cast(int, x), 0xB1, 0xF, 0xF, true));
    x += __builtin_bit_cast(float, __builtin_amdgcn_update_dpp(0, __builtin_bit_cast(int, x), 0x4E, 0xF, 0xF, true));
    x += __builtin_bit_cast(float, __builtin_amdgcn_update_dpp(0, __builtin_bit_cast(int, x), 0x141, 0xF, 0xF, true));
    x += __builtin_bit_cast(float, __builtin_amdgcn_update_dpp(0, __builtin_bit_cast(int, x), 0x140, 0xF, 0xF, true));
    return x;
}
constexpr int SC_CH = 16, SC_STR = 400;
__device__ __forceinline__ void scan_phase(KP p, LAS float* buf, int tid, int bid, int G) {
    const int wid = tid >> 6, lane = tid & 63;
    const bf16_t* RKV = (const bf16_t*)(p->ws + W_RKV); const bf16_t* DEC = (const bf16_t*)(p->ws + W_DEC); const bf16_t* AA = (const bf16_t*)(p->ws + W_AA);
    float* SO = (float*)(p->ws + W_SO);
    const bool producer = wid >= 4;
    for (int u = bid; u < 768; u += G) {
        int bh, half, T, row0; const float* S0; float* Sout;
        if (u < 256) { bh = u >> 1; half = u & 1; T = TP; row0 = (bh >> 4) * TP; S0 = nullptr; Sout = p->out + O_SP + (size_t)bh * 4096; }
        else { const int v = u - 256; bh = v >> 1; half = v & 1; T = TS; row0 = MPR + (bh >> 4) * TS; S0 = p->in[2] + (size_t)bh * 4096; Sout = p->out + O_SS + (size_t)bh * 4096; }
        const int h = bh & 15, nchunk = T / SC_CH;
        if (producer) {
            const int t2 = tid - 256, pi = t2 >> 4, pj = t2 & 15, kc = h * 64 + 4 * pj;
            const f32x4 kkv = *(const f32x4*)(p->in[21] + kc), kav = *(const f32x4*)(p->in[22] + kc), w0v = *(const f32x4*)(p->in[13] + kc), a0v = *(const f32x4*)(p->in[16] + kc);
            u32x2 pr, pk, pvv, pa, pd;
#define SC_LOAD(c) do { const size_t o = (size_t)(row0 + (c) * SC_CH + pi) * D + kc; pr = *(const u32x2*)(RKV + o); pk = *(const u32x2*)(RKV + (size_t)MP * D + o); \
            pvv = *(const u32x2*)(RKV + (size_t)2 * MP * D + o); pa = *(const u32x2*)(AA + o); pd = *(const u32x2*)(DEC + o); } while (0)
#define SC_STORE(bi) do { LAS float* rec = buf + (bi) * (SC_CH * SC_STR) + pi * SC_STR; \
            const f32x4 r = (f32x4){bf_lo(pr.x), bf_hi(pr.x), bf_lo(pr.y), bf_hi(pr.y)}, k = (f32x4){bf_lo(pk.x), bf_hi(pk.x), bf_lo(pk.y), bf_hi(pk.y)}; \
            const f32x4 v = (f32x4){bf_lo(pvv.x), bf_hi(pvv.x), bf_lo(pvv.y), bf_hi(pvv.y)}; \
            f32x4 a = (f32x4){bf_lo(pa.x), bf_hi(pa.x), bf_lo(pa.y), bf_hi(pa.y)} + a0v; f32x4 w = (f32x4){bf_lo(pd.x), bf_hi(pd.x), bf_lo(pd.y), bf_hi(pd.y)} + w0v; \
            _Pragma("unroll") for (int j = 0; j < 4; ++j) { a[j] = sigmoidf_(a[j]); w[j] = __expf(-__expf(-softplusf_(-w[j]) - 0.5f)); } \
            const f32x4 q = k * kkv; float ss = (q[0] * q[0] + q[1] * q[1]) + (q[2] * q[2] + q[3] * q[3]); ss = dpp_sum16(ss); \
            const float inv = 1.f / fmaxf(sqrtf(ss), 1e-12f); const f32x4 nk = q * inv; \
            const f32x4 kp = k * (1.f + (a - 1.f) * kav), bb = nk * a; \
            float br = (bb[0] * r[0] + bb[1] * r[1]) + (bb[2] * r[2] + bb[3] * r[3]), kr = (kp[0] * r[0] + kp[1] * r[1]) + (kp[2] * r[2] + kp[3] * r[3]); \
            br = dpp_sum16(br); kr = dpp_sum16(kr); \
            *(LAS f32x4*)(rec + 4 * pj) = w; *(LAS f32x4*)(rec + 64 + 4 * pj) = nk; *(LAS f32x4*)(rec + 128 + 4 * pj) = bb; \
            *(LAS f32x4*)(rec + 192 + 4 * pj) = kp; *(LAS f32x4*)(rec + 256 + 4 * pj) = w * r; *(LAS f32x4*)(rec + 320 + 4 * pj) = v; \
            if (pj == 0) *(LAS f32x2*)(rec + 384) = (f32x2){br, kr}; } while (0)
            SC_LOAD(0); SC_STORE(0);
            if (nchunk > 1) SC_LOAD(1);
            __syncthreads();
            for (int c = 0; c < nchunk; ++c) {
                if (c + 1 < nchunk) { SC_STORE((c + 1) & 1); if (c + 2 < nchunk) SC_LOAD(c + 2); }
                __syncthreads();
            }
#undef SC_LOAD
#undef SC_STORE
        } else {
            const int rp = lane >> 4, kq = lane & 15, vA = half * 32 + wid * 8 + rp * 2;
            f32x4 sA = (f32x4){0.f, 0.f, 0.f, 0.f}, sB = sA;
            if (S0) { sA = *(const f32x4*)(S0 + vA * 64 + kq * 4); sB = *(const f32x4*)(S0 + (vA + 1) * 64 + kq * 4); }
            float* op = SO + (size_t)(row0 + kq) * D + h * 64 + vA;
            __syncthreads();
            for (int c = 0; c < nchunk; ++c) {
                const LAS float* cb = buf + (c & 1) * (SC_CH * SC_STR);
                float oA = 0.f, oB = 0.f;
#pragma unroll
                for (int i = 0; i < SC_CH; ++i) {
                    const LAS float* rec = cb + i * SC_STR;
                    const f32x4 wd = *(const LAS f32x4*)(rec + kq * 4), kk = *(const LAS f32x4*)(rec + 64 + kq * 4), bb = *(const LAS f32x4*)(rec + 128 + kq * 4),
                                kp = *(const LAS f32x4*)(rec + 192 + kq * 4), wr = *(const LAS f32x4*)(rec + 256 + kq * 4);
                    const f32x2 vv = *(const LAS f32x2*)(rec + 320 + vA), sc = *(const LAS f32x2*)(rec + 384);
                    float d1A = (sA[0] * kk[0] + sA[1] * kk[1]) + (sA[2] * kk[2] + sA[3] * kk[3]);
                    float d1B = (sB[0] * kk[0] + sB[1] * kk[1]) + (sB[2] * kk[2] + sB[3] * kk[3]);
                    float d2A = (sA[0] * wr[0] + sA[1] * wr[1]) + (sA[2] * wr[2] + sA[3] * wr[3]);
                    float d2B = (sB[0] * wr[0] + sB[1] * wr[1]) + (sB[2] * wr[2] + sB[3] * wr[3]);
                    d1A = dpp_sum16(d1A); d1B = dpp_sum16(d1B); d2A = dpp_sum16(d2A); d2B = dpp_sum16(d2B);
                    const float saA = -d1A, saB = -d1B;
                    const float tA = d2A + saA * sc.x + vv.x * sc.y, tB = d2B + saB * sc.x + vv.y * sc.y;
                    sA = sA * wd + bb * saA + kp * vv.x;
                    sB = sB * wd + bb * saB + kp * vv.y;
                    oA = kq == i ? tA : oA; oB = kq == i ? tB : oB;
                }
                *(f32x2*)(op + (size_t)c * SC_CH * D) = (f32x2){oA, oB};
                __syncthreads();
            }
            *(f32x4*)(Sout + vA * 64 + kq * 4) = sA; *(f32x4*)(Sout + (vA + 1) * 64 + kq * 4) = sB;
        }
    }
}
__device__ __forceinline__ void post_phase(KP p, int tid, int bid, int G) {
    const int lane = tid & 63, gw = bid * 8 + (tid >> 6), nw = G * 8;
    const bf16_t* RKV = (const bf16_t*)(p->ws + W_RKV); const bf16_t* AA = (const bf16_t*)(p->ws + W_AA); const bf16_t* GG = (const bf16_t*)(p->ws + W_GG);
    const float* SO = (const float*)(p->ws + W_SO); bf16_t* OG = (bf16_t*)(p->ws + W_OG);
    const float* k_a = p->in[22]; const float* a0p = p->in[16]; const float* r_k = p->in[23]; const float* gnw = p->in[24]; const float* gnb = p->in[25];
    const int c0 = lane * 16;
    for (int row = gw; row < MR; row += nw) {
        const size_t o = (size_t)row * D + c0;
        float ov[16], rv[16], kv[16], vv[16], av[16], gv[16];
#pragma unroll
        for (int q = 0; q < 4; ++q) { const f32x4 x = *(const f32x4*)(SO + o + 4 * q); ov[4 * q] = x[0]; ov[4 * q + 1] = x[1]; ov[4 * q + 2] = x[2]; ov[4 * q + 3] = x[3]; }
#define LD16(dst, ptr) do { const u32x4 a_ = *(const u32x4*)(ptr), b_ = *(const u32x4*)((ptr) + 8); \
        dst[0] = bf_lo(a_.x); dst[1] = bf_hi(a_.x); dst[2] = bf_lo(a_.y); dst[3] = bf_hi(a_.y); dst[4] = bf_lo(a_.z); dst[5] = bf_hi(a_.z); dst[6] = bf_lo(a_.w); dst[7] = bf_hi(a_.w); \
        dst[8] = bf_lo(b_.x); dst[9] = bf_hi(b_.x); dst[10] = bf_lo(b_.y); dst[11] = bf_hi(b_.y); dst[12] = bf_lo(b_.z); dst[13] = bf_hi(b_.z); dst[14] = bf_lo(b_.w); dst[15] = bf_hi(b_.w); } while (0)
        LD16(rv, RKV + o); LD16(kv, RKV + (size_t)MP * D + o); LD16(vv, RKV + (size_t)2 * MP * D + o); LD16(av, AA + o); LD16(gv, GG + o);
#undef LD16
        float sm = 0.f, rk = 0.f;
#pragma unroll
        for (int e = 0; e < 16; ++e) { sm += ov[e]; const float kp = kv[e] * (1.f + (sigmoidf_(a0p[c0 + e] + av[e]) - 1.f) * k_a[c0 + e]); rk += rv[e] * kp * r_k[c0 + e]; }
        sm += shx(sm, 1, lane); sm += shx(sm, 2, lane); rk += shx(rk, 1, lane); rk += shx(rk, 2, lane);
        const float mean = sm * (1.f / 64.f);
        float vs = 0.f;
#pragma unroll
        for (int e = 0; e < 16; ++e) { const float d = ov[e] - mean; vs += d * d; }
        vs += shx(vs, 1, lane); vs += shx(vs, 2, lane);
        const float rstd = __builtin_amdgcn_rsqf(vs * (1.f / 64.f) + GN_EPS);
        unsigned w[8];
#pragma unroll
        for (int e = 0; e < 16; e += 2) {
            const float y0 = ((ov[e] - mean) * rstd * gnw[c0 + e] + gnb[c0 + e] + rk * vv[e]) * gv[e];
            const float y1 = ((ov[e + 1] - mean) * rstd * gnw[c0 + e + 1] + gnb[c0 + e + 1] + rk * vv[e + 1]) * gv[e + 1];
            w[e >> 1] = cvt_pk(y0, y1);
        }
        *(u32x4*)(OG + o) = (u32x4){w[0], w[1], w[2], w[3]}; *(u32x4*)(OG + o + 8) = (u32x4){w[4], w[5], w[6], w[7]};
    }
}

__device__ __forceinline__ int crow(int r, int hi) { return (r & 3) + 8 * (r >> 2) + 4 * hi; }
__device__ __forceinline__ bf16x8 pack8(f32x4 a, f32x4 b) {
    u32x4 w; w.x = cvt_pk(a[0], a[1]); w.y = cvt_pk(a[2], a[3]); w.z = cvt_pk(b[0], b[1]); w.w = cvt_pk(b[2], b[3]);
    return __builtin_bit_cast(bf16x8, w);
}
__device__ __forceinline__ void attn_phase(KP p, int tid, int bid, int G) {
    const int lane = tid & 63, gw = bid * 8 + (tid >> 6), nw = G * 8;
    const bf16_t* QB = (const bf16_t*)(p->ws + W_QB); bf16_t* AO = (bf16_t*)(p->ws + W_OG);
    const int ql = lane & 31, hi = lane >> 5;
    constexpr int NU_P = BP * NH * 65;
    for (int u = gw; u < NU_P + BS * NH * 2; u += nw) {
        int bh, Q0, nq, npast, row_base, Tn; const float *kc, *vc, *kn, *vn;
        if (u < NU_P) { bh = u / 65; Q0 = (u - bh * 65) * 32; nq = min(32, TP - Q0); npast = 0; row_base = (bh >> 4) * TP; Tn = TP;
            kc = nullptr; vc = nullptr; kn = p->out + O_KP + (size_t)bh * TP * HD; vn = p->out + O_VP + (size_t)bh * TP * HD; }
        else { const int v = u - NU_P; bh = v >> 1; Q0 = (v & 1) * 32; nq = 32; npast = PAST; row_base = MPR + (bh >> 4) * TS; Tn = TS;
            kc = p->in[4] + (size_t)bh * PAST * HD; vc = p->in[5] + (size_t)bh * PAST * HD; kn = p->out + O_KS + (size_t)bh * TS * HD; vn = p->out + O_VS + (size_t)bh * TS * HD; }
        const int h = bh & 15, qpos0 = npast + Q0;
        bf16x8 qf[4];
        { const bf16_t* qp = QB + (size_t)(row_base + Q0 + min(ql, nq - 1)) * D + h * 64 + hi * 8;
#pragma unroll
          for (int s = 0; s < 4; ++s) qf[s] = *(const bf16x8*)(qp + 16 * s); }
        f32x16 o0, o1;
#pragma unroll
        for (int r = 0; r < 16; ++r) { o0[r] = 0.f; o1[r] = 0.f; }
        float carry = ql < nq ? 0.f : -1e30f;
        const int qpos = qpos0 + ql;
        f32x4 kc4[8];
#define ATT_TILE_PTRS(P0_, kb_, vb_, lim_) const bool inpast_ = (P0_) < npast; \
            const float* kb_ = inpast_ ? kc + (size_t)(P0_) * HD : kn + (size_t)((P0_) - npast) * HD; \
            const float* vb_ = inpast_ ? vc + (size_t)(P0_) * HD : vn + (size_t)((P0_) - npast) * HD; \
            const int lim_ = inpast_ ? 31 : min(31, Tn - 1 - ((P0_) - npast));
        { ATT_TILE_PTRS((qpos0 >> 5) * 32, kb0, vb0, lim0); (void)vb0;
          const float* kp = kb0 + (size_t)min(ql, lim0) * HD + hi * 8;
#pragma unroll
          for (int s = 0; s < 4; ++s) { kc4[2 * s] = *(const f32x4*)(kp + 16 * s); kc4[2 * s + 1] = *(const f32x4*)(kp + 16 * s + 4); } }
        for (int kt = qpos0 >> 5; kt >= 0; --kt) {
            const int P0 = kt * 32;
            ATT_TILE_PTRS(P0, kb, vb, lim); (void)kb;
            float x0[16], x1[16];
#pragma unroll
            for (int r = 0; r < 16; ++r) { const float* vp = vb + (size_t)min(crow(r, hi), lim) * HD + ql; x0[r] = vp[0]; x1[r] = vp[32]; }
            f32x4 kn4[8];
            { const int Pn = kt > 0 ? P0 - 32 : P0; ATT_TILE_PTRS(Pn, kbn, vbn, limn); (void)vbn;
              const float* kp = kbn + (size_t)min(ql, limn) * HD + hi * 8;
#pragma unroll
              for (int s = 0; s < 4; ++s) { kn4[2 * s] = *(const f32x4*)(kp + 16 * s); kn4[2 * s + 1] = *(const f32x4*)(kp + 16 * s + 4); } }
            f32x16 st;
#pragma unroll
            for (int r = 0; r < 16; ++r) st[r] = 0.f;
#pragma unroll
            for (int s = 0; s < 4; ++s) st = __builtin_amdgcn_mfma_f32_32x32x16_bf16(pack8(kc4[2 * s], kc4[2 * s + 1]), qf[s], st, 0, 0, 0);
            float L[16];
            float own[4];
#pragma unroll
            for (int g = 0; g < 4; ++g) { float sg = 0.f;
#pragma unroll
                for (int i = 0; i < 4; ++i) { const int r = 4 * g + i; const bool vis = (P0 + crow(r, hi)) < qpos; L[r] = vis ? -softplusf_(st[r]) : 0.f; sg += L[r]; }
                own[g] = sg; }
            float oth[4];
#pragma unroll
            for (int g = 0; g < 4; ++g) oth[g] = shx(own[g], 32, lane);
            float suf = carry;
            float A[16];
#pragma unroll
            for (int g = 3; g >= 0; --g) {
                float c = suf + (hi == 0 ? oth[g] : 0.f);
#pragma unroll
                for (int i = 3; i >= 0; --i) { const int r = 4 * g + i; c += L[r]; const bool vis = (P0 + crow(r, hi)) < qpos; A[r] = vis ? __expf(st[r] + c) : 0.f; }
                suf += own[g] + oth[g];
            }
            carry = suf;
            const bf16x8 pa0 = pack8((f32x4){A[0], A[1], A[2], A[3]}, (f32x4){A[4], A[5], A[6], A[7]});
            const bf16x8 pa1 = pack8((f32x4){A[8], A[9], A[10], A[11]}, (f32x4){A[12], A[13], A[14], A[15]});
            o0 = __builtin_amdgcn_mfma_f32_32x32x16_bf16(pa0, pack8((f32x4){x0[0], x0[1], x0[2], x0[3]}, (f32x4){x0[4], x0[5], x0[6], x0[7]}), o0, 0, 0, 0);
            o1 = __builtin_amdgcn_mfma_f32_32x32x16_bf16(pa0, pack8((f32x4){x1[0], x1[1], x1[2], x1[3]}, (f32x4){x1[4], x1[5], x1[6], x1[7]}), o1, 0, 0, 0);
            o0 = __builtin_amdgcn_mfma_f32_32x32x16_bf16(pa1, pack8((f32x4){x0[8], x0[9], x0[10], x0[11]}, (f32x4){x0[12], x0[13], x0[14], x0[15]}), o0, 0, 0, 0);
            o1 = __builtin_amdgcn_mfma_f32_32x32x16_bf16(pa1, pack8((f32x4){x1[8], x1[9], x1[10], x1[11]}, (f32x4){x1[12], x1[13], x1[14], x1[15]}), o1, 0, 0, 0);
#pragma unroll
            for (int e = 0; e < 8; ++e) kc4[e] = kn4[e];
            if (!__any(carry >= -104.f)) break;
        }
#undef ATT_TILE_PTRS
        bf16_t* op = AO + (size_t)(row_base + Q0) * D + h * 64 + ql;
#pragma unroll
        for (int r = 0; r < 16; ++r) { const int qr = crow(r, hi); if (qr < nq) { op[(size_t)qr * D] = (bf16_t)(cvt_pk(o0[r], 0.f) & 0xffffu); op[(size_t)qr * D + 32] = (bf16_t)(cvt_pk(o1[r], 0.f) & 0xffffu); } }
    }
}

constexpr int NPHASE = 23;
#ifndef PHM
#define PHM 0xffff
#endif
#define EN(k) (((PHM) >> (k)) & 1)
constexpr int LDS_BYTES = 131072 + 8 * 576 * 4;
template <class Epi, class Sched>
__device__ __forceinline__ void run_gemm(LAS unsigned char* lds, int wb, const bf16_t* A, const bf16_t* Bt, int M, int N, int K, const Sched S, const Epi E) {
    pg8::Gemm g{A, Bt, M, N, K, wb};
    pg8::gemm_phase<Epi, Sched, true, true>(lds, g, S, E);
}
__global__ void __launch_bounds__(512, 2) mega(Params p_unused) {
    LAS unsigned char* lds = (LAS unsigned char*)lds_raw;
    cg::grid_group grid = cg::this_grid();
    KP p = (KP)__builtin_amdgcn_kernarg_segment_ptr();
    const int ph_lo = p->ph_lo, ph_hi = p->ph_hi;
    const int wb = __builtin_amdgcn_readfirstlane((int)threadIdx.x) & ~63;
    for (int pi_ = ph_lo; pi_ < ph_hi; ++pi_) {
        asm volatile("" ::: "v1","v2","v3","v4","v5","v6","v7","v8","v9","v10","v11","v12","v13","v14","v15","v16","v17","v18","v19","v20","v21","v22","v23","v24","v25","v26","v27","v28","v29","v30","v31","v32","v33","v34","v35","v36","v37","v38","v39","v40","v41","v42","v43","v44","v45","v46","v47","v48","v49","v50","v51","v52","v53","v54","v55","v56","v57","v58","v59","v60","v61","v62","v63","v64","v65","v66","v67","v68","v69","v70","v71","v72","v73","v74","v75","v76","v77","v78","v79","v80","v81","v82","v83","v84","v85","v86","v87","v88","v89","v90","v91","v92","v93","v94","v95","v96","v97","v98","v99","v100","v101","v102","v103","v104","v105","v106","v107","v108","v109","v110","v111","v112","v113","v114","v115","v116","v117","v118","v119","v120","v121","v122","v123","v124","v125","v126","v127","v128","v129","v130","v131","v132","v133","v134","v135","v136","v137","v138","v139","v140","v141","v142","v143","v144","v145","v146","v147","v148","v149","v150","v151","v152","v153","v154","v155","v156","v157","v158","v159","v160","v161","v162","v163","v164","v165","v166","v167","v168","v169","v170","v171","v172","v173","v174","v175","v176","v177","v178","v179","v180","v181","v182","v183","v184","v185","v186","v187","v188","v189","v190","v191","v192","v193","v194","v195","v196","v197","v198","v199","v200","v201","v202","v203","v204","v205","v206","v207","v208","v209","v210","v211","v212","v213","v214","v215","v216","v217","v218","v219","v220","v221","v222","v223","v224","v225","v226","v227","v228","v229","v230","v231","v232","v233","v234","v235","v236","v237","v238","v239","v240","v241","v242","v243","v244","v245","v246","v247","v248","v249");
        asm volatile("" : "+s"(p));
        const int phc = p->seq[pi_], ph = phc & 63; const bool dry = (phc & 64) != 0;
        int bid = blockIdx.x, G = gridDim.x;
        asm volatile("" : "+s"(bid), "+s"(G));
#define TID_HERE (wb + lane_now())
        int ffn = -1; bool ffn_in = false;
        if (ph == 1 || ph == 2) { ffn = 0; ffn_in = ph == 1; } else if (ph == 11 || ph == 12) { ffn = 1; ffn_in = ph == 11; }
        else if (ph == 14 || ph == 15) { ffn = 2; ffn_in = ph == 14; } else if (ph == 21 || ph == 22) { ffn = 3; ffn_in = ph == 21; }
        if (EN(0) && ph == 0) { { const int tid = TID_HERE; convert_weights(p, (LAS float*)lds, tid, bid, G); assemble_x(p, tid, bid, G); } }
        else if (EN(1) && ffn >= 0 && ffn_in) {
            pg8::StaticOrder S; S.init(MP, NIN, G, bid); S.nt0 = D / 64;
            unsigned char* ws = p->ws; EpiSwiGLU E{(bf16_t*)(ws + W_HB)};
            run_gemm(lds, wb, (const bf16_t*)(ws + W_XN), (const bf16_t*)(ws + W_WIN + ffn * SZ_WIN1), MP, NIN, D, S, E);
        } else if (EN(2) && ffn >= 0) {
            TailOrder S; S.init(MP, D, DFFP, G, bid, false);
            unsigned char* ws = p->ws; EpiRes E{(float*)(ws + W_X), dry ? 0.f : 0.5f, (ffn == 3 && !dry) ? p->out : nullptr};
            run_gemm(lds, wb, (const bf16_t*)(ws + W_HB), (const bf16_t*)(ws + W_WOUT + ffn * SZ_WOUT1), MP, D, DFFP, S, E);
        }
        else if (EN(3) && ph == 3) mixprep_phase(p, TID_HERE, bid, G);
        else if (EN(4) && ph == 4) {
            G1Order S{G, bid};
            unsigned char* ws = p->ws; EpiG1 E{(bf16_t*)(ws + W_RKV), (float*)(ws + W_L1)};
            run_gemm(lds, wb, (const bf16_t*)(ws + W_AALL), (const bf16_t*)(ws + W_WG1), 5 * MP, 3584, D, S, E);
        }
        else if (EN(5) && ph == 5) act_phase(p, bid * 512 + TID_HERE, G * 512);
        else if (EN(6) && ph == 6) {
            pg8::StaticOrder S; S.init(MP, 3072, G, bid); S.nt0 = 4;
            unsigned char* ws = p->ws; EpiG2 E{(bf16_t*)(ws + W_DEC)};
            run_gemm(lds, wb, (const bf16_t*)(ws + W_A2), (const bf16_t*)(ws + W_WL2), MP, 3072, 256, S, E);
        }
        else if (EN(7) && ph == 7) scan_phase(p, (LAS float*)lds, TID_HERE, bid, G);
        else if (EN(8) && ph == 8) post_phase(p, TID_HERE, bid, G);
        else if (EN(9) && (ph == 9 || ph == 19)) {
            TailOrder S; S.init(MP, D, D, G, bid, false);
            unsigned char* ws = p->ws; EpiRes E{(float*)(ws + W_X), dry ? 0.f : 1.0f, nullptr};
            run_gemm(lds, wb, (const bf16_t*)(ws + W_OG), (const bf16_t*)(ws + (ph == 9 ? W_WO1 : W_WO2)), MP, D, D, S, E);
        }
        else if (EN(10) && ph == 10) norm_phase(p, p->in[7] + D, TID_HERE, bid, G);
        else if (EN(10) && ph == 13) norm_phase(p, p->in[7] + 2 * D, TID_HERE, bid, G);
        else if (EN(10) && ph == 16) norm_phase(p, p->in[10] + D, TID_HERE, bid, G);
        else if (EN(11) && ph == 17) {
            pg8::StaticOrder S; S.init(MP, 3 * D, G, bid); S.nt0 = D / 64;
            unsigned char* ws = p->ws; EpiQKV E{(bf16_t*)(ws + W_QB), p->out, p->in[28], p->in[29]};
            run_gemm(lds, wb, (const bf16_t*)(ws + W_XN), (const bf16_t*)(ws + W_WQKV), MP, 3 * D, D, S, E);
        }
        else if (EN(12) && ph == 18) attn_phase(p, TID_HERE, bid, G);
        else if (EN(10) && ph == 20) norm_phase(p, p->in[7] + 3 * D, TID_HERE, bid, G, true);
        if (pi_ + 1 < ph_hi) grid.sync();
    }
}

#ifndef ONE_LAUNCH
#define ONE_LAUNCH 1
#endif
extern "C" void kernel_launch(void* const* d_in, const int* in_sizes, int n_in, void* d_out, int out_size, void* d_ws, size_t ws_size, hipStream_t stream) {
    static int grid = 0;
    if (grid == 0) {
        if (n_in != 31 || (size_t)out_size != O_END || ws_size < W_END) { fprintf(stderr, "kernel_launch: unexpected sizes (n_in %d out %d ws %zu need %zu)\n", n_in, out_size, ws_size, (size_t)W_END); grid = -1; return; }
        int dev = 0, cus = 0, per_cu = 0;
        hipGetDevice(&dev); hipDeviceGetAttribute(&cus, hipDeviceAttributeMultiprocessorCount, dev);
        if (hipFuncSetAttribute((const void*)mega, hipFuncAttributeMaxDynamicSharedMemorySize, LDS_BYTES) != hipSuccess) { fprintf(stderr, "kernel_launch: hipFuncSetAttribute failed\n"); grid = -1; return; }
        hipOccupancyMaxActiveBlocksPerMultiprocessor(&per_cu, (const void*)mega, 512, LDS_BYTES);
        (void)hipGetLastError();
        if (per_cu < 1) per_cu = 1;
        grid = cus * per_cu;
    }
    if (grid < 0) return;
    Params p{};
    for (int i = 0; i < 31; ++i) p.in[i] = (const float*)d_in[i];
    p.out = (float*)d_out; p.ws = (unsigned char*)d_ws;
    int nseq = 0;
    for (int ph = 0; ph < NPHASE; ++ph) {
        p.seq[nseq++] = ph;
#ifdef REP_OF
        for (int r = 0; r < (REP_OF(ph)); ++r) p.seq[nseq++] = (ph | ((ph == 2 || ph == 9) ? 64 : 0));
#endif
    }
#if ONE_LAUNCH
    p.ph_lo = 0; p.ph_hi = nseq;
    void* args[] = {&p};
    hipError_t e = hipLaunchCooperativeKernel((const void*)mega, dim3(grid), dim3(512), args, LDS_BYTES, stream);
    if (e != hipSuccess) fprintf(stderr, "cooperative launch failed: %s (grid %d)\n", hipGetErrorString(e), grid);
#else
    for (int ph = 0; ph < nseq; ++ph) { p.ph_lo = ph; p.ph_hi = ph + 1; hipLaunchKernelGGL(mega, dim3(grid), dim3(512), LDS_BYTES, stream, p); }
#endif
}
```

```cpp
#include <hip/hip_runtime.h>
#include <hip/hip_cooperative_groups.h>
#include <cstdio>
#include <cstdint>
namespace cg = cooperative_groups;
__device__ __forceinline__ int lane_now() { int l; asm volatile("v_mbcnt_lo_u32_b32 %0, -1, 0\n\tv_mbcnt_hi_u32_b32 %0, -1, %0" : "=v"(l)); return l; }
namespace pg8 {
#define PG8_LAS __attribute__((address_space(3)))
typedef unsigned short bf16_t;
typedef short bf16x8 __attribute__((ext_vector_type(8)));
typedef float f32x4 __attribute__((ext_vector_type(4)));
typedef unsigned u32x4 __attribute__((ext_vector_type(4)));
constexpr int BM = 256, BK = 64, HALF = 128, HTB = HALF * BK * 2  , STAGE_BYTES = 8 * HTB, NXCD = 8, WGM = 8;

__host__ __device__ __forceinline__ int lds_byte(int r, int c) { const int st = (r >> 4) * 2 + (c >> 5), rr = r & 15, cc = c & 31, ob = rr * 64 + cc * 2; return st * 1024 + (ob ^ (((ob >> 9) & 1) << 5)); }
__host__ __device__ __forceinline__ void stage_rc(int b, int& R, int& C) { const int st = b / 1024, sb = b % 1024, swz = sb ^ (((sb >> 9) & 1) << 5); R = (st >> 1) * 16 + swz / 64; C = (st & 1) * 32 + (swz % 64) / 2; }
__host__ __device__ __forceinline__ int perm32(int rho) { const int n = rho >> 4, i = rho & 15; return 8 * (i >> 2) + 4 * n + (i & 3); }

struct Unit { int pm, pn, kb, nt, fl, tl; };
struct Gemm { const bf16_t* A; const bf16_t* Bt; int M, N, K, wb; float* skp; unsigned* skf; };

struct StaticOrder {
    static constexpr bool STREAM = false; int nM, nN, nwg, G, c, nt0;
    __host__ __device__ void init(int M, int N, int G_, int c_) { nM = M / BM; nN = N / BM; nwg = nM * nN; G = G_; c = c_; }
    __host__ __device__ bool next(int i, Unit& u) const {
        const long L = (long)i * G + c; if (L >= nwg) return false;
        int wgid = (int)L; { const int q = nwg / NXCD, r = nwg % NXCD, xcd = wgid % NXCD, off = wgid / NXCD; wgid = (xcd < r ? xcd * (q + 1) : r * (q + 1) + (xcd - r) * q) + off; }
        const int nig = WGM * nN, gid = wgid / nig, fm = gid * WGM, gsz = (nM - fm) < WGM ? (nM - fm) : WGM;
        u.pm = fm + ((wgid % nig) % gsz); u.pn = (wgid % nig) / gsz; u.kb = 0; u.nt = nt0; u.fl = 0; u.tl = 0; return true;
    }
    __device__ __forceinline__ void a_ready(const Unit&) const {}
    __device__ __forceinline__ void done(const Unit&) const {}
};
typedef __attribute__((address_space(1))) f32x4 gf32x4;
typedef unsigned long long u64_t;
__device__ __forceinline__ void streamk_store(const f32x4 (&acc)[2][2][4][2], const Unit& u, float* skp, unsigned* skf, int tid) {
    u64_t* q = (u64_t*)(skp + (size_t)u.tl * 65536) + 2 * tid;
#pragma unroll
    for (int a = 0; a < 2; ++a)
#pragma unroll
        for (int b = 0; b < 2; ++b)
#pragma unroll
            for (int m = 0; m < 4; ++m)
#pragma unroll
                for (int n = 0; n < 2; ++n) { const f32x4 v = acc[a][b][m][n];
                    __hip_atomic_store(q, ((u64_t)__float_as_uint(v[1]) << 32) | __float_as_uint(v[0]), __ATOMIC_RELAXED, __HIP_MEMORY_SCOPE_AGENT);
                    __hip_atomic_store(q + 1, ((u64_t)__float_as_uint(v[3]) << 32) | __float_as_uint(v[2]), __ATOMIC_RELAXED, __HIP_MEMORY_SCOPE_AGENT);
                    q += 1024; asm volatile("" : "+v"(q) :: "memory"); }
    asm volatile("s_waitcnt vmcnt(0)" ::: "memory");
    __builtin_amdgcn_s_barrier();
    if (tid == 0) __hip_atomic_store(skf + u.tl, 1u, __ATOMIC_RELAXED, __HIP_MEMORY_SCOPE_AGENT);
}
__device__ __forceinline__ const float* streamk_wait(const Unit& u, float* skp, unsigned* skf, int tid) {
    if (u.fl == 2) {
        if (tid == 0) { while (__hip_atomic_load(skf + u.tl, __ATOMIC_RELAXED, __HIP_MEMORY_SCOPE_AGENT) == 0u) __builtin_amdgcn_s_sleep(2); }
        __builtin_amdgcn_s_barrier();
        __builtin_amdgcn_fence(__ATOMIC_ACQUIRE, "agent");
    } else __builtin_amdgcn_s_barrier();
    return skp + (size_t)u.tl * 65536;
}
__device__ __forceinline__ f32x4 streamk_part(const float* part, int idx, int tid) {
    const u64_t* q = (const u64_t*)part + (size_t)idx * 1024 + 2 * tid;
    const u64_t a = __hip_atomic_load(q, __ATOMIC_RELAXED, __HIP_MEMORY_SCOPE_AGENT), b = __hip_atomic_load(q + 1, __ATOMIC_RELAXED, __HIP_MEMORY_SCOPE_AGENT);
    return (f32x4){__uint_as_float((unsigned)a), __uint_as_float((unsigned)(a >> 32)), __uint_as_float((unsigned)b), __uint_as_float((unsigned)(b >> 32))};
}
template <class Epi, class Sched, bool ALIGN_EPI = false, bool SP2 = false>
__device__ __forceinline__ void gemm_phase(PG8_LAS unsigned char* lds, const Gemm g, const Sched& S, const Epi& E) {
    int tid = g.wb + lane_now(); asm volatile("" : "+v"(tid)); const int wid = __builtin_amdgcn_readfirstlane(tid >> 6), lane = tid & 63, wr = wid >> 2, wc = wid & 3, fr = lane & 15, fq = lane >> 4;
    const int K = g.K, nt = K / BK;
    unsigned voffA[2], voffB[2];
#pragma unroll
    for (int i = 0; i < 2; ++i) { int R, C; stage_rc(tid * 16 + i * 8192, R, C); const int Rb = Epi::PERM ? ((R & ~31) + perm32(R & 31)) : R;
        voffA[i] = (unsigned)(R * K + C) * 2u; voffB[i] = (unsigned)(Rb * K + C) * 2u; }
    const size_t kstep = (size_t)(BK * 2);
    const size_t hstep = (size_t)HALF * K * 2;
    const size_t tstep = 2 * hstep;
    const unsigned ldsw = (unsigned)wid * 1024u;
    const int aoff = lds_byte(wr * 64 + fr, fq * 8), boff = lds_byte(wc * 32 + fr, fq * 8);
#define PG8_SA(b, h) (((b) * 2 + (h)) * HTB)
#define PG8_SB(b, h) ((4 + (b) * 2 + (h)) * HTB)
#define PG8_STAGE(bufoff, gbase, voff) do { _Pragma("unroll") for (int _i = 0; _i < 2; ++_i) \
        __builtin_amdgcn_global_load_lds((const unsigned*)((const char*)(gbase) + (voff)[_i]), (PG8_LAS unsigned*)(lds + (bufoff) + ldsw + _i * 8192), 16, 0, 0); } while (0)
#define PG8_LDA(dst, b, h) do { _Pragma("unroll") for (int m = 0; m < 4; ++m) _Pragma("unroll") for (int k = 0; k < 2; ++k) dst[m][k] = *(const PG8_LAS bf16x8*)(lds + PG8_SA(b, h) + aoff + m * 2048 + k * 1024); } while (0)
#define PG8_LDB(dst, b, h) do { _Pragma("unroll") for (int n = 0; n < 2; ++n) _Pragma("unroll") for (int k = 0; k < 2; ++k) dst[n][k] = *(const PG8_LAS bf16x8*)(lds + PG8_SB(b, h) + boff + n * 2048 + k * 1024); } while (0)
#define PG8_MMA(ai, bj, At, Bt) do { __builtin_amdgcn_s_setprio(1); _Pragma("unroll") for (int m = 0; m < 4; ++m) _Pragma("unroll") for (int n = 0; n < 2; ++n) _Pragma("unroll") for (int k = 0; k < 2; ++k) \
        acc[ai][bj][m][n] = __builtin_amdgcn_mfma_f32_16x16x32_bf16(Bt[n][k], At[m][k], acc[ai][bj][m][n], 0, 0, 0); __builtin_amdgcn_s_setprio(0); } while (0)
#define PG8_WAIT_V(n) asm volatile("s_waitcnt vmcnt(" #n ")" ::: "memory")
#define PG8_WAIT_L(n) asm volatile("s_waitcnt lgkmcnt(" #n ")" ::: "memory")
#define PG8_BAR __builtin_amdgcn_s_barrier()
#define PG8_SCHED __builtin_amdgcn_sched_barrier(0)
    Unit cur, nxt; int ui = 0;
    if (!S.next(0, cur)) return;
    f32x4 acc[2][2][4][2];
#pragma unroll
    for (int a = 0; a < 2; ++a)
#pragma unroll
        for (int b = 0; b < 2; ++b)
#pragma unroll
            for (int m = 0; m < 4; ++m)
#pragma unroll
                for (int n = 0; n < 2; ++n) acc[a][b][m][n] = (f32x4){0.f, 0.f, 0.f, 0.f};
    bf16x8 At[4][2], B0[2][2], B1[2][2];
    const char* cA = (const char*)g.A + (size_t)cur.pm * tstep + cur.kb; const char* cB = (const char*)g.Bt + (size_t)cur.pn * tstep + cur.kb;
    S.a_ready(cur);
    if constexpr (SP2) {
        PG8_STAGE(PG8_SB(0, 0), cB, voffB); PG8_STAGE(PG8_SB(0, 1), cB + hstep, voffB); PG8_STAGE(PG8_SA(0, 0), cA, voffA); PG8_STAGE(PG8_SA(0, 1), cA + hstep, voffA);
        if (wr == 1) PG8_BAR;
        PG8_WAIT_V(2); PG8_BAR;
        PG8_STAGE(PG8_SB(1, 0), cB + kstep, voffB); PG8_STAGE(PG8_SA(1, 0), cA + kstep, voffA); PG8_STAGE(PG8_SB(1, 1), cB + hstep + kstep, voffB);
        PG8_WAIT_V(6); PG8_BAR;
    } else {
        PG8_STAGE(PG8_SB(0, 0), cB, voffB); PG8_STAGE(PG8_SA(0, 0), cA, voffA); PG8_STAGE(PG8_SB(0, 1), cB + hstep, voffB); PG8_STAGE(PG8_SA(0, 1), cA + hstep, voffA);
        if (wr == 1) PG8_BAR;
        PG8_WAIT_V(4); PG8_BAR;
        PG8_STAGE(PG8_SB(1, 0), cB + kstep, voffB); PG8_STAGE(PG8_SA(1, 0), cA + kstep, voffA); PG8_STAGE(PG8_SB(1, 1), cB + hstep + kstep, voffB);
        PG8_WAIT_V(6); PG8_BAR;
    }
    for (;;) {
        const bool has_next = S.next(ui + 1, nxt);
        const char* nA = has_next ? (const char*)g.A + (size_t)nxt.pm * tstep + nxt.kb : cA; const char* nB = has_next ? (const char*)g.Bt + (size_t)nxt.pn * tstep + nxt.kb : cB;
        const int ntu = cur.nt;
        for (int t = 0; t < ntu; t += 2) {
            const bool last = (t == ntu - 2);
            const char* a1 = cA + (size_t)(t + 1) * kstep;
            const char* a2 = last ? nA : cA + (size_t)(t + 2) * kstep; const char* b2 = last ? nB : cB + (size_t)(t + 2) * kstep;
            const char* a3 = a2 + kstep; const char* b3 = b2 + kstep;
            if (last && has_next) S.a_ready(nxt);
            if constexpr (SP2) {
            PG8_LDB(B0, 0, 0); PG8_LDB(B1, 0, 1); PG8_SCHED; PG8_LDA(At, 0, 0); PG8_STAGE(PG8_SA(1, 1), a1 + hstep, voffA);
            PG8_WAIT_V(8); PG8_WAIT_L(0); PG8_BAR; PG8_MMA(0, 0, At, B0); PG8_MMA(0, 1, At, B1); PG8_BAR; PG8_SCHED;
            PG8_LDA(At, 0, 1); PG8_STAGE(PG8_SB(0, 0), b2, voffB); PG8_STAGE(PG8_SB(0, 1), b2 + hstep, voffB); PG8_STAGE(PG8_SA(0, 0), a2, voffA);
            PG8_WAIT_V(8); PG8_WAIT_L(0); PG8_BAR; PG8_MMA(1, 0, At, B0); PG8_MMA(1, 1, At, B1); PG8_BAR; PG8_SCHED;
            PG8_LDB(B0, 1, 0); PG8_LDB(B1, 1, 1); PG8_SCHED; PG8_LDA(At, 1, 0); PG8_STAGE(PG8_SA(0, 1), a2 + hstep, voffA);
            PG8_WAIT_V(8); PG8_WAIT_L(0); PG8_BAR; PG8_MMA(0, 0, At, B0); PG8_MMA(0, 1, At, B1); PG8_BAR; PG8_SCHED;
            PG8_LDA(At, 1, 1); PG8_STAGE(PG8_SB(1, 0), b3, voffB); PG8_STAGE(PG8_SB(1, 1), b3 + hstep, voffB); PG8_STAGE(PG8_SA(1, 0), a3, voffA);
            PG8_WAIT_V(8); PG8_WAIT_L(0); PG8_BAR; PG8_MMA(1, 0, At, B0); PG8_MMA(1, 1, At, B1); PG8_BAR; PG8_SCHED;
            } else {
            PG8_LDB(B0, 0, 0); PG8_SCHED; PG8_LDA(At, 0, 0); PG8_STAGE(PG8_SA(1, 1), a1 + hstep, voffA);
            PG8_WAIT_L(8); PG8_BAR; PG8_WAIT_L(0); PG8_MMA(0, 0, At, B0); PG8_BAR; PG8_SCHED;
            PG8_LDB(B1, 0, 1); PG8_STAGE(PG8_SB(0, 0), b2, voffB);
            PG8_BAR; PG8_WAIT_L(0); PG8_MMA(0, 1, At, B1); PG8_BAR;
            PG8_LDA(At, 0, 1); PG8_STAGE(PG8_SA(0, 0), a2, voffA);
            PG8_BAR; PG8_WAIT_L(0); PG8_MMA(1, 0, At, B0); PG8_BAR; PG8_SCHED;
            PG8_STAGE(PG8_SB(0, 1), b2 + hstep, voffB);
            PG8_WAIT_V(6); PG8_BAR; PG8_MMA(1, 1, At, B1); PG8_BAR;
            PG8_LDB(B0, 1, 0); PG8_SCHED; PG8_LDA(At, 1, 0); PG8_STAGE(PG8_SA(0, 1), a2 + hstep, voffA);
            PG8_WAIT_L(8); PG8_BAR; PG8_WAIT_L(0); PG8_MMA(0, 0, At, B0); PG8_BAR; PG8_SCHED;
            PG8_LDB(B1, 1, 1); PG8_STAGE(PG8_SB(1, 0), b3, voffB);
            PG8_BAR; PG8_WAIT_L(0); PG8_MMA(0, 1, At, B1); PG8_BAR;
            PG8_LDA(At, 1, 1); PG8_STAGE(PG8_SA(1, 0), a3, voffA);
            PG8_BAR; PG8_WAIT_L(0); PG8_MMA(1, 0, At, B0); PG8_BAR; PG8_SCHED;
            PG8_STAGE(PG8_SB(1, 1), b3 + hstep, voffB);
            PG8_WAIT_V(6); PG8_BAR; PG8_MMA(1, 1, At, B1); PG8_BAR;
            }
        }
        if constexpr (ALIGN_EPI) { if (wr == 0) PG8_BAR; }
        if constexpr (!Epi::AFTER_DRAIN) { int t_ = g.wb + lane_now(); asm volatile("" : "+v"(t_)); const int fr_ = t_ & 15, fq_ = (t_ >> 4) & 3; if constexpr (!Sched::STREAM) E(acc, cur, wr, wc, fr_, fq_); else { if (cur.fl == 1) streamk_store(acc, cur, g.skp, g.skf, t_); else { const float* part_ = streamk_wait(cur, g.skp, g.skf, t_); int t2_ = g.wb + lane_now(); asm volatile("" : "+v"(t2_)); E(acc, cur, wr, wc, t2_ & 15, (t2_ >> 4) & 3, part_, t2_); } } S.done(cur); }
        if (!has_next) break;
#pragma unroll
        for (int a = 0; a < 2; ++a)
#pragma unroll
            for (int b = 0; b < 2; ++b)
#pragma unroll
                for (int m = 0; m < 4; ++m)
#pragma unroll
                    for (int n = 0; n < 2; ++n) acc[a][b][m][n] = (f32x4){0.f, 0.f, 0.f, 0.f};
        cur = nxt; cA = nA; cB = nB; ++ui;
        if constexpr (ALIGN_EPI) { if (wr == 1) PG8_BAR; }
    }
    PG8_WAIT_V(0);
    if constexpr (!ALIGN_EPI) { if (wr == 0) PG8_BAR; }
    PG8_BAR;
    if constexpr (Epi::AFTER_DRAIN) { E.fused(acc, cur, wr, wc, fr, fq, lds, wid, lane); S.done(cur); }
#undef PG8_SA
#undef PG8_SB
#undef PG8_STAGE
#undef PG8_LDA
#undef PG8_LDB
#undef PG8_MMA
#undef PG8_WAIT_V
#undef PG8_WAIT_L
#undef PG8_BAR
#undef PG8_SCHED
}
}

#define LAS __attribute__((address_space(3)))
typedef unsigned short bf16_t;
typedef short bf16x8 __attribute__((ext_vector_type(8)));
typedef float f32x4 __attribute__((ext_vector_type(4)));
typedef float f32x2 __attribute__((ext_vector_type(2)));
typedef float f32x16 __attribute__((ext_vector_type(16)));
typedef unsigned u32x4 __attribute__((ext_vector_type(4)));
typedef unsigned u32x2 __attribute__((ext_vector_type(2)));

constexpr int D = 1024, NH = 16, HD = 64;
constexpr int BP = 8, TP = 2064, SEQP = 2048, NMETA = 16, BS = 16, TS = 64, PAST = 4096;
constexpr int MPR = BP * TP;
constexpr int MR = MPR + BS * TS;
constexpr int MP = 17664;
constexpr int NTM = 69;
constexpr int DFF = 2752, DFFP = 2816, NIN = 5632;
constexpr float RMS_EPS = 1e-6f, GN_EPS = 64e-5f;
constexpr float LOG2E = 1.4426950408889634f;

constexpr size_t O_YP = 0, O_YS = 16777216, O_SP = 17825792, O_SHP = 18350080, O_KP = 18358272, O_VP = 35266560,
                 O_SS = 52174848, O_SHS = 53223424, O_KS = 53239808, O_VS = 54288384, O_END = 55336960;

constexpr size_t SZ_ROWBF = (size_t)MP * D * 2, SZ_ROWF = (size_t)MP * D * 4;
constexpr size_t W_X = 0;
constexpr size_t W_XN = W_X + SZ_ROWF;
constexpr size_t W_HB = W_XN + SZ_ROWBF;
constexpr size_t W_WIN = W_HB + (size_t)MP * DFFP * 2;
constexpr size_t SZ_WIN1 = (size_t)NIN * D * 2, SZ_WOUT1 = (size_t)D * DFFP * 2;
constexpr size_t W_WOUT = W_WIN + 4 * SZ_WIN1;
constexpr size_t W_WG1 = W_WOUT + 4 * SZ_WOUT1;
constexpr size_t W_WL2 = W_WG1 + (size_t)3584 * D * 2;
constexpr size_t W_WO1 = W_WL2 + (size_t)3072 * 256 * 2;
constexpr size_t W_WQKV = W_WO1 + (size_t)D * D * 2;
constexpr size_t W_WO2 = W_WQKV + (size_t)3 * D * D * 2;
constexpr size_t W_AALL = W_WO2 + (size_t)D * D * 2;
constexpr size_t W_RKV = W_AALL + 5 * SZ_ROWBF;
constexpr size_t W_L1 = W_RKV + 3 * SZ_ROWBF;
constexpr size_t W_A2 = W_L1 + (size_t)2 * MP * 256 * 4;
constexpr size_t W_DEC = W_A2 + (size_t)MP * 256 * 2;
constexpr size_t W_AA = W_DEC + SZ_ROWBF;
constexpr size_t W_GG = W_AA + SZ_ROWBF;
constexpr size_t W_SO = W_GG + SZ_ROWBF;
constexpr size_t W_OG = W_SO + SZ_ROWF;
constexpr size_t W_QB = W_OG + SZ_ROWBF;
constexpr size_t W_RSQ = W_QB + SZ_ROWBF;
constexpr size_t W_SKF = W_RSQ + (size_t)5 * MP * 4;
constexpr size_t W_SKP = W_SKF + 64 * 1024 * 4;
constexpr size_t W_END = W_SKP + (size_t)277 * 262144;

struct Params { const float* in[31]; float* out; unsigned char* ws; int ph_lo, ph_hi; int seq[64]; };
typedef const Params __attribute__((address_space(4)))* KP;

__device__ __forceinline__ unsigned cvt_pk(float lo, float hi) { unsigned r; asm("v_cvt_pk_bf16_f32 %0, %1, %2" : "=v"(r) : "v"(lo), "v"(hi)); return r; }
__device__ __forceinline__ void store_bf4(bf16_t* p, f32x4 v) { u32x2 w; w.x = cvt_pk(v[0], v[1]); w.y = cvt_pk(v[2], v[3]); *(u32x2*)p = w; }
__device__ __forceinline__ float bf_lo(unsigned w) { return __uint_as_float(w << 16); }
__device__ __forceinline__ float bf_hi(unsigned w) { return __uint_as_float(w & 0xffff0000u); }
__device__ __forceinline__ float sigmoidf_(float x) { return __builtin_amdgcn_rcpf(1.f + __expf(-x)); }
__device__ __forceinline__ float softplusf_(float x) { return fmaxf(x, 0.f) + __logf(1.f + __expf(-fabsf(x))); }
__device__ __forceinline__ float shx(float v, int o, int lane) { return __builtin_bit_cast(float, __builtin_amdgcn_ds_bpermute((lane ^ o) << 2, __builtin_bit_cast(int, v))); }
__device__ __forceinline__ float wave_sum(float v, int lane) {
#pragma unroll
    for (int o = 1; o < 64; o <<= 1) v += shx(v, o, lane);
    return v;
}
__device__ __forceinline__ void row_bt(int row, int& grp, int& b, int& t) { if (row < MPR) { grp = 0; b = row / TP; t = row - b * TP; } else { grp = 1; const int r = row - MPR; b = r >> 6; t = r & 63; } }

using pg8::Unit;
extern __shared__ __attribute__((aligned(16))) unsigned char lds_raw[];
struct EpiSwiGLU {
    static constexpr bool PERM = true, AFTER_DRAIN = false;
    bf16_t* HB; const float* rsq;
    __device__ __forceinline__ void operator()(const f32x4 (&acc)[2][2][4][2], const Unit& u, int wr, int wc, int fr, int fq) const {
        const int row0 = u.pm * 256 + wr * 64 + fr, col0 = u.pn * 128 + wc * 32 + 8 * fq;
#pragma unroll
        for (int ai = 0; ai < 2; ++ai)
#pragma unroll
            for (int m = 0; m < 4; ++m) {
                bf16_t* rowp = HB + (size_t)(row0 + ai * 128 + m * 16) * DFFP + col0;
                const float rs = __builtin_amdgcn_rsqf(rsq[row0 + ai * 128 + m * 16] * (1.f / D) + RMS_EPS);
                float hv[8];
#pragma unroll
                for (int n = 0; n < 2; ++n)
#pragma unroll
                    for (int j = 0; j < 4; ++j) { const float g = acc[ai][0][m][n][j] * rs, up = acc[ai][1][m][n][j] * rs; hv[n * 4 + j] = g * sigmoidf_(g) * up; }
                u32x4 w; w.x = cvt_pk(hv[0], hv[1]); w.y = cvt_pk(hv[2], hv[3]); w.z = cvt_pk(hv[4], hv[5]); w.w = cvt_pk(hv[6], hv[7]);
                *(u32x4*)rowp = w;
            }
    }
};
struct EpiRes {
    static constexpr bool PERM = false, AFTER_DRAIN = false;
    float* X; float scale; float* out; bf16_t* XB; float* rsq;
    __device__ __forceinline__ void operator()(const f32x4 (&acc)[2][2][4][2], const Unit& u, int wr, int wc, int fr, int fq, const float* part = nullptr, int tid = 0) const {
        const bool hasp = u.fl == 2;
        float* const X_ = X; float* const out_ = out; bf16_t* const XB_ = XB; float* const rsq_ = rsq; const float sc_ = scale;
        const int row0 = u.pm * 256 + wr * 64 + fr, col0 = u.pn * 256 + wc * 32 + 4 * fq, ln = fq * 16 + fr;
#pragma unroll
        for (int ai = 0; ai < 2; ++ai)
#pragma unroll
            for (int m = 0; m < 4; ++m) {
                const int row = row0 + ai * 128 + m * 16;
                const unsigned off = (unsigned)row * D + col0;
                if (out_ == nullptr) {
                    float ss = 0.f;
#pragma unroll
                    for (int bj = 0; bj < 2; ++bj)
#pragma unroll
                        for (int n = 0; n < 2; ++n) { f32x4* q = (f32x4*)(X_ + off + bj * 128 + n * 16); f32x4 av = acc[ai][bj][m][n]; if (hasp) av += pg8::streamk_part(part, ((ai * 2 + bj) * 4 + m) * 2 + n, tid); const f32x4 x = *q + av * sc_; *q = x;
                            if (XB_) { store_bf4(XB_ + off + bj * 128 + n * 16, x); ss += (x[0] * x[0] + x[1] * x[1]) + (x[2] * x[2] + x[3] * x[3]); } }
                    if (XB_) { ss += shx(ss, 16, ln); ss += shx(ss, 32, ln); if (fq == 0) unsafeAtomicAdd(rsq_ + row, ss); }
                } else if (row < MR) {
                    float* dp = nullptr;
                    if (row < MPR) { const int b = row / TP, t = row - b * TP; if (t >= NMETA) dp = out_ + O_YP + ((size_t)b * SEQP + (t - NMETA)) * D + col0; }
                    else dp = out_ + O_YS + (size_t)(row - MPR) * D + col0;
                    if (dp) {
#pragma unroll
                        for (int bj = 0; bj < 2; ++bj)
#pragma unroll
                            for (int n = 0; n < 2; ++n) { f32x4 av = acc[ai][bj][m][n]; if (hasp) av += pg8::streamk_part(part, ((ai * 2 + bj) * 4 + m) * 2 + n, tid); *(f32x4*)(dp + bj * 128 + n * 16) = *(const f32x4*)(X_ + off + bj * 128 + n * 16) + av * sc_; }
                    }
                }
                asm volatile("" ::: "memory");
            }
    }
};
struct StreamOrder {
    static constexpr bool STREAM = true;
    int nN, ppt, c; long s, e;
    __device__ void init(int M, int N, int K, int G, int c_) {
        nN = N / 256; ppt = K / 128;
        c = (G % 8 == 0) ? (c_ % 8) * (G / 8) + c_ / 8 : c_;
        const long P = (long)(M / 256) * nN * ppt;
        s = (long)c * P / G; e = (long)(c + 1) * P / G;
    }
    __device__ bool next(int i, Unit& u) const {
        const int t = (int)(s / ppt) + i; const long t0 = (long)t * ppt;
        if (t0 >= e) return false;
        const long lo = s > t0 ? s : t0, hi = e < t0 + ppt ? e : t0 + ppt;
        u.pm = t / nN; u.pn = t - u.pm * nN; u.tl = t;
        u.kb = (int)(lo - t0) * 256; u.nt = (int)(hi - lo) * 2;
        u.fl = lo > t0 ? 1 : (hi < t0 + ppt ? 2 : 0);
        return true;
    }
    __device__ __forceinline__ void a_ready(const Unit&) const {}
    __device__ __forceinline__ void done(const Unit&) const {}
};
struct EpiG1 {
    static constexpr bool PERM = true, AFTER_DRAIN = false;
    bf16_t* RKV; float* L1;
    __device__ __forceinline__ void operator()(const f32x4 (&acc)[2][2][4][2], const Unit& u, int wr, int wc, int fr, int fq) const {
        const unsigned row0 = (unsigned)((u.pm % NTM) * 256 + wr * 64 + fr), cw = wc * 32 + 8 * fq;
        if (u.pn < 12) {
            bf16_t* base = RKV + (size_t)(u.pn >> 2) * MP * D;
            const unsigned off0 = row0 * D + (u.pn & 3) * 256 + cw;
#pragma unroll
            for (int ai = 0; ai < 2; ++ai)
#pragma unroll
                for (int m = 0; m < 4; ++m)
#pragma unroll
                    for (int bj = 0; bj < 2; ++bj) { const f32x4 v0 = acc[ai][bj][m][0], v1 = acc[ai][bj][m][1];
                        u32x4 w; w.x = cvt_pk(v0[0], v0[1]); w.y = cvt_pk(v0[2], v0[3]); w.z = cvt_pk(v1[0], v1[1]); w.w = cvt_pk(v1[2], v1[3]);
                        *(u32x4*)(base + (off0 + (unsigned)((ai * 128 + m * 16) * D + bj * 128))) = w; }
        } else {
            float* base = L1 + (size_t)(u.pn - 12) * MP * 256;
            const unsigned off0 = row0 * 256 + cw;
#pragma unroll
            for (int ai = 0; ai < 2; ++ai)
#pragma unroll
                for (int m = 0; m < 4; ++m)
#pragma unroll
                    for (int bj = 0; bj < 2; ++bj)
#pragma unroll
                        for (int n = 0; n < 2; ++n) *(f32x4*)(base + (off0 + (unsigned)((ai * 128 + m * 16) * 256 + bj * 128 + n * 4))) = acc[ai][bj][m][n];
        }
    }
};
struct EpiG2 {
    static constexpr bool PERM = true, AFTER_DRAIN = false;
    bf16_t* LW;
    __device__ __forceinline__ void operator()(const f32x4 (&acc)[2][2][4][2], const Unit& u, int wr, int wc, int fr, int fq) const {
        bf16_t* base = LW + (size_t)(u.pn >> 2) * MP * D;
        const unsigned off0 = (unsigned)(u.pm * 256 + wr * 64 + fr) * D + (u.pn & 3) * 256 + wc * 32 + 8 * fq;
#pragma unroll
        for (int ai = 0; ai < 2; ++ai)
#pragma unroll
            for (int m = 0; m < 4; ++m)
#pragma unroll
                for (int bj = 0; bj < 2; ++bj) { const f32x4 v0 = acc[ai][bj][m][0], v1 = acc[ai][bj][m][1];
                    u32x4 w; w.x = cvt_pk(v0[0], v0[1]); w.y = cvt_pk(v0[2], v0[3]); w.z = cvt_pk(v1[0], v1[1]); w.w = cvt_pk(v1[2], v1[3]);
                    *(u32x4*)(base + (off0 + (unsigned)((ai * 128 + m * 16) * D + bj * 128))) = w; }
    }
};
struct EpiQKV {
    static constexpr bool PERM = false, AFTER_DRAIN = false;
    bf16_t* QB; float* out; const float* qg; const float* kg; const float* rsq;
    __device__ __forceinline__ void operator()(const f32x4 (&acc)[2][2][4][2], const Unit& u, int wr, int wc, int fr, int fq) const {
        const int sec = u.pn >> 2, head = (u.pn & 3) * 4 + wc, row0 = u.pm * 256 + wr * 64 + fr;
        f32x4 gn[2][2];
#pragma unroll
        for (int bj = 0; bj < 2; ++bj)
#pragma unroll
            for (int n = 0; n < 2; ++n) { const int d = 32 * bj + 16 * n + 4 * fq;
                gn[bj][n] = sec == 0 ? *(const f32x4*)(qg + d) * 0.125f : (sec == 1 ? *(const f32x4*)(kg + d) : (f32x4){1.f, 1.f, 1.f, 1.f}); }
#pragma unroll
        for (int ai = 0; ai < 2; ++ai)
#pragma unroll
            for (int m = 0; m < 4; ++m) {
                const int row = row0 + ai * 128 + m * 16;
                const float rx = __builtin_amdgcn_rsqf(rsq[row] * (1.f / D) + RMS_EPS);
                float ss = 0.f;
#pragma unroll
                for (int bj = 0; bj < 2; ++bj)
#pragma unroll
                    for (int n = 0; n < 2; ++n) { const f32x4 x = acc[ai][bj][m][n]; ss += (x[0] * x[0] + x[1] * x[1]) + (x[2] * x[2] + x[3] * x[3]); }
                { const int ln = fq * 16 + fr; ss += shx(ss, 16, ln); ss += shx(ss, 32, ln); }
                const float rs = rx * (sec == 2 ? 1.f : __builtin_amdgcn_rsqf(ss * rx * rx * (1.f / 64.f) + RMS_EPS));
                if (row < MR) {
                    if (sec == 0) {
                        bf16_t* qp = QB + (size_t)row * D + head * 64 + 4 * fq;
#pragma unroll
                        for (int bj = 0; bj < 2; ++bj)
#pragma unroll
                            for (int n = 0; n < 2; ++n) { const f32x4 x = acc[ai][bj][m][n] * rs * gn[bj][n]; u32x2 w; w.x = cvt_pk(x[0], x[1]); w.y = cvt_pk(x[2], x[3]); *(u32x2*)(qp + 32 * bj + 16 * n) = w; }
                    } else {
                        int grp, b, t; row_bt(row, grp, b, t);
                        float* dp = grp == 0 ? out + (sec == 1 ? O_KP : O_VP) + (((size_t)b * NH + head) * TP + t) * HD
                                             : out + (sec == 1 ? O_KS : O_VS) + (((size_t)b * NH + head) * TS + t) * HD;
                        dp += 4 * fq;
#pragma unroll
                        for (int bj = 0; bj < 2; ++bj)
#pragma unroll
                            for (int n = 0; n < 2; ++n) *(f32x4*)(dp + 32 * bj + 16 * n) = acc[ai][bj][m][n] * rs * gn[bj][n];
                    }
                }
            }
    }
};
struct G1Order {
    static constexpr bool STREAM = false;
    int G, c;
    __device__ bool next(int i, Unit& u) const {
        const long L = (long)i * G + c; if (L >= 966) return false;
        int w = (int)L; { const int q = 966 / 8, r = 966 % 8, xcd = w % 8, off = w / 8; w = (xcd < r ? xcd * (q + 1) : r * (q + 1) + (xcd - r) * q) + off; }
        const int pm = w / 14, q = w % 14;
        if (q < 12) { u.pm = (q >> 2) * NTM + pm; u.pn = q; } else { u.pm = (q - 9) * NTM + pm; u.pn = q; }
        u.kb = 0; u.nt = 16; u.fl = 0; u.tl = 0;
        return true;
    }
    __device__ __forceinline__ void a_ready(const Unit&) const {}
    __device__ __forceinline__ void done(const Unit&) const {}
};

struct Job { const float* src; bf16_t* dst; const float* mu; int ld, Ksrc, koff, Kdst, rows, map, smode; };
__device__ __forceinline__ int srccol(int map, int n, int ld) {
    if (map == 0) return n < ld ? n : -1;
    if (map == 1) { const int pn = n >> 8, c = n & 255, bj = c >> 7, j = c & 127, hc = pn * 128 + j; return hc < DFF ? (bj ? DFF + hc : hc) : -1; }
    { const int t = n >> 8, c = n & 255, bj = c >> 7, wc = (c & 127) >> 5, i = c & 31; return t * 256 + 64 * wc + 32 * bj + i; }
}
__device__ __forceinline__ Job get_job(KP p, int j) {
    Job J; J.mu = nullptr; J.koff = 0; J.map = 0; J.smode = 0;
    unsigned char* ws = p->ws;
    if (j < 4) { J.src = p->in[8] + (size_t)j * D * 2 * DFF; J.dst = (bf16_t*)(ws + W_WIN + j * SZ_WIN1); J.ld = 2 * DFF; J.Ksrc = D; J.Kdst = D; J.rows = NIN; J.map = 1; J.mu = p->in[7] + (size_t)j * D; J.smode = 2; }
    else if (j < 8) { const int i = j - 4; J.src = p->in[9] + (size_t)i * DFF * D; J.dst = (bf16_t*)(ws + W_WOUT + i * SZ_WOUT1); J.ld = D; J.Ksrc = DFF; J.Kdst = DFFP; J.rows = D; }
    else if (j < 11) { const int g = j - 8; J.src = p->in[12] + (size_t)g * D * D; J.dst = (bf16_t*)(ws + W_WG1) + (size_t)g * D * D; J.ld = D; J.Ksrc = D; J.Kdst = D; J.rows = D; }
    else if (j < 17) { const int idx = j - 11, part = idx / 3, which = idx % 3;
        J.src = which == 0 ? p->in[14] : (which == 1 ? p->in[17] : p->in[19]); J.ld = which == 2 ? 128 : 64; J.rows = J.ld;
        J.mu = p->in[11] + (which == 0 ? 1 : (which == 1 ? 4 : 5)) * D; J.smode = part + 1;
        J.dst = (bf16_t*)(ws + W_WG1) + (size_t)(3072 + part * 256 + which * 64) * D; J.Ksrc = D; J.Kdst = D; }
    else if (j < 20) { const int which = j - 17; J.src = which == 0 ? p->in[15] : (which == 1 ? p->in[18] : p->in[20]); J.ld = D; J.rows = D;
        J.Ksrc = which == 2 ? 128 : 64; J.koff = which * 64; J.Kdst = 256; J.dst = (bf16_t*)(ws + W_WL2) + (size_t)which * D * 256; }
    else if (j == 20) { J.src = p->in[26]; J.dst = (bf16_t*)(ws + W_WO1); J.ld = D; J.Ksrc = D; J.Kdst = D; J.rows = D; }
    else if (j == 21) { J.src = p->in[27]; J.dst = (bf16_t*)(ws + W_WQKV); J.ld = 3 * D; J.Ksrc = D; J.Kdst = D; J.rows = 3 * D; J.map = 2; J.mu = p->in[10] + D; J.smode = 2; }
    else { J.src = p->in[30]; J.dst = (bf16_t*)(ws + W_WO2); J.ld = D; J.Ksrc = D; J.Kdst = D; J.rows = D; }
    return J;
}
__device__ __forceinline__ void convert_weights(KP p, LAS float* tl, int tid, int bid, int G) {
    int rot = 0;
    for (int j = 0; j < 23; ++j) {
        const Job J = get_job(p, j);
        const int nkt = J.Kdst >> 6, nnt = (J.rows + 255) >> 8, ntile = nnt * nkt;
        int first = bid - rot; if (first < 0) first += G;
        for (int t = first; t < ntile; t += G) {
            const int n0 = (t / nkt) << 8, k0 = (t % nkt) << 6;
            const bool inside = k0 >= J.koff && k0 < J.koff + J.Ksrc;
            if (inside) {
                const int nn = tid & 255, kh = tid >> 8;
                const int sc = (n0 + nn) < J.rows ? srccol(J.map, n0 + nn, J.ld) : -1;
                const float* sp = J.src + (size_t)(k0 - J.koff + kh) * J.ld + (sc >= 0 ? sc : 0);
                float v[32];
#pragma unroll
                for (int it = 0; it < 32; ++it) v[it] = sc >= 0 ? sp[(size_t)(2 * it) * J.ld] : 0.f;
                if (J.smode) {
#pragma unroll
                    for (int it = 0; it < 32; ++it) { const float m = J.mu[k0 - J.koff + kh + 2 * it]; v[it] *= J.smode == 1 ? 1.f - m : m; }
                }
#pragma unroll
                for (int it = 0; it < 32; ++it) tl[(kh + 2 * it) * 257 + nn] = v[it];
            }
            __syncthreads();
            {
                const int nn = tid >> 1, kh = (tid & 1) * 32;
                if (n0 + nn < J.rows) {
                    bf16_t* dp = J.dst + (size_t)(n0 + nn) * J.Kdst + k0 + kh;
#pragma unroll
                    for (int q = 0; q < 4; ++q) {
                        const unsigned z_ = (unsigned)tid >> 31;
                        u32x4 w = (u32x4){z_, z_, z_, z_};
                        if (inside) { float v[8];
#pragma unroll
                            for (int e = 0; e < 8; ++e) v[e] = tl[(kh + q * 8 + e) * 257 + nn];
                            w.x = cvt_pk(v[0], v[1]); w.y = cvt_pk(v[2], v[3]); w.z = cvt_pk(v[4], v[5]); w.w = cvt_pk(v[6], v[7]); }
                        *(u32x4*)(dp + q * 8) = w;
                    }
                }
            }
            __syncthreads();
        }
        rot = (rot + ntile) % G;
    }
}
__device__ __forceinline__ float row_rstd(const f32x4 (&v)[4], int lane) {
    float s = 0.f;
#pragma unroll
    for (int i = 0; i < 4; ++i) s += (v[i][0] * v[i][0] + v[i][1] * v[i][1]) + (v[i][2] * v[i][2] + v[i][3] * v[i][3]);
    s = wave_sum(s, lane);
    return __builtin_amdgcn_rsqf(s * (1.f / D) + RMS_EPS);
}

__device__ __forceinline__ void assemble_x(KP p, int tid, int bid, int G) {
    const int lane = tid & 63, gw = bid * 8 + (tid >> 6), nw = G * 8;
    float* X = (float*)(p->ws + W_X); bf16_t* XN = (bf16_t*)(p->ws + W_XN);
    for (int row = gw; row < MP; row += nw) {
        f32x4 v[4];
        const float* src = nullptr;
        if (row < MPR) { const int b = row / TP, t = row - b * TP; src = t < NMETA ? p->in[6] + (size_t)t * D : p->in[0] + ((size_t)b * SEQP + (t - NMETA)) * D; }
        else if (row < MR) src = p->in[1] + (size_t)(row - MPR) * D;
#pragma unroll
        for (int i = 0; i < 4; ++i) { const float zf = __uint_as_float((unsigned)tid >> 31); v[i] = src ? *(const f32x4*)(src + lane * 4 + 256 * i) : (f32x4){zf, zf, zf, zf}; }
        float ssq = 0.f;
#pragma unroll
        for (int i = 0; i < 4; ++i) ssq += (v[i][0] * v[i][0] + v[i][1] * v[i][1]) + (v[i][2] * v[i][2] + v[i][3] * v[i][3]);
        ssq = wave_sum(ssq, lane);
#pragma unroll
        for (int i = 0; i < 4; ++i) { const int c = lane * 4 + 256 * i; *(f32x4*)(X + (size_t)row * D + c) = v[i]; store_bf4(XN + (size_t)row * D + c, v[i]); }
        float* rsq = (float*)(p->ws + W_RSQ);
        if (lane < 5) rsq[(size_t)lane * MP + row] = lane == 0 ? ssq : 0.f;
    }    for (int i = gw * 64 + lane; i < 64 * 1024; i += nw * 64) ((unsigned*)(p->ws + W_SKF))[i] = 0u;
    for (int i = gw * 64 + lane; i < 65536; i += nw * 64) ((float*)(p->ws + W_SKP) + (size_t)276 * 65536)[i] = 0.f;
}
__device__ __forceinline__ void norm_phase(KP p, const float* g, int tid, int bid, int G, bool copy_y = false) {
    const int lane = tid & 63, gw = bid * 8 + (tid >> 6), nw = G * 8;
    const float* X = (const float*)(p->ws + W_X); bf16_t* XN = (bf16_t*)(p->ws + W_XN);
    for (int row = gw; row < MP; row += nw) {
        f32x4 v[4];
#pragma unroll
        for (int i = 0; i < 4; ++i) v[i] = *(const f32x4*)(X + (size_t)row * D + lane * 4 + 256 * i);
        const float rs = row_rstd(v, lane);
#pragma unroll
        for (int i = 0; i < 4; ++i) { const int c = lane * 4 + 256 * i; store_bf4(XN + (size_t)row * D + c, v[i] * rs * *(const f32x4*)(g + c)); }
        if (copy_y && row < MR) {
            float* dp = nullptr;
            if (row < MPR) { const int b = row / TP, t = row - b * TP; if (t >= NMETA) dp = p->out + O_YP + ((size_t)b * SEQP + (t - NMETA)) * D; }
            else dp = p->out + O_YS + (size_t)(row - MPR) * D;
            if (dp) {
#pragma unroll
                for (int i = 0; i < 4; ++i) *(f32x4*)(dp + lane * 4 + 256 * i) = v[i];
            }
        }
    }
}
__device__ __forceinline__ void mixprep_phase(KP p, int tid, int bid, int G) {
    const int lane = tid & 63, gw = bid * 8 + (tid >> 6), nw = G * 8;
    const float* X = (const float*)(p->ws + W_X); bf16_t* A = (bf16_t*)(p->ws + W_AALL);
    const float* g = p->in[10]; const float* mu = p->in[11];
    for (int row = gw; row < MR; row += nw) {
        int grp, b, t; row_bt(row, grp, b, t);
        f32x4 v[4], pv[4];
#pragma unroll
        for (int i = 0; i < 4; ++i) v[i] = *(const f32x4*)(X + (size_t)row * D + lane * 4 + 256 * i);
        const float rs = row_rstd(v, lane);
        if (t > 0) {
#pragma unroll
            for (int i = 0; i < 4; ++i) pv[i] = *(const f32x4*)(X + (size_t)(row - 1) * D + lane * 4 + 256 * i);
            const float rp = row_rstd(pv, lane);
#pragma unroll
            for (int i = 0; i < 4; ++i) pv[i] = pv[i] * rp * *(const f32x4*)(g + lane * 4 + 256 * i);
        } else {
#pragma unroll
            for (int i = 0; i < 4; ++i) { const float zf = __uint_as_float((unsigned)tid >> 31); pv[i] = grp == 0 ? (f32x4){zf, zf, zf, zf} : *(const f32x4*)(p->in[3] + (size_t)b * D + lane * 4 + 256 * i); }
        }
        const bool last = t == (grp == 0 ? TP - 1 : TS - 1);
        float* sh = grp == 0 ? p->out + O_SHP + (size_t)b * D : p->out + O_SHS + (size_t)b * D;
#pragma unroll
        for (int i = 0; i < 4; ++i) {
            const int c = lane * 4 + 256 * i; const size_t o = (size_t)row * D + c;
            const f32x4 h = v[i] * rs * *(const f32x4*)(g + c), dx = pv[i] - h;
            store_bf4(A + o, h + dx * *(const f32x4*)(mu + c));
            store_bf4(A + (size_t)MP * D + o, h + dx * *(const f32x4*)(mu + 2 * D + c));
            store_bf4(A + (size_t)2 * MP * D + o, h + dx * *(const f32x4*)(mu + 3 * D + c));
            store_bf4(A + (size_t)3 * MP * D + o, h);
            store_bf4(A + (size_t)4 * MP * D + o, pv[i]);
            if (last) *(f32x4*)(sh + c) = h;
        }
    }
}
__device__ __forceinline__ void act_phase(KP p, int gtid, int nthr) {
    const float* L1 = (const float*)(p->ws + W_L1); bf16_t* A2 = (bf16_t*)(p->ws + W_A2);
    for (int i = gtid; i < MP * 64; i += nthr) {
        const int c = (i & 63) * 4;
        f32x4 v = *(const f32x4*)(L1 + (size_t)i * 4) + *(const f32x4*)(L1 + (size_t)MP * 256 + (size_t)i * 4);
        if (c < 64) {
#pragma unroll
            for (int j = 0; j < 4; ++j) v[j] = 1.f - 2.f * __builtin_amdgcn_rcpf(1.f + __expf(2.f * v[j]));
        } else if (c >= 128) {
#pragma unroll
            for (int j = 0; j < 4; ++j) v[j] = sigmoidf_(v[j]);
        }
        store_bf4(A2 + (size_t)i * 4, v);
    }
}

__device__ __forceinline__ float dpp_sum16(float x) {
    x += __builtin_bit_cast(float, __builtin_amdgcn_update_dpp(0, __builtin_bit_cast(int, x), 0xB1, 0xF, 0xF, true));
    x += __builtin_bit_cast(float, __builtin_amdgcn_update_dpp(0, __builtin_bit_cast(int, x), 0x4E, 0xF, 0xF, true));
    x += __builtin_bit_cast(float, __builtin_amdgcn_update_dpp(0, __builtin_bit_cast(int, x), 0x141, 0xF, 0xF, true));
    x += __builtin_bit_cast(float, __builtin_amdgcn_update_dpp(0, __builtin_bit_cast(int, x), 0x140, 0xF, 0xF, true));
    return x;
}
constexpr int SC_CH = 16, SC_STR = 400;
__device__ __forceinline__ void scan_phase(KP p, LAS float* buf, int tid, int bid, int G) {
    const int wid = tid >> 6, lane = tid & 63;
    const bf16_t* RKV = (const bf16_t*)(p->ws + W_RKV); const bf16_t* DEC = (const bf16_t*)(p->ws + W_DEC); const bf16_t* AA = (const bf16_t*)(p->ws + W_AA);
    float* SO = (float*)(p->ws + W_SO);
    const bool producer = wid >= 4;
    for (int u = bid; u < 768; u += G) {
        int bh, half, T, row0; const float* S0; float* Sout;
        if (u < 256) { bh = u >> 1; half = u & 1; T = TP; row0 = (bh >> 4) * TP; S0 = nullptr; Sout = p->out + O_SP + (size_t)bh * 4096; }
        else { const int v = u - 256; bh = v >> 1; half = v & 1; T = TS; row0 = MPR + (bh >> 4) * TS; S0 = p->in[2] + (size_t)bh * 4096; Sout = p->out + O_SS + (size_t)bh * 4096; }
        const int h = bh & 15, nchunk = T / SC_CH;
        if (producer) {
            const int t2 = tid - 256, pi = t2 >> 4, pj = t2 & 15, kc = h * 64 + 4 * pj;
            const f32x4 kkv = *(const f32x4*)(p->in[21] + kc), kav = *(const f32x4*)(p->in[22] + kc), w0v = *(const f32x4*)(p->in[13] + kc), a0v = *(const f32x4*)(p->in[16] + kc);
            u32x2 pr, pk, pvv, pa, pd;
#define SC_LOAD(c) do { const size_t o = (size_t)(row0 + (c) * SC_CH + pi) * D + kc; pr = *(const u32x2*)(RKV + o); pk = *(const u32x2*)(RKV + (size_t)MP * D + o); \
            pvv = *(const u32x2*)(RKV + (size_t)2 * MP * D + o); pa = *(const u32x2*)(AA + o); pd = *(const u32x2*)(DEC + o); } while (0)
#define SC_STORE(bi) do { LAS float* rec = buf + (bi) * (SC_CH * SC_STR) + pi * SC_STR; \
            const f32x4 r = (f32x4){bf_lo(pr.x), bf_hi(pr.x), bf_lo(pr.y), bf_hi(pr.y)}, k = (f32x4){bf_lo(pk.x), bf_hi(pk.x), bf_lo(pk.y), bf_hi(pk.y)}; \
            const f32x4 v = (f32x4){bf_lo(pvv.x), bf_hi(pvv.x), bf_lo(pvv.y), bf_hi(pvv.y)}; \
            f32x4 a = (f32x4){bf_lo(pa.x), bf_hi(pa.x), bf_lo(pa.y), bf_hi(pa.y)} + a0v; f32x4 w = (f32x4){bf_lo(pd.x), bf_hi(pd.x), bf_lo(pd.y), bf_hi(pd.y)} + w0v; \
            _Pragma("unroll") for (int j = 0; j < 4; ++j) { a[j] = sigmoidf_(a[j]); w[j] = __expf(-__expf(-softplusf_(-w[j]) - 0.5f)); } \
            const f32x4 q = k * kkv; float ss = (q[0] * q[0] + q[1] * q[1]) + (q[2] * q[2] + q[3] * q[3]); ss = dpp_sum16(ss); \
            const float inv = 1.f / fmaxf(sqrtf(ss), 1e-12f); const f32x4 nk = q * inv; \
            const f32x4 kp = k * (1.f + (a - 1.f) * kav), bb = nk * a; \
            float br = (bb[0] * r[0] + bb[1] * r[1]) + (bb[2] * r[2] + bb[3] * r[3]), kr = (kp[0] * r[0] + kp[1] * r[1]) + (kp[2] * r[2] + kp[3] * r[3]); \
            br = dpp_sum16(br); kr = dpp_sum16(kr); \
            *(LAS f32x4*)(rec + 4 * pj) = w; *(LAS f32x4*)(rec + 64 + 4 * pj) = nk; *(LAS f32x4*)(rec + 128 + 4 * pj) = bb; \
            *(LAS f32x4*)(rec + 192 + 4 * pj) = kp; *(LAS f32x4*)(rec + 256 + 4 * pj) = w * r; *(LAS f32x4*)(rec + 320 + 4 * pj) = v; \
            if (pj == 0) *(LAS f32x2*)(rec + 384) = (f32x2){br, kr}; } while (0)
            SC_LOAD(0); SC_STORE(0);
            if (nchunk > 1) SC_LOAD(1);
            __syncthreads();
            for (int c = 0; c < nchunk; ++c) {
                if (c + 1 < nchunk) { SC_STORE((c + 1) & 1); if (c + 2 < nchunk) SC_LOAD(c + 2); }
                __syncthreads();
            }
#undef SC_LOAD
#undef SC_STORE
        } else {
            const int rp = lane >> 4, kq = lane & 15, vA = half * 32 + wid * 8 + rp * 2;
            f32x4 sA = (f32x4){0.f, 0.f, 0.f, 0.f}, sB = sA;
            if (S0) { sA = *(const f32x4*)(S0 + vA * 64 + kq * 4); sB = *(const f32x4*)(S0 + (vA + 1) * 64 + kq * 4); }
            float* op = SO + (size_t)(row0 + kq) * D + h * 64 + vA;
            __syncthreads();
            for (int c = 0; c < nchunk; ++c) {
                const LAS float* cb = buf + (c & 1) * (SC_CH * SC_STR);
                float oA = 0.f, oB = 0.f;
#pragma unroll
                for (int i = 0; i < SC_CH; ++i) {
                    const LAS float* rec = cb + i * SC_STR;
                    const f32x4 wd = *(const LAS f32x4*)(rec + kq * 4), kk = *(const LAS f32x4*)(rec + 64 + kq * 4), bb = *(const LAS f32x4*)(rec + 128 + kq * 4),
                                kp = *(const LAS f32x4*)(rec + 192 + kq * 4), wr = *(const LAS f32x4*)(rec + 256 + kq * 4);
                    const f32x2 vv = *(const LAS f32x2*)(rec + 320 + vA), sc = *(const LAS f32x2*)(rec + 384);
                    float d1A = (sA[0] * kk[0] + sA[1] * kk[1]) + (sA[2] * kk[2] + sA[3] * kk[3]);
                    float d1B = (sB[0] * kk[0] + sB[1] * kk[1]) + (sB[2] * kk[2] + sB[3] * kk[3]);
                    float d2A = (sA[0] * wr[0] + sA[1] * wr[1]) + (sA[2] * wr[2] + sA[3] * wr[3]);
                    float d2B = (sB[0] * wr[0] + sB[1] * wr[1]) + (sB[2] * wr[2] + sB[3] * wr[3]);
                    d1A = dpp_sum16(d1A); d1B = dpp_sum16(d1B); d2A = dpp_sum16(d2A); d2B = dpp_sum16(d2B);
                    const float saA = -d1A, saB = -d1B;
                    const float tA = d2A + saA * sc.x + vv.x * sc.y, tB = d2B + saB * sc.x + vv.y * sc.y;
                    sA = sA * wd + bb * saA + kp * vv.x;
                    sB = sB * wd + bb * saB + kp * vv.y;
                    oA = kq == i ? tA : oA; oB = kq == i ? tB : oB;
                }
                *(f32x2*)(op + (size_t)c * SC_CH * D) = (f32x2){oA, oB};
                __syncthreads();
            }
            *(f32x4*)(Sout + vA * 64 + kq * 4) = sA; *(f32x4*)(Sout + (vA + 1) * 64 + kq * 4) = sB;
        }
    }
}
__device__ __forceinline__ void post_phase(KP p, int tid, int bid, int G) {
    const int lane = tid & 63, gw = bid * 8 + (tid >> 6), nw = G * 8;
    const bf16_t* RKV = (const bf16_t*)(p->ws + W_RKV); const bf16_t* AA = (const bf16_t*)(p->ws + W_AA); const bf16_t* GG = (const bf16_t*)(p->ws + W_GG);
    const float* SO = (const float*)(p->ws + W_SO); bf16_t* OG = (bf16_t*)(p->ws + W_OG);
    const float* k_a = p->in[22]; const float* a0p = p->in[16]; const float* r_k = p->in[23]; const float* gnw = p->in[24]; const float* gnb = p->in[25];
    const int c0 = lane * 16;
    for (int row = gw; row < MR; row += nw) {
        const size_t o = (size_t)row * D + c0;
        float ov[16], rv[16], kv[16], vv[16], av[16], gv[16];
#pragma unroll
        for (int q = 0; q < 4; ++q) { const f32x4 x = *(const f32x4*)(SO + o + 4 * q); ov[4 * q] = x[0]; ov[4 * q + 1] = x[1]; ov[4 * q + 2] = x[2]; ov[4 * q + 3] = x[3]; }
#define LD16(dst, ptr) do { const u32x4 a_ = *(const u32x4*)(ptr), b_ = *(const u32x4*)((ptr) + 8); \
        dst[0] = bf_lo(a_.x); dst[1] = bf_hi(a_.x); dst[2] = bf_lo(a_.y); dst[3] = bf_hi(a_.y); dst[4] = bf_lo(a_.z); dst[5] = bf_hi(a_.z); dst[6] = bf_lo(a_.w); dst[7] = bf_hi(a_.w); \
        dst[8] = bf_lo(b_.x); dst[9] = bf_hi(b_.x); dst[10] = bf_lo(b_.y); dst[11] = bf_hi(b_.y); dst[12] = bf_lo(b_.z); dst[13] = bf_hi(b_.z); dst[14] = bf_lo(b_.w); dst[15] = bf_hi(b_.w); } while (0)
        LD16(rv, RKV + o); LD16(kv, RKV + (size_t)MP * D + o); LD16(vv, RKV + (size_t)2 * MP * D + o); LD16(av, AA + o); LD16(gv, GG + o);
#undef LD16
        float sm = 0.f, rk = 0.f;
#pragma unroll
        for (int e = 0; e < 16; ++e) { sm += ov[e]; const float kp = kv[e] * (1.f + (sigmoidf_(a0p[c0 + e] + av[e]) - 1.f) * k_a[c0 + e]); rk += rv[e] * kp * r_k[c0 + e]; }
        sm += shx(sm, 1, lane); sm += shx(sm, 2, lane); rk += shx(rk, 1, lane); rk += shx(rk, 2, lane);
        const float mean = sm * (1.f / 64.f);
        float vs = 0.f;
#pragma unroll
        for (int e = 0; e < 16; ++e) { const float d = ov[e] - mean; vs += d * d; }
        vs += shx(vs, 1, lane); vs += shx(vs, 2, lane);
        const float rstd = __builtin_amdgcn_rsqf(vs * (1.f / 64.f) + GN_EPS);
        unsigned w[8];
#pragma unroll
        for (int e = 0; e < 16; e += 2) {
            const float y0 = ((ov[e] - mean) * rstd * gnw[c0 + e] + gnb[c0 + e] + rk * vv[e]) * gv[e];
            const float y1 = ((ov[e + 1] - mean) * rstd * gnw[c0 + e + 1] + gnb[c0 + e + 1] + rk * vv[e + 1]) * gv[e + 1];
            w[e >> 1] = cvt_pk(y0, y1);
        }
        *(u32x4*)(OG + o) = (u32x4){w[0], w[1], w[2], w[3]}; *(u32x4*)(OG + o + 8) = (u32x4){w[4], w[5], w[6], w[7]};
    }
}

__device__ __forceinline__ int crow(int r, int hi) { return (r & 3) + 8 * (r >> 2) + 4 * hi; }
__device__ __forceinline__ bf16x8 pack8(f32x4 a, f32x4 b) {
    u32x4 w; w.x = cvt_pk(a[0], a[1]); w.y = cvt_pk(a[2], a[3]); w.z = cvt_pk(b[0], b[1]); w.w = cvt_pk(b[2], b[3]);
    return __builtin_bit_cast(bf16x8, w);
}
__device__ __forceinline__ void attn_phase(KP p, int tid, int bid, int G) {
    const int lane = tid & 63, gw = bid * 8 + (tid >> 6), nw = G * 8;
    const bf16_t* QB = (const bf16_t*)(p->ws + W_QB); bf16_t* AO = (bf16_t*)(p->ws + W_OG);
    const int ql = lane & 31, hi = lane >> 5;
    constexpr int NU_P = BP * NH * 65;
    for (int u = gw; u < NU_P + BS * NH * 2; u += nw) {
        int bh, Q0, nq, npast, row_base, Tn; const float *kc, *vc, *kn, *vn;
        if (u < NU_P) { bh = u / 65; Q0 = (u - bh * 65) * 32; nq = min(32, TP - Q0); npast = 0; row_base = (bh >> 4) * TP; Tn = TP;
            kc = nullptr; vc = nullptr; kn = p->out + O_KP + (size_t)bh * TP * HD; vn = p->out + O_VP + (size_t)bh * TP * HD; }
        else { const int v = u - NU_P; bh = v >> 1; Q0 = (v & 1) * 32; nq = 32; npast = PAST; row_base = MPR + (bh >> 4) * TS; Tn = TS;
            kc = p->in[4] + (size_t)bh * PAST * HD; vc = p->in[5] + (size_t)bh * PAST * HD; kn = p->out + O_KS + (size_t)bh * TS * HD; vn = p->out + O_VS + (size_t)bh * TS * HD; }
        const int h = bh & 15, qpos0 = npast + Q0;
        bf16x8 qf[4];
        { const bf16_t* qp = QB + (size_t)(row_base + Q0 + min(ql, nq - 1)) * D + h * 64 + hi * 8;
#pragma unroll
          for (int s = 0; s < 4; ++s) qf[s] = *(const bf16x8*)(qp + 16 * s); }
        f32x16 o0, o1;
#pragma unroll
        for (int r = 0; r < 16; ++r) { o0[r] = 0.f; o1[r] = 0.f; }
        float carry = ql < nq ? 0.f : -1e30f;
        const int qpos = qpos0 + ql;
        f32x4 kc4[8];
#define ATT_TILE_PTRS(P0_, kb_, vb_, lim_) const bool inpast_ = (P0_) < npast; \
            const float* kb_ = inpast_ ? kc + (size_t)(P0_) * HD : kn + (size_t)((P0_) - npast) * HD; \
            const float* vb_ = inpast_ ? vc + (size_t)(P0_) * HD : vn + (size_t)((P0_) - npast) * HD; \
            const int lim_ = inpast_ ? 31 : min(31, Tn - 1 - ((P0_) - npast));
        { ATT_TILE_PTRS((qpos0 >> 5) * 32, kb0, vb0, lim0); (void)vb0;
          const float* kp = kb0 + (size_t)min(ql, lim0) * HD + hi * 8;
#pragma unroll
          for (int s = 0; s < 4; ++s) { kc4[2 * s] = *(const f32x4*)(kp + 16 * s); kc4[2 * s + 1] = *(const f32x4*)(kp + 16 * s + 4); } }
        for (int kt = qpos0 >> 5; kt >= 0; --kt) {
            const int P0 = kt * 32;
            ATT_TILE_PTRS(P0, kb, vb, lim); (void)kb;
            float x0[16], x1[16];
#pragma unroll
            for (int r = 0; r < 16; ++r) { const float* vp = vb + (size_t)min(crow(r, hi), lim) * HD + ql; x0[r] = vp[0]; x1[r] = vp[32]; }
            f32x4 kn4[8];
            { const int Pn = kt > 0 ? P0 - 32 : P0; ATT_TILE_PTRS(Pn, kbn, vbn, limn); (void)vbn;
              const float* kp = kbn + (size_t)min(ql, limn) * HD + hi * 8;
#pragma unroll
              for (int s = 0; s < 4; ++s) { kn4[2 * s] = *(const f32x4*)(kp + 16 * s); kn4[2 * s + 1] = *(const f32x4*)(kp + 16 * s + 4); } }
            f32x16 st;
#pragma unroll
            for (int r = 0; r < 16; ++r) st[r] = 0.f;
#pragma unroll
            for (int s = 0; s < 4; ++s) st = __builtin_amdgcn_mfma_f32_32x32x16_bf16(pack8(kc4[2 * s], kc4[2 * s + 1]), qf[s], st, 0, 0, 0);
            float L[16];
            float own[4];
#pragma unroll
            for (int g = 0; g < 4; ++g) { float sg = 0.f;
#pragma unroll
                for (int i = 0; i < 4; ++i) { const int r = 4 * g + i; const bool vis = (P0 + crow(r, hi)) < qpos; L[r] = vis ? -softplusf_(st[r]) : 0.f; sg += L[r]; }
                own[g] = sg; }
            float oth[4];
#pragma unroll
            for (int g = 0; g < 4; ++g) oth[g] = shx(own[g], 32, lane);
            float suf = carry;
            float A[16];
#pragma unroll
            for (int g = 3; g >= 0; --g) {
                float c = suf + (hi == 0 ? oth[g] : 0.f);
#pragma unroll
                for (int i = 3; i >= 0; --i) { const int r = 4 * g + i; c += L[r]; const bool vis = (P0 + crow(r, hi)) < qpos; A[r] = vis ? __expf(st[r] + c) : 0.f; }
                suf += own[g] + oth[g];
            }
            carry = suf;
            const bf16x8 pa0 = pack8((f32x4){A[0], A[1], A[2], A[3]}, (f32x4){A[4], A[5], A[6], A[7]});
            const bf16x8 pa1 = pack8((f32x4){A[8], A[9], A[10], A[11]}, (f32x4){A[12], A[13], A[14], A[15]});
            o0 = __builtin_amdgcn_mfma_f32_32x32x16_bf16(pa0, pack8((f32x4){x0[0], x0[1], x0[2], x0[3]}, (f32x4){x0[4], x0[5], x0[6], x0[7]}), o0, 0, 0, 0);
            o1 = __builtin_amdgcn_mfma_f32_32x32x16_bf16(pa0, pack8((f32x4){x1[0], x1[1], x1[2], x1[3]}, (f32x4){x1[4], x1[5], x1[6], x1[7]}), o1, 0, 0, 0);
            o0 = __builtin_amdgcn_mfma_f32_32x32x16_bf16(pa1, pack8((f32x4){x0[8], x0[9], x0[10], x0[11]}, (f32x4){x0[12], x0[13], x0[14], x0[15]}), o0, 0, 0, 0);
            o1 = __builtin_amdgcn_mfma_f32_32x32x16_bf16(pa1, pack8((f32x4){x1[8], x1[9], x1[10], x1[11]}, (f32x4){x1[12], x1[13], x1[14], x1[15]}), o1, 0, 0, 0);
#pragma unroll
            for (int e = 0; e < 8; ++e) kc4[e] = kn4[e];
            if (!__any(carry >= -104.f)) break;
        }
#undef ATT_TILE_PTRS
        bf16_t* op = AO + (size_t)(row_base + Q0) * D + h * 64 + ql;
#pragma unroll
        for (int r = 0; r < 16; ++r) { const int qr = crow(r, hi); if (qr < nq) { op[(size_t)qr * D] = (bf16_t)(cvt_pk(o0[r], 0.f) & 0xffffu); op[(size_t)qr * D + 32] = (bf16_t)(cvt_pk(o1[r], 0.f) & 0xffffu); } }
    }
}

constexpr int NPHASE = 23;
#ifndef PHM
#define PHM 0xffff
#endif
#define EN(k) (((PHM) >> (k)) & 1)
constexpr int LDS_BYTES = 131072 + 8 * 576 * 4;
template <class Epi, class Sched>
__device__ __forceinline__ void run_gemm(LAS unsigned char* lds, int wb, const bf16_t* A, const bf16_t* Bt, int M, int N, int K, const Sched& S, const Epi& E, float* skp = nullptr, unsigned* skf = nullptr) {
    pg8::Gemm g{A, Bt, M, N, K, wb, skp, skf};
    pg8::gemm_phase<Epi, Sched, true, true>(lds, g, S, E);
}
__global__ void __launch_bounds__(512, 2) mega(Params p_unused) {
    LAS unsigned char* lds = (LAS unsigned char*)lds_raw;
    cg::grid_group grid = cg::this_grid();
    KP p = (KP)__builtin_amdgcn_kernarg_segment_ptr();
    const int ph_lo = p->ph_lo, ph_hi = p->ph_hi;
    const int wb = __builtin_amdgcn_readfirstlane((int)threadIdx.x) & ~63;
    for (int pi_ = ph_lo; pi_ < ph_hi; ++pi_) {
        asm volatile("" ::: "v1","v2","v3","v4","v5","v6","v7","v8","v9","v10","v11","v12","v13","v14","v15","v16","v17","v18","v19","v20","v21","v22","v23","v24","v25","v26","v27","v28","v29","v30","v31","v32","v33","v34","v35","v36","v37","v38","v39","v40","v41","v42","v43","v44","v45","v46","v47","v48","v49","v50","v51","v52","v53","v54","v55","v56","v57","v58","v59","v60","v61","v62","v63","v64","v65","v66","v67","v68","v69","v70","v71","v72","v73","v74","v75","v76","v77","v78","v79","v80","v81","v82","v83","v84","v85","v86","v87","v88","v89","v90","v91","v92","v93","v94","v95","v96","v97","v98","v99","v100","v101","v102","v103","v104","v105","v106","v107","v108","v109","v110","v111","v112","v113","v114","v115","v116","v117","v118","v119","v120","v121","v122","v123","v124","v125","v126","v127","v128","v129","v130","v131","v132","v133","v134","v135","v136","v137","v138","v139","v140","v141","v142","v143","v144","v145","v146","v147","v148","v149","v150","v151","v152","v153","v154","v155","v156","v157","v158","v159","v160","v161","v162","v163","v164","v165","v166","v167","v168","v169","v170","v171","v172","v173","v174","v175","v176","v177","v178","v179","v180","v181","v182","v183","v184","v185","v186","v187","v188","v189","v190","v191","v192","v193","v194","v195","v196","v197","v198","v199","v200","v201","v202","v203","v204","v205","v206","v207","v208","v209","v210","v211","v212","v213","v214","v215","v216","v217","v218","v219","v220","v221","v222","v223","v224","v225","v226","v227","v228","v229","v230","v231","v232","v233","v234","v235","v236","v237","v238","v239","v240","v241","v242","v243","v244","v245","v246","v247","v248","v249");
        asm volatile("" : "+s"(p));
        const int phc = p->seq[pi_], ph = phc & 63; const bool dry = (phc & 64) != 0;
        int bid = blockIdx.x, G = gridDim.x;
        asm volatile("" : "+s"(bid), "+s"(G));
#define TID_HERE (wb + lane_now())
        int ffn = -1; bool ffn_in = false;
        if (ph == 1 || ph == 2) { ffn = 0; ffn_in = ph == 1; } else if (ph == 11 || ph == 12) { ffn = 1; ffn_in = ph == 11; }
        else if (ph == 14 || ph == 15) { ffn = 2; ffn_in = ph == 14; } else if (ph == 21 || ph == 22) { ffn = 3; ffn_in = ph == 21; }
        if (EN(0) && ph == 0) { { const int tid = TID_HERE; convert_weights(p, (LAS float*)lds, tid, bid, G); assemble_x(p, tid, bid, G); } }
        else if (EN(1) && ffn >= 0 && ffn_in) {
            pg8::StaticOrder S; S.init(MP, NIN, G, bid); S.nt0 = D / 64;
            unsigned char* ws = p->ws; EpiSwiGLU E{(bf16_t*)(ws + W_HB), (const float*)(ws + W_RSQ) + (size_t)(ffn == 0 ? 0 : (ffn == 1 ? 1 : (ffn == 2 ? 2 : 4))) * MP};
            run_gemm(lds, wb, (const bf16_t*)(ws + W_XN), (const bf16_t*)(ws + W_WIN + ffn * SZ_WIN1), MP, NIN, D, S, E);
        } else if (EN(2) && ffn >= 0) {
            pg8::StaticOrder S; S.init(MP, D, G, bid); S.nt0 = DFFP / 64;
            unsigned char* ws = p->ws; const bool fold = (ffn == 1 || ffn == 2) && !dry;
            EpiRes E{(float*)(ws + W_X), dry ? 0.f : 0.5f, (ffn == 3 && !dry) ? p->out : nullptr, fold ? (bf16_t*)(ws + W_XN) : nullptr, (float*)(ws + W_RSQ) + (size_t)(ffn == 1 ? 2 : 3) * MP};
            run_gemm(lds, wb, (const bf16_t*)(ws + W_HB), (const bf16_t*)(ws + W_WOUT + ffn * SZ_WOUT1), MP, D, DFFP, S, E, (float*)(ws + W_SKP), (unsigned*)(ws + W_SKF) + pi_ * 1024);
        }
        else if (EN(3) && ph == 3) mixprep_phase(p, TID_HERE, bid, G);
        else if (EN(4) && ph == 4) {
            G1Order S{G, bid};
            unsigned char* ws = p->ws; EpiG1 E{(bf16_t*)(ws + W_RKV), (float*)(ws + W_L1)};
            run_gemm(lds, wb, (const bf16_t*)(ws + W_AALL), (const bf16_t*)(ws + W_WG1), 5 * MP, 3584, D, S, E);
        }
        else if (EN(5) && ph == 5) act_phase(p, bid * 512 + TID_HERE, G * 512);
        else if (EN(6) && ph == 6) {
            pg8::StaticOrder S; S.init(MP, 3072, G, bid); S.nt0 = 4;
            unsigned char* ws = p->ws; EpiG2 E{(bf16_t*)(ws + W_DEC)};
            run_gemm(lds, wb, (const bf16_t*)(ws + W_A2), (const bf16_t*)(ws + W_WL2), MP, 3072, 256, S, E);
        }
        else if (EN(7) && ph == 7) scan_phase(p, (LAS float*)lds, TID_HERE, bid, G);
        else if (EN(8) && ph == 8) post_phase(p, TID_HERE, bid, G);
        else if (EN(9) && (ph == 9 || ph == 19)) {
            pg8::StaticOrder S; S.init(MP, D, G, bid); S.nt0 = D / 64;
            unsigned char* ws = p->ws; EpiRes E{(float*)(ws + W_X), dry ? 0.f : 1.0f, nullptr, dry ? nullptr : (bf16_t*)(ws + W_XN), (float*)(ws + W_RSQ) + (size_t)(ph == 9 ? 1 : 4) * MP};
            run_gemm(lds, wb, (const bf16_t*)(ws + W_OG), (const bf16_t*)(ws + (ph == 9 ? W_WO1 : W_WO2)), MP, D, D, S, E, (float*)(ws + W_SKP), (unsigned*)(ws + W_SKF) + pi_ * 1024);
        }
        else if (EN(11) && ph == 17) {
            pg8::StaticOrder S; S.init(MP, 3 * D, G, bid); S.nt0 = D / 64;
            unsigned char* ws = p->ws; EpiQKV E{(bf16_t*)(ws + W_QB), p->out, p->in[28], p->in[29], (const float*)(ws + W_RSQ) + (size_t)3 * MP};
            run_gemm(lds, wb, (const bf16_t*)(ws + W_XN), (const bf16_t*)(ws + W_WQKV), MP, 3 * D, D, S, E);
        }
        else if (EN(12) && ph == 18) attn_phase(p, TID_HERE, bid, G);
        if (pi_ + 1 < ph_hi) grid.sync();
    }
}

#ifndef ONE_LAUNCH
#define ONE_LAUNCH 1
#endif
extern "C" void kernel_launch(void* const* d_in, const int* in_sizes, int n_in, void* d_out, int out_size, void* d_ws, size_t ws_size, hipStream_t stream) {
    static int grid = 0;
    if (grid == 0) {
        if (n_in != 31 || (size_t)out_size != O_END || ws_size < W_END) { fprintf(stderr, "kernel_launch: unexpected sizes (n_in %d out %d ws %zu need %zu)\n", n_in, out_size, ws_size, (size_t)W_END); grid = -1; return; }
        int dev = 0, cus = 0, per_cu = 0;
        hipGetDevice(&dev); hipDeviceGetAttribute(&cus, hipDeviceAttributeMultiprocessorCount, dev);
        if (hipFuncSetAttribute((const void*)mega, hipFuncAttributeMaxDynamicSharedMemorySize, LDS_BYTES) != hipSuccess) { fprintf(stderr, "kernel_launch: hipFuncSetAttribute failed\n"); grid = -1; return; }
        hipOccupancyMaxActiveBlocksPerMultiprocessor(&per_cu, (const void*)mega, 512, LDS_BYTES);
        (void)hipGetLastError();
        if (per_cu < 1) per_cu = 1;
        grid = cus * per_cu;
    }
    if (grid < 0) return;
    Params p{};
    for (int i = 0; i < 31; ++i) p.in[i] = (const float*)d_in[i];
    p.out = (float*)d_out; p.ws = (unsigned char*)d_ws;
    int nseq = 0;
    for (int ph = 0; ph < NPHASE; ++ph) {
        if (ph == 10 || ph == 13 || ph == 16 || ph == 20) continue;
        p.seq[nseq++] = ph;
#ifdef REP_OF
        for (int r = 0; r < (REP_OF(ph)); ++r) p.seq[nseq++] = (ph | ((ph == 2 || ph == 9) ? 64 : 0));
#endif
    }
#if ONE_LAUNCH
    p.ph_lo = 0; p.ph_hi = nseq;
    void* args[] = {&p};
    hipError_t e = hipLaunchCooperativeKernel((const void*)mega, dim3(grid), dim3(512), args, LDS_BYTES, stream);
    if (e != hipSuccess) fprintf(stderr, "cooperative launch failed: %s (grid %d)\n", hipGetErrorString(e), grid);
#else
    for (int ph = 0; ph < nseq; ++ph) { p.ph_lo = ph; p.ph_hi = ph + 1; hipLaunchKernelGGL(mega, dim3(grid), dim3(512), LDS_BYTES, stream, p); }
#endif
}
```

```cpp
#include <hip/hip_runtime.h>
#include <hip/hip_cooperative_groups.h>
#include <cstdio>
#include <cstdint>
namespace cg = cooperative_groups;
__device__ __forceinline__ int lane_now() { int l; asm volatile("v_mbcnt_lo_u32_b32 %0, -1, 0\n\tv_mbcnt_hi_u32_b32 %0, -1, %0" : "=v"(l)); return l; }
namespace pg8 {
#define PG8_LAS __attribute__((address_space(3)))
typedef unsigned short bf16_t;
typedef short bf16x8 __attribute__((ext_vector_type(8)));
typedef float f32x4 __attribute__((ext_vector_type(4)));
typedef unsigned u32x4 __attribute__((ext_vector_type(4)));
constexpr int BM = 256, BK = 64, HALF = 128, HTB = HALF * BK * 2  , STAGE_BYTES = 8 * HTB, NXCD = 8, WGM = 8;

__host__ __device__ __forceinline__ int lds_byte(int r, int c) { const int st = (r >> 4) * 2 + (c >> 5), rr = r & 15, cc = c & 31, ob = rr * 64 + cc * 2; return st * 1024 + (ob ^ (((ob >> 9) & 1) << 5)); }
__host__ __device__ __forceinline__ void stage_rc(int b, int& R, int& C) { const int st = b / 1024, sb = b % 1024, swz = sb ^ (((sb >> 9) & 1) << 5); R = (st >> 1) * 16 + swz / 64; C = (st & 1) * 32 + (swz % 64) / 2; }
__host__ __device__ __forceinline__ int perm32(int rho) { const int n = rho >> 4, i = rho & 15; return 8 * (i >> 2) + 4 * n + (i & 3); }

struct Unit { int pm, pn, kb, nt, fl, tl; };
struct Gemm { const bf16_t* A; const bf16_t* Bt; int M, N, K, wb; float* skp; unsigned* skf; };

struct StaticOrder {
    static constexpr bool STREAM = false; int nM, nN, nwg, G, c, nt0;
    __host__ __device__ void init(int M, int N, int G_, int c_) { nM = M / BM; nN = N / BM; nwg = nM * nN; G = G_; c = c_; }
    __host__ __device__ bool next(int i, Unit& u) const {
        const long L = (long)i * G + c; if (L >= nwg) return false;
        int wgid = (int)L; { const int q = nwg / NXCD, r = nwg % NXCD, xcd = wgid % NXCD, off = wgid / NXCD; wgid = (xcd < r ? xcd * (q + 1) : r * (q + 1) + (xcd - r) * q) + off; }
        const int nig = WGM * nN, gid = wgid / nig, fm = gid * WGM, gsz = (nM - fm) < WGM ? (nM - fm) : WGM;
        u.pm = fm + ((wgid % nig) % gsz); u.pn = (wgid % nig) / gsz; u.kb = 0; u.nt = nt0; u.fl = 0; u.tl = 0; return true;
    }
    __device__ __forceinline__ void a_ready(const Unit&) const {}
    __device__ __forceinline__ void done(const Unit&) const {}
};
typedef __attribute__((address_space(1))) f32x4 gf32x4;
typedef unsigned long long u64_t;
__device__ __forceinline__ void streamk_store(const f32x4 (&acc)[2][2][4][2], const Unit& u, float* skp, unsigned* skf, int tid) {
    u64_t* q = (u64_t*)(skp + (size_t)u.tl * 65536) + 2 * tid;
#pragma unroll
    for (int a = 0; a < 2; ++a)
#pragma unroll
        for (int b = 0; b < 2; ++b)
#pragma unroll
            for (int m = 0; m < 4; ++m)
#pragma unroll
                for (int n = 0; n < 2; ++n) { const f32x4 v = acc[a][b][m][n];
                    __hip_atomic_store(q, ((u64_t)__float_as_uint(v[1]) << 32) | __float_as_uint(v[0]), __ATOMIC_RELAXED, __HIP_MEMORY_SCOPE_AGENT);
                    __hip_atomic_store(q + 1, ((u64_t)__float_as_uint(v[3]) << 32) | __float_as_uint(v[2]), __ATOMIC_RELAXED, __HIP_MEMORY_SCOPE_AGENT);
                    q += 1024; asm volatile("" : "+v"(q) :: "memory"); }
    asm volatile("s_waitcnt vmcnt(0)" ::: "memory");
    __builtin_amdgcn_s_barrier();
    if (tid == 0) __hip_atomic_store(skf + u.tl, 1u, __ATOMIC_RELAXED, __HIP_MEMORY_SCOPE_AGENT);
}
__device__ __forceinline__ const float* streamk_wait(const Unit& u, float* skp, unsigned* skf, int tid) {
    if (u.fl == 2) {
        if (tid == 0) { while (__hip_atomic_load(skf + u.tl, __ATOMIC_RELAXED, __HIP_MEMORY_SCOPE_AGENT) == 0u) __builtin_amdgcn_s_sleep(2); }
        __builtin_amdgcn_s_barrier();
        __builtin_amdgcn_fence(__ATOMIC_ACQUIRE, "agent");
    } else __builtin_amdgcn_s_barrier();
    return skp + (size_t)u.tl * 65536;
}
__device__ __forceinline__ f32x4 streamk_part(const float* part, int idx, int tid) {
    const u64_t* q = (const u64_t*)part + (size_t)idx * 1024 + 2 * tid;
    const u64_t a = __hip_atomic_load(q, __ATOMIC_RELAXED, __HIP_MEMORY_SCOPE_AGENT), b = __hip_atomic_load(q + 1, __ATOMIC_RELAXED, __HIP_MEMORY_SCOPE_AGENT);
    return (f32x4){__uint_as_float((unsigned)a), __uint_as_float((unsigned)(a >> 32)), __uint_as_float((unsigned)b), __uint_as_float((unsigned)(b >> 32))};
}
template <class Epi, class Sched, bool ALIGN_EPI = false, bool SP2 = false>
__device__ __forceinline__ void gemm_phase(PG8_LAS unsigned char* lds, const Gemm g, const Sched& S, const Epi& E) {
    int tid = g.wb + lane_now(); asm volatile("" : "+v"(tid)); const int wid = __builtin_amdgcn_readfirstlane(tid >> 6), lane = tid & 63, wr = wid >> 2, wc = wid & 3, fr = lane & 15, fq = lane >> 4;
    const int K = g.K, nt = K / BK;
    unsigned voffA[2], voffB[2];
#pragma unroll
    for (int i = 0; i < 2; ++i) { int R, C; stage_rc(tid * 16 + i * 8192, R, C); const int Rb = Epi::PERM ? ((R & ~31) + perm32(R & 31)) : R;
        voffA[i] = (unsigned)(R * K + C) * 2u; voffB[i] = (unsigned)(Rb * K + C) * 2u; }
    const size_t kstep = (size_t)(BK * 2);
    const size_t hstep = (size_t)HALF * K * 2;
    const size_t tstep = 2 * hstep;
    const unsigned ldsw = (unsigned)wid * 1024u;
    const int aoff = lds_byte(wr * 64 + fr, fq * 8), boff = lds_byte(wc * 32 + fr, fq * 8);
#define PG8_SA(b, h) (((b) * 2 + (h)) * HTB)
#define PG8_SB(b, h) ((4 + (b) * 2 + (h)) * HTB)
#define PG8_STAGE(bufoff, gbase, voff) do { _Pragma("unroll") for (int _i = 0; _i < 2; ++_i) \
        __builtin_amdgcn_global_load_lds((const unsigned*)((const char*)(gbase) + (voff)[_i]), (PG8_LAS unsigned*)(lds + (bufoff) + ldsw + _i * 8192), 16, 0, 0); } while (0)
#define PG8_LDA(dst, b, h) do { _Pragma("unroll") for (int m = 0; m < 4; ++m) _Pragma("unroll") for (int k = 0; k < 2; ++k) dst[m][k] = *(const PG8_LAS bf16x8*)(lds + PG8_SA(b, h) + aoff + m * 2048 + k * 1024); } while (0)
#define PG8_LDB(dst, b, h) do { _Pragma("unroll") for (int n = 0; n < 2; ++n) _Pragma("unroll") for (int k = 0; k < 2; ++k) dst[n][k] = *(const PG8_LAS bf16x8*)(lds + PG8_SB(b, h) + boff + n * 2048 + k * 1024); } while (0)
#define PG8_MMA(ai, bj, At, Bt) do { __builtin_amdgcn_s_setprio(1); _Pragma("unroll") for (int m = 0; m < 4; ++m) _Pragma("unroll") for (int n = 0; n < 2; ++n) _Pragma("unroll") for (int k = 0; k < 2; ++k) \
        acc[ai][bj][m][n] = __builtin_amdgcn_mfma_f32_16x16x32_bf16(Bt[n][k], At[m][k], acc[ai][bj][m][n], 0, 0, 0); __builtin_amdgcn_s_setprio(0); } while (0)
#define PG8_WAIT_V(n) asm volatile("s_waitcnt vmcnt(" #n ")" ::: "memory")
#define PG8_WAIT_L(n) asm volatile("s_waitcnt lgkmcnt(" #n ")" ::: "memory")
#define PG8_BAR __builtin_amdgcn_s_barrier()
#define PG8_SCHED __builtin_amdgcn_sched_barrier(0)
    Unit cur, nxt; int ui = 0;
    if (!S.next(0, cur)) return;
    f32x4 acc[2][2][4][2];
#pragma unroll
    for (int a = 0; a < 2; ++a)
#pragma unroll
        for (int b = 0; b < 2; ++b)
#pragma unroll
            for (int m = 0; m < 4; ++m)
#pragma unroll
                for (int n = 0; n < 2; ++n) acc[a][b][m][n] = (f32x4){0.f, 0.f, 0.f, 0.f};
    bf16x8 At[4][2], B0[2][2], B1[2][2];
    const char* cA = (const char*)g.A + (size_t)cur.pm * tstep + cur.kb; const char* cB = (const char*)g.Bt + (size_t)cur.pn * tstep + cur.kb;
    S.a_ready(cur);
    if constexpr (SP2) {
        PG8_STAGE(PG8_SB(0, 0), cB, voffB); PG8_STAGE(PG8_SB(0, 1), cB + hstep, voffB); PG8_STAGE(PG8_SA(0, 0), cA, voffA); PG8_STAGE(PG8_SA(0, 1), cA + hstep, voffA);
        if (wr == 1) PG8_BAR;
        PG8_WAIT_V(2); PG8_BAR;
        PG8_STAGE(PG8_SB(1, 0), cB + kstep, voffB); PG8_STAGE(PG8_SA(1, 0), cA + kstep, voffA); PG8_STAGE(PG8_SB(1, 1), cB + hstep + kstep, voffB);
        PG8_WAIT_V(6); PG8_BAR;
    } else {
        PG8_STAGE(PG8_SB(0, 0), cB, voffB); PG8_STAGE(PG8_SA(0, 0), cA, voffA); PG8_STAGE(PG8_SB(0, 1), cB + hstep, voffB); PG8_STAGE(PG8_SA(0, 1), cA + hstep, voffA);
        if (wr == 1) PG8_BAR;
        PG8_WAIT_V(4); PG8_BAR;
        PG8_STAGE(PG8_SB(1, 0), cB + kstep, voffB); PG8_STAGE(PG8_SA(1, 0), cA + kstep, voffA); PG8_STAGE(PG8_SB(1, 1), cB + hstep + kstep, voffB);
        PG8_WAIT_V(6); PG8_BAR;
    }
    for (;;) {
        const bool has_next = S.next(ui + 1, nxt);
        const char* nA = has_next ? (const char*)g.A + (size_t)nxt.pm * tstep + nxt.kb : cA; const char* nB = has_next ? (const char*)g.Bt + (size_t)nxt.pn * tstep + nxt.kb : cB;
        const int ntu = cur.nt;
        for (int t = 0; t < ntu; t += 2) {
            const bool last = (t == ntu - 2);
            const char* a1 = cA + (size_t)(t + 1) * kstep;
            const char* a2 = last ? nA : cA + (size_t)(t + 2) * kstep; const char* b2 = last ? nB : cB + (size_t)(t + 2) * kstep;
            const char* a3 = a2 + kstep; const char* b3 = b2 + kstep;
            if (last && has_next) S.a_ready(nxt);
            if constexpr (SP2) {
            PG8_LDB(B0, 0, 0); PG8_LDB(B1, 0, 1); PG8_SCHED; PG8_LDA(At, 0, 0); PG8_STAGE(PG8_SA(1, 1), a1 + hstep, voffA);
            PG8_WAIT_V(8); PG8_WAIT_L(0); PG8_BAR; PG8_MMA(0, 0, At, B0); PG8_MMA(0, 1, At, B1); PG8_BAR; PG8_SCHED;
            PG8_LDA(At, 0, 1); PG8_STAGE(PG8_SB(0, 0), b2, voffB); PG8_STAGE(PG8_SB(0, 1), b2 + hstep, voffB); PG8_STAGE(PG8_SA(0, 0), a2, voffA);
            PG8_WAIT_V(8); PG8_WAIT_L(0); PG8_BAR; PG8_MMA(1, 0, At, B0); PG8_MMA(1, 1, At, B1); PG8_BAR; PG8_SCHED;
            PG8_LDB(B0, 1, 0); PG8_LDB(B1, 1, 1); PG8_SCHED; PG8_LDA(At, 1, 0); PG8_STAGE(PG8_SA(0, 1), a2 + hstep, voffA);
            PG8_WAIT_V(8); PG8_WAIT_L(0); PG8_BAR; PG8_MMA(0, 0, At, B0); PG8_MMA(0, 1, At, B1); PG8_BAR; PG8_SCHED;
            PG8_LDA(At, 1, 1); PG8_STAGE(PG8_SB(1, 0), b3, voffB); PG8_STAGE(PG8_SB(1, 1), b3 + hstep, voffB); PG8_STAGE(PG8_SA(1, 0), a3, voffA);
            PG8_WAIT_V(8); PG8_WAIT_L(0); PG8_BAR; PG8_MMA(1, 0, At, B0); PG8_MMA(1, 1, At, B1); PG8_BAR; PG8_SCHED;
            } else {
            PG8_LDB(B0, 0, 0); PG8_SCHED; PG8_LDA(At, 0, 0); PG8_STAGE(PG8_SA(1, 1), a1 + hstep, voffA);
            PG8_WAIT_L(8); PG8_BAR; PG8_WAIT_L(0); PG8_MMA(0, 0, At, B0); PG8_BAR; PG8_SCHED;
            PG8_LDB(B1, 0, 1); PG8_STAGE(PG8_SB(0, 0), b2, voffB);
            PG8_BAR; PG8_WAIT_L(0); PG8_MMA(0, 1, At, B1); PG8_BAR;
            PG8_LDA(At, 0, 1); PG8_STAGE(PG8_SA(0, 0), a2, voffA);
            PG8_BAR; PG8_WAIT_L(0); PG8_MMA(1, 0, At, B0); PG8_BAR; PG8_SCHED;
            PG8_STAGE(PG8_SB(0, 1), b2 + hstep, voffB);
            PG8_WAIT_V(6); PG8_BAR; PG8_MMA(1, 1, At, B1); PG8_BAR;
            PG8_LDB(B0, 1, 0); PG8_SCHED; PG8_LDA(At, 1, 0); PG8_STAGE(PG8_SA(0, 1), a2 + hstep, voffA);
            PG8_WAIT_L(8); PG8_BAR; PG8_WAIT_L(0); PG8_MMA(0, 0, At, B0); PG8_BAR; PG8_SCHED;
            PG8_LDB(B1, 1, 1); PG8_STAGE(PG8_SB(1, 0), b3, voffB);
            PG8_BAR; PG8_WAIT_L(0); PG8_MMA(0, 1, At, B1); PG8_BAR;
            PG8_LDA(At, 1, 1); PG8_STAGE(PG8_SA(1, 0), a3, voffA);
            PG8_BAR; PG8_WAIT_L(0); PG8_MMA(1, 0, At, B0); PG8_BAR; PG8_SCHED;
            PG8_STAGE(PG8_SB(1, 1), b3 + hstep, voffB);
            PG8_WAIT_V(6); PG8_BAR; PG8_MMA(1, 1, At, B1); PG8_BAR;
            }
        }
        if constexpr (ALIGN_EPI) { if (wr == 0) PG8_BAR; }
        if constexpr (!Epi::AFTER_DRAIN) { int t_ = g.wb + lane_now(); asm volatile("" : "+v"(t_)); const int fr_ = t_ & 15, fq_ = (t_ >> 4) & 3; if constexpr (!Sched::STREAM) E(acc, cur, wr, wc, fr_, fq_); else { if (cur.fl == 1) streamk_store(acc, cur, g.skp, g.skf, t_); else { const float* part_ = streamk_wait(cur, g.skp, g.skf, t_); int t2_ = g.wb + lane_now(); asm volatile("" : "+v"(t2_)); E(acc, cur, wr, wc, t2_ & 15, (t2_ >> 4) & 3, part_, t2_); } } S.done(cur); }
        if (!has_next) break;
#pragma unroll
        for (int a = 0; a < 2; ++a)
#pragma unroll
            for (int b = 0; b < 2; ++b)
#pragma unroll
                for (int m = 0; m < 4; ++m)
#pragma unroll
                    for (int n = 0; n < 2; ++n) acc[a][b][m][n] = (f32x4){0.f, 0.f, 0.f, 0.f};
        cur = nxt; cA = nA; cB = nB; ++ui;
        if constexpr (ALIGN_EPI) { if (wr == 1) PG8_BAR; }
    }
    PG8_WAIT_V(0);
    if constexpr (!ALIGN_EPI) { if (wr == 0) PG8_BAR; }
    PG8_BAR;
    if constexpr (Epi::AFTER_DRAIN) { E.fused(acc, cur, wr, wc, fr, fq, lds, wid, lane); S.done(cur); }
#undef PG8_SA
#undef PG8_SB
#undef PG8_STAGE
#undef PG8_LDA
#undef PG8_LDB
#undef PG8_MMA
#undef PG8_WAIT_V
#undef PG8_WAIT_L
#undef PG8_BAR
#undef PG8_SCHED
}
}

#define LAS __attribute__((address_space(3)))
typedef unsigned short bf16_t;
typedef short bf16x8 __attribute__((ext_vector_type(8)));
typedef float f32x4 __attribute__((ext_vector_type(4)));
typedef float f32x2 __attribute__((ext_vector_type(2)));
typedef float f32x16 __attribute__((ext_vector_type(16)));
typedef unsigned u32x4 __attribute__((ext_vector_type(4)));
typedef unsigned u32x2 __attribute__((ext_vector_type(2)));

constexpr int D = 1024, NH = 16, HD = 64;
constexpr int BP = 8, TP = 2064, SEQP = 2048, NMETA = 16, BS = 16, TS = 64, PAST = 4096;
constexpr int MPR = BP * TP;
constexpr int MR = MPR + BS * TS;
constexpr int MP = 17664;
constexpr int NTM = 69;
constexpr int DFF = 2752, DFFP = 2816, NIN = 5632;
constexpr float RMS_EPS = 1e-6f, GN_EPS = 64e-5f;
constexpr float LOG2E = 1.4426950408889634f;

constexpr size_t O_YP = 0, O_YS = 16777216, O_SP = 17825792, O_SHP = 18350080, O_KP = 18358272, O_VP = 35266560,
                 O_SS = 52174848, O_SHS = 53223424, O_KS = 53239808, O_VS = 54288384, O_END = 55336960;

constexpr size_t SZ_ROWBF = (size_t)MP * D * 2, SZ_ROWF = (size_t)MP * D * 4;
constexpr size_t W_X = 0;
constexpr size_t W_XN = W_X + SZ_ROWF;
constexpr size_t W_HB = W_XN + SZ_ROWBF;
constexpr size_t W_WIN = W_HB + (size_t)MP * DFFP * 2;
constexpr size_t SZ_WIN1 = (size_t)NIN * D * 2, SZ_WOUT1 = (size_t)D * DFFP * 2;
constexpr size_t W_WOUT = W_WIN + 4 * SZ_WIN1;
constexpr size_t W_WG1 = W_WOUT + 4 * SZ_WOUT1;
constexpr size_t W_WL2 = W_WG1 + (size_t)3584 * D * 2;
constexpr size_t W_WO1 = W_WL2 + (size_t)3072 * 256 * 2;
constexpr size_t W_WQKV = W_WO1 + (size_t)D * D * 2;
constexpr size_t W_WO2 = W_WQKV + (size_t)3 * D * D * 2;
constexpr size_t W_AALL = W_WO2 + (size_t)D * D * 2;
constexpr size_t W_RKV = W_AALL + 5 * SZ_ROWBF;
constexpr size_t W_L1 = W_RKV + 3 * SZ_ROWBF;
constexpr size_t W_A2 = W_L1 + (size_t)2 * MP * 256 * 4;
constexpr size_t W_DEC = W_A2 + (size_t)MP * 256 * 2;
constexpr size_t W_AA = W_DEC + SZ_ROWBF;
constexpr size_t W_GG = W_AA + SZ_ROWBF;
constexpr size_t W_SO = W_GG + SZ_ROWBF;
constexpr size_t W_OG = W_SO + SZ_ROWF;
constexpr size_t W_QB = W_OG + SZ_ROWBF;
constexpr size_t W_RSQ = W_QB + SZ_ROWBF;
constexpr size_t W_SKF = W_RSQ + (size_t)5 * MP * 4;
constexpr size_t W_SKP = W_SKF + 64 * 1024 * 4;
constexpr size_t W_END = W_SKP + (size_t)277 * 262144;

struct Params { const float* in[31]; float* out; unsigned char* ws; int ph_lo, ph_hi; int seq[64]; };
typedef const Params __attribute__((address_space(4)))* KP;

__device__ __forceinline__ unsigned cvt_pk(float lo, float hi) { unsigned r; asm("v_cvt_pk_bf16_f32 %0, %1, %2" : "=v"(r) : "v"(lo), "v"(hi)); return r; }
__device__ __forceinline__ void store_bf4(bf16_t* p, f32x4 v) { u32x2 w; w.x = cvt_pk(v[0], v[1]); w.y = cvt_pk(v[2], v[3]); *(u32x2*)p = w; }
__device__ __forceinline__ float bf_lo(unsigned w) { return __uint_as_float(w << 16); }
__device__ __forceinline__ float bf_hi(unsigned w) { return __uint_as_float(w & 0xffff0000u); }
__device__ __forceinline__ float sigmoidf_(float x) { return __builtin_amdgcn_rcpf(1.f + __expf(-x)); }
__device__ __forceinline__ float softplusf_(float x) { return fmaxf(x, 0.f) + __logf(1.f + __expf(-fabsf(x))); }
__device__ __forceinline__ float shx(float v, int o, int lane) { return __builtin_bit_cast(float, __builtin_amdgcn_ds_bpermute((lane ^ o) << 2, __builtin_bit_cast(int, v))); }
__device__ __forceinline__ float wave_sum(float v, int lane) {
#pragma unroll
    for (int o = 1; o < 64; o <<= 1) v += shx(v, o, lane);
    return v;
}
__device__ __forceinline__ void row_bt(int row, int& grp, int& b, int& t) { if (row < MPR) { grp = 0; b = row / TP; t = row - b * TP; } else { grp = 1; const int r = row - MPR; b = r >> 6; t = r & 63; } }

using pg8::Unit;
extern __shared__ __attribute__((aligned(16))) unsigned char lds_raw[];
struct EpiSwiGLU {
    static constexpr bool PERM = true, AFTER_DRAIN = false;
    bf16_t* HB; const float* rsq;
    __device__ __forceinline__ void operator()(const f32x4 (&acc)[2][2][4][2], const Unit& u, int wr, int wc, int fr, int fq) const {
        const int row0 = u.pm * 256 + wr * 64 + fr, col0 = u.pn * 128 + wc * 32 + 8 * fq;
#pragma unroll
        for (int ai = 0; ai < 2; ++ai)
#pragma unroll
            for (int m = 0; m < 4; ++m) {
                bf16_t* rowp = HB + (size_t)(row0 + ai * 128 + m * 16) * DFFP + col0;
                const float rs = __builtin_amdgcn_rsqf(rsq[row0 + ai * 128 + m * 16] * (1.f / D) + RMS_EPS);
                float hv[8];
#pragma unroll
                for (int n = 0; n < 2; ++n)
#pragma unroll
                    for (int j = 0; j < 4; ++j) { const float g = acc[ai][0][m][n][j] * rs, up = acc[ai][1][m][n][j] * rs; hv[n * 4 + j] = g * sigmoidf_(g) * up; }
                u32x4 w; w.x = cvt_pk(hv[0], hv[1]); w.y = cvt_pk(hv[2], hv[3]); w.z = cvt_pk(hv[4], hv[5]); w.w = cvt_pk(hv[6], hv[7]);
                *(u32x4*)rowp = w;
            }
    }
};
struct EpiRes {
    static constexpr bool PERM = false, AFTER_DRAIN = false;
    float* X; float scale; float* out; bf16_t* XB; float* rsq;
    __device__ __forceinline__ void operator()(const f32x4 (&acc)[2][2][4][2], const Unit& u, int wr, int wc, int fr, int fq, const float* part = nullptr, int tid = 0) const {
        const bool hasp = u.fl == 2;
        float* const X_ = X; float* const out_ = out; bf16_t* const XB_ = XB; float* const rsq_ = rsq; const float sc_ = scale;
        const int row0 = u.pm * 256 + wr * 64 + fr, col0 = u.pn * 256 + wc * 32 + 4 * fq, ln = fq * 16 + fr;
#pragma unroll
        for (int ai = 0; ai < 2; ++ai)
#pragma unroll
            for (int m = 0; m < 4; ++m) {
                const int row = row0 + ai * 128 + m * 16;
                const unsigned off = (unsigned)row * D + col0;
                if (out_ == nullptr) {
                    float ss = 0.f;
#pragma unroll
                    for (int bj = 0; bj < 2; ++bj)
#pragma unroll
                        for (int n = 0; n < 2; ++n) { f32x4* q = (f32x4*)(X_ + off + bj * 128 + n * 16); f32x4 av = acc[ai][bj][m][n]; if (hasp) av += pg8::streamk_part(part, ((ai * 2 + bj) * 4 + m) * 2 + n, tid); const f32x4 x = *q + av * sc_; *q = x;
                            if (XB_) { store_bf4(XB_ + off + bj * 128 + n * 16, x); ss += (x[0] * x[0] + x[1] * x[1]) + (x[2] * x[2] + x[3] * x[3]); } }
                    if (XB_) { ss += shx(ss, 16, ln); ss += shx(ss, 32, ln); if (fq == 0) unsafeAtomicAdd(rsq_ + row, ss); }
                } else if (row < MR) {
                    float* dp = nullptr;
                    if (row < MPR) { const int b = row / TP, t = row - b * TP; if (t >= NMETA) dp = out_ + O_YP + ((size_t)b * SEQP + (t - NMETA)) * D + col0; }
                    else dp = out_ + O_YS + (size_t)(row - MPR) * D + col0;
                    if (dp) {
#pragma unroll
                        for (int bj = 0; bj < 2; ++bj)
#pragma unroll
                            for (int n = 0; n < 2; ++n) { f32x4 av = acc[ai][bj][m][n]; if (hasp) av += pg8::streamk_part(part, ((ai * 2 + bj) * 4 + m) * 2 + n, tid); *(f32x4*)(dp + bj * 128 + n * 16) = *(const f32x4*)(X_ + off + bj * 128 + n * 16) + av * sc_; }
                    }
                }
                asm volatile("" ::: "memory");
            }
    }
};
struct StreamOrder {
    static constexpr bool STREAM = true;
    int nN, ppt, c; long s, e;
    __device__ void init(int M, int N, int K, int G, int c_) {
        nN = N / 256; ppt = K / 128;
        c = (G % 8 == 0) ? (c_ % 8) * (G / 8) + c_ / 8 : c_;
        const long P = (long)(M / 256) * nN * ppt;
        s = (long)c * P / G; e = (long)(c + 1) * P / G;
    }
    __device__ bool next(int i, Unit& u) const {
        const int t = (int)(s / ppt) + i; const long t0 = (long)t * ppt;
        if (t0 >= e) return false;
        const long lo = s > t0 ? s : t0, hi = e < t0 + ppt ? e : t0 + ppt;
        u.pm = t / nN; u.pn = t - u.pm * nN; u.tl = t;
        u.kb = (int)(lo - t0) * 256; u.nt = (int)(hi - lo) * 2;
        u.fl = lo > t0 ? 1 : (hi < t0 + ppt ? 2 : 0);
        return true;
    }
    __device__ __forceinline__ void a_ready(const Unit&) const {}
    __device__ __forceinline__ void done(const Unit&) const {}
};
struct EpiG1 {
    static constexpr bool PERM = true, AFTER_DRAIN = false;
    bf16_t* RKV; float* L1;
    __device__ __forceinline__ void operator()(const f32x4 (&acc)[2][2][4][2], const Unit& u, int wr, int wc, int fr, int fq) const {
        const unsigned row0 = (unsigned)((u.pm % NTM) * 256 + wr * 64 + fr), cw = wc * 32 + 8 * fq;
        if (u.pn < 12) {
            bf16_t* base = RKV + (size_t)(u.pn >> 2) * MP * D;
            const unsigned off0 = row0 * D + (u.pn & 3) * 256 + cw;
#pragma unroll
            for (int ai = 0; ai < 2; ++ai)
#pragma unroll
                for (int m = 0; m < 4; ++m)
#pragma unroll
                    for (int bj = 0; bj < 2; ++bj) { const f32x4 v0 = acc[ai][bj][m][0], v1 = acc[ai][bj][m][1];
                        u32x4 w; w.x = cvt_pk(v0[0], v0[1]); w.y = cvt_pk(v0[2], v0[3]); w.z = cvt_pk(v1[0], v1[1]); w.w = cvt_pk(v1[2], v1[3]);
                        *(u32x4*)(base + (off0 + (unsigned)((ai * 128 + m * 16) * D + bj * 128))) = w; }
        } else {
            float* base = L1 + (size_t)(u.pn - 12) * MP * 256;
            const unsigned off0 = row0 * 256 + cw;
#pragma unroll
            for (int ai = 0; ai < 2; ++ai)
#pragma unroll
                for (int m = 0; m < 4; ++m)
#pragma unroll
                    for (int bj = 0; bj < 2; ++bj)
#pragma unroll
                        for (int n = 0; n < 2; ++n) *(f32x4*)(base + (off0 + (unsigned)((ai * 128 + m * 16) * 256 + bj * 128 + n * 4))) = acc[ai][bj][m][n];
        }
    }
};
struct EpiG2 {
    static constexpr bool PERM = true, AFTER_DRAIN = false;
    bf16_t* LW;
    __device__ __forceinline__ void operator()(const f32x4 (&acc)[2][2][4][2], const Unit& u, int wr, int wc, int fr, int fq) const {
        bf16_t* base = LW + (size_t)(u.pn >> 2) * MP * D;
        const unsigned off0 = (unsigned)(u.pm * 256 + wr * 64 + fr) * D + (u.pn & 3) * 256 + wc * 32 + 8 * fq;
#pragma unroll
        for (int ai = 0; ai < 2; ++ai)
#pragma unroll
            for (int m = 0; m < 4; ++m)
#pragma unroll
                for (int bj = 0; bj < 2; ++bj) { const f32x4 v0 = acc[ai][bj][m][0], v1 = acc[ai][bj][m][1];
                    u32x4 w; w.x = cvt_pk(v0[0], v0[1]); w.y = cvt_pk(v0[2], v0[3]); w.z = cvt_pk(v1[0], v1[1]); w.w = cvt_pk(v1[2], v1[3]);
                    *(u32x4*)(base + (off0 + (unsigned)((ai * 128 + m * 16) * D + bj * 128))) = w; }
    }
};
struct EpiQKV {
    static constexpr bool PERM = false, AFTER_DRAIN = false;
    bf16_t* QB; float* out; const float* qg; const float* kg; const float* rsq;
    __device__ __forceinline__ void operator()(const f32x4 (&acc)[2][2][4][2], const Unit& u, int wr, int wc, int fr, int fq) const {
        const int sec = u.pn >> 2, head = (u.pn & 3) * 4 + wc, row0 = u.pm * 256 + wr * 64 + fr;
        f32x4 gn[2][2];
#pragma unroll
        for (int bj = 0; bj < 2; ++bj)
#pragma unroll
            for (int n = 0; n < 2; ++n) { const int d = 32 * bj + 16 * n + 4 * fq;
                gn[bj][n] = sec == 0 ? *(const f32x4*)(qg + d) * 0.125f : (sec == 1 ? *(const f32x4*)(kg + d) : (f32x4){1.f, 1.f, 1.f, 1.f}); }
#pragma unroll
        for (int ai = 0; ai < 2; ++ai)
#pragma unroll
            for (int m = 0; m < 4; ++m) {
                const int row = row0 + ai * 128 + m * 16;
                const float rx = __builtin_amdgcn_rsqf(rsq[row] * (1.f / D) + RMS_EPS);
                float ss = 0.f;
#pragma unroll
                for (int bj = 0; bj < 2; ++bj)
#pragma unroll
                    for (int n = 0; n < 2; ++n) { const f32x4 x = acc[ai][bj][m][n]; ss += (x[0] * x[0] + x[1] * x[1]) + (x[2] * x[2] + x[3] * x[3]); }
                { const int ln = fq * 16 + fr; ss += shx(ss, 16, ln); ss += shx(ss, 32, ln); }
                const float rs = rx * (sec == 2 ? 1.f : __builtin_amdgcn_rsqf(ss * rx * rx * (1.f / 64.f) + RMS_EPS));
                if (row < MR) {
                    if (sec == 0) {
                        bf16_t* qp = QB + (size_t)row * D + head * 64 + 4 * fq;
#pragma unroll
                        for (int bj = 0; bj < 2; ++bj)
#pragma unroll
                            for (int n = 0; n < 2; ++n) { const f32x4 x = acc[ai][bj][m][n] * rs * gn[bj][n]; u32x2 w; w.x = cvt_pk(x[0], x[1]); w.y = cvt_pk(x[2], x[3]); *(u32x2*)(qp + 32 * bj + 16 * n) = w; }
                    } else {
                        int grp, b, t; row_bt(row, grp, b, t);
                        float* dp = grp == 0 ? out + (sec == 1 ? O_KP : O_VP) + (((size_t)b * NH + head) * TP + t) * HD
                                             : out + (sec == 1 ? O_KS : O_VS) + (((size_t)b * NH + head) * TS + t) * HD;
                        dp += 4 * fq;
#pragma unroll
                        for (int bj = 0; bj < 2; ++bj)
#pragma unroll
                            for (int n = 0; n < 2; ++n) *(f32x4*)(dp + 32 * bj + 16 * n) = acc[ai][bj][m][n] * rs * gn[bj][n];
                    }
                }
            }
    }
};
struct G1Order {
    static constexpr bool STREAM = false;
    int G, c;
    __device__ bool next(int i, Unit& u) const {
        const long L = (long)i * G + c; if (L >= 966) return false;
        int w = (int)L; { const int q = 966 / 8, r = 966 % 8, xcd = w % 8, off = w / 8; w = (xcd < r ? xcd * (q + 1) : r * (q + 1) + (xcd - r) * q) + off; }
        const int pm = w / 14, q = w % 14;
        if (q < 12) { u.pm = (q >> 2) * NTM + pm; u.pn = q; } else { u.pm = (q - 9) * NTM + pm; u.pn = q; }
        u.kb = 0; u.nt = 16; u.fl = 0; u.tl = 0;
        return true;
    }
    __device__ __forceinline__ void a_ready(const Unit&) const {}
    __device__ __forceinline__ void done(const Unit&) const {}
};

struct Job { const float* src; bf16_t* dst; const float* mu; int ld, Ksrc, koff, Kdst, rows, map, smode; };
__device__ __forceinline__ int srccol(int map, int n, int ld) {
    if (map == 0) return n < ld ? n : -1;
    if (map == 1) { const int pn = n >> 8, c = n & 255, bj = c >> 7, j = c & 127, hc = pn * 128 + j; return hc < DFF ? (bj ? DFF + hc : hc) : -1; }
    { const int t = n >> 8, c = n & 255, bj = c >> 7, wc = (c & 127) >> 5, i = c & 31; return t * 256 + 64 * wc + 32 * bj + i; }
}
__device__ __forceinline__ Job get_job(KP p, int j) {
    Job J; J.mu = nullptr; J.koff = 0; J.map = 0; J.smode = 0;
    unsigned char* ws = p->ws;
    if (j < 4) { J.src = p->in[8] + (size_t)j * D * 2 * DFF; J.dst = (bf16_t*)(ws + W_WIN + j * SZ_WIN1); J.ld = 2 * DFF; J.Ksrc = D; J.Kdst = D; J.rows = NIN; J.map = 1; J.mu = p->in[7] + (size_t)j * D; J.smode = 2; }
    else if (j < 8) { const int i = j - 4; J.src = p->in[9] + (size_t)i * DFF * D; J.dst = (bf16_t*)(ws + W_WOUT + i * SZ_WOUT1); J.ld = D; J.Ksrc = DFF; J.Kdst = DFFP; J.rows = D; }
    else if (j < 11) { const int g = j - 8; J.src = p->in[12] + (size_t)g * D * D; J.dst = (bf16_t*)(ws + W_WG1) + (size_t)g * D * D; J.ld = D; J.Ksrc = D; J.Kdst = D; J.rows = D; }
    else if (j < 17) { const int idx = j - 11, part = idx / 3, which = idx % 3;
        J.src = which == 0 ? p->in[14] : (which == 1 ? p->in[17] : p->in[19]); J.ld = which == 2 ? 128 : 64; J.rows = J.ld;
        J.mu = p->in[11] + (which == 0 ? 1 : (which == 1 ? 4 : 5)) * D; J.smode = part + 1;
        J.dst = (bf16_t*)(ws + W_WG1) + (size_t)(3072 + part * 256 + which * 64) * D; J.Ksrc = D; J.Kdst = D; }
    else if (j < 20) { const int which = j - 17; J.src = which == 0 ? p->in[15] : (which == 1 ? p->in[18] : p->in[20]); J.ld = D; J.rows = D;
        J.Ksrc = which == 2 ? 128 : 64; J.koff = which * 64; J.Kdst = 256; J.dst = (bf16_t*)(ws + W_WL2) + (size_t)which * D * 256; }
    else if (j == 20) { J.src = p->in[26]; J.dst = (bf16_t*)(ws + W_WO1); J.ld = D; J.Ksrc = D; J.Kdst = D; J.rows = D; }
    else if (j == 21) { J.src = p->in[27]; J.dst = (bf16_t*)(ws + W_WQKV); J.ld = 3 * D; J.Ksrc = D; J.Kdst = D; J.rows = 3 * D; J.map = 2; J.mu = p->in[10] + D; J.smode = 2; }
    else { J.src = p->in[30]; J.dst = (bf16_t*)(ws + W_WO2); J.ld = D; J.Ksrc = D; J.Kdst = D; J.rows = D; }
    return J;
}
__device__ __forceinline__ void convert_weights(KP p, LAS float* tl, int tid, int bid, int G) {
    int rot = 0;
    for (int j = 0; j < 23; ++j) {
        const Job J = get_job(p, j);
        const int nkt = J.Kdst >> 6, nnt = (J.rows + 255) >> 8, ntile = nnt * nkt;
        int first = bid - rot; if (first < 0) first += G;
        for (int t = first; t < ntile; t += G) {
            const int n0 = (t / nkt) << 8, k0 = (t % nkt) << 6;
            const bool inside = k0 >= J.koff && k0 < J.koff + J.Ksrc;
            if (inside) {
                const int nn = tid & 255, kh = tid >> 8;
                const int sc = (n0 + nn) < J.rows ? srccol(J.map, n0 + nn, J.ld) : -1;
                const float* sp = J.src + (size_t)(k0 - J.koff + kh) * J.ld + (sc >= 0 ? sc : 0);
                float v[32];
#pragma unroll
                for (int it = 0; it < 32; ++it) v[it] = sc >= 0 ? sp[(size_t)(2 * it) * J.ld] : 0.f;
                if (J.smode) {
#pragma unroll
                    for (int it = 0; it < 32; ++it) { const float m = J.mu[k0 - J.koff + kh + 2 * it]; v[it] *= J.smode == 1 ? 1.f - m : m; }
                }
#pragma unroll
                for (int it = 0; it < 32; ++it) tl[(kh + 2 * it) * 257 + nn] = v[it];
            }
            __syncthreads();
            {
                const int nn = tid >> 1, kh = (tid & 1) * 32;
                if (n0 + nn < J.rows) {
                    bf16_t* dp = J.dst + (size_t)(n0 + nn) * J.Kdst + k0 + kh;
#pragma unroll
                    for (int q = 0; q < 4; ++q) {
                        const unsigned z_ = (unsigned)tid >> 31;
                        u32x4 w = (u32x4){z_, z_, z_, z_};
                        if (inside) { float v[8];
#pragma unroll
                            for (int e = 0; e < 8; ++e) v[e] = tl[(kh + q * 8 + e) * 257 + nn];
                            w.x = cvt_pk(v[0], v[1]); w.y = cvt_pk(v[2], v[3]); w.z = cvt_pk(v[4], v[5]); w.w = cvt_pk(v[6], v[7]); }
                        *(u32x4*)(dp + q * 8) = w;
                    }
                }
            }
            __syncthreads();
        }
        rot = (rot + ntile) % G;
    }
}
__device__ __forceinline__ float row_rstd(const f32x4 (&v)[4], int lane) {
    float s = 0.f;
#pragma unroll
    for (int i = 0; i < 4; ++i) s += (v[i][0] * v[i][0] + v[i][1] * v[i][1]) + (v[i][2] * v[i][2] + v[i][3] * v[i][3]);
    s = wave_sum(s, lane);
    return __builtin_amdgcn_rsqf(s * (1.f / D) + RMS_EPS);
}

__device__ __forceinline__ void assemble_x(KP p, int tid, int bid, int G) {
    const int lane = tid & 63, gw = bid * 8 + (tid >> 6), nw = G * 8;
    float* X = (float*)(p->ws + W_X); bf16_t* XN = (bf16_t*)(p->ws + W_XN);
    for (int row = gw; row < MP; row += nw) {
        f32x4 v[4];
        const float* src = nullptr;
        if (row < MPR) { const int b = row / TP, t = row - b * TP; src = t < NMETA ? p->in[6] + (size_t)t * D : p->in[0] + ((size_t)b * SEQP + (t - NMETA)) * D; }
        else if (row < MR) src = p->in[1] + (size_t)(row - MPR) * D;
#pragma unroll
        for (int i = 0; i < 4; ++i) { const float zf = __uint_as_float((unsigned)tid >> 31); v[i] = src ? *(const f32x4*)(src + lane * 4 + 256 * i) : (f32x4){zf, zf, zf, zf}; }
        float ssq = 0.f;
#pragma unroll
        for (int i = 0; i < 4; ++i) ssq += (v[i][0] * v[i][0] + v[i][1] * v[i][1]) + (v[i][2] * v[i][2] + v[i][3] * v[i][3]);
        ssq = wave_sum(ssq, lane);
#pragma unroll
        for (int i = 0; i < 4; ++i) { const int c = lane * 4 + 256 * i; *(f32x4*)(X + (size_t)row * D + c) = v[i]; store_bf4(XN + (size_t)row * D + c, v[i]); }
        float* rsq = (float*)(p->ws + W_RSQ);
        if (lane < 5) rsq[(size_t)lane * MP + row] = lane == 0 ? ssq : 0.f;
    }    for (int i = gw * 64 + lane; i < 64 * 1024; i += nw * 64) ((unsigned*)(p->ws + W_SKF))[i] = 0u;
    for (int i = gw * 64 + lane; i < 65536; i += nw * 64) ((float*)(p->ws + W_SKP) + (size_t)276 * 65536)[i] = 0.f;
}
__device__ __forceinline__ void norm_phase(KP p, const float* g, int tid, int bid, int G, bool copy_y = false) {
    const int lane = tid & 63, gw = bid * 8 + (tid >> 6), nw = G * 8;
    const float* X = (const float*)(p->ws + W_X); bf16_t* XN = (bf16_t*)(p->ws + W_XN);
    for (int row = gw; row < MP; row += nw) {
        f32x4 v[4];
#pragma unroll
        for (int i = 0; i < 4; ++i) v[i] = *(const f32x4*)(X + (size_t)row * D + lane * 4 + 256 * i);
        const float rs = row_rstd(v, lane);
#pragma unroll
        for (int i = 0; i < 4; ++i) { const int c = lane * 4 + 256 * i; store_bf4(XN + (size_t)row * D + c, v[i] * rs * *(const f32x4*)(g + c)); }
        if (copy_y && row < MR) {
            float* dp = nullptr;
            if (row < MPR) { const int b = row / TP, t = row - b * TP; if (t >= NMETA) dp = p->out + O_YP + ((size_t)b * SEQP + (t - NMETA)) * D; }
            else dp = p->out + O_YS + (size_t)(row - MPR) * D;
            if (dp) {
#pragma unroll
                for (int i = 0; i < 4; ++i) *(f32x4*)(dp + lane * 4 + 256 * i) = v[i];
            }
        }
    }
}
__device__ __forceinline__ void mixprep_phase(KP p, int tid, int bid, int G) {
    const int lane = tid & 63, gw = bid * 8 + (tid >> 6), nw = G * 8;
    const float* X = (const float*)(p->ws + W_X); bf16_t* A = (bf16_t*)(p->ws + W_AALL);
    const float* g = p->in[10]; const float* mu = p->in[11];
    for (int row = gw; row < MR; row += nw) {
        int grp, b, t; row_bt(row, grp, b, t);
        f32x4 v[4], pv[4];
#pragma unroll
        for (int i = 0; i < 4; ++i) v[i] = *(const f32x4*)(X + (size_t)row * D + lane * 4 + 256 * i);
        const float rs = row_rstd(v, lane);
        if (t > 0) {
#pragma unroll
            for (int i = 0; i < 4; ++i) pv[i] = *(const f32x4*)(X + (size_t)(row - 1) * D + lane * 4 + 256 * i);
            const float rp = row_rstd(pv, lane);
#pragma unroll
            for (int i = 0; i < 4; ++i) pv[i] = pv[i] * rp * *(const f32x4*)(g + lane * 4 + 256 * i);
        } else {
#pragma unroll
            for (int i = 0; i < 4; ++i) { const float zf = __uint_as_float((unsigned)tid >> 31); pv[i] = grp == 0 ? (f32x4){zf, zf, zf, zf} : *(const f32x4*)(p->in[3] + (size_t)b * D + lane * 4 + 256 * i); }
        }
        const bool last = t == (grp == 0 ? TP - 1 : TS - 1);
        float* sh = grp == 0 ? p->out + O_SHP + (size_t)b * D : p->out + O_SHS + (size_t)b * D;
#pragma unroll
        for (int i = 0; i < 4; ++i) {
            const int c = lane * 4 + 256 * i; const size_t o = (size_t)row * D + c;
            const f32x4 h = v[i] * rs * *(const f32x4*)(g + c), dx = pv[i] - h;
            store_bf4(A + o, h + dx * *(const f32x4*)(mu + c));
            store_bf4(A + (size_t)MP * D + o, h + dx * *(const f32x4*)(mu + 2 * D + c));
            store_bf4(A + (size_t)2 * MP * D + o, h + dx * *(const f32x4*)(mu + 3 * D + c));
            store_bf4(A + (size_t)3 * MP * D + o, h);
            store_bf4(A + (size_t)4 * MP * D + o, pv[i]);
            if (last) *(f32x4*)(sh + c) = h;
        }
    }
}
__device__ __forceinline__ void act_phase(KP p, int gtid, int nthr) {
    const float* L1 = (const float*)(p->ws + W_L1); bf16_t* A2 = (bf16_t*)(p->ws + W_A2);
    for (int i = gtid; i < MP * 64; i += nthr) {
        const int c = (i & 63) * 4;
        f32x4 v = *(const f32x4*)(L1 + (size_t)i * 4) + *(const f32x4*)(L1 + (size_t)MP * 256 + (size_t)i * 4);
        if (c < 64) {
#pragma unroll
            for (int j = 0; j < 4; ++j) v[j] = 1.f - 2.f * __builtin_amdgcn_rcpf(1.f + __expf(2.f * v[j]));
        } else if (c >= 128) {
#pragma unroll
            for (int j = 0; j < 4; ++j) v[j] = sigmoidf_(v[j]);
        }
        store_bf4(A2 + (size_t)i * 4, v);
    }
}

__device__ __forceinline__ float dpp_sum16(float x) {
    x += __builtin_bit_cast(float, __builtin_amdgcn_update_dpp(0, __builtin_bit_cast(int, x), 0xB1, 0xF, 0xF, true));
    x += __builtin_bit_cast(float, __builtin_amdgcn_update_dpp(0, __builtin_bit_cast(int, x), 0x4E, 0xF, 0xF, true));
    x += __builtin_bit_cast(float, __builtin_amdgcn_update_dpp(0, __builtin_bit_cast(int, x), 0x141, 0xF, 0xF, true));
    x += __builtin_bit_cast(float, __builtin_amdgcn_update_dpp(0, __builtin_bit_cast(int, x), 0x140, 0xF, 0xF, true));
    return x;
}
constexpr int SC_CH = 16, SC_STR = 400;
__device__ __forceinline__ void scan_phase(KP p, LAS float* buf, int tid, int bid, int G) {
    const int wid = tid >> 6, lane = tid & 63;
    const bf16_t* RKV = (const bf16_t*)(p->ws + W_RKV); const bf16_t* DEC = (const bf16_t*)(p->ws + W_DEC); const bf16_t* AA = (const bf16_t*)(p->ws + W_AA);
    float* SO = (float*)(p->ws + W_SO);
    const bool producer = wid >= 4;
    for (int u = bid; u < 768; u += G) {
        int bh, half, T, row0; const float* S0; float* Sout;
        if (u < 256) { bh = u >> 1; half = u & 1; T = TP; row0 = (bh >> 4) * TP; S0 = nullptr; Sout = p->out + O_SP + (size_t)bh * 4096; }
        else { const int v = u - 256; bh = v >> 1; half = v & 1; T = TS; row0 = MPR + (bh >> 4) * TS; S0 = p->in[2] + (size_t)bh * 4096; Sout = p->out + O_SS + (size_t)bh * 4096; }
        const int h = bh & 15, nchunk = T / SC_CH;
        if (producer) {
            const int t2 = tid - 256, pi = t2 >> 4, pj = t2 & 15, kc = h * 64 + 4 * pj;
            const f32x4 kkv = *(const f32x4*)(p->in[21] + kc), kav = *(const f32x4*)(p->in[22] + kc), w0v = *(const f32x4*)(p->in[13] + kc), a0v = *(const f32x4*)(p->in[16] + kc);
            u32x2 pr, pk, pvv, pa, pd;
#define SC_LOAD(c) do { const size_t o = (size_t)(row0 + (c) * SC_CH + pi) * D + kc; pr = *(const u32x2*)(RKV + o); pk = *(const u32x2*)(RKV + (size_t)MP * D + o); \
            pvv = *(const u32x2*)(RKV + (size_t)2 * MP * D + o); pa = *(const u32x2*)(AA + o); pd = *(const u32x2*)(DEC + o); } while (0)
#define SC_STORE(bi) do { LAS float* rec = buf + (bi) * (SC_CH * SC_STR) + pi * SC_STR; \
            const f32x4 r = (f32x4){bf_lo(pr.x), bf_hi(pr.x), bf_lo(pr.y), bf_hi(pr.y)}, k = (f32x4){bf_lo(pk.x), bf_hi(pk.x), bf_lo(pk.y), bf_hi(pk.y)}; \
            const f32x4 v = (f32x4){bf_lo(pvv.x), bf_hi(pvv.x), bf_lo(pvv.y), bf_hi(pvv.y)}; \
            f32x4 a = (f32x4){bf_lo(pa.x), bf_hi(pa.x), bf_lo(pa.y), bf_hi(pa.y)} + a0v; f32x4 w = (f32x4){bf_lo(pd.x), bf_hi(pd.x), bf_lo(pd.y), bf_hi(pd.y)} + w0v; \
            _Pragma("unroll") for (int j = 0; j < 4; ++j) { a[j] = sigmoidf_(a[j]); w[j] = __expf(-__expf(-softplusf_(-w[j]) - 0.5f)); } \
            const f32x4 q = k * kkv; float ss = (q[0] * q[0] + q[1] * q[1]) + (q[2] * q[2] + q[3] * q[3]); ss = dpp_sum16(ss); \
            const float inv = 1.f / fmaxf(sqrtf(ss), 1e-12f); const f32x4 nk = q * inv; \
            const f32x4 kp = k * (1.f + (a - 1.f) * kav), bb = nk * a; \
            float br = (bb[0] * r[0] + bb[1] * r[1]) + (bb[2] * r[2] + bb[3] * r[3]), kr = (kp[0] * r[0] + kp[1] * r[1]) + (kp[2] * r[2] + kp[3] * r[3]); \
            br = dpp_sum16(br); kr = dpp_sum16(kr); \
            *(LAS f32x4*)(rec + 4 * pj) = w; *(LAS f32x4*)(rec + 64 + 4 * pj) = nk; *(LAS f32x4*)(rec + 128 + 4 * pj) = bb; \
            *(LAS f32x4*)(rec + 192 + 4 * pj) = kp; *(LAS f32x4*)(rec + 256 + 4 * pj) = w * r; *(LAS f32x4*)(rec + 320 + 4 * pj) = v; \
            if (pj == 0) *(LAS f32x2*)(rec + 384) = (f32x2){br, kr}; } while (0)
            SC_LOAD(0); SC_STORE(0);
            if (nchunk > 1) SC_LOAD(1);
            __syncthreads();
            for (int c = 0; c < nchunk; ++c) {
                if (c + 1 < nchunk) { SC_STORE((c + 1) & 1); if (c + 2 < nchunk) SC_LOAD(c + 2); }
                __syncthreads();
            }
#undef SC_LOAD
#undef SC_STORE
        } else {
            const int rp = lane >> 4, kq = lane & 15, vA = half * 32 + wid * 8 + rp * 2;
            f32x4 sA = (f32x4){0.f, 0.f, 0.f, 0.f}, sB = sA;
            if (S0) { sA = *(const f32x4*)(S0 + vA * 64 + kq * 4); sB = *(const f32x4*)(S0 + (vA + 1) * 64 + kq * 4); }
            float* op = SO + (size_t)(row0 + kq) * D + h * 64 + vA;
            __syncthreads();
            for (int c = 0; c < nchunk; ++c) {
                const LAS float* cb = buf + (c & 1) * (SC_CH * SC_STR);
                float oA = 0.f, oB = 0.f;
#pragma unroll
                for (int i = 0; i < SC_CH; ++i) {
                    const LAS float* rec = cb + i * SC_STR;
                    const f32x4 wd = *(const LAS f32x4*)(rec + kq * 4), kk = *(const LAS f32x4*)(rec + 64 + kq * 4), bb = *(const LAS f32x4*)(rec + 128 + kq * 4),
                                kp = *(const LAS f32x4*)(rec + 192 + kq * 4), wr = *(const LAS f32x4*)(rec + 256 + kq * 4);
                    const f32x2 vv = *(const LAS f32x2*)(rec + 320 + vA), sc = *(const LAS f32x2*)(rec + 384);
                    const f32x2 t1A = sA.hi * kk.hi + sA.lo * kk.lo, t1B = sB.hi * kk.hi + sB.lo * kk.lo, t2A = sA.hi * wr.hi + sA.lo * wr.lo, t2B = sB.hi * wr.hi + sB.lo * wr.lo;
                    float d1A = t1A.x + t1A.y, d1B = t1B.x + t1B.y, d2A = t2A.x + t2A.y, d2B = t2B.x + t2B.y;
#define DPPR(ctl) "v_add_f32_dpp %0, %0, %0 " ctl " row_mask:0xf bank_mask:0xf bound_ctrl:1\n\tv_add_f32_dpp %1, %1, %1 " ctl " row_mask:0xf bank_mask:0xf bound_ctrl:1\n\t" \
                  "v_add_f32_dpp %2, %2, %2 " ctl " row_mask:0xf bank_mask:0xf bound_ctrl:1\n\tv_add_f32_dpp %3, %3, %3 " ctl " row_mask:0xf bank_mask:0xf bound_ctrl:1\n\t"
                    asm("s_nop 1\n\t" DPPR("quad_perm:[1,0,3,2]") DPPR("quad_perm:[2,3,0,1]") DPPR("row_half_mirror") DPPR("row_mirror") : "+v"(d1A), "+v"(d1B), "+v"(d2A), "+v"(d2B));
#undef DPPR
                    const float saA = -d1A, saB = -d1B;
                    const float tA = d2A + saA * sc.x + vv.x * sc.y, tB = d2B + saB * sc.x + vv.y * sc.y;
                    sA = sA * wd + bb * saA + kp * vv.x;
                    sB = sB * wd + bb * saB + kp * vv.y;
                    oA = kq == i ? tA : oA; oB = kq == i ? tB : oB;
                }
                *(f32x2*)(op + (size_t)c * SC_CH * D) = (f32x2){oA, oB};
                __syncthreads();
            }
            *(f32x4*)(Sout + vA * 64 + kq * 4) = sA; *(f32x4*)(Sout + (vA + 1) * 64 + kq * 4) = sB;
        }
    }
}
__device__ __forceinline__ void post_phase(KP p, int tid, int bid, int G) {
    const int lane = tid & 63, gw = bid * 8 + (tid >> 6), nw = G * 8;
    const bf16_t* RKV = (const bf16_t*)(p->ws + W_RKV); const bf16_t* AA = (const bf16_t*)(p->ws + W_AA); const bf16_t* GG = (const bf16_t*)(p->ws + W_GG);
    const float* SO = (const float*)(p->ws + W_SO); bf16_t* OG = (bf16_t*)(p->ws + W_OG);
    const float* k_a = p->in[22]; const float* a0p = p->in[16]; const float* r_k = p->in[23]; const float* gnw = p->in[24]; const float* gnb = p->in[25];
    const int c0 = lane * 16;
    for (int row = gw; row < MR; row += nw) {
        const size_t o = (size_t)row * D + c0;
        float ov[16], rv[16], kv[16], vv[16], av[16], gv[16];
#pragma unroll
        for (int q = 0; q < 4; ++q) { const f32x4 x = *(const f32x4*)(SO + o + 4 * q); ov[4 * q] = x[0]; ov[4 * q + 1] = x[1]; ov[4 * q + 2] = x[2]; ov[4 * q + 3] = x[3]; }
#define LD16(dst, ptr) do { const u32x4 a_ = *(const u32x4*)(ptr), b_ = *(const u32x4*)((ptr) + 8); \
        dst[0] = bf_lo(a_.x); dst[1] = bf_hi(a_.x); dst[2] = bf_lo(a_.y); dst[3] = bf_hi(a_.y); dst[4] = bf_lo(a_.z); dst[5] = bf_hi(a_.z); dst[6] = bf_lo(a_.w); dst[7] = bf_hi(a_.w); \
        dst[8] = bf_lo(b_.x); dst[9] = bf_hi(b_.x); dst[10] = bf_lo(b_.y); dst[11] = bf_hi(b_.y); dst[12] = bf_lo(b_.z); dst[13] = bf_hi(b_.z); dst[14] = bf_lo(b_.w); dst[15] = bf_hi(b_.w); } while (0)
        LD16(rv, RKV + o); LD16(kv, RKV + (size_t)MP * D + o); LD16(vv, RKV + (size_t)2 * MP * D + o); LD16(av, AA + o); LD16(gv, GG + o);
#undef LD16
        float sm = 0.f, rk = 0.f;
#pragma unroll
        for (int e = 0; e < 16; ++e) { sm += ov[e]; const float kp = kv[e] * (1.f + (sigmoidf_(a0p[c0 + e] + av[e]) - 1.f) * k_a[c0 + e]); rk += rv[e] * kp * r_k[c0 + e]; }
        sm += shx(sm, 1, lane); sm += shx(sm, 2, lane); rk += shx(rk, 1, lane); rk += shx(rk, 2, lane);
        const float mean = sm * (1.f / 64.f);
        float vs = 0.f;
#pragma unroll
        for (int e = 0; e < 16; ++e) { const float d = ov[e] - mean; vs += d * d; }
        vs += shx(vs, 1, lane); vs += shx(vs, 2, lane);
        const float rstd = __builtin_amdgcn_rsqf(vs * (1.f / 64.f) + GN_EPS);
        unsigned w[8];
#pragma unroll
        for (int e = 0; e < 16; e += 2) {
            const float y0 = ((ov[e] - mean) * rstd * gnw[c0 + e] + gnb[c0 + e] + rk * vv[e]) * gv[e];
            const float y1 = ((ov[e + 1] - mean) * rstd * gnw[c0 + e + 1] + gnb[c0 + e + 1] + rk * vv[e + 1]) * gv[e + 1];
            w[e >> 1] = cvt_pk(y0, y1);
        }
        *(u32x4*)(OG + o) = (u32x4){w[0], w[1], w[2], w[3]}; *(u32x4*)(OG + o + 8) = (u32x4){w[4], w[5], w[6], w[7]};
    }
}

__device__ __forceinline__ int crow(int r, int hi) { return (r & 3) + 8 * (r >> 2) + 4 * hi; }
__device__ __forceinline__ bf16x8 pack8(f32x4 a, f32x4 b) {
    u32x4 w; w.x = cvt_pk(a[0], a[1]); w.y = cvt_pk(a[2], a[3]); w.z = cvt_pk(b[0], b[1]); w.w = cvt_pk(b[2], b[3]);
    return __builtin_bit_cast(bf16x8, w);
}
__device__ __forceinline__ void attn_phase(KP p, int tid, int bid, int G) {
    const int lane = tid & 63, gw = bid * 8 + (tid >> 6), nw = G * 8;
    const bf16_t* QB = (const bf16_t*)(p->ws + W_QB); bf16_t* AO = (bf16_t*)(p->ws + W_OG);
    const int ql = lane & 31, hi = lane >> 5;
    constexpr int NU_P = BP * NH * 65;
    for (int u = gw; u < NU_P + BS * NH * 2; u += nw) {
        int bh, Q0, nq, npast, row_base, Tn; const float *kc, *vc, *kn, *vn;
        if (u < NU_P) { bh = u / 65; Q0 = (u - bh * 65) * 32; nq = min(32, TP - Q0); npast = 0; row_base = (bh >> 4) * TP; Tn = TP;
            kc = nullptr; vc = nullptr; kn = p->out + O_KP + (size_t)bh * TP * HD; vn = p->out + O_VP + (size_t)bh * TP * HD; }
        else { const int v = u - NU_P; bh = v >> 1; Q0 = (v & 1) * 32; nq = 32; npast = PAST; row_base = MPR + (bh >> 4) * TS; Tn = TS;
            kc = p->in[4] + (size_t)bh * PAST * HD; vc = p->in[5] + (size_t)bh * PAST * HD; kn = p->out + O_KS + (size_t)bh * TS * HD; vn = p->out + O_VS + (size_t)bh * TS * HD; }
        const int h = bh & 15, qpos0 = npast + Q0;
        bf16x8 qf[4];
        { const bf16_t* qp = QB + (size_t)(row_base + Q0 + min(ql, nq - 1)) * D + h * 64 + hi * 8;
#pragma unroll
          for (int s = 0; s < 4; ++s) qf[s] = *(const bf16x8*)(qp + 16 * s); }
        f32x16 o0, o1;
#pragma unroll
        for (int r = 0; r < 16; ++r) { o0[r] = 0.f; o1[r] = 0.f; }
        float carry = ql < nq ? 0.f : -1e30f;
        const int qpos = qpos0 + ql;
        f32x4 kc4[8];
#define ATT_TILE_PTRS(P0_, kb_, vb_, lim_) const bool inpast_ = (P0_) < npast; \
            const float* kb_ = inpast_ ? kc + (size_t)(P0_) * HD : kn + (size_t)((P0_) - npast) * HD; \
            const float* vb_ = inpast_ ? vc + (size_t)(P0_) * HD : vn + (size_t)((P0_) - npast) * HD; \
            const int lim_ = inpast_ ? 31 : min(31, Tn - 1 - ((P0_) - npast));
        { ATT_TILE_PTRS((qpos0 >> 5) * 32, kb0, vb0, lim0); (void)vb0;
          const float* kp = kb0 + (size_t)min(ql, lim0) * HD + hi * 8;
#pragma unroll
          for (int s = 0; s < 4; ++s) { kc4[2 * s] = *(const f32x4*)(kp + 16 * s); kc4[2 * s + 1] = *(const f32x4*)(kp + 16 * s + 4); } }
        for (int kt = qpos0 >> 5; kt >= 0; --kt) {
            const int P0 = kt * 32;
            ATT_TILE_PTRS(P0, kb, vb, lim); (void)kb;
            float x0[16], x1[16];
#pragma unroll
            for (int r = 0; r < 16; ++r) { const float* vp = vb + (size_t)min(crow(r, hi), lim) * HD + ql; x0[r] = vp[0]; x1[r] = vp[32]; }
            f32x4 kn4[8];
            { const int Pn = kt > 0 ? P0 - 32 : P0; ATT_TILE_PTRS(Pn, kbn, vbn, limn); (void)vbn;
              const float* kp = kbn + (size_t)min(ql, limn) * HD + hi * 8;
#pragma unroll
              for (int s = 0; s < 4; ++s) { kn4[2 * s] = *(const f32x4*)(kp + 16 * s); kn4[2 * s + 1] = *(const f32x4*)(kp + 16 * s + 4); } }
            f32x16 st;
#pragma unroll
            for (int r = 0; r < 16; ++r) st[r] = 0.f;
#pragma unroll
            for (int s = 0; s < 4; ++s) st = __builtin_amdgcn_mfma_f32_32x32x16_bf16(pack8(kc4[2 * s], kc4[2 * s + 1]), qf[s], st, 0, 0, 0);
            float L[16];
            float own[4];
#pragma unroll
            for (int g = 0; g < 4; ++g) { float sg = 0.f;
#pragma unroll
                for (int i = 0; i < 4; ++i) { const int r = 4 * g + i; const bool vis = (P0 + crow(r, hi)) < qpos; L[r] = vis ? -softplusf_(st[r]) : 0.f; sg += L[r]; }
                own[g] = sg; }
            float oth[4];
#pragma unroll
            for (int g = 0; g < 4; ++g) oth[g] = shx(own[g], 32, lane);
            float suf = carry;
            float A[16];
#pragma unroll
            for (int g = 3; g >= 0; --g) {
                float c = suf + (hi == 0 ? oth[g] : 0.f);
#pragma unroll
                for (int i = 3; i >= 0; --i) { const int r = 4 * g + i; c += L[r]; const bool vis = (P0 + crow(r, hi)) < qpos; A[r] = vis ? __expf(st[r] + c) : 0.f; }
                suf += own[g] + oth[g];
            }
            carry = suf;
            const bf16x8 pa0 = pack8((f32x4){A[0], A[1], A[2], A[3]}, (f32x4){A[4], A[5], A[6], A[7]});
            const bf16x8 pa1 = pack8((f32x4){A[8], A[9], A[10], A[11]}, (f32x4){A[12], A[13], A[14], A[15]});
            o0 = __builtin_amdgcn_mfma_f32_32x32x16_bf16(pa0, pack8((f32x4){x0[0], x0[1], x0[2], x0[3]}, (f32x4){x0[4], x0[5], x0[6], x0[7]}), o0, 0, 0, 0);
            o1 = __builtin_amdgcn_mfma_f32_32x32x16_bf16(pa0, pack8((f32x4){x1[0], x1[1], x1[2], x1[3]}, (f32x4){x1[4], x1[5], x1[6], x1[7]}), o1, 0, 0, 0);
            o0 = __builtin_amdgcn_mfma_f32_32x32x16_bf16(pa1, pack8((f32x4){x0[8], x0[9], x0[10], x0[11]}, (f32x4){x0[12], x0[13], x0[14], x0[15]}), o0, 0, 0, 0);
            o1 = __builtin_amdgcn_mfma_f32_32x32x16_bf16(pa1, pack8((f32x4){x1[8], x1[9], x1[10], x1[11]}, (f32x4){x1[12], x1[13], x1[14], x1[15]}), o1, 0, 0, 0);
#pragma unroll
            for (int e = 0; e < 8; ++e) kc4[e] = kn4[e];
            if (!__any(carry >= -104.f)) break;
        }
#undef ATT_TILE_PTRS
        bf16_t* op = AO + (size_t)(row_base + Q0) * D + h * 64 + ql;
#pragma unroll
        for (int r = 0; r < 16; ++r) { const int qr = crow(r, hi); if (qr < nq) { op[(size_t)qr * D] = (bf16_t)(cvt_pk(o0[r], 0.f) & 0xffffu); op[(size_t)qr * D + 32] = (bf16_t)(cvt_pk(o1[r], 0.f) & 0xffffu); } }
    }
}

constexpr int NPHASE = 23;
#ifndef PHM
#define PHM 0xffff
#endif
#define EN(k) (((PHM) >> (k)) & 1)
constexpr int LDS_BYTES = 131072 + 8 * 576 * 4;
template <class Epi, class Sched>
__device__ __forceinline__ void run_gemm(LAS unsigned char* lds, int wb, const bf16_t* A, const bf16_t* Bt, int M, int N, int K, const Sched& S, const Epi& E, float* skp = nullptr, unsigned* skf = nullptr) {
    pg8::Gemm g{A, Bt, M, N, K, wb, skp, skf};
    pg8::gemm_phase<Epi, Sched, true, true>(lds, g, S, E);
}
__global__ void __launch_bounds__(512, 2) mega(Params p_unused) {
    LAS unsigned char* lds = (LAS unsigned char*)lds_raw;
    cg::grid_group grid = cg::this_grid();
    KP p = (KP)__builtin_amdgcn_kernarg_segment_ptr();
    const int ph_lo = p->ph_lo, ph_hi = p->ph_hi;
    const int wb = __builtin_amdgcn_readfirstlane((int)threadIdx.x) & ~63;
    for (int pi_ = ph_lo; pi_ < ph_hi; ++pi_) {
        asm volatile("" ::: "v1","v2","v3","v4","v5","v6","v7","v8","v9","v10","v11","v12","v13","v14","v15","v16","v17","v18","v19","v20","v21","v22","v23","v24","v25","v26","v27","v28","v29","v30","v31","v32","v33","v34","v35","v36","v37","v38","v39","v40","v41","v42","v43","v44","v45","v46","v47","v48","v49","v50","v51","v52","v53","v54","v55","v56","v57","v58","v59","v60","v61","v62","v63","v64","v65","v66","v67","v68","v69","v70","v71","v72","v73","v74","v75","v76","v77","v78","v79","v80","v81","v82","v83","v84","v85","v86","v87","v88","v89","v90","v91","v92","v93","v94","v95","v96","v97","v98","v99","v100","v101","v102","v103","v104","v105","v106","v107","v108","v109","v110","v111","v112","v113","v114","v115","v116","v117","v118","v119","v120","v121","v122","v123","v124","v125","v126","v127","v128","v129","v130","v131","v132","v133","v134","v135","v136","v137","v138","v139","v140","v141","v142","v143","v144","v145","v146","v147","v148","v149","v150","v151","v152","v153","v154","v155","v156","v157","v158","v159","v160","v161","v162","v163","v164","v165","v166","v167","v168","v169","v170","v171","v172","v173","v174","v175","v176","v177","v178","v179","v180","v181","v182","v183","v184","v185","v186","v187","v188","v189","v190","v191","v192","v193","v194","v195","v196","v197","v198","v199","v200","v201","v202","v203","v204","v205","v206","v207","v208","v209","v210","v211","v212","v213","v214","v215","v216","v217","v218","v219","v220","v221","v222","v223","v224","v225","v226","v227","v228","v229","v230","v231","v232","v233","v234","v235","v236","v237","v238","v239","v240","v241","v242","v243","v244","v245","v246","v247","v248","v249");
        asm volatile("" : "+s"(p));
        const int phc = p->seq[pi_], ph = phc & 63; const bool dry = (phc & 64) != 0;
        int bid = blockIdx.x, G = gridDim.x;
        asm volatile("" : "+s"(bid), "+s"(G));
#define TID_HERE (wb + lane_now())
        int ffn = -1; bool ffn_in = false;
        if (ph == 1 || ph == 2) { ffn = 0; ffn_in = ph == 1; } else if (ph == 11 || ph == 12) { ffn = 1; ffn_in = ph == 11; }
        else if (ph == 14 || ph == 15) { ffn = 2; ffn_in = ph == 14; } else if (ph == 21 || ph == 22) { ffn = 3; ffn_in = ph == 21; }
        if (EN(0) && ph == 0) { { const int tid = TID_HERE; convert_weights(p, (LAS float*)lds, tid, bid, G); assemble_x(p, tid, bid, G); } }
        else if (EN(1) && ffn >= 0 && ffn_in) {
            pg8::StaticOrder S; S.init(MP, NIN, G, bid); S.nt0 = D / 64;
            unsigned char* ws = p->ws; EpiSwiGLU E{(bf16_t*)(ws + W_HB), (const float*)(ws + W_RSQ) + (size_t)(ffn == 0 ? 0 : (ffn == 1 ? 1 : (ffn == 2 ? 2 : 4))) * MP};
            run_gemm(lds, wb, (const bf16_t*)(ws + W_XN), (const bf16_t*)(ws + W_WIN + ffn * SZ_WIN1), MP, NIN, D, S, E);
        } else if (EN(2) && ffn >= 0) {
            pg8::StaticOrder S; S.init(MP, D, G, bid); S.nt0 = DFFP / 64;
            unsigned char* ws = p->ws; const bool fold = (ffn == 1 || ffn == 2) && !dry;
            EpiRes E{(float*)(ws + W_X), dry ? 0.f : 0.5f, (ffn == 3 && !dry) ? p->out : nullptr, fold ? (bf16_t*)(ws + W_XN) : nullptr, (float*)(ws + W_RSQ) + (size_t)(ffn == 1 ? 2 : 3) * MP};
            run_gemm(lds, wb, (const bf16_t*)(ws + W_HB), (const bf16_t*)(ws + W_WOUT + ffn * SZ_WOUT1), MP, D, DFFP, S, E, (float*)(ws + W_SKP), (unsigned*)(ws + W_SKF) + pi_ * 1024);
        }
        else if (EN(3) && ph == 3) mixprep_phase(p, TID_HERE, bid, G);
        else if (EN(4) && ph == 4) {
            G1Order S{G, bid};
            unsigned char* ws = p->ws; EpiG1 E{(bf16_t*)(ws + W_RKV), (float*)(ws + W_L1)};
            run_gemm(lds, wb, (const bf16_t*)(ws + W_AALL), (const bf16_t*)(ws + W_WG1), 5 * MP, 3584, D, S, E);
        }
        else if (EN(5) && ph == 5) act_phase(p, bid * 512 + TID_HERE, G * 512);
        else if (EN(6) && ph == 6) {
            pg8::StaticOrder S; S.init(MP, 3072, G, bid); S.nt0 = 4;
            unsigned char* ws = p->ws; EpiG2 E{(bf16_t*)(ws + W_DEC)};
            run_gemm(lds, wb, (const bf16_t*)(ws + W_A2), (const bf16_t*)(ws + W_WL2), MP, 3072, 256, S, E);
        }
        else if (EN(7) && ph == 7) scan_phase(p, (LAS float*)lds, TID_HERE, bid, G);
        else if (EN(8) && ph == 8) post_phase(p, TID_HERE, bid, G);
        else if (EN(9) && (ph == 9 || ph == 19)) {
            pg8::StaticOrder S; S.init(MP, D, G, bid); S.nt0 = D / 64;
            unsigned char* ws = p->ws; EpiRes E{(float*)(ws + W_X), dry ? 0.f : 1.0f, nullptr, dry ? nullptr : (bf16_t*)(ws + W_XN), (float*)(ws + W_RSQ) + (size_t)(ph == 9 ? 1 : 4) * MP};
            run_gemm(lds, wb, (const bf16_t*)(ws + W_OG), (const bf16_t*)(ws + (ph == 9 ? W_WO1 : W_WO2)), MP, D, D, S, E, (float*)(ws + W_SKP), (unsigned*)(ws + W_SKF) + pi_ * 1024);
        }
        else if (EN(11) && ph == 17) {
            pg8::StaticOrder S; S.init(MP, 3 * D, G, bid); S.nt0 = D / 64;
            unsigned char* ws = p->ws; EpiQKV E{(bf16_t*)(ws + W_QB), p->out, p->in[28], p->in[29], (const float*)(ws + W_RSQ) + (size_t)3 * MP};
            run_gemm(lds, wb, (const bf16_t*)(ws + W_XN), (const bf16_t*)(ws + W_WQKV), MP, 3 * D, D, S, E);
        }
        else if (EN(12) && ph == 18) attn_phase(p, TID_HERE, bid, G);
        if (pi_ + 1 < ph_hi) grid.sync();
    }
}

#ifndef ONE_LAUNCH
#define ONE_LAUNCH 1
#endif
extern "C" void kernel_launch(void* const* d_in, const int* in_sizes, int n_in, void* d_out, int out_size, void* d_ws, size_t ws_size, hipStream_t stream) {
    static int grid = 0;
    if (grid == 0) {
        if (n_in != 31 || (size_t)out_size != O_END || ws_size < W_END) { fprintf(stderr, "kernel_launch: unexpected sizes (n_in %d out %d ws %zu need %zu)\n", n_in, out_size, ws_size, (size_t)W_END); grid = -1; return; }
        int dev = 0, cus = 0, per_cu = 0;
        hipGetDevice(&dev); hipDeviceGetAttribute(&cus, hipDeviceAttributeMultiprocessorCount, dev);
        if (hipFuncSetAttribute((const void*)mega, hipFuncAttributeMaxDynamicSharedMemorySize, LDS_BYTES) != hipSuccess) { fprintf(stderr, "kernel_launch: hipFuncSetAttribute failed\n"); grid = -1; return; }
        hipOccupancyMaxActiveBlocksPerMultiprocessor(&per_cu, (const void*)mega, 512, LDS_BYTES);
        (void)hipGetLastError();
        if (per_cu < 1) per_cu = 1;
        grid = cus * per_cu;
    }
    if (grid < 0) return;
    Params p{};
    for (int i = 0; i < 31; ++i) p.in[i] = (const float*)d_in[i];
    p.out = (float*)d_out; p.ws = (unsigned char*)d_ws;
    int nseq = 0;
    for (int ph = 0; ph < NPHASE; ++ph) {
        if (ph == 10 || ph == 13 || ph == 16 || ph == 20) continue;
        p.seq[nseq++] = ph;
#ifdef REP_OF
        for (int r = 0; r < (REP_OF(ph)); ++r) p.seq[nseq++] = (ph | ((ph == 2 || ph == 9) ? 64 : 0));
#endif
    }
#if ONE_LAUNCH
    p.ph_lo = 0; p.ph_hi = nseq;
    void* args[] = {&p};
    hipError_t e = hipLaunchCooperativeKernel((const void*)mega, dim3(grid), dim3(512), args, LDS_BYTES, stream);
    if (e != hipSuccess) fprintf(stderr, "cooperative launch failed: %s (grid %d)\n", hipGetErrorString(e), grid);
#else
    for (int ph = 0; ph < nseq; ++ph) { p.ph_lo = ph; p.ph_hi = ph + 1; hipLaunchKernelGGL(mega, dim3(grid), dim3(512), LDS_BYTES, stream, p); }
#endif
}
```

```cpp
#include <hip/hip_runtime.h>
#include <hip/hip_cooperative_groups.h>
#include <cstdio>
#include <cstdint>
namespace cg = cooperative_groups;
__device__ __forceinline__ int lane_now() { int l; asm volatile("v_mbcnt_lo_u32_b32 %0, -1, 0\n\tv_mbcnt_hi_u32_b32 %0, -1, %0" : "=v"(l)); return l; }
namespace pg8 {
#define PG8_LAS __attribute__((address_space(3)))
typedef unsigned short bf16_t;
typedef short bf16x8 __attribute__((ext_vector_type(8)));
typedef float f32x4 __attribute__((ext_vector_type(4)));
typedef unsigned u32x4 __attribute__((ext_vector_type(4)));
constexpr int BM = 256, BK = 64, HALF = 128, HTB = HALF * BK * 2  , STAGE_BYTES = 8 * HTB, NXCD = 8, WGM = 8;

__host__ __device__ __forceinline__ int lds_byte(int r, int c) { const int st = (r >> 4) * 2 + (c >> 5), rr = r & 15, cc = c & 31, ob = rr * 64 + cc * 2; return st * 1024 + (ob ^ (((ob >> 9) & 1) << 5)); }
__host__ __device__ __forceinline__ void stage_rc(int b, int& R, int& C) { const int st = b / 1024, sb = b % 1024, swz = sb ^ (((sb >> 9) & 1) << 5); R = (st >> 1) * 16 + swz / 64; C = (st & 1) * 32 + (swz % 64) / 2; }
__host__ __device__ __forceinline__ int perm32(int rho) { const int n = rho >> 4, i = rho & 15; return 8 * (i >> 2) + 4 * n + (i & 3); }

struct Unit { int pm, pn, kb, nt, fl, tl; };
struct Gemm { const bf16_t* A; const bf16_t* Bt; int M, N, K, wb; float* skp; unsigned* skf; };

struct StaticOrder {
    static constexpr bool STREAM = false; int nM, nN, nwg, G, c, nt0;
    __host__ __device__ void init(int M, int N, int G_, int c_) { nM = M / BM; nN = N / BM; nwg = nM * nN; G = G_; c = c_; }
    __host__ __device__ bool next(int i, Unit& u) const {
        const long L = (long)i * G + c; if (L >= nwg) return false;
        int wgid = (int)L; { const int q = nwg / NXCD, r = nwg % NXCD, xcd = wgid % NXCD, off = wgid / NXCD; wgid = (xcd < r ? xcd * (q + 1) : r * (q + 1) + (xcd - r) * q) + off; }
        const int nig = WGM * nN, gid = wgid / nig, fm = gid * WGM, gsz = (nM - fm) < WGM ? (nM - fm) : WGM;
        u.pm = fm + ((wgid % nig) % gsz); u.pn = (wgid % nig) / gsz; u.kb = 0; u.nt = nt0; u.fl = 0; u.tl = 0; return true;
    }
    __device__ __forceinline__ void a_ready(const Unit&) const {}
    __device__ __forceinline__ void done(const Unit&) const {}
};
typedef __attribute__((address_space(1))) f32x4 gf32x4;
typedef unsigned long long u64_t;
__device__ __forceinline__ void streamk_store(const f32x4 (&acc)[2][2][4][2], const Unit& u, float* skp, unsigned* skf, int tid) {
    u64_t* q = (u64_t*)(skp + (size_t)u.tl * 65536) + 2 * tid;
#pragma unroll
    for (int a = 0; a < 2; ++a)
#pragma unroll
        for (int b = 0; b < 2; ++b)
#pragma unroll
            for (int m = 0; m < 4; ++m)
#pragma unroll
                for (int n = 0; n < 2; ++n) { const f32x4 v = acc[a][b][m][n];
                    __hip_atomic_store(q, ((u64_t)__float_as_uint(v[1]) << 32) | __float_as_uint(v[0]), __ATOMIC_RELAXED, __HIP_MEMORY_SCOPE_AGENT);
                    __hip_atomic_store(q + 1, ((u64_t)__float_as_uint(v[3]) << 32) | __float_as_uint(v[2]), __ATOMIC_RELAXED, __HIP_MEMORY_SCOPE_AGENT);
                    q += 1024; asm volatile("" : "+v"(q) :: "memory"); }
    asm volatile("s_waitcnt vmcnt(0)" ::: "memory");
    __builtin_amdgcn_s_barrier();
    if (tid == 0) __hip_atomic_store(skf + u.tl, 1u, __ATOMIC_RELAXED, __HIP_MEMORY_SCOPE_AGENT);
}
__device__ __forceinline__ const float* streamk_wait(const Unit& u, float* skp, unsigned* skf, int tid) {
    if (u.fl == 2) {
        if (tid == 0) { while (__hip_atomic_load(skf + u.tl, __ATOMIC_RELAXED, __HIP_MEMORY_SCOPE_AGENT) == 0u) __builtin_amdgcn_s_sleep(2); }
        __builtin_amdgcn_s_barrier();
        __builtin_amdgcn_fence(__ATOMIC_ACQUIRE, "agent");
    } else __builtin_amdgcn_s_barrier();
    return skp + (size_t)u.tl * 65536;
}
__device__ __forceinline__ f32x4 streamk_part(const float* part, int idx, int tid) {
    const u64_t* q = (const u64_t*)part + (size_t)idx * 1024 + 2 * tid;
    const u64_t a = __hip_atomic_load(q, __ATOMIC_RELAXED, __HIP_MEMORY_SCOPE_AGENT), b = __hip_atomic_load(q + 1, __ATOMIC_RELAXED, __HIP_MEMORY_SCOPE_AGENT);
    return (f32x4){__uint_as_float((unsigned)a), __uint_as_float((unsigned)(a >> 32)), __uint_as_float((unsigned)b), __uint_as_float((unsigned)(b >> 32))};
}
template <class Epi, class Sched, bool ALIGN_EPI = false, bool SP2 = false>
__device__ __forceinline__ void gemm_phase(PG8_LAS unsigned char* lds, const Gemm g, const Sched& S, const Epi& E) {
    int tid = g.wb + lane_now(); asm volatile("" : "+v"(tid)); const int wid = __builtin_amdgcn_readfirstlane(tid >> 6), lane = tid & 63, wr = wid >> 2, wc = wid & 3, fr = lane & 15, fq = lane >> 4;
    const int K = g.K, nt = K / BK;
    unsigned voffA[2], voffB[2];
#pragma unroll
    for (int i = 0; i < 2; ++i) { int R, C; stage_rc(tid * 16 + i * 8192, R, C); const int Rb = Epi::PERM ? ((R & ~31) + perm32(R & 31)) : R;
        voffA[i] = (unsigned)(R * K + C) * 2u; voffB[i] = (unsigned)(Rb * K + C) * 2u; }
    const size_t kstep = (size_t)(BK * 2);
    const size_t hstep = (size_t)HALF * K * 2;
    const size_t tstep = 2 * hstep;
    const unsigned ldsw = (unsigned)wid * 1024u;
    const int aoff = lds_byte(wr * 64 + fr, fq * 8), boff = lds_byte(wc * 32 + fr, fq * 8);
#define PG8_SA(b, h) (((b) * 2 + (h)) * HTB)
#define PG8_SB(b, h) ((4 + (b) * 2 + (h)) * HTB)
#define PG8_STAGE(bufoff, gbase, voff) do { _Pragma("unroll") for (int _i = 0; _i < 2; ++_i) \
        __builtin_amdgcn_global_load_lds((const unsigned*)((const char*)(gbase) + (voff)[_i]), (PG8_LAS unsigned*)(lds + (bufoff) + ldsw + _i * 8192), 16, 0, 0); } while (0)
#define PG8_LDA(dst, b, h) do { _Pragma("unroll") for (int m = 0; m < 4; ++m) _Pragma("unroll") for (int k = 0; k < 2; ++k) dst[m][k] = *(const PG8_LAS bf16x8*)(lds + PG8_SA(b, h) + aoff + m * 2048 + k * 1024); } while (0)
#define PG8_LDB(dst, b, h) do { _Pragma("unroll") for (int n = 0; n < 2; ++n) _Pragma("unroll") for (int k = 0; k < 2; ++k) dst[n][k] = *(const PG8_LAS bf16x8*)(lds + PG8_SB(b, h) + boff + n * 2048 + k * 1024); } while (0)
#define PG8_MMA(ai, bj, At, Bt) do { __builtin_amdgcn_s_setprio(1); _Pragma("unroll") for (int m = 0; m < 4; ++m) _Pragma("unroll") for (int n = 0; n < 2; ++n) _Pragma("unroll") for (int k = 0; k < 2; ++k) \
        acc[ai][bj][m][n] = __builtin_amdgcn_mfma_f32_16x16x32_bf16(Bt[n][k], At[m][k], acc[ai][bj][m][n], 0, 0, 0); __builtin_amdgcn_s_setprio(0); } while (0)
#define PG8_WAIT_V(n) asm volatile("s_waitcnt vmcnt(" #n ")" ::: "memory")
#define PG8_WAIT_L(n) asm volatile("s_waitcnt lgkmcnt(" #n ")" ::: "memory")
#define PG8_BAR __builtin_amdgcn_s_barrier()
#define PG8_SCHED __builtin_amdgcn_sched_barrier(0)
    Unit cur, nxt; int ui = 0;
    if (!S.next(0, cur)) return;
    f32x4 acc[2][2][4][2];
#pragma unroll
    for (int a = 0; a < 2; ++a)
#pragma unroll
        for (int b = 0; b < 2; ++b)
#pragma unroll
            for (int m = 0; m < 4; ++m)
#pragma unroll
                for (int n = 0; n < 2; ++n) acc[a][b][m][n] = (f32x4){0.f, 0.f, 0.f, 0.f};
    bf16x8 At[4][2], B0[2][2], B1[2][2];
    const char* cA = (const char*)g.A + (size_t)cur.pm * tstep + cur.kb; const char* cB = (const char*)g.Bt + (size_t)cur.pn * tstep + cur.kb;
    S.a_ready(cur);
    if constexpr (SP2) {
        PG8_STAGE(PG8_SB(0, 0), cB, voffB); PG8_STAGE(PG8_SB(0, 1), cB + hstep, voffB); PG8_STAGE(PG8_SA(0, 0), cA, voffA); PG8_STAGE(PG8_SA(0, 1), cA + hstep, voffA);
        if (wr == 1) PG8_BAR;
        PG8_WAIT_V(2); PG8_BAR;
        PG8_STAGE(PG8_SB(1, 0), cB + kstep, voffB); PG8_STAGE(PG8_SA(1, 0), cA + kstep, voffA); PG8_STAGE(PG8_SB(1, 1), cB + hstep + kstep, voffB);
        PG8_WAIT_V(6); PG8_BAR;
    } else {
        PG8_STAGE(PG8_SB(0, 0), cB, voffB); PG8_STAGE(PG8_SA(0, 0), cA, voffA); PG8_STAGE(PG8_SB(0, 1), cB + hstep, voffB); PG8_STAGE(PG8_SA(0, 1), cA + hstep, voffA);
        if (wr == 1) PG8_BAR;
        PG8_WAIT_V(4); PG8_BAR;
        PG8_STAGE(PG8_SB(1, 0), cB + kstep, voffB); PG8_STAGE(PG8_SA(1, 0), cA + kstep, voffA); PG8_STAGE(PG8_SB(1, 1), cB + hstep + kstep, voffB);
        PG8_WAIT_V(6); PG8_BAR;
    }
    for (;;) {
        const bool has_next = S.next(ui + 1, nxt);
        const char* nA = has_next ? (const char*)g.A + (size_t)nxt.pm * tstep + nxt.kb : cA; const char* nB = has_next ? (const char*)g.Bt + (size_t)nxt.pn * tstep + nxt.kb : cB;
        const int ntu = cur.nt;
        for (int t = 0; t < ntu; t += 2) {
            const bool last = (t == ntu - 2);
            const char* a1 = cA + (size_t)(t + 1) * kstep;
            const char* a2 = last ? nA : cA + (size_t)(t + 2) * kstep; const char* b2 = last ? nB : cB + (size_t)(t + 2) * kstep;
            const char* a3 = a2 + kstep; const char* b3 = b2 + kstep;
            if (last && has_next) S.a_ready(nxt);
            if constexpr (SP2) {
            PG8_LDB(B0, 0, 0); PG8_LDB(B1, 0, 1); PG8_SCHED; PG8_LDA(At, 0, 0); PG8_STAGE(PG8_SA(1, 1), a1 + hstep, voffA);
            PG8_WAIT_V(8); PG8_WAIT_L(0); PG8_BAR; PG8_MMA(0, 0, At, B0); PG8_MMA(0, 1, At, B1); PG8_BAR; PG8_SCHED;
            PG8_LDA(At, 0, 1); PG8_STAGE(PG8_SB(0, 0), b2, voffB); PG8_STAGE(PG8_SB(0, 1), b2 + hstep, voffB); PG8_STAGE(PG8_SA(0, 0), a2, voffA);
            PG8_WAIT_V(8); PG8_WAIT_L(0); PG8_BAR; PG8_MMA(1, 0, At, B0); PG8_MMA(1, 1, At, B1); PG8_BAR; PG8_SCHED;
            PG8_LDB(B0, 1, 0); PG8_LDB(B1, 1, 1); PG8_SCHED; PG8_LDA(At, 1, 0); PG8_STAGE(PG8_SA(0, 1), a2 + hstep, voffA);
            PG8_WAIT_V(8); PG8_WAIT_L(0); PG8_BAR; PG8_MMA(0, 0, At, B0); PG8_MMA(0, 1, At, B1); PG8_BAR; PG8_SCHED;
            PG8_LDA(At, 1, 1); PG8_STAGE(PG8_SB(1, 0), b3, voffB); PG8_STAGE(PG8_SB(1, 1), b3 + hstep, voffB); PG8_STAGE(PG8_SA(1, 0), a3, voffA);
            PG8_WAIT_V(8); PG8_WAIT_L(0); PG8_BAR; PG8_MMA(1, 0, At, B0); PG8_MMA(1, 1, At, B1); PG8_BAR; PG8_SCHED;
            } else {
            PG8_LDB(B0, 0, 0); PG8_SCHED; PG8_LDA(At, 0, 0); PG8_STAGE(PG8_SA(1, 1), a1 + hstep, voffA);
            PG8_WAIT_L(8); PG8_BAR; PG8_WAIT_L(0); PG8_MMA(0, 0, At, B0); PG8_BAR; PG8_SCHED;
            PG8_LDB(B1, 0, 1); PG8_STAGE(PG8_SB(0, 0), b2, voffB);
            PG8_BAR; PG8_WAIT_L(0); PG8_MMA(0, 1, At, B1); PG8_BAR;
            PG8_LDA(At, 0, 1); PG8_STAGE(PG8_SA(0, 0), a2, voffA);
            PG8_BAR; PG8_WAIT_L(0); PG8_MMA(1, 0, At, B0); PG8_BAR; PG8_SCHED;
            PG8_STAGE(PG8_SB(0, 1), b2 + hstep, voffB);
            PG8_WAIT_V(6); PG8_BAR; PG8_MMA(1, 1, At, B1); PG8_BAR;
            PG8_LDB(B0, 1, 0); PG8_SCHED; PG8_LDA(At, 1, 0); PG8_STAGE(PG8_SA(0, 1), a2 + hstep, voffA);
            PG8_WAIT_L(8); PG8_BAR; PG8_WAIT_L(0); PG8_MMA(0, 0, At, B0); PG8_BAR; PG8_SCHED;
            PG8_LDB(B1, 1, 1); PG8_STAGE(PG8_SB(1, 0), b3, voffB);
            PG8_BAR; PG8_WAIT_L(0); PG8_MMA(0, 1, At, B1); PG8_BAR;
            PG8_LDA(At, 1, 1); PG8_STAGE(PG8_SA(1, 0), a3, voffA);
            PG8_BAR; PG8_WAIT_L(0); PG8_MMA(1, 0, At, B0); PG8_BAR; PG8_SCHED;
            PG8_STAGE(PG8_SB(1, 1), b3 + hstep, voffB);
            PG8_WAIT_V(6); PG8_BAR; PG8_MMA(1, 1, At, B1); PG8_BAR;
            }
        }
        if constexpr (ALIGN_EPI) { if (wr == 0) PG8_BAR; }
        if constexpr (!Epi::AFTER_DRAIN) { int t_ = g.wb + lane_now(); asm volatile("" : "+v"(t_)); const int fr_ = t_ & 15, fq_ = (t_ >> 4) & 3; if constexpr (!Sched::STREAM) E(acc, cur, wr, wc, fr_, fq_); else { if (cur.fl == 1) streamk_store(acc, cur, g.skp, g.skf, t_); else { const float* part_ = streamk_wait(cur, g.skp, g.skf, t_); int t2_ = g.wb + lane_now(); asm volatile("" : "+v"(t2_)); E(acc, cur, wr, wc, t2_ & 15, (t2_ >> 4) & 3, part_, t2_); } } S.done(cur); }
        if (!has_next) break;
#pragma unroll
        for (int a = 0; a < 2; ++a)
#pragma unroll
            for (int b = 0; b < 2; ++b)
#pragma unroll
                for (int m = 0; m < 4; ++m)
#pragma unroll
                    for (int n = 0; n < 2; ++n) acc[a][b][m][n] = (f32x4){0.f, 0.f, 0.f, 0.f};
        cur = nxt; cA = nA; cB = nB; ++ui;
        if constexpr (ALIGN_EPI) { if (wr == 1) PG8_BAR; }
    }
    PG8_WAIT_V(0);
    if constexpr (!ALIGN_EPI) { if (wr == 0) PG8_BAR; }
    PG8_BAR;
    if constexpr (Epi::AFTER_DRAIN) { E.fused(acc, cur, wr, wc, fr, fq, lds, wid, lane); S.done(cur); }
#undef PG8_SA
#undef PG8_SB
#undef PG8_STAGE
#undef PG8_LDA
#undef PG8_LDB
#undef PG8_MMA
#undef PG8_WAIT_V
#undef PG8_WAIT_L
#undef PG8_BAR
#undef PG8_SCHED
}
}

#define LAS __attribute__((address_space(3)))
typedef unsigned short bf16_t;
typedef short bf16x8 __attribute__((ext_vector_type(8)));
typedef float f32x4 __attribute__((ext_vector_type(4)));
typedef float f32x2 __attribute__((ext_vector_type(2)));
typedef float f32x16 __attribute__((ext_vector_type(16)));
typedef unsigned u32x4 __attribute__((ext_vector_type(4)));
typedef unsigned u32x2 __attribute__((ext_vector_type(2)));

constexpr int D = 1024, NH = 16, HD = 64;
constexpr int BP = 8, TP = 2064, SEQP = 2048, NMETA = 16, BS = 16, TS = 64, PAST = 4096;
constexpr int MPR = BP * TP;
constexpr int MR = MPR + BS * TS;
constexpr int MP = 17664;
constexpr int NTM = 69;
constexpr int DFF = 2752, DFFP = 2816, NIN = 5632;
constexpr float RMS_EPS = 1e-6f, GN_EPS = 64e-5f;
constexpr float LOG2E = 1.4426950408889634f;

constexpr size_t O_YP = 0, O_YS = 16777216, O_SP = 17825792, O_SHP = 18350080, O_KP = 18358272, O_VP = 35266560,
                 O_SS = 52174848, O_SHS = 53223424, O_KS = 53239808, O_VS = 54288384, O_END = 55336960;

constexpr size_t SZ_ROWBF = (size_t)MP * D * 2, SZ_ROWF = (size_t)MP * D * 4;
constexpr size_t W_X = 0;
constexpr size_t W_XN = W_X + SZ_ROWF;
constexpr size_t W_HB = W_XN + SZ_ROWBF;
constexpr size_t W_WIN = W_HB + (size_t)MP * DFFP * 2;
constexpr size_t SZ_WIN1 = (size_t)NIN * D * 2, SZ_WOUT1 = (size_t)D * DFFP * 2;
constexpr size_t W_WOUT = W_WIN + 4 * SZ_WIN1;
constexpr size_t W_WG1 = W_WOUT + 4 * SZ_WOUT1;
constexpr size_t W_WL2 = W_WG1 + (size_t)3584 * D * 2;
constexpr size_t W_WO1 = W_WL2 + (size_t)3072 * 256 * 2;
constexpr size_t W_WQKV = W_WO1 + (size_t)D * D * 2;
constexpr size_t W_WO2 = W_WQKV + (size_t)3 * D * D * 2;
constexpr size_t W_AALL = W_WO2 + (size_t)D * D * 2;
constexpr size_t W_RKV = W_AALL + 5 * SZ_ROWBF;
constexpr size_t W_L1 = W_RKV + 3 * SZ_ROWBF;
constexpr size_t W_A2 = W_L1 + (size_t)2 * MP * 256 * 4;
constexpr size_t W_DEC = W_A2 + (size_t)MP * 256 * 2;
constexpr size_t W_AA = W_DEC + SZ_ROWBF;
constexpr size_t W_GG = W_AA + SZ_ROWBF;
constexpr size_t W_SO = W_GG + SZ_ROWBF;
constexpr size_t W_OG = W_SO + SZ_ROWF;
constexpr size_t W_QB = W_OG + SZ_ROWBF;
constexpr size_t W_RSQ = W_QB + SZ_ROWBF;
constexpr size_t W_SKF = W_RSQ + (size_t)5 * MP * 4;
constexpr size_t W_SKP = W_SKF + 64 * 1024 * 4;
constexpr size_t W_BAR = W_SKP + (size_t)277 * 262144;
constexpr size_t W_END = W_BAR + 16384;

struct Params { const float* in[31]; float* out; unsigned char* ws; int ph_lo, ph_hi; int seq[64]; };
typedef const Params __attribute__((address_space(4)))* KP;

__device__ __forceinline__ unsigned cvt_pk(float lo, float hi) { unsigned r; asm("v_cvt_pk_bf16_f32 %0, %1, %2" : "=v"(r) : "v"(lo), "v"(hi)); return r; }
__device__ __forceinline__ void store_bf4(bf16_t* p, f32x4 v) { u32x2 w; w.x = cvt_pk(v[0], v[1]); w.y = cvt_pk(v[2], v[3]); *(u32x2*)p = w; }
__device__ __forceinline__ float bf_lo(unsigned w) { return __uint_as_float(w << 16); }
__device__ __forceinline__ float bf_hi(unsigned w) { return __uint_as_float(w & 0xffff0000u); }
__device__ __forceinline__ float sigmoidf_(float x) { return __builtin_amdgcn_rcpf(1.f + __expf(-x)); }
__device__ __forceinline__ float softplusf_(float x) { return fmaxf(x, 0.f) + __logf(1.f + __expf(-fabsf(x))); }
__device__ __forceinline__ float shx(float v, int o, int lane) { return __builtin_bit_cast(float, __builtin_amdgcn_ds_bpermute((lane ^ o) << 2, __builtin_bit_cast(int, v))); }
__device__ __forceinline__ float wave_sum(float v, int lane) {
#pragma unroll
    for (int o = 1; o < 64; o <<= 1) v += shx(v, o, lane);
    return v;
}
__device__ __forceinline__ void row_bt(int row, int& grp, int& b, int& t) { if (row < MPR) { grp = 0; b = row / TP; t = row - b * TP; } else { grp = 1; const int r = row - MPR; b = r >> 6; t = r & 63; } }

using pg8::Unit;
extern __shared__ __attribute__((aligned(16))) unsigned char lds_raw[];
struct EpiSwiGLU {
    static constexpr bool PERM = true, AFTER_DRAIN = false;
    bf16_t* HB; const float* rsq;
    __device__ __forceinline__ void operator()(const f32x4 (&acc)[2][2][4][2], const Unit& u, int wr, int wc, int fr, int fq) const {
        const int row0 = u.pm * 256 + wr * 64 + fr, col0 = u.pn * 128 + wc * 32 + 8 * fq;
#pragma unroll
        for (int ai = 0; ai < 2; ++ai)
#pragma unroll
            for (int m = 0; m < 4; ++m) {
                bf16_t* rowp = HB + (size_t)(row0 + ai * 128 + m * 16) * DFFP + col0;
                const float rs = __builtin_amdgcn_rsqf(rsq[row0 + ai * 128 + m * 16] * (1.f / D) + RMS_EPS);
                float hv[8];
#pragma unroll
                for (int n = 0; n < 2; ++n)
#pragma unroll
                    for (int j = 0; j < 4; ++j) { const float g = acc[ai][0][m][n][j] * rs, up = acc[ai][1][m][n][j] * rs; hv[n * 4 + j] = g * sigmoidf_(g) * up; }
                u32x4 w; w.x = cvt_pk(hv[0], hv[1]); w.y = cvt_pk(hv[2], hv[3]); w.z = cvt_pk(hv[4], hv[5]); w.w = cvt_pk(hv[6], hv[7]);
                *(u32x4*)rowp = w;
            }
    }
};
struct EpiRes {
    static constexpr bool PERM = false, AFTER_DRAIN = false;
    float* X; float scale; float* out; bf16_t* XB; float* rsq;
    __device__ __forceinline__ void operator()(const f32x4 (&acc)[2][2][4][2], const Unit& u, int wr, int wc, int fr, int fq, const float* part = nullptr, int tid = 0) const {
        const bool hasp = u.fl == 2;
        float* const X_ = X; float* const out_ = out; bf16_t* const XB_ = XB; float* const rsq_ = rsq; const float sc_ = scale;
        const int row0 = u.pm * 256 + wr * 64 + fr, col0 = u.pn * 256 + wc * 32 + 4 * fq, ln = fq * 16 + fr;
#pragma unroll
        for (int ai = 0; ai < 2; ++ai)
#pragma unroll
            for (int m = 0; m < 4; ++m) {
                const int row = row0 + ai * 128 + m * 16;
                const unsigned off = (unsigned)row * D + col0;
                if (out_ == nullptr) {
                    float ss = 0.f;
#pragma unroll
                    for (int bj = 0; bj < 2; ++bj)
#pragma unroll
                        for (int n = 0; n < 2; ++n) { f32x4* q = (f32x4*)(X_ + off + bj * 128 + n * 16); f32x4 av = acc[ai][bj][m][n]; if (hasp) av += pg8::streamk_part(part, ((ai * 2 + bj) * 4 + m) * 2 + n, tid); const f32x4 x = *q + av * sc_; *q = x;
                            if (XB_) { store_bf4(XB_ + off + bj * 128 + n * 16, x); ss += (x[0] * x[0] + x[1] * x[1]) + (x[2] * x[2] + x[3] * x[3]); } }
                    if (XB_) { ss += shx(ss, 16, ln); ss += shx(ss, 32, ln); if (fq == 0) unsafeAtomicAdd(rsq_ + row, ss); }
                } else if (row < MR) {
                    float* dp = nullptr;
                    if (row < MPR) { const int b = row / TP, t = row - b * TP; if (t >= NMETA) dp = out_ + O_YP + ((size_t)b * SEQP + (t - NMETA)) * D + col0; }
                    else dp = out_ + O_YS + (size_t)(row - MPR) * D + col0;
                    if (dp) {
#pragma unroll
                        for (int bj = 0; bj < 2; ++bj)
#pragma unroll
                            for (int n = 0; n < 2; ++n) { f32x4 av = acc[ai][bj][m][n]; if (hasp) av += pg8::streamk_part(part, ((ai * 2 + bj) * 4 + m) * 2 + n, tid); *(f32x4*)(dp + bj * 128 + n * 16) = *(const f32x4*)(X_ + off + bj * 128 + n * 16) + av * sc_; }
                    }
                }
                asm volatile("" ::: "memory");
            }
    }
};
struct StreamOrder {
    static constexpr bool STREAM = true;
    int nN, ppt, c; long s, e;
    __device__ void init(int M, int N, int K, int G, int c_) {
        nN = N / 256; ppt = K / 128;
        c = (G % 8 == 0) ? (c_ % 8) * (G / 8) + c_ / 8 : c_;
        const long P = (long)(M / 256) * nN * ppt;
        s = (long)c * P / G; e = (long)(c + 1) * P / G;
    }
    __device__ bool next(int i, Unit& u) const {
        const int t = (int)(s / ppt) + i; const long t0 = (long)t * ppt;
        if (t0 >= e) return false;
        const long lo = s > t0 ? s : t0, hi = e < t0 + ppt ? e : t0 + ppt;
        u.pm = t / nN; u.pn = t - u.pm * nN; u.tl = t;
        u.kb = (int)(lo - t0) * 256; u.nt = (int)(hi - lo) * 2;
        u.fl = lo > t0 ? 1 : (hi < t0 + ppt ? 2 : 0);
        return true;
    }
    __device__ __forceinline__ void a_ready(const Unit&) const {}
    __device__ __forceinline__ void done(const Unit&) const {}
};
struct EpiG1 {
    static constexpr bool PERM = true, AFTER_DRAIN = false;
    bf16_t* RKV; float* L1;
    __device__ __forceinline__ void operator()(const f32x4 (&acc)[2][2][4][2], const Unit& u, int wr, int wc, int fr, int fq) const {
        const unsigned row0 = (unsigned)((u.pm % NTM) * 256 + wr * 64 + fr), cw = wc * 32 + 8 * fq;
        if (u.pn < 12) {
            bf16_t* base = RKV + (size_t)(u.pn >> 2) * MP * D;
            const unsigned off0 = row0 * D + (u.pn & 3) * 256 + cw;
#pragma unroll
            for (int ai = 0; ai < 2; ++ai)
#pragma unroll
                for (int m = 0; m < 4; ++m)
#pragma unroll
                    for (int bj = 0; bj < 2; ++bj) { const f32x4 v0 = acc[ai][bj][m][0], v1 = acc[ai][bj][m][1];
                        u32x4 w; w.x = cvt_pk(v0[0], v0[1]); w.y = cvt_pk(v0[2], v0[3]); w.z = cvt_pk(v1[0], v1[1]); w.w = cvt_pk(v1[2], v1[3]);
                        *(u32x4*)(base + (off0 + (unsigned)((ai * 128 + m * 16) * D + bj * 128))) = w; }
        } else {
            float* base = L1 + (size_t)(u.pn - 12) * MP * 256;
            const unsigned off0 = row0 * 256 + cw;
#pragma unroll
            for (int ai = 0; ai < 2; ++ai)
#pragma unroll
                for (int m = 0; m < 4; ++m)
#pragma unroll
                    for (int bj = 0; bj < 2; ++bj)
#pragma unroll
                        for (int n = 0; n < 2; ++n) *(f32x4*)(base + (off0 + (unsigned)((ai * 128 + m * 16) * 256 + bj * 128 + n * 4))) = acc[ai][bj][m][n];
        }
    }
};
struct EpiG2 {
    static constexpr bool PERM = true, AFTER_DRAIN = false;
    bf16_t* LW;
    __device__ __forceinline__ void operator()(const f32x4 (&acc)[2][2][4][2], const Unit& u, int wr, int wc, int fr, int fq) const {
        bf16_t* base = LW + (size_t)(u.pn >> 2) * MP * D;
        const unsigned off0 = (unsigned)(u.pm * 256 + wr * 64 + fr) * D + (u.pn & 3) * 256 + wc * 32 + 8 * fq;
#pragma unroll
        for (int ai = 0; ai < 2; ++ai)
#pragma unroll
            for (int m = 0; m < 4; ++m)
#pragma unroll
                for (int bj = 0; bj < 2; ++bj) { const f32x4 v0 = acc[ai][bj][m][0], v1 = acc[ai][bj][m][1];
                    u32x4 w; w.x = cvt_pk(v0[0], v0[1]); w.y = cvt_pk(v0[2], v0[3]); w.z = cvt_pk(v1[0], v1[1]); w.w = cvt_pk(v1[2], v1[3]);
                    *(u32x4*)(base + (off0 + (unsigned)((ai * 128 + m * 16) * D + bj * 128))) = w; }
    }
};
struct EpiQKV {
    static constexpr bool PERM = false, AFTER_DRAIN = false;
    bf16_t* QB; float* out; const float* qg; const float* kg; const float* rsq;
    __device__ __forceinline__ void operator()(const f32x4 (&acc)[2][2][4][2], const Unit& u, int wr, int wc, int fr, int fq) const {
        const int sec = u.pn >> 2, head = (u.pn & 3) * 4 + wc, row0 = u.pm * 256 + wr * 64 + fr;
        f32x4 gn[2][2];
#pragma unroll
        for (int bj = 0; bj < 2; ++bj)
#pragma unroll
            for (int n = 0; n < 2; ++n) { const int d = 32 * bj + 16 * n + 4 * fq;
                gn[bj][n] = sec == 0 ? *(const f32x4*)(qg + d) * 0.125f : (sec == 1 ? *(const f32x4*)(kg + d) : (f32x4){1.f, 1.f, 1.f, 1.f}); }
#pragma unroll
        for (int ai = 0; ai < 2; ++ai)
#pragma unroll
            for (int m = 0; m < 4; ++m) {
                const int row = row0 + ai * 128 + m * 16;
                const float rx = __builtin_amdgcn_rsqf(rsq[row] * (1.f / D) + RMS_EPS);
                float ss = 0.f;
#pragma unroll
                for (int bj = 0; bj < 2; ++bj)
#pragma unroll
                    for (int n = 0; n < 2; ++n) { const f32x4 x = acc[ai][bj][m][n]; ss += (x[0] * x[0] + x[1] * x[1]) + (x[2] * x[2] + x[3] * x[3]); }
                { const int ln = fq * 16 + fr; ss += shx(ss, 16, ln); ss += shx(ss, 32, ln); }
                const float rs = rx * (sec == 2 ? 1.f : __builtin_amdgcn_rsqf(ss * rx * rx * (1.f / 64.f) + RMS_EPS));
                if (row < MR) {
                    if (sec == 0) {
                        bf16_t* qp = QB + (size_t)row * D + head * 64 + 4 * fq;
#pragma unroll
                        for (int bj = 0; bj < 2; ++bj)
#pragma unroll
                            for (int n = 0; n < 2; ++n) { const f32x4 x = acc[ai][bj][m][n] * rs * gn[bj][n]; u32x2 w; w.x = cvt_pk(x[0], x[1]); w.y = cvt_pk(x[2], x[3]); *(u32x2*)(qp + 32 * bj + 16 * n) = w; }
                    } else {
                        int grp, b, t; row_bt(row, grp, b, t);
                        float* dp = grp == 0 ? out + (sec == 1 ? O_KP : O_VP) + (((size_t)b * NH + head) * TP + t) * HD
                                             : out + (sec == 1 ? O_KS : O_VS) + (((size_t)b * NH + head) * TS + t) * HD;
                        dp += 4 * fq;
#pragma unroll
                        for (int bj = 0; bj < 2; ++bj)
#pragma unroll
                            for (int n = 0; n < 2; ++n) *(f32x4*)(dp + 32 * bj + 16 * n) = acc[ai][bj][m][n] * rs * gn[bj][n];
                    }
                }
            }
    }
};
struct G1Order {
    static constexpr bool STREAM = false;
    int G, c;
    __device__ bool next(int i, Unit& u) const {
        const long L = (long)i * G + c; if (L >= 966) return false;
        int w = (int)L; { const int q = 966 / 8, r = 966 % 8, xcd = w % 8, off = w / 8; w = (xcd < r ? xcd * (q + 1) : r * (q + 1) + (xcd - r) * q) + off; }
        const int pm = w / 14, q = w % 14;
        if (q < 12) { u.pm = (q >> 2) * NTM + pm; u.pn = q; } else { u.pm = (q - 9) * NTM + pm; u.pn = q; }
        u.kb = 0; u.nt = 16; u.fl = 0; u.tl = 0;
        return true;
    }
    __device__ __forceinline__ void a_ready(const Unit&) const {}
    __device__ __forceinline__ void done(const Unit&) const {}
};

struct Job { const float* src; bf16_t* dst; const float* mu; int ld, Ksrc, koff, Kdst, rows, map, smode; };
__device__ __forceinline__ int srccol(int map, int n, int ld) {
    if (map == 0) return n < ld ? n : -1;
    if (map == 1) { const int pn = n >> 8, c = n & 255, bj = c >> 7, j = c & 127, hc = pn * 128 + j; return hc < DFF ? (bj ? DFF + hc : hc) : -1; }
    { const int t = n >> 8, c = n & 255, bj = c >> 7, wc = (c & 127) >> 5, i = c & 31; return t * 256 + 64 * wc + 32 * bj + i; }
}
__device__ __forceinline__ Job get_job(KP p, int j) {
    Job J; J.mu = nullptr; J.koff = 0; J.map = 0; J.smode = 0;
    unsigned char* ws = p->ws;
    if (j < 4) { J.src = p->in[8] + (size_t)j * D * 2 * DFF; J.dst = (bf16_t*)(ws + W_WIN + j * SZ_WIN1); J.ld = 2 * DFF; J.Ksrc = D; J.Kdst = D; J.rows = NIN; J.map = 1; J.mu = p->in[7] + (size_t)j * D; J.smode = 2; }
    else if (j < 8) { const int i = j - 4; J.src = p->in[9] + (size_t)i * DFF * D; J.dst = (bf16_t*)(ws + W_WOUT + i * SZ_WOUT1); J.ld = D; J.Ksrc = DFF; J.Kdst = DFFP; J.rows = D; }
    else if (j < 11) { const int g = j - 8; J.src = p->in[12] + (size_t)g * D * D; J.dst = (bf16_t*)(ws + W_WG1) + (size_t)g * D * D; J.ld = D; J.Ksrc = D; J.Kdst = D; J.rows = D; }
    else if (j < 17) { const int idx = j - 11, part = idx / 3, which = idx % 3;
        J.src = which == 0 ? p->in[14] : (which == 1 ? p->in[17] : p->in[19]); J.ld = which == 2 ? 128 : 64; J.rows = J.ld;
        J.mu = p->in[11] + (which == 0 ? 1 : (which == 1 ? 4 : 5)) * D; J.smode = part + 1;
        J.dst = (bf16_t*)(ws + W_WG1) + (size_t)(3072 + part * 256 + which * 64) * D; J.Ksrc = D; J.Kdst = D; }
    else if (j < 20) { const int which = j - 17; J.src = which == 0 ? p->in[15] : (which == 1 ? p->in[18] : p->in[20]); J.ld = D; J.rows = D;
        J.Ksrc = which == 2 ? 128 : 64; J.koff = which * 64; J.Kdst = 256; J.dst = (bf16_t*)(ws + W_WL2) + (size_t)which * D * 256; }
    else if (j == 20) { J.src = p->in[26]; J.dst = (bf16_t*)(ws + W_WO1); J.ld = D; J.Ksrc = D; J.Kdst = D; J.rows = D; }
    else if (j == 21) { J.src = p->in[27]; J.dst = (bf16_t*)(ws + W_WQKV); J.ld = 3 * D; J.Ksrc = D; J.Kdst = D; J.rows = 3 * D; J.map = 2; J.mu = p->in[10] + D; J.smode = 2; }
    else { J.src = p->in[30]; J.dst = (bf16_t*)(ws + W_WO2); J.ld = D; J.Ksrc = D; J.Kdst = D; J.rows = D; }
    return J;
}
__device__ __forceinline__ void convert_weights(KP p, LAS float* tl, int tid, int bid, int G) {
    int rot = 0;
    for (int j = 0; j < 23; ++j) {
        const Job J = get_job(p, j);
        const int nkt = J.Kdst >> 6, nnt = (J.rows + 255) >> 8, ntile = nnt * nkt;
        int first = bid - rot; if (first < 0) first += G;
        for (int t = first; t < ntile; t += G) {
            const int n0 = (t / nkt) << 8, k0 = (t % nkt) << 6;
            const bool inside = k0 >= J.koff && k0 < J.koff + J.Ksrc;
            if (inside) {
                const int nn = tid & 255, kh = tid >> 8;
                const int sc = (n0 + nn) < J.rows ? srccol(J.map, n0 + nn, J.ld) : -1;
                const float* sp = J.src + (size_t)(k0 - J.koff + kh) * J.ld + (sc >= 0 ? sc : 0);
                float v[32];
#pragma unroll
                for (int it = 0; it < 32; ++it) v[it] = sc >= 0 ? sp[(size_t)(2 * it) * J.ld] : 0.f;
                if (J.smode) {
#pragma unroll
                    for (int it = 0; it < 32; ++it) { const float m = J.mu[k0 - J.koff + kh + 2 * it]; v[it] *= J.smode == 1 ? 1.f - m : m; }
                }
#pragma unroll
                for (int it = 0; it < 32; ++it) tl[(kh + 2 * it) * 257 + nn] = v[it];
            }
            __syncthreads();
            {
                const int nn = tid >> 1, kh = (tid & 1) * 32;
                if (n0 + nn < J.rows) {
                    bf16_t* dp = J.dst + (size_t)(n0 + nn) * J.Kdst + k0 + kh;
#pragma unroll
                    for (int q = 0; q < 4; ++q) {
                        const unsigned z_ = (unsigned)tid >> 31;
                        u32x4 w = (u32x4){z_, z_, z_, z_};
                        if (inside) { float v[8];
#pragma unroll
                            for (int e = 0; e < 8; ++e) v[e] = tl[(kh + q * 8 + e) * 257 + nn];
                            w.x = cvt_pk(v[0], v[1]); w.y = cvt_pk(v[2], v[3]); w.z = cvt_pk(v[4], v[5]); w.w = cvt_pk(v[6], v[7]); }
                        *(u32x4*)(dp + q * 8) = w;
                    }
                }
            }
            __syncthreads();
        }
        rot = (rot + ntile) % G;
    }
}
__device__ __forceinline__ float row_rstd(const f32x4 (&v)[4], int lane) {
    float s = 0.f;
#pragma unroll
    for (int i = 0; i < 4; ++i) s += (v[i][0] * v[i][0] + v[i][1] * v[i][1]) + (v[i][2] * v[i][2] + v[i][3] * v[i][3]);
    s = wave_sum(s, lane);
    return __builtin_amdgcn_rsqf(s * (1.f / D) + RMS_EPS);
}

__device__ __forceinline__ void assemble_x(KP p, int tid, int bid, int G) {
    const int lane = tid & 63, gw = bid * 8 + (tid >> 6), nw = G * 8;
    float* X = (float*)(p->ws + W_X); bf16_t* XN = (bf16_t*)(p->ws + W_XN);
    for (int row = gw; row < MP; row += nw) {
        f32x4 v[4];
        const float* src = nullptr;
        if (row < MPR) { const int b = row / TP, t = row - b * TP; src = t < NMETA ? p->in[6] + (size_t)t * D : p->in[0] + ((size_t)b * SEQP + (t - NMETA)) * D; }
        else if (row < MR) src = p->in[1] + (size_t)(row - MPR) * D;
#pragma unroll
        for (int i = 0; i < 4; ++i) { const float zf = __uint_as_float((unsigned)tid >> 31); v[i] = src ? *(const f32x4*)(src + lane * 4 + 256 * i) : (f32x4){zf, zf, zf, zf}; }
        float ssq = 0.f;
#pragma unroll
        for (int i = 0; i < 4; ++i) ssq += (v[i][0] * v[i][0] + v[i][1] * v[i][1]) + (v[i][2] * v[i][2] + v[i][3] * v[i][3]);
        ssq = wave_sum(ssq, lane);
#pragma unroll
        for (int i = 0; i < 4; ++i) { const int c = lane * 4 + 256 * i; *(f32x4*)(X + (size_t)row * D + c) = v[i]; store_bf4(XN + (size_t)row * D + c, v[i]); }
        float* rsq = (float*)(p->ws + W_RSQ);
        if (lane < 5) rsq[(size_t)lane * MP + row] = lane == 0 ? ssq : 0.f;
    }    for (int i = gw * 64 + lane; i < 64 * 1024; i += nw * 64) ((unsigned*)(p->ws + W_SKF))[i] = 0u;
    for (int i = gw * 64 + lane; i < 65536; i += nw * 64) ((float*)(p->ws + W_SKP) + (size_t)276 * 65536)[i] = 0.f;
}
__device__ __forceinline__ void norm_phase(KP p, const float* g, int tid, int bid, int G, bool copy_y = false) {
    const int lane = tid & 63, gw = bid * 8 + (tid >> 6), nw = G * 8;
    const float* X = (const float*)(p->ws + W_X); bf16_t* XN = (bf16_t*)(p->ws + W_XN);
    for (int row = gw; row < MP; row += nw) {
        f32x4 v[4];
#pragma unroll
        for (int i = 0; i < 4; ++i) v[i] = *(const f32x4*)(X + (size_t)row * D + lane * 4 + 256 * i);
        const float rs = row_rstd(v, lane);
#pragma unroll
        for (int i = 0; i < 4; ++i) { const int c = lane * 4 + 256 * i; store_bf4(XN + (size_t)row * D + c, v[i] * rs * *(const f32x4*)(g + c)); }
        if (copy_y && row < MR) {
            float* dp = nullptr;
            if (row < MPR) { const int b = row / TP, t = row - b * TP; if (t >= NMETA) dp = p->out + O_YP + ((size_t)b * SEQP + (t - NMETA)) * D; }
            else dp = p->out + O_YS + (size_t)(row - MPR) * D;
            if (dp) {
#pragma unroll
                for (int i = 0; i < 4; ++i) *(f32x4*)(dp + lane * 4 + 256 * i) = v[i];
            }
        }
    }
}
__device__ __forceinline__ void mixprep_phase(KP p, int tid, int bid, int G) {
    const int lane = tid & 63, gw = bid * 8 + (tid >> 6), nw = G * 8;
    const float* X = (const float*)(p->ws + W_X); bf16_t* A = (bf16_t*)(p->ws + W_AALL);
    const float* g = p->in[10]; const float* mu = p->in[11];
    for (int row = gw; row < MR; row += nw) {
        int grp, b, t; row_bt(row, grp, b, t);
        f32x4 v[4], pv[4];
#pragma unroll
        for (int i = 0; i < 4; ++i) v[i] = *(const f32x4*)(X + (size_t)row * D + lane * 4 + 256 * i);
        const float rs = row_rstd(v, lane);
        if (t > 0) {
#pragma unroll
            for (int i = 0; i < 4; ++i) pv[i] = *(const f32x4*)(X + (size_t)(row - 1) * D + lane * 4 + 256 * i);
            const float rp = row_rstd(pv, lane);
#pragma unroll
            for (int i = 0; i < 4; ++i) pv[i] = pv[i] * rp * *(const f32x4*)(g + lane * 4 + 256 * i);
        } else {
#pragma unroll
            for (int i = 0; i < 4; ++i) { const float zf = __uint_as_float((unsigned)tid >> 31); pv[i] = grp == 0 ? (f32x4){zf, zf, zf, zf} : *(const f32x4*)(p->in[3] + (size_t)b * D + lane * 4 + 256 * i); }
        }
        const bool last = t == (grp == 0 ? TP - 1 : TS - 1);
        float* sh = grp == 0 ? p->out + O_SHP + (size_t)b * D : p->out + O_SHS + (size_t)b * D;
#pragma unroll
        for (int i = 0; i < 4; ++i) {
            const int c = lane * 4 + 256 * i; const size_t o = (size_t)row * D + c;
            const f32x4 h = v[i] * rs * *(const f32x4*)(g + c), dx = pv[i] - h;
            store_bf4(A + o, h + dx * *(const f32x4*)(mu + c));
            store_bf4(A + (size_t)MP * D + o, h + dx * *(const f32x4*)(mu + 2 * D + c));
            store_bf4(A + (size_t)2 * MP * D + o, h + dx * *(const f32x4*)(mu + 3 * D + c));
            store_bf4(A + (size_t)3 * MP * D + o, h);
            store_bf4(A + (size_t)4 * MP * D + o, pv[i]);
            if (last) *(f32x4*)(sh + c) = h;
        }
    }
}
__device__ __forceinline__ void act_phase(KP p, int gtid, int nthr) {
    const float* L1 = (const float*)(p->ws + W_L1); bf16_t* A2 = (bf16_t*)(p->ws + W_A2);
    for (int i = gtid; i < MP * 64; i += nthr) {
        const int c = (i & 63) * 4;
        f32x4 v = *(const f32x4*)(L1 + (size_t)i * 4) + *(const f32x4*)(L1 + (size_t)MP * 256 + (size_t)i * 4);
        if (c < 64) {
#pragma unroll
            for (int j = 0; j < 4; ++j) v[j] = 1.f - 2.f * __builtin_amdgcn_rcpf(1.f + __expf(2.f * v[j]));
        } else if (c >= 128) {
#pragma unroll
            for (int j = 0; j < 4; ++j) v[j] = sigmoidf_(v[j]);
        }
        store_bf4(A2 + (size_t)i * 4, v);
    }
}

__device__ __forceinline__ float dpp_sum16(float x) {
    x += __builtin_bit_cast(float, __builtin_amdgcn_update_dpp(0, __builtin_bit_cast(int, x), 0xB1, 0xF, 0xF, true));
    x += __builtin_bit_cast(float, __builtin_amdgcn_update_dpp(0, __builtin_bit_cast(int, x), 0x4E, 0xF, 0xF, true));
    x += __builtin_bit_cast(float, __builtin_amdgcn_update_dpp(0, __builtin_bit_cast(int, x), 0x141, 0xF, 0xF, true));
    x += __builtin_bit_cast(float, __builtin_amdgcn_update_dpp(0, __builtin_bit_cast(int, x), 0x140, 0xF, 0xF, true));
    return x;
}
constexpr int SC_CH = 16, SC_STR = 400;
__device__ __forceinline__ void scan_phase(KP p, LAS float* buf, int tid, int bid, int G) {
    const int wid = tid >> 6, lane = tid & 63;
    const bf16_t* RKV = (const bf16_t*)(p->ws + W_RKV); const bf16_t* DEC = (const bf16_t*)(p->ws + W_DEC); const bf16_t* AA = (const bf16_t*)(p->ws + W_AA);
    float* SO = (float*)(p->ws + W_SO);
    const bool producer = wid >= 4;
    for (int u = bid; u < 768; u += G) {
        int bh, half, T, row0; const float* S0; float* Sout;
        if (u < 256) { bh = u >> 1; half = u & 1; T = TP; row0 = (bh >> 4) * TP; S0 = nullptr; Sout = p->out + O_SP + (size_t)bh * 4096; }
        else { const int v = u - 256; bh = v >> 1; half = v & 1; T = TS; row0 = MPR + (bh >> 4) * TS; S0 = p->in[2] + (size_t)bh * 4096; Sout = p->out + O_SS + (size_t)bh * 4096; }
        const int h = bh & 15, nchunk = T / SC_CH;
        if (producer) {
            const int t2 = tid - 256, pi = t2 >> 4, pj = t2 & 15, kc = h * 64 + 4 * pj;
            const f32x4 kkv = *(const f32x4*)(p->in[21] + kc), kav = *(const f32x4*)(p->in[22] + kc), w0v = *(const f32x4*)(p->in[13] + kc), a0v = *(const f32x4*)(p->in[16] + kc);
            u32x2 pr, pk, pvv, pa, pd;
#define SC_LOAD(c) do { const size_t o = (size_t)(row0 + (c) * SC_CH + pi) * D + kc; pr = *(const u32x2*)(RKV + o); pk = *(const u32x2*)(RKV + (size_t)MP * D + o); \
            pvv = *(const u32x2*)(RKV + (size_t)2 * MP * D + o); pa = *(const u32x2*)(AA + o); pd = *(const u32x2*)(DEC + o); } while (0)
#define SC_STORE(bi) do { LAS float* rec = buf + (bi) * (SC_CH * SC_STR) + pi * SC_STR; \
            const f32x4 r = (f32x4){bf_lo(pr.x), bf_hi(pr.x), bf_lo(pr.y), bf_hi(pr.y)}, k = (f32x4){bf_lo(pk.x), bf_hi(pk.x), bf_lo(pk.y), bf_hi(pk.y)}; \
            const f32x4 v = (f32x4){bf_lo(pvv.x), bf_hi(pvv.x), bf_lo(pvv.y), bf_hi(pvv.y)}; \
            f32x4 a = (f32x4){bf_lo(pa.x), bf_hi(pa.x), bf_lo(pa.y), bf_hi(pa.y)} + a0v; f32x4 w = (f32x4){bf_lo(pd.x), bf_hi(pd.x), bf_lo(pd.y), bf_hi(pd.y)} + w0v; \
            _Pragma("unroll") for (int j = 0; j < 4; ++j) { a[j] = sigmoidf_(a[j]); w[j] = __expf(-__expf(-softplusf_(-w[j]) - 0.5f)); } \
            const f32x4 q = k * kkv; float ss = (q[0] * q[0] + q[1] * q[1]) + (q[2] * q[2] + q[3] * q[3]); ss = dpp_sum16(ss); \
            const float inv = 1.f / fmaxf(sqrtf(ss), 1e-12f); const f32x4 nk = q * inv; \
            const f32x4 kp = k * (1.f + (a - 1.f) * kav), bb = nk * a; \
            float br = (bb[0] * r[0] + bb[1] * r[1]) + (bb[2] * r[2] + bb[3] * r[3]), kr = (kp[0] * r[0] + kp[1] * r[1]) + (kp[2] * r[2] + kp[3] * r[3]); \
            br = dpp_sum16(br); kr = dpp_sum16(kr); \
            *(LAS f32x4*)(rec + 4 * pj) = w; *(LAS f32x4*)(rec + 64 + 4 * pj) = nk; *(LAS f32x4*)(rec + 128 + 4 * pj) = bb; \
            *(LAS f32x4*)(rec + 192 + 4 * pj) = kp; *(LAS f32x4*)(rec + 256 + 4 * pj) = w * r; *(LAS f32x4*)(rec + 320 + 4 * pj) = v; \
            if (pj == 0) *(LAS f32x2*)(rec + 384) = (f32x2){br, kr}; } while (0)
            SC_LOAD(0); SC_STORE(0);
            if (nchunk > 1) SC_LOAD(1);
            __syncthreads();
            for (int c = 0; c < nchunk; ++c) {
                if (c + 1 < nchunk) { SC_STORE((c + 1) & 1); if (c + 2 < nchunk) SC_LOAD(c + 2); }
                __syncthreads();
            }
#undef SC_LOAD
#undef SC_STORE
        } else {
            const int rp = lane >> 4, kq = lane & 15, vA = half * 32 + wid * 8 + rp * 2;
            f32x4 sA = (f32x4){0.f, 0.f, 0.f, 0.f}, sB = sA;
            if (S0) { sA = *(const f32x4*)(S0 + vA * 64 + kq * 4); sB = *(const f32x4*)(S0 + (vA + 1) * 64 + kq * 4); }
            float* op = SO + (size_t)(row0 + kq) * D + h * 64 + vA;
            __syncthreads();
            for (int c = 0; c < nchunk; ++c) {
                const LAS float* cb = buf + (c & 1) * (SC_CH * SC_STR);
                float oA = 0.f, oB = 0.f;
#pragma unroll
                for (int i = 0; i < SC_CH; ++i) {
                    const LAS float* rec = cb + i * SC_STR;
                    const f32x4 wd = *(const LAS f32x4*)(rec + kq * 4), kk = *(const LAS f32x4*)(rec + 64 + kq * 4), bb = *(const LAS f32x4*)(rec + 128 + kq * 4),
                                kp = *(const LAS f32x4*)(rec + 192 + kq * 4), wr = *(const LAS f32x4*)(rec + 256 + kq * 4);
                    const f32x2 vv = *(const LAS f32x2*)(rec + 320 + vA), sc = *(const LAS f32x2*)(rec + 384);
                    const f32x2 t1A = sA.hi * kk.hi + sA.lo * kk.lo, t1B = sB.hi * kk.hi + sB.lo * kk.lo, t2A = sA.hi * wr.hi + sA.lo * wr.lo, t2B = sB.hi * wr.hi + sB.lo * wr.lo;
                    float d1A = t1A.x + t1A.y, d1B = t1B.x + t1B.y, d2A = t2A.x + t2A.y, d2B = t2B.x + t2B.y;
#define DPPR(ctl) "v_add_f32_dpp %0, %0, %0 " ctl " row_mask:0xf bank_mask:0xf bound_ctrl:1\n\tv_add_f32_dpp %1, %1, %1 " ctl " row_mask:0xf bank_mask:0xf bound_ctrl:1\n\t" \
                  "v_add_f32_dpp %2, %2, %2 " ctl " row_mask:0xf bank_mask:0xf bound_ctrl:1\n\tv_add_f32_dpp %3, %3, %3 " ctl " row_mask:0xf bank_mask:0xf bound_ctrl:1\n\t"
                    asm("s_nop 1\n\t" DPPR("quad_perm:[1,0,3,2]") DPPR("quad_perm:[2,3,0,1]") DPPR("row_half_mirror") DPPR("row_mirror") : "+v"(d1A), "+v"(d1B), "+v"(d2A), "+v"(d2B));
#undef DPPR
                    const float saA = -d1A, saB = -d1B;
                    const float tA = d2A + saA * sc.x + vv.x * sc.y, tB = d2B + saB * sc.x + vv.y * sc.y;
                    sA = sA * wd + bb * saA + kp * vv.x;
                    sB = sB * wd + bb * saB + kp * vv.y;
                    oA = kq == i ? tA : oA; oB = kq == i ? tB : oB;
                }
                *(f32x2*)(op + (size_t)c * SC_CH * D) = (f32x2){oA, oB};
                __syncthreads();
            }
            *(f32x4*)(Sout + vA * 64 + kq * 4) = sA; *(f32x4*)(Sout + (vA + 1) * 64 + kq * 4) = sB;
        }
    }
}
__device__ __forceinline__ void post_phase(KP p, int tid, int bid, int G) {
    const int lane = tid & 63, gw = bid * 8 + (tid >> 6), nw = G * 8;
    const bf16_t* RKV = (const bf16_t*)(p->ws + W_RKV); const bf16_t* AA = (const bf16_t*)(p->ws + W_AA); const bf16_t* GG = (const bf16_t*)(p->ws + W_GG);
    const float* SO = (const float*)(p->ws + W_SO); bf16_t* OG = (bf16_t*)(p->ws + W_OG);
    const float* k_a = p->in[22]; const float* a0p = p->in[16]; const float* r_k = p->in[23]; const float* gnw = p->in[24]; const float* gnb = p->in[25];
    const int c0 = lane * 16;
    for (int row = gw; row < MR; row += nw) {
        const size_t o = (size_t)row * D + c0;
        float ov[16], rv[16], kv[16], vv[16], av[16], gv[16];
#pragma unroll
        for (int q = 0; q < 4; ++q) { const f32x4 x = *(const f32x4*)(SO + o + 4 * q); ov[4 * q] = x[0]; ov[4 * q + 1] = x[1]; ov[4 * q + 2] = x[2]; ov[4 * q + 3] = x[3]; }
#define LD16(dst, ptr) do { const u32x4 a_ = *(const u32x4*)(ptr), b_ = *(const u32x4*)((ptr) + 8); \
        dst[0] = bf_lo(a_.x); dst[1] = bf_hi(a_.x); dst[2] = bf_lo(a_.y); dst[3] = bf_hi(a_.y); dst[4] = bf_lo(a_.z); dst[5] = bf_hi(a_.z); dst[6] = bf_lo(a_.w); dst[7] = bf_hi(a_.w); \
        dst[8] = bf_lo(b_.x); dst[9] = bf_hi(b_.x); dst[10] = bf_lo(b_.y); dst[11] = bf_hi(b_.y); dst[12] = bf_lo(b_.z); dst[13] = bf_hi(b_.z); dst[14] = bf_lo(b_.w); dst[15] = bf_hi(b_.w); } while (0)
        LD16(rv, RKV + o); LD16(kv, RKV + (size_t)MP * D + o); LD16(vv, RKV + (size_t)2 * MP * D + o); LD16(av, AA + o); LD16(gv, GG + o);
#undef LD16
        float sm = 0.f, rk = 0.f;
#pragma unroll
        for (int e = 0; e < 16; ++e) { sm += ov[e]; const float kp = kv[e] * (1.f + (sigmoidf_(a0p[c0 + e] + av[e]) - 1.f) * k_a[c0 + e]); rk += rv[e] * kp * r_k[c0 + e]; }
        sm += shx(sm, 1, lane); sm += shx(sm, 2, lane); rk += shx(rk, 1, lane); rk += shx(rk, 2, lane);
        const float mean = sm * (1.f / 64.f);
        float vs = 0.f;
#pragma unroll
        for (int e = 0; e < 16; ++e) { const float d = ov[e] - mean; vs += d * d; }
        vs += shx(vs, 1, lane); vs += shx(vs, 2, lane);
        const float rstd = __builtin_amdgcn_rsqf(vs * (1.f / 64.f) + GN_EPS);
        unsigned w[8];
#pragma unroll
        for (int e = 0; e < 16; e += 2) {
            const float y0 = ((ov[e] - mean) * rstd * gnw[c0 + e] + gnb[c0 + e] + rk * vv[e]) * gv[e];
            const float y1 = ((ov[e + 1] - mean) * rstd * gnw[c0 + e + 1] + gnb[c0 + e + 1] + rk * vv[e + 1]) * gv[e + 1];
            w[e >> 1] = cvt_pk(y0, y1);
        }
        *(u32x4*)(OG + o) = (u32x4){w[0], w[1], w[2], w[3]}; *(u32x4*)(OG + o + 8) = (u32x4){w[4], w[5], w[6], w[7]};
    }
}

__device__ __forceinline__ int crow(int r, int hi) { return (r & 3) + 8 * (r >> 2) + 4 * hi; }
__device__ __forceinline__ bf16x8 pack8(f32x4 a, f32x4 b) {
    u32x4 w; w.x = cvt_pk(a[0], a[1]); w.y = cvt_pk(a[2], a[3]); w.z = cvt_pk(b[0], b[1]); w.w = cvt_pk(b[2], b[3]);
    return __builtin_bit_cast(bf16x8, w);
}
__device__ __forceinline__ void attn_phase(KP p, int tid, int bid, int G) {
    const int lane = tid & 63, gw = bid * 8 + (tid >> 6), nw = G * 8;
    const bf16_t* QB = (const bf16_t*)(p->ws + W_QB); bf16_t* AO = (bf16_t*)(p->ws + W_OG);
    const int ql = lane & 31, hi = lane >> 5;
    constexpr int NU_P = BP * NH * 65;
    for (int u = gw; u < NU_P + BS * NH * 2; u += nw) {
        int bh, Q0, nq, npast, row_base, Tn; const float *kc, *vc, *kn, *vn;
        if (u < NU_P) { bh = u / 65; Q0 = (u - bh * 65) * 32; nq = min(32, TP - Q0); npast = 0; row_base = (bh >> 4) * TP; Tn = TP;
            kc = nullptr; vc = nullptr; kn = p->out + O_KP + (size_t)bh * TP * HD; vn = p->out + O_VP + (size_t)bh * TP * HD; }
        else { const int v = u - NU_P; bh = v >> 1; Q0 = (v & 1) * 32; nq = 32; npast = PAST; row_base = MPR + (bh >> 4) * TS; Tn = TS;
            kc = p->in[4] + (size_t)bh * PAST * HD; vc = p->in[5] + (size_t)bh * PAST * HD; kn = p->out + O_KS + (size_t)bh * TS * HD; vn = p->out + O_VS + (size_t)bh * TS * HD; }
        const int h = bh & 15, qpos0 = npast + Q0;
        bf16x8 qf[4];
        { const bf16_t* qp = QB + (size_t)(row_base + Q0 + min(ql, nq - 1)) * D + h * 64 + hi * 8;
#pragma unroll
          for (int s = 0; s < 4; ++s) qf[s] = *(const bf16x8*)(qp + 16 * s); }
        f32x16 o0, o1;
#pragma unroll
        for (int r = 0; r < 16; ++r) { o0[r] = 0.f; o1[r] = 0.f; }
        float carry = ql < nq ? 0.f : -1e30f;
        const int qpos = qpos0 + ql;
        f32x4 kc4[8];
#define ATT_TILE_PTRS(P0_, kb_, vb_, lim_) const bool inpast_ = (P0_) < npast; \
            const float* kb_ = inpast_ ? kc + (size_t)(P0_) * HD : kn + (size_t)((P0_) - npast) * HD; \
            const float* vb_ = inpast_ ? vc + (size_t)(P0_) * HD : vn + (size_t)((P0_) - npast) * HD; \
            const int lim_ = inpast_ ? 31 : min(31, Tn - 1 - ((P0_) - npast));
        { ATT_TILE_PTRS((qpos0 >> 5) * 32, kb0, vb0, lim0); (void)vb0;
          const float* kp = kb0 + (size_t)min(ql, lim0) * HD + hi * 8;
#pragma unroll
          for (int s = 0; s < 4; ++s) { kc4[2 * s] = *(const f32x4*)(kp + 16 * s); kc4[2 * s + 1] = *(const f32x4*)(kp + 16 * s + 4); } }
        for (int kt = qpos0 >> 5; kt >= 0; --kt) {
            const int P0 = kt * 32;
            ATT_TILE_PTRS(P0, kb, vb, lim); (void)kb;
            float x0[16], x1[16];
#pragma unroll
            for (int r = 0; r < 16; ++r) { const float* vp = vb + (size_t)min(crow(r, hi), lim) * HD + ql; x0[r] = vp[0]; x1[r] = vp[32]; }
            f32x4 kn4[8];
            { const int Pn = kt > 0 ? P0 - 32 : P0; ATT_TILE_PTRS(Pn, kbn, vbn, limn); (void)vbn;
              const float* kp = kbn + (size_t)min(ql, limn) * HD + hi * 8;
#pragma unroll
              for (int s = 0; s < 4; ++s) { kn4[2 * s] = *(const f32x4*)(kp + 16 * s); kn4[2 * s + 1] = *(const f32x4*)(kp + 16 * s + 4); } }
            f32x16 st;
#pragma unroll
            for (int r = 0; r < 16; ++r) st[r] = 0.f;
#pragma unroll
            for (int s = 0; s < 4; ++s) st = __builtin_amdgcn_mfma_f32_32x32x16_bf16(pack8(kc4[2 * s], kc4[2 * s + 1]), qf[s], st, 0, 0, 0);
            float L[16];
            float own[4];
#pragma unroll
            for (int g = 0; g < 4; ++g) { float sg = 0.f;
#pragma unroll
                for (int i = 0; i < 4; ++i) { const int r = 4 * g + i; const bool vis = (P0 + crow(r, hi)) < qpos; L[r] = vis ? -softplusf_(st[r]) : 0.f; sg += L[r]; }
                own[g] = sg; }
            float oth[4];
#pragma unroll
            for (int g = 0; g < 4; ++g) oth[g] = shx(own[g], 32, lane);
            float suf = carry;
            float A[16];
#pragma unroll
            for (int g = 3; g >= 0; --g) {
                float c = suf + (hi == 0 ? oth[g] : 0.f);
#pragma unroll
                for (int i = 3; i >= 0; --i) { const int r = 4 * g + i; c += L[r]; const bool vis = (P0 + crow(r, hi)) < qpos; A[r] = vis ? __expf(st[r] + c) : 0.f; }
                suf += own[g] + oth[g];
            }
            carry = suf;
            const bf16x8 pa0 = pack8((f32x4){A[0], A[1], A[2], A[3]}, (f32x4){A[4], A[5], A[6], A[7]});
            const bf16x8 pa1 = pack8((f32x4){A[8], A[9], A[10], A[11]}, (f32x4){A[12], A[13], A[14], A[15]});
            o0 = __builtin_amdgcn_mfma_f32_32x32x16_bf16(pa0, pack8((f32x4){x0[0], x0[1], x0[2], x0[3]}, (f32x4){x0[4], x0[5], x0[6], x0[7]}), o0, 0, 0, 0);
            o1 = __builtin_amdgcn_mfma_f32_32x32x16_bf16(pa0, pack8((f32x4){x1[0], x1[1], x1[2], x1[3]}, (f32x4){x1[4], x1[5], x1[6], x1[7]}), o1, 0, 0, 0);
            o0 = __builtin_amdgcn_mfma_f32_32x32x16_bf16(pa1, pack8((f32x4){x0[8], x0[9], x0[10], x0[11]}, (f32x4){x0[12], x0[13], x0[14], x0[15]}), o0, 0, 0, 0);
            o1 = __builtin_amdgcn_mfma_f32_32x32x16_bf16(pa1, pack8((f32x4){x1[8], x1[9], x1[10], x1[11]}, (f32x4){x1[12], x1[13], x1[14], x1[15]}), o1, 0, 0, 0);
#pragma unroll
            for (int e = 0; e < 8; ++e) kc4[e] = kn4[e];
            if (!__any(carry >= -104.f)) break;
        }
#undef ATT_TILE_PTRS
        bf16_t* op = AO + (size_t)(row_base + Q0) * D + h * 64 + ql;
#pragma unroll
        for (int r = 0; r < 16; ++r) { const int qr = crow(r, hi); if (qr < nq) { op[(size_t)qr * D] = (bf16_t)(cvt_pk(o0[r], 0.f) & 0xffffu); op[(size_t)qr * D + 32] = (bf16_t)(cvt_pk(o1[r], 0.f) & 0xffffu); } }
    }
}

#define XB_TMO      128
#define XB_XCNT(j)  (256  + 64 * (j))
#define XB_XSUB(j)  (1280 + 64 * (j))
#define XB_XGEN(j)  (2304 + 64 * (j))
#define XB_TOP      3328
#define XB_TOPGEN   3392
#define XCD_BAR_WORDS 3456
#define XB_SPIN_CAP (1u << 18)

__device__ __forceinline__ unsigned xb_ld(unsigned* p)              { return __hip_atomic_load(p, __ATOMIC_RELAXED, __HIP_MEMORY_SCOPE_AGENT); }
__device__ __forceinline__ unsigned xb_add(unsigned* p, unsigned v) { return __hip_atomic_fetch_add(p, v, __ATOMIC_RELAXED, __HIP_MEMORY_SCOPE_AGENT); }
__device__ __forceinline__ unsigned xb_xcc_id() { return (unsigned)__builtin_amdgcn_s_getreg((3 << 11) | 20) & 0xFu; }
#define XB_SPIN(cond, bar) do { unsigned _sp = 0; while (cond) { __builtin_amdgcn_s_sleep(1); \
    if ((++_sp & 255u) == 0u) { if (xb_ld(&(bar)[XB_TMO])) break; if (_sp > XB_SPIN_CAP) { atomicAdd(&(bar)[XB_TMO], 1u); break; } } } } while (0)

struct XcdBarrier {
    unsigned* bar; unsigned x;
    volatile LAS unsigned* st;
};

__device__ __forceinline__ XcdBarrier xcd_barrier_post(unsigned* bar, volatile LAS unsigned* st, bool xb_tid0) {
    XcdBarrier b; b.bar = bar; b.x = xb_xcc_id(); b.st = st;
    if (xb_tid0) (void)xb_add(&bar[XB_XCNT(b.x)], 1u);
    return b;
}
__device__ __forceinline__ void xcd_barrier_complete(unsigned* bar, unsigned x, unsigned& nloc, unsigned& nx) {
    const unsigned G = gridDim.x * gridDim.y * gridDim.z;
    unsigned sum, cnt, mine, sp = 0u;
    for (;;) {
        sum = 0u; cnt = 0u; mine = 0u;
#pragma unroll
        for (unsigned j = 0; j < 16; ++j) { const unsigned c = xb_ld(&bar[XB_XCNT(j)]); sum += c; cnt += (c > 0u) ? 1u : 0u; mine = (j == x) ? c : mine; }
        if (sum == G) break;
        __builtin_amdgcn_s_sleep(1);
        if ((++sp & 255u) == 0u) { if (xb_ld(&bar[XB_TMO])) break; if (sp > XB_SPIN_CAP) { atomicAdd(&bar[XB_TMO], 1u); break; } }
    }
    nloc = mine > 0u ? mine : 1u; nx = cnt > 0u ? cnt : 1u;
}

__device__ __forceinline__ void xcd_barrier(const XcdBarrier& b, bool xb_tid0) {
    asm volatile("s_waitcnt vmcnt(0)" ::: "memory");
    __syncthreads();
    if (xb_tid0) {
        unsigned* bar = b.bar;
        __builtin_amdgcn_s_waitcnt(0);
        unsigned nloc = b.st[0], nx = b.st[1];
        if (nloc == 0u) { xcd_barrier_complete(bar, b.x, nloc, nx); b.st[0] = nloc; b.st[1] = nx; }
        const unsigned old = xb_add(&bar[XB_XSUB(b.x)], 1u);
        const unsigned gen = old / nloc;
        if (old + 1u == (gen + 1u) * nloc) {
            __builtin_amdgcn_fence(__ATOMIC_RELEASE, "agent");
            asm volatile("s_waitcnt vmcnt(0)" ::: "memory");
            const unsigned og = xb_add(&bar[XB_TOP], 1u);
            const unsigned tg = og / nx;
            if (og + 1u == (tg + 1u) * nx) xb_add(&bar[XB_TOPGEN], 1u);
            else XB_SPIN(xb_ld(&bar[XB_TOPGEN]) == tg, bar);
            __builtin_amdgcn_fence(__ATOMIC_ACQUIRE, "agent");
            xb_add(&bar[XB_XGEN(b.x)], 1u);
            asm volatile("s_waitcnt vmcnt(0)" ::: "memory");
        } else {
            XB_SPIN(xb_ld(&bar[XB_XGEN(b.x)]) == gen, bar);
            __builtin_amdgcn_fence(__ATOMIC_ACQUIRE, "agent");
            asm volatile("s_waitcnt vmcnt(0)" ::: "memory");
        }
    }
    __syncthreads();
}
constexpr int NPHASE = 23;
#ifndef PHM
#define PHM 0xffff
#endif
#define EN(k) (((PHM) >> (k)) & 1)
constexpr int LDS_BYTES = 131072 + 8 * 576 * 4;
template <class Epi, class Sched>
__device__ __forceinline__ void run_gemm(LAS unsigned char* lds, int wb, const bf16_t* A, const bf16_t* Bt, int M, int N, int K, const Sched& S, const Epi& E, float* skp = nullptr, unsigned* skf = nullptr) {
    pg8::Gemm g{A, Bt, M, N, K, wb, skp, skf};
    pg8::gemm_phase<Epi, Sched, true, true>(lds, g, S, E);
}
__global__ void __launch_bounds__(512, 2) mega(Params p_unused) {
    LAS unsigned char* lds = (LAS unsigned char*)lds_raw;
    cg::grid_group grid = cg::this_grid();
    KP p = (KP)__builtin_amdgcn_kernarg_segment_ptr();
    const int ph_lo = p->ph_lo, ph_hi = p->ph_hi;
    const int wb = __builtin_amdgcn_readfirstlane((int)threadIdx.x) & ~63;
    { LAS unsigned* stw = (LAS unsigned*)(lds + 131072); if ((int)threadIdx.x < 2) stw[threadIdx.x] = 0u; __syncthreads(); }
    const XcdBarrier xbar = xcd_barrier_post((unsigned*)(p->ws + W_BAR), (volatile LAS unsigned*)(lds + 131072), threadIdx.x == 0);
    for (int pi_ = ph_lo; pi_ < ph_hi; ++pi_) {
        asm volatile("" ::: "v1","v2","v3","v4","v5","v6","v7","v8","v9","v10","v11","v12","v13","v14","v15","v16","v17","v18","v19","v20","v21","v22","v23","v24","v25","v26","v27","v28","v29","v30","v31","v32","v33","v34","v35","v36","v37","v38","v39","v40","v41","v42","v43","v44","v45","v46","v47","v48","v49","v50","v51","v52","v53","v54","v55","v56","v57","v58","v59","v60","v61","v62","v63","v64","v65","v66","v67","v68","v69","v70","v71","v72","v73","v74","v75","v76","v77","v78","v79","v80","v81","v82","v83","v84","v85","v86","v87","v88","v89","v90","v91","v92","v93","v94","v95","v96","v97","v98","v99","v100","v101","v102","v103","v104","v105","v106","v107","v108","v109","v110","v111","v112","v113","v114","v115","v116","v117","v118","v119","v120","v121","v122","v123","v124","v125","v126","v127","v128","v129","v130","v131","v132","v133","v134","v135","v136","v137","v138","v139","v140","v141","v142","v143","v144","v145","v146","v147","v148","v149","v150","v151","v152","v153","v154","v155","v156","v157","v158","v159","v160","v161","v162","v163","v164","v165","v166","v167","v168","v169","v170","v171","v172","v173","v174","v175","v176","v177","v178","v179","v180","v181","v182","v183","v184","v185","v186","v187","v188","v189","v190","v191","v192","v193","v194","v195","v196","v197","v198","v199","v200","v201","v202","v203","v204","v205","v206","v207","v208","v209","v210","v211","v212","v213","v214","v215","v216","v217","v218","v219","v220","v221","v222","v223","v224","v225","v226","v227","v228","v229","v230","v231","v232","v233","v234","v235","v236","v237","v238","v239","v240","v241","v242","v243","v244","v245","v246","v247","v248","v249");
        asm volatile("" : "+s"(p));
        const int phc = p->seq[pi_], ph = phc & 63; const bool dry = (phc & 64) != 0;
        int bid = blockIdx.x, G = gridDim.x;
        asm volatile("" : "+s"(bid), "+s"(G));
#define TID_HERE (wb + lane_now())
        int ffn = -1; bool ffn_in = false;
        if (ph == 1 || ph == 2) { ffn = 0; ffn_in = ph == 1; } else if (ph == 11 || ph == 12) { ffn = 1; ffn_in = ph == 11; }
        else if (ph == 14 || ph == 15) { ffn = 2; ffn_in = ph == 14; } else if (ph == 21 || ph == 22) { ffn = 3; ffn_in = ph == 21; }
        if (EN(0) && ph == 0) { { const int tid = TID_HERE; convert_weights(p, (LAS float*)lds, tid, bid, G); assemble_x(p, tid, bid, G); } }
        else if (EN(1) && ffn >= 0 && ffn_in) {
            pg8::StaticOrder S; S.init(MP, NIN, G, bid); S.nt0 = D / 64;
            unsigned char* ws = p->ws; EpiSwiGLU E{(bf16_t*)(ws + W_HB), (const float*)(ws + W_RSQ) + (size_t)(ffn == 0 ? 0 : (ffn == 1 ? 1 : (ffn == 2 ? 2 : 4))) * MP};
            run_gemm(lds, wb, (const bf16_t*)(ws + W_XN), (const bf16_t*)(ws + W_WIN + ffn * SZ_WIN1), MP, NIN, D, S, E);
        } else if (EN(2) && ffn >= 0) {
            pg8::StaticOrder S; S.init(MP, D, G, bid); S.nt0 = DFFP / 64;
            unsigned char* ws = p->ws; const bool fold = (ffn == 1 || ffn == 2) && !dry;
            EpiRes E{(float*)(ws + W_X), dry ? 0.f : 0.5f, (ffn == 3 && !dry) ? p->out : nullptr, fold ? (bf16_t*)(ws + W_XN) : nullptr, (float*)(ws + W_RSQ) + (size_t)(ffn == 1 ? 2 : 3) * MP};
            run_gemm(lds, wb, (const bf16_t*)(ws + W_HB), (const bf16_t*)(ws + W_WOUT + ffn * SZ_WOUT1), MP, D, DFFP, S, E, (float*)(ws + W_SKP), (unsigned*)(ws + W_SKF) + pi_ * 1024);
        }
        else if (EN(3) && ph == 3) mixprep_phase(p, TID_HERE, bid, G);
        else if (EN(4) && ph == 4) {
            G1Order S{G, bid};
            unsigned char* ws = p->ws; EpiG1 E{(bf16_t*)(ws + W_RKV), (float*)(ws + W_L1)};
            run_gemm(lds, wb, (const bf16_t*)(ws + W_AALL), (const bf16_t*)(ws + W_WG1), 5 * MP, 3584, D, S, E);
        }
        else if (EN(5) && ph == 5) act_phase(p, bid * 512 + TID_HERE, G * 512);
        else if (EN(6) && ph == 6) {
            pg8::StaticOrder S; S.init(MP, 3072, G, bid); S.nt0 = 4;
            unsigned char* ws = p->ws; EpiG2 E{(bf16_t*)(ws + W_DEC)};
            run_gemm(lds, wb, (const bf16_t*)(ws + W_A2), (const bf16_t*)(ws + W_WL2), MP, 3072, 256, S, E);
        }
        else if (EN(7) && ph == 7) scan_phase(p, (LAS float*)lds, TID_HERE, bid, G);
        else if (EN(8) && ph == 8) post_phase(p, TID_HERE, bid, G);
        else if (EN(9) && (ph == 9 || ph == 19)) {
            pg8::StaticOrder S; S.init(MP, D, G, bid); S.nt0 = D / 64;
            unsigned char* ws = p->ws; EpiRes E{(float*)(ws + W_X), dry ? 0.f : 1.0f, nullptr, dry ? nullptr : (bf16_t*)(ws + W_XN), (float*)(ws + W_RSQ) + (size_t)(ph == 9 ? 1 : 4) * MP};
            run_gemm(lds, wb, (const bf16_t*)(ws + W_OG), (const bf16_t*)(ws + (ph == 9 ? W_WO1 : W_WO2)), MP, D, D, S, E, (float*)(ws + W_SKP), (unsigned*)(ws + W_SKF) + pi_ * 1024);
        }
        else if (EN(11) && ph == 17) {
            pg8::StaticOrder S; S.init(MP, 3 * D, G, bid); S.nt0 = D / 64;
            unsigned char* ws = p->ws; EpiQKV E{(bf16_t*)(ws + W_QB), p->out, p->in[28], p->in[29], (const float*)(ws + W_RSQ) + (size_t)3 * MP};
            run_gemm(lds, wb, (const bf16_t*)(ws + W_XN), (const bf16_t*)(ws + W_WQKV), MP, 3 * D, D, S, E);
        }
        else if (EN(12) && ph == 18) attn_phase(p, TID_HERE, bid, G);
        if (pi_ + 1 < ph_hi) { if (pi_ == ph_lo) grid.sync(); else xcd_barrier(xbar, (wb + lane_now()) == 0); }
    }
}

#ifndef ONE_LAUNCH
#define ONE_LAUNCH 1
#endif
extern "C" void kernel_launch(void* const* d_in, const int* in_sizes, int n_in, void* d_out, int out_size, void* d_ws, size_t ws_size, hipStream_t stream) {
    static int grid = 0;
    if (grid == 0) {
        if (n_in != 31 || (size_t)out_size != O_END || ws_size < W_END) { fprintf(stderr, "kernel_launch: unexpected sizes (n_in %d out %d ws %zu need %zu)\n", n_in, out_size, ws_size, (size_t)W_END); grid = -1; return; }
        int dev = 0, cus = 0, per_cu = 0;
        hipGetDevice(&dev); hipDeviceGetAttribute(&cus, hipDeviceAttributeMultiprocessorCount, dev);
        if (hipFuncSetAttribute((const void*)mega, hipFuncAttributeMaxDynamicSharedMemorySize, LDS_BYTES) != hipSuccess) { fprintf(stderr, "kernel_launch: hipFuncSetAttribute failed\n"); grid = -1; return; }
        hipOccupancyMaxActiveBlocksPerMultiprocessor(&per_cu, (const void*)mega, 512, LDS_BYTES);
        (void)hipGetLastError();
        if (per_cu < 1) per_cu = 1;
        grid = cus * per_cu;
    }
    if (grid < 0) return;
    Params p{};
    for (int i = 0; i < 31; ++i) p.in[i] = (const float*)d_in[i];
    p.out = (float*)d_out; p.ws = (unsigned char*)d_ws;
    int nseq = 0;
    for (int ph = 0; ph < NPHASE; ++ph) {
        if (ph == 10 || ph == 13 || ph == 16 || ph == 20) continue;
        p.seq[nseq++] = ph;
#ifdef REP_OF
        for (int r = 0; r < (REP_OF(ph)); ++r) p.seq[nseq++] = (ph | ((ph == 2 || ph == 9) ? 64 : 0));
#endif
    }
#if ONE_LAUNCH
    (void)hipMemsetAsync((unsigned char*)d_ws + W_BAR, 0, 16384, stream);
    p.ph_lo = 0; p.ph_hi = nseq;
    void* args[] = {&p};
    hipError_t e = hipLaunchCooperativeKernel((const void*)mega, dim3(grid), dim3(512), args, LDS_BYTES, stream);
    if (e != hipSuccess) fprintf(stderr, "cooperative launch failed: %s (grid %d)\n", hipGetErrorString(e), grid);
#else
    for (int ph = 0; ph < nseq; ++ph) { p.ph_lo = ph; p.ph_hi = ph + 1; hipLaunchKernelGGL(mega, dim3(grid), dim3(512), LDS_BYTES, stream, p); }
#endif
}
```

```cpp
#include <hip/hip_runtime.h>
#include <hip/hip_cooperative_groups.h>
#include <cstdio>
#include <cstdint>
namespace cg = cooperative_groups;
__device__ __forceinline__ int lane_now() { int l; asm volatile("v_mbcnt_lo_u32_b32 %0, -1, 0\n\tv_mbcnt_hi_u32_b32 %0, -1, %0" : "=v"(l)); return l; }
namespace pg8 {
#define PG8_LAS __attribute__((address_space(3)))
typedef unsigned short bf16_t;
typedef short bf16x8 __attribute__((ext_vector_type(8)));
typedef float f32x4 __attribute__((ext_vector_type(4)));
typedef unsigned u32x4 __attribute__((ext_vector_type(4)));
constexpr int BM = 256, BK = 64, HALF = 128, HTB = HALF * BK * 2  , STAGE_BYTES = 8 * HTB, NXCD = 8, WGM = 8;

__host__ __device__ __forceinline__ int lds_byte(int r, int c) { const int st = (r >> 4) * 2 + (c >> 5), rr = r & 15, cc = c & 31, ob = rr * 64 + cc * 2; return st * 1024 + (ob ^ (((ob >> 9) & 1) << 5)); }
__host__ __device__ __forceinline__ void stage_rc(int b, int& R, int& C) { const int st = b / 1024, sb = b % 1024, swz = sb ^ (((sb >> 9) & 1) << 5); R = (st >> 1) * 16 + swz / 64; C = (st & 1) * 32 + (swz % 64) / 2; }
__host__ __device__ __forceinline__ int perm32(int rho) { const int n = rho >> 4, i = rho & 15; return 8 * (i >> 2) + 4 * n + (i & 3); }

struct Unit { int pm, pn, kb, nt, fl, tl; };
struct Gemm { const bf16_t* A; const bf16_t* Bt; int M, N, K, wb; float* skp; unsigned* skf; };

struct StaticOrder {
    static constexpr bool STREAM = false; int nM, nN, nwg, G, c, nt0;
    __host__ __device__ void init(int M, int N, int G_, int c_) { nM = M / BM; nN = N / BM; nwg = nM * nN; G = G_; c = c_; }
    __host__ __device__ bool next(int i, Unit& u) const {
        const long L = (long)i * G + c; if (L >= nwg) return false;
        int wgid = (int)L; { const int q = nwg / NXCD, r = nwg % NXCD, xcd = wgid % NXCD, off = wgid / NXCD; wgid = (xcd < r ? xcd * (q + 1) : r * (q + 1) + (xcd - r) * q) + off; }
        const int nig = WGM * nN, gid = wgid / nig, fm = gid * WGM, gsz = (nM - fm) < WGM ? (nM - fm) : WGM;
        u.pm = fm + ((wgid % nig) % gsz); u.pn = (wgid % nig) / gsz; u.kb = 0; u.nt = nt0; u.fl = 0; u.tl = 0; return true;
    }
    __device__ __forceinline__ void a_ready(const Unit&) const {}
    __device__ __forceinline__ void done(const Unit&) const {}
};
typedef __attribute__((address_space(1))) f32x4 gf32x4;
typedef unsigned long long u64_t;
__device__ __forceinline__ void streamk_store(const f32x4 (&acc)[2][2][4][2], const Unit& u, float* skp, unsigned* skf, int tid) {
    u64_t* q = (u64_t*)(skp + (size_t)u.tl * 65536) + 2 * tid;
#pragma unroll
    for (int a = 0; a < 2; ++a)
#pragma unroll
        for (int b = 0; b < 2; ++b)
#pragma unroll
            for (int m = 0; m < 4; ++m)
#pragma unroll
                for (int n = 0; n < 2; ++n) { const f32x4 v = acc[a][b][m][n];
                    __hip_atomic_store(q, ((u64_t)__float_as_uint(v[1]) << 32) | __float_as_uint(v[0]), __ATOMIC_RELAXED, __HIP_MEMORY_SCOPE_AGENT);
                    __hip_atomic_store(q + 1, ((u64_t)__float_as_uint(v[3]) << 32) | __float_as_uint(v[2]), __ATOMIC_RELAXED, __HIP_MEMORY_SCOPE_AGENT);
                    q += 1024; asm volatile("" : "+v"(q) :: "memory"); }
    asm volatile("s_waitcnt vmcnt(0)" ::: "memory");
    __builtin_amdgcn_s_barrier();
    if (tid == 0) __hip_atomic_store(skf + u.tl, 1u, __ATOMIC_RELAXED, __HIP_MEMORY_SCOPE_AGENT);
}
__device__ __forceinline__ const float* streamk_wait(const Unit& u, float* skp, unsigned* skf, int tid) {
    if (u.fl == 2) {
        if (tid == 0) { while (__hip_atomic_load(skf + u.tl, __ATOMIC_RELAXED, __HIP_MEMORY_SCOPE_AGENT) == 0u) __builtin_amdgcn_s_sleep(2); }
        __builtin_amdgcn_s_barrier();
        __builtin_amdgcn_fence(__ATOMIC_ACQUIRE, "agent");
    } else __builtin_amdgcn_s_barrier();
    return skp + (size_t)u.tl * 65536;
}
__device__ __forceinline__ f32x4 streamk_part(const float* part, int idx, int tid) {
    const u64_t* q = (const u64_t*)part + (size_t)idx * 1024 + 2 * tid;
    const u64_t a = __hip_atomic_load(q, __ATOMIC_RELAXED, __HIP_MEMORY_SCOPE_AGENT), b = __hip_atomic_load(q + 1, __ATOMIC_RELAXED, __HIP_MEMORY_SCOPE_AGENT);
    return (f32x4){__uint_as_float((unsigned)a), __uint_as_float((unsigned)(a >> 32)), __uint_as_float((unsigned)b), __uint_as_float((unsigned)(b >> 32))};
}
template <class Epi, class Sched, bool ALIGN_EPI = false, bool SP2 = false>
__device__ __forceinline__ void gemm_phase(PG8_LAS unsigned char* lds, const Gemm g, const Sched& S, const Epi& E) {
    int tid = g.wb + lane_now(); asm volatile("" : "+v"(tid)); const int wid = __builtin_amdgcn_readfirstlane(tid >> 6), lane = tid & 63, wr = wid >> 2, wc = wid & 3, fr = lane & 15, fq = lane >> 4;
    const int K = g.K, nt = K / BK;
    unsigned voffA[2], voffB[2];
#pragma unroll
    for (int i = 0; i < 2; ++i) { int R, C; stage_rc(tid * 16 + i * 8192, R, C); const int Rb = Epi::PERM ? ((R & ~31) + perm32(R & 31)) : R;
        voffA[i] = (unsigned)(R * K + C) * 2u; voffB[i] = (unsigned)(Rb * K + C) * 2u; }
    const size_t kstep = (size_t)(BK * 2);
    const size_t hstep = (size_t)HALF * K * 2;
    const size_t tstep = 2 * hstep;
    const unsigned ldsw = (unsigned)wid * 1024u;
    const int aoff = lds_byte(wr * 64 + fr, fq * 8), boff = lds_byte(wc * 32 + fr, fq * 8);
#define PG8_SA(b, h) (((b) * 2 + (h)) * HTB)
#define PG8_SB(b, h) ((4 + (b) * 2 + (h)) * HTB)
#define PG8_STAGE(bufoff, gbase, voff) do { _Pragma("unroll") for (int _i = 0; _i < 2; ++_i) \
        __builtin_amdgcn_global_load_lds((const unsigned*)((const char*)(gbase) + (voff)[_i]), (PG8_LAS unsigned*)(lds + (bufoff) + ldsw + _i * 8192), 16, 0, 0); } while (0)
#define PG8_LDA(dst, b, h) do { _Pragma("unroll") for (int m = 0; m < 4; ++m) _Pragma("unroll") for (int k = 0; k < 2; ++k) dst[m][k] = *(const PG8_LAS bf16x8*)(lds + PG8_SA(b, h) + aoff + m * 2048 + k * 1024); } while (0)
#define PG8_LDB(dst, b, h) do { _Pragma("unroll") for (int n = 0; n < 2; ++n) _Pragma("unroll") for (int k = 0; k < 2; ++k) dst[n][k] = *(const PG8_LAS bf16x8*)(lds + PG8_SB(b, h) + boff + n * 2048 + k * 1024); } while (0)
#define PG8_MMA(ai, bj, At, Bt) do { __builtin_amdgcn_s_setprio(1); _Pragma("unroll") for (int m = 0; m < 4; ++m) _Pragma("unroll") for (int n = 0; n < 2; ++n) _Pragma("unroll") for (int k = 0; k < 2; ++k) \
        acc[ai][bj][m][n] = __builtin_amdgcn_mfma_f32_16x16x32_bf16(Bt[n][k], At[m][k], acc[ai][bj][m][n], 0, 0, 0); __builtin_amdgcn_s_setprio(0); } while (0)
#define PG8_WAIT_V(n) asm volatile("s_waitcnt vmcnt(" #n ")" ::: "memory")
#define PG8_WAIT_L(n) asm volatile("s_waitcnt lgkmcnt(" #n ")" ::: "memory")
#define PG8_BAR __builtin_amdgcn_s_barrier()
#define PG8_SCHED __builtin_amdgcn_sched_barrier(0)
    Unit cur, nxt; int ui = 0;
    if (!S.next(0, cur)) return;
    f32x4 acc[2][2][4][2];
#pragma unroll
    for (int a = 0; a < 2; ++a)
#pragma unroll
        for (int b = 0; b < 2; ++b)
#pragma unroll
            for (int m = 0; m < 4; ++m)
#pragma unroll
                for (int n = 0; n < 2; ++n) acc[a][b][m][n] = (f32x4){0.f, 0.f, 0.f, 0.f};
    bf16x8 At[4][2], B0[2][2], B1[2][2];
    const char* cA = (const char*)g.A + (size_t)cur.pm * tstep + cur.kb; const char* cB = (const char*)g.Bt + (size_t)cur.pn * tstep + cur.kb;
    S.a_ready(cur);
    if constexpr (SP2) {
        PG8_STAGE(PG8_SB(0, 0), cB, voffB); PG8_STAGE(PG8_SB(0, 1), cB + hstep, voffB); PG8_STAGE(PG8_SA(0, 0), cA, voffA); PG8_STAGE(PG8_SA(0, 1), cA + hstep, voffA);
        if (wr == 1) PG8_BAR;
        PG8_WAIT_V(2); PG8_BAR;
        PG8_STAGE(PG8_SB(1, 0), cB + kstep, voffB); PG8_STAGE(PG8_SA(1, 0), cA + kstep, voffA); PG8_STAGE(PG8_SB(1, 1), cB + hstep + kstep, voffB);
        PG8_WAIT_V(6); PG8_BAR;
    } else {
        PG8_STAGE(PG8_SB(0, 0), cB, voffB); PG8_STAGE(PG8_SA(0, 0), cA, voffA); PG8_STAGE(PG8_SB(0, 1), cB + hstep, voffB); PG8_STAGE(PG8_SA(0, 1), cA + hstep, voffA);
        if (wr == 1) PG8_BAR;
        PG8_WAIT_V(4); PG8_BAR;
        PG8_STAGE(PG8_SB(1, 0), cB + kstep, voffB); PG8_STAGE(PG8_SA(1, 0), cA + kstep, voffA); PG8_STAGE(PG8_SB(1, 1), cB + hstep + kstep, voffB);
        PG8_WAIT_V(6); PG8_BAR;
    }
    for (;;) {
        const bool has_next = S.next(ui + 1, nxt);
        const char* nA = has_next ? (const char*)g.A + (size_t)nxt.pm * tstep + nxt.kb : cA; const char* nB = has_next ? (const char*)g.Bt + (size_t)nxt.pn * tstep + nxt.kb : cB;
        const int ntu = cur.nt;
        for (int t = 0; t < ntu; t += 2) {
            const bool last = (t == ntu - 2);
            const char* a1 = cA + (size_t)(t + 1) * kstep;
            const char* a2 = last ? nA : cA + (size_t)(t + 2) * kstep; const char* b2 = last ? nB : cB + (size_t)(t + 2) * kstep;
            const char* a3 = a2 + kstep; const char* b3 = b2 + kstep;
            if (last && has_next) S.a_ready(nxt);
            if constexpr (SP2) {
            PG8_LDB(B0, 0, 0); PG8_LDB(B1, 0, 1); PG8_SCHED; PG8_LDA(At, 0, 0); PG8_STAGE(PG8_SA(1, 1), a1 + hstep, voffA);
            PG8_WAIT_V(8); PG8_WAIT_L(0); PG8_BAR; PG8_MMA(0, 0, At, B0); PG8_MMA(0, 1, At, B1); PG8_BAR; PG8_SCHED;
            PG8_LDA(At, 0, 1); PG8_STAGE(PG8_SB(0, 0), b2, voffB); PG8_STAGE(PG8_SB(0, 1), b2 + hstep, voffB); PG8_STAGE(PG8_SA(0, 0), a2, voffA);
            PG8_WAIT_V(8); PG8_WAIT_L(0); PG8_BAR; PG8_MMA(1, 0, At, B0); PG8_MMA(1, 1, At, B1); PG8_BAR; PG8_SCHED;
            PG8_LDB(B0, 1, 0); PG8_LDB(B1, 1, 1); PG8_SCHED; PG8_LDA(At, 1, 0); PG8_STAGE(PG8_SA(0, 1), a2 + hstep, voffA);
            PG8_WAIT_V(8); PG8_WAIT_L(0); PG8_BAR; PG8_MMA(0, 0, At, B0); PG8_MMA(0, 1, At, B1); PG8_BAR; PG8_SCHED;
            PG8_LDA(At, 1, 1); PG8_STAGE(PG8_SB(1, 0), b3, voffB); PG8_STAGE(PG8_SB(1, 1), b3 + hstep, voffB); PG8_STAGE(PG8_SA(1, 0), a3, voffA);
            PG8_WAIT_V(8); PG8_WAIT_L(0); PG8_BAR; PG8_MMA(1, 0, At, B0); PG8_MMA(1, 1, At, B1); PG8_BAR; PG8_SCHED;
            } else {
            PG8_LDB(B0, 0, 0); PG8_SCHED; PG8_LDA(At, 0, 0); PG8_STAGE(PG8_SA(1, 1), a1 + hstep, voffA);
            PG8_WAIT_L(8); PG8_BAR; PG8_WAIT_L(0); PG8_MMA(0, 0, At, B0); PG8_BAR; PG8_SCHED;
            PG8_LDB(B1, 0, 1); PG8_STAGE(PG8_SB(0, 0), b2, voffB);
            PG8_BAR; PG8_WAIT_L(0); PG8_MMA(0, 1, At, B1); PG8_BAR;
            PG8_LDA(At, 0, 1); PG8_STAGE(PG8_SA(0, 0), a2, voffA);
            PG8_BAR; PG8_WAIT_L(0); PG8_MMA(1, 0, At, B0); PG8_BAR; PG8_SCHED;
            PG8_STAGE(PG8_SB(0, 1), b2 + hstep, voffB);
            PG8_WAIT_V(6); PG8_BAR; PG8_MMA(1, 1, At, B1); PG8_BAR;
            PG8_LDB(B0, 1, 0); PG8_SCHED; PG8_LDA(At, 1, 0); PG8_STAGE(PG8_SA(0, 1), a2 + hstep, voffA);
            PG8_WAIT_L(8); PG8_BAR; PG8_WAIT_L(0); PG8_MMA(0, 0, At, B0); PG8_BAR; PG8_SCHED;
            PG8_LDB(B1, 1, 1); PG8_STAGE(PG8_SB(1, 0), b3, voffB);
            PG8_BAR; PG8_WAIT_L(0); PG8_MMA(0, 1, At, B1); PG8_BAR;
            PG8_LDA(At, 1, 1); PG8_STAGE(PG8_SA(1, 0), a3, voffA);
            PG8_BAR; PG8_WAIT_L(0); PG8_MMA(1, 0, At, B0); PG8_BAR; PG8_SCHED;
            PG8_STAGE(PG8_SB(1, 1), b3 + hstep, voffB);
            PG8_WAIT_V(6); PG8_BAR; PG8_MMA(1, 1, At, B1); PG8_BAR;
            }
        }
        if constexpr (ALIGN_EPI) { if (wr == 0) PG8_BAR; }
        if constexpr (!Epi::AFTER_DRAIN) { int t_ = g.wb + lane_now(); asm volatile("" : "+v"(t_)); const int fr_ = t_ & 15, fq_ = (t_ >> 4) & 3; if constexpr (!Sched::STREAM) E(acc, cur, wr, wc, fr_, fq_); else { if (cur.fl == 1) streamk_store(acc, cur, g.skp, g.skf, t_); else { const float* part_ = streamk_wait(cur, g.skp, g.skf, t_); int t2_ = g.wb + lane_now(); asm volatile("" : "+v"(t2_)); E(acc, cur, wr, wc, t2_ & 15, (t2_ >> 4) & 3, part_, t2_); } } S.done(cur); }
        if (!has_next) break;
#pragma unroll
        for (int a = 0; a < 2; ++a)
#pragma unroll
            for (int b = 0; b < 2; ++b)
#pragma unroll
                for (int m = 0; m < 4; ++m)
#pragma unroll
                    for (int n = 0; n < 2; ++n) acc[a][b][m][n] = (f32x4){0.f, 0.f, 0.f, 0.f};
        cur = nxt; cA = nA; cB = nB; ++ui;
        if constexpr (ALIGN_EPI) { if (wr == 1) PG8_BAR; }
    }
    PG8_WAIT_V(0);
    if constexpr (!ALIGN_EPI) { if (wr == 0) PG8_BAR; }
    PG8_BAR;
    if constexpr (Epi::AFTER_DRAIN) { E.fused(acc, cur, wr, wc, fr, fq, lds, wid, lane); S.done(cur); }
#undef PG8_SA
#undef PG8_SB
#undef PG8_STAGE
#undef PG8_LDA
#undef PG8_LDB
#undef PG8_MMA
#undef PG8_WAIT_V
#undef PG8_WAIT_L
#undef PG8_BAR
#undef PG8_SCHED
}
}

#define LAS __attribute__((address_space(3)))
typedef unsigned short bf16_t;
typedef short bf16x8 __attribute__((ext_vector_type(8)));
typedef float f32x4 __attribute__((ext_vector_type(4)));
typedef float f32x2 __attribute__((ext_vector_type(2)));
typedef float f32x16 __attribute__((ext_vector_type(16)));
typedef unsigned u32x4 __attribute__((ext_vector_type(4)));
typedef unsigned u32x2 __attribute__((ext_vector_type(2)));

constexpr int D = 1024, NH = 16, HD = 64;
constexpr int BP = 8, TP = 2064, SEQP = 2048, NMETA = 16, BS = 16, TS = 64, PAST = 4096;
constexpr int MPR = BP * TP;
constexpr int MR = MPR + BS * TS;
constexpr int MP = 17664;
constexpr int NTM = 69;
constexpr int DFF = 2752, DFFP = 2816, NIN = 5632;
constexpr float RMS_EPS = 1e-6f, GN_EPS = 64e-5f;
constexpr float LOG2E = 1.4426950408889634f;

constexpr size_t O_YP = 0, O_YS = 16777216, O_SP = 17825792, O_SHP = 18350080, O_KP = 18358272, O_VP = 35266560,
                 O_SS = 52174848, O_SHS = 53223424, O_KS = 53239808, O_VS = 54288384, O_END = 55336960;

constexpr size_t SZ_ROWBF = (size_t)MP * D * 2, SZ_ROWF = (size_t)MP * D * 4;
constexpr size_t W_X = 0;
constexpr size_t W_XN = W_X + SZ_ROWF;
constexpr size_t W_HB = W_XN + SZ_ROWBF;
constexpr size_t W_WIN = W_HB + (size_t)MP * DFFP * 2;
constexpr size_t SZ_WIN1 = (size_t)NIN * D * 2, SZ_WOUT1 = (size_t)D * DFFP * 2;
constexpr size_t W_WOUT = W_WIN + 4 * SZ_WIN1;
constexpr size_t W_WG1 = W_WOUT + 4 * SZ_WOUT1;
constexpr size_t W_WL2 = W_WG1 + (size_t)3584 * D * 2;
constexpr size_t W_WO1 = W_WL2 + (size_t)3072 * 256 * 2;
constexpr size_t W_WQKV = W_WO1 + (size_t)D * D * 2;
constexpr size_t W_WO2 = W_WQKV + (size_t)3 * D * D * 2;
constexpr size_t W_AALL = W_WO2 + (size_t)D * D * 2;
constexpr size_t W_RKV = W_AALL + 5 * SZ_ROWBF;
constexpr size_t W_L1 = W_RKV + 3 * SZ_ROWBF;
constexpr size_t W_A2 = W_L1 + (size_t)2 * MP * 256 * 4;
constexpr size_t W_DEC = W_A2 + (size_t)MP * 256 * 2;
constexpr size_t W_AA = W_DEC + SZ_ROWBF;
constexpr size_t W_GG = W_AA + SZ_ROWBF;
constexpr size_t W_SO = W_GG + SZ_ROWBF;
constexpr size_t W_OG = W_SO + SZ_ROWF;
constexpr size_t W_QB = W_OG + SZ_ROWBF;
constexpr size_t W_RSQ = W_QB + SZ_ROWBF;
constexpr size_t W_SKF = W_RSQ + (size_t)5 * MP * 4;
constexpr size_t W_SKP = W_SKF + 64 * 1024 * 4;
constexpr size_t W_BAR = W_SKP + (size_t)277 * 262144;
constexpr size_t W_END = W_BAR + 16384;

struct Params { const float* in[31]; float* out; unsigned char* ws; int ph_lo, ph_hi; int seq[64]; };
typedef const Params __attribute__((address_space(4)))* KP;

__device__ __forceinline__ unsigned cvt_pk(float lo, float hi) { unsigned r; asm("v_cvt_pk_bf16_f32 %0, %1, %2" : "=v"(r) : "v"(lo), "v"(hi)); return r; }
__device__ __forceinline__ void store_bf4(bf16_t* p, f32x4 v) { u32x2 w; w.x = cvt_pk(v[0], v[1]); w.y = cvt_pk(v[2], v[3]); *(u32x2*)p = w; }
__device__ __forceinline__ float bf_lo(unsigned w) { return __uint_as_float(w << 16); }
__device__ __forceinline__ float bf_hi(unsigned w) { return __uint_as_float(w & 0xffff0000u); }
__device__ __forceinline__ float sigmoidf_(float x) { return __builtin_amdgcn_rcpf(1.f + __expf(-x)); }
__device__ __forceinline__ float softplusf_(float x) { return fmaxf(x, 0.f) + __logf(1.f + __expf(-fabsf(x))); }
__device__ __forceinline__ float shx(float v, int o, int lane) { return __builtin_bit_cast(float, __builtin_amdgcn_ds_bpermute((lane ^ o) << 2, __builtin_bit_cast(int, v))); }
__device__ __forceinline__ float wave_sum(float v, int lane) {
#pragma unroll
    for (int o = 1; o < 64; o <<= 1) v += shx(v, o, lane);
    return v;
}
__device__ __forceinline__ void row_bt(int row, int& grp, int& b, int& t) { if (row < MPR) { grp = 0; b = row / TP; t = row - b * TP; } else { grp = 1; const int r = row - MPR; b = r >> 6; t = r & 63; } }

using pg8::Unit;
extern __shared__ __attribute__((aligned(16))) unsigned char lds_raw[];
struct EpiSwiGLU {
    static constexpr bool PERM = true, AFTER_DRAIN = false;
    bf16_t* HB; const float* rsq;
    __device__ __forceinline__ void operator()(const f32x4 (&acc)[2][2][4][2], const Unit& u, int wr, int wc, int fr, int fq) const {
        const int row0 = u.pm * 256 + wr * 64 + fr, col0 = u.pn * 128 + wc * 32 + 8 * fq;
#pragma unroll
        for (int ai = 0; ai < 2; ++ai)
#pragma unroll
            for (int m = 0; m < 4; ++m) {
                bf16_t* rowp = HB + (size_t)(row0 + ai * 128 + m * 16) * DFFP + col0;
                const float rs = __builtin_amdgcn_rsqf(rsq[row0 + ai * 128 + m * 16] * (1.f / D) + RMS_EPS);
                float hv[8];
#pragma unroll
                for (int n = 0; n < 2; ++n)
#pragma unroll
                    for (int j = 0; j < 4; ++j) { const float g = acc[ai][0][m][n][j] * rs, up = acc[ai][1][m][n][j] * rs; hv[n * 4 + j] = g * sigmoidf_(g) * up; }
                u32x4 w; w.x = cvt_pk(hv[0], hv[1]); w.y = cvt_pk(hv[2], hv[3]); w.z = cvt_pk(hv[4], hv[5]); w.w = cvt_pk(hv[6], hv[7]);
                *(u32x4*)rowp = w;
            }
    }
};
struct EpiRes {
    static constexpr bool PERM = false, AFTER_DRAIN = false;
    float* X; float scale; float* out; bf16_t* XB; float* rsq; float* spl;
    __device__ __forceinline__ void operator()(const f32x4 (&acc)[2][2][4][2], const Unit& u, int wr, int wc, int fr, int fq, const float* part = nullptr, int tid = 0) const {
        const bool hasp = u.fl == 2;
        if (u.fl == 1 && spl != nullptr) {
            const int t_ = (wr * 4 + wc) * 64 + fq * 16 + fr;
            f32x4* q = (f32x4*)(spl + (size_t)u.tl * 65536) + t_;
#pragma unroll
            for (int ai = 0; ai < 2; ++ai)
#pragma unroll
                for (int bj = 0; bj < 2; ++bj)
#pragma unroll
                    for (int m = 0; m < 4; ++m)
#pragma unroll
                        for (int n = 0; n < 2; ++n) q[(((ai * 2 + bj) * 4 + m) * 2 + n) * 512] = acc[ai][bj][m][n];
            return;
        }
        float* const X_ = X; float* const out_ = out; bf16_t* const XB_ = XB; float* const rsq_ = rsq; const float sc_ = scale;
        const int row0 = u.pm * 256 + wr * 64 + fr, col0 = u.pn * 256 + wc * 32 + 4 * fq, ln = fq * 16 + fr;
#pragma unroll
        for (int ai = 0; ai < 2; ++ai)
#pragma unroll
            for (int m = 0; m < 4; ++m) {
                const int row = row0 + ai * 128 + m * 16;
                const unsigned off = (unsigned)row * D + col0;
                if (out_ == nullptr) {
                    float ss = 0.f;
#pragma unroll
                    for (int bj = 0; bj < 2; ++bj)
#pragma unroll
                        for (int n = 0; n < 2; ++n) { f32x4* q = (f32x4*)(X_ + off + bj * 128 + n * 16); f32x4 av = acc[ai][bj][m][n]; if (hasp) av += pg8::streamk_part(part, ((ai * 2 + bj) * 4 + m) * 2 + n, tid); const f32x4 x = *q + av * sc_; *q = x;
                            if (XB_) { store_bf4(XB_ + off + bj * 128 + n * 16, x); ss += (x[0] * x[0] + x[1] * x[1]) + (x[2] * x[2] + x[3] * x[3]); } }
                    if (XB_) { ss += shx(ss, 16, ln); ss += shx(ss, 32, ln); if (fq == 0) unsafeAtomicAdd(rsq_ + row, ss); }
                } else if (row < MR) {
                    float* dp = nullptr;
                    if (row < MPR) { const int b = row / TP, t = row - b * TP; if (t >= NMETA) dp = out_ + O_YP + ((size_t)b * SEQP + (t - NMETA)) * D + col0; }
                    else dp = out_ + O_YS + (size_t)(row - MPR) * D + col0;
                    if (dp) {
#pragma unroll
                        for (int bj = 0; bj < 2; ++bj)
#pragma unroll
                            for (int n = 0; n < 2; ++n) { f32x4 av = acc[ai][bj][m][n]; if (hasp) av += pg8::streamk_part(part, ((ai * 2 + bj) * 4 + m) * 2 + n, tid); *(f32x4*)(dp + bj * 128 + n * 16) = *(const f32x4*)(X_ + off + bj * 128 + n * 16) + av * sc_; }
                    }
                }
                asm volatile("" ::: "memory");
            }
    }
};
struct TailSplitOrder {
    static constexpr bool STREAM = false;
    pg8::StaticOrder so; int G, c, ns, ntsplit;
    __device__ void init(int M, int N, int K, int G_, int c_, int ns_) { so.init(M, N, 1, 0); so.nt0 = K / 64; G = G_; c = c_; ns = ns_; ntsplit = so.nt0 / ns_; }
    __device__ bool next(int i, Unit& u) const {
        const int L = i * G + c;
        if (L < G && L < so.nwg) return so.next(L, u);
        const int L2 = L - G; if (so.nwg <= G || L2 < 0 || L2 >= (so.nwg - G) * ns) return false;
        const int j = L2 / ns, ch = L2 - j * ns;
        so.next(G + j, u); u.kb = ch * ntsplit * 128; u.nt = ntsplit; u.fl = 1; u.tl = L2; return true;
    }
    __device__ __forceinline__ void a_ready(const Unit&) const {}
    __device__ __forceinline__ void done(const Unit&) const {}
};
struct StreamOrder {
    static constexpr bool STREAM = true;
    int nN, ppt, c; long s, e;
    __device__ void init(int M, int N, int K, int G, int c_) {
        nN = N / 256; ppt = K / 128;
        c = (G % 8 == 0) ? (c_ % 8) * (G / 8) + c_ / 8 : c_;
        const long P = (long)(M / 256) * nN * ppt;
        s = (long)c * P / G; e = (long)(c + 1) * P / G;
    }
    __device__ bool next(int i, Unit& u) const {
        const int t = (int)(s / ppt) + i; const long t0 = (long)t * ppt;
        if (t0 >= e) return false;
        const long lo = s > t0 ? s : t0, hi = e < t0 + ppt ? e : t0 + ppt;
        u.pm = t / nN; u.pn = t - u.pm * nN; u.tl = t;
        u.kb = (int)(lo - t0) * 256; u.nt = (int)(hi - lo) * 2;
        u.fl = lo > t0 ? 1 : (hi < t0 + ppt ? 2 : 0);
        return true;
    }
    __device__ __forceinline__ void a_ready(const Unit&) const {}
    __device__ __forceinline__ void done(const Unit&) const {}
};
struct EpiG1 {
    static constexpr bool PERM = true, AFTER_DRAIN = false;
    bf16_t* RKV; float* L1;
    __device__ __forceinline__ void operator()(const f32x4 (&acc)[2][2][4][2], const Unit& u, int wr, int wc, int fr, int fq) const {
        const unsigned row0 = (unsigned)((u.pm % NTM) * 256 + wr * 64 + fr), cw = wc * 32 + 8 * fq;
        if (u.pn < 12) {
            bf16_t* base = RKV + (size_t)(u.pn >> 2) * MP * D;
            const unsigned off0 = row0 * D + (u.pn & 3) * 256 + cw;
#pragma unroll
            for (int ai = 0; ai < 2; ++ai)
#pragma unroll
                for (int m = 0; m < 4; ++m)
#pragma unroll
                    for (int bj = 0; bj < 2; ++bj) { const f32x4 v0 = acc[ai][bj][m][0], v1 = acc[ai][bj][m][1];
                        u32x4 w; w.x = cvt_pk(v0[0], v0[1]); w.y = cvt_pk(v0[2], v0[3]); w.z = cvt_pk(v1[0], v1[1]); w.w = cvt_pk(v1[2], v1[3]);
                        *(u32x4*)(base + (off0 + (unsigned)((ai * 128 + m * 16) * D + bj * 128))) = w; }
        } else {
            float* base = L1 + (size_t)(u.pn - 12) * MP * 256;
            const unsigned off0 = row0 * 256 + cw;
#pragma unroll
            for (int ai = 0; ai < 2; ++ai)
#pragma unroll
                for (int m = 0; m < 4; ++m)
#pragma unroll
                    for (int bj = 0; bj < 2; ++bj)
#pragma unroll
                        for (int n = 0; n < 2; ++n) *(f32x4*)(base + (off0 + (unsigned)((ai * 128 + m * 16) * 256 + bj * 128 + n * 4))) = acc[ai][bj][m][n];
        }
    }
};
struct EpiG2 {
    static constexpr bool PERM = true, AFTER_DRAIN = false;
    bf16_t* LW;
    __device__ __forceinline__ void operator()(const f32x4 (&acc)[2][2][4][2], const Unit& u, int wr, int wc, int fr, int fq) const {
        bf16_t* base = LW + (size_t)(u.pn >> 2) * MP * D;
        const unsigned off0 = (unsigned)(u.pm * 256 + wr * 64 + fr) * D + (u.pn & 3) * 256 + wc * 32 + 8 * fq;
#pragma unroll
        for (int ai = 0; ai < 2; ++ai)
#pragma unroll
            for (int m = 0; m < 4; ++m)
#pragma unroll
                for (int bj = 0; bj < 2; ++bj) { const f32x4 v0 = acc[ai][bj][m][0], v1 = acc[ai][bj][m][1];
                    u32x4 w; w.x = cvt_pk(v0[0], v0[1]); w.y = cvt_pk(v0[2], v0[3]); w.z = cvt_pk(v1[0], v1[1]); w.w = cvt_pk(v1[2], v1[3]);
                    *(u32x4*)(base + (off0 + (unsigned)((ai * 128 + m * 16) * D + bj * 128))) = w; }
    }
};
struct EpiQKV {
    static constexpr bool PERM = false, AFTER_DRAIN = false;
    bf16_t* QB; float* out; const float* qg; const float* kg; const float* rsq;
    __device__ __forceinline__ void operator()(const f32x4 (&acc)[2][2][4][2], const Unit& u, int wr, int wc, int fr, int fq) const {
        const int sec = u.pn >> 2, head = (u.pn & 3) * 4 + wc, row0 = u.pm * 256 + wr * 64 + fr;
        f32x4 gn[2][2];
#pragma unroll
        for (int bj = 0; bj < 2; ++bj)
#pragma unroll
            for (int n = 0; n < 2; ++n) { const int d = 32 * bj + 16 * n + 4 * fq;
                gn[bj][n] = sec == 0 ? *(const f32x4*)(qg + d) * 0.125f : (sec == 1 ? *(const f32x4*)(kg + d) : (f32x4){1.f, 1.f, 1.f, 1.f}); }
#pragma unroll
        for (int ai = 0; ai < 2; ++ai)
#pragma unroll
            for (int m = 0; m < 4; ++m) {
                const int row = row0 + ai * 128 + m * 16;
                const float rx = __builtin_amdgcn_rsqf(rsq[row] * (1.f / D) + RMS_EPS);
                float ss = 0.f;
#pragma unroll
                for (int bj = 0; bj < 2; ++bj)
#pragma unroll
                    for (int n = 0; n < 2; ++n) { const f32x4 x = acc[ai][bj][m][n]; ss += (x[0] * x[0] + x[1] * x[1]) + (x[2] * x[2] + x[3] * x[3]); }
                { const int ln = fq * 16 + fr; ss += shx(ss, 16, ln); ss += shx(ss, 32, ln); }
                const float rs = rx * (sec == 2 ? 1.f : __builtin_amdgcn_rsqf(ss * rx * rx * (1.f / 64.f) + RMS_EPS));
                if (row < MR) {
                    if (sec == 0) {
                        bf16_t* qp = QB + (size_t)row * D + head * 64 + 4 * fq;
#pragma unroll
                        for (int bj = 0; bj < 2; ++bj)
#pragma unroll
                            for (int n = 0; n < 2; ++n) { const f32x4 x = acc[ai][bj][m][n] * rs * gn[bj][n]; u32x2 w; w.x = cvt_pk(x[0], x[1]); w.y = cvt_pk(x[2], x[3]); *(u32x2*)(qp + 32 * bj + 16 * n) = w; }
                    } else {
                        int grp, b, t; row_bt(row, grp, b, t);
                        float* dp = grp == 0 ? out + (sec == 1 ? O_KP : O_VP) + (((size_t)b * NH + head) * TP + t) * HD
                                             : out + (sec == 1 ? O_KS : O_VS) + (((size_t)b * NH + head) * TS + t) * HD;
                        dp += 4 * fq;
#pragma unroll
                        for (int bj = 0; bj < 2; ++bj)
#pragma unroll
                            for (int n = 0; n < 2; ++n) *(f32x4*)(dp + 32 * bj + 16 * n) = acc[ai][bj][m][n] * rs * gn[bj][n];
                    }
                }
            }
    }
};
struct G1Order {
    static constexpr bool STREAM = false;
    int G, c;
    __device__ bool next(int i, Unit& u) const {
        const long L = (long)i * G + c; if (L >= 966) return false;
        int w = (int)L; { const int q = 966 / 8, r = 966 % 8, xcd = w % 8, off = w / 8; w = (xcd < r ? xcd * (q + 1) : r * (q + 1) + (xcd - r) * q) + off; }
        const int pm = w / 14, q = w % 14;
        if (q < 12) { u.pm = (q >> 2) * NTM + pm; u.pn = q; } else { u.pm = (q - 9) * NTM + pm; u.pn = q; }
        u.kb = 0; u.nt = 16; u.fl = 0; u.tl = 0;
        return true;
    }
    __device__ __forceinline__ void a_ready(const Unit&) const {}
    __device__ __forceinline__ void done(const Unit&) const {}
};

struct Job { const float* src; bf16_t* dst; const float* mu; int ld, Ksrc, koff, Kdst, rows, map, smode; };
__device__ __forceinline__ int srccol(int map, int n, int ld) {
    if (map == 0) return n < ld ? n : -1;
    if (map == 1) { const int pn = n >> 8, c = n & 255, bj = c >> 7, j = c & 127, hc = pn * 128 + j; return hc < DFF ? (bj ? DFF + hc : hc) : -1; }
    { const int t = n >> 8, c = n & 255, bj = c >> 7, wc = (c & 127) >> 5, i = c & 31; return t * 256 + 64 * wc + 32 * bj + i; }
}
__device__ __forceinline__ Job get_job(KP p, int j) {
    Job J; J.mu = nullptr; J.koff = 0; J.map = 0; J.smode = 0;
    unsigned char* ws = p->ws;
    if (j < 4) { J.src = p->in[8] + (size_t)j * D * 2 * DFF; J.dst = (bf16_t*)(ws + W_WIN + j * SZ_WIN1); J.ld = 2 * DFF; J.Ksrc = D; J.Kdst = D; J.rows = NIN; J.map = 1; J.mu = p->in[7] + (size_t)j * D; J.smode = 2; }
    else if (j < 8) { const int i = j - 4; J.src = p->in[9] + (size_t)i * DFF * D; J.dst = (bf16_t*)(ws + W_WOUT + i * SZ_WOUT1); J.ld = D; J.Ksrc = DFF; J.Kdst = DFFP; J.rows = D; }
    else if (j < 11) { const int g = j - 8; J.src = p->in[12] + (size_t)g * D * D; J.dst = (bf16_t*)(ws + W_WG1) + (size_t)g * D * D; J.ld = D; J.Ksrc = D; J.Kdst = D; J.rows = D; }
    else if (j < 17) { const int idx = j - 11, part = idx / 3, which = idx % 3;
        J.src = which == 0 ? p->in[14] : (which == 1 ? p->in[17] : p->in[19]); J.ld = which == 2 ? 128 : 64; J.rows = J.ld;
        J.mu = p->in[11] + (which == 0 ? 1 : (which == 1 ? 4 : 5)) * D; J.smode = part + 1;
        J.dst = (bf16_t*)(ws + W_WG1) + (size_t)(3072 + part * 256 + which * 64) * D; J.Ksrc = D; J.Kdst = D; }
    else if (j < 20) { const int which = j - 17; J.src = which == 0 ? p->in[15] : (which == 1 ? p->in[18] : p->in[20]); J.ld = D; J.rows = D;
        J.Ksrc = which == 2 ? 128 : 64; J.koff = which * 64; J.Kdst = 256; J.dst = (bf16_t*)(ws + W_WL2) + (size_t)which * D * 256; }
    else if (j == 20) { J.src = p->in[26]; J.dst = (bf16_t*)(ws + W_WO1); J.ld = D; J.Ksrc = D; J.Kdst = D; J.rows = D; }
    else if (j == 21) { J.src = p->in[27]; J.dst = (bf16_t*)(ws + W_WQKV); J.ld = 3 * D; J.Ksrc = D; J.Kdst = D; J.rows = 3 * D; J.map = 2; J.mu = p->in[10] + D; J.smode = 2; }
    else { J.src = p->in[30]; J.dst = (bf16_t*)(ws + W_WO2); J.ld = D; J.Ksrc = D; J.Kdst = D; J.rows = D; }
    return J;
}
__device__ __forceinline__ void convert_weights(KP p, LAS float* tl, int tid, int bid, int G) {
    int rot = 0;
    for (int j = 0; j < 23; ++j) {
        const Job J = get_job(p, j);
        const int nkt = J.Kdst >> 6, nnt = (J.rows + 255) >> 8, ntile = nnt * nkt;
        int first = bid - rot; if (first < 0) first += G;
        for (int t = first; t < ntile; t += G) {
            const int n0 = (t / nkt) << 8, k0 = (t % nkt) << 6;
            const bool inside = k0 >= J.koff && k0 < J.koff + J.Ksrc;
            if (inside) {
                const int nn = tid & 255, kh = tid >> 8;
                const int sc = (n0 + nn) < J.rows ? srccol(J.map, n0 + nn, J.ld) : -1;
                const float* sp = J.src + (size_t)(k0 - J.koff + kh) * J.ld + (sc >= 0 ? sc : 0);
                float v[32];
#pragma unroll
                for (int it = 0; it < 32; ++it) v[it] = sc >= 0 ? sp[(size_t)(2 * it) * J.ld] : 0.f;
                if (J.smode) {
#pragma unroll
                    for (int it = 0; it < 32; ++it) { const float m = J.mu[k0 - J.koff + kh + 2 * it]; v[it] *= J.smode == 1 ? 1.f - m : m; }
                }
#pragma unroll
                for (int it = 0; it < 32; ++it) tl[(kh + 2 * it) * 257 + nn] = v[it];
            }
            __syncthreads();
            {
                const int nn = tid >> 1, kh = (tid & 1) * 32;
                if (n0 + nn < J.rows) {
                    bf16_t* dp = J.dst + (size_t)(n0 + nn) * J.Kdst + k0 + kh;
#pragma unroll
                    for (int q = 0; q < 4; ++q) {
                        const unsigned z_ = (unsigned)tid >> 31;
                        u32x4 w = (u32x4){z_, z_, z_, z_};
                        if (inside) { float v[8];
#pragma unroll
                            for (int e = 0; e < 8; ++e) v[e] = tl[(kh + q * 8 + e) * 257 + nn];
                            w.x = cvt_pk(v[0], v[1]); w.y = cvt_pk(v[2], v[3]); w.z = cvt_pk(v[4], v[5]); w.w = cvt_pk(v[6], v[7]); }
                        *(u32x4*)(dp + q * 8) = w;
                    }
                }
            }
            __syncthreads();
        }
        rot = (rot + ntile) % G;
    }
}
__device__ __forceinline__ float row_rstd(const f32x4 (&v)[4], int lane) {
    float s = 0.f;
#pragma unroll
    for (int i = 0; i < 4; ++i) s += (v[i][0] * v[i][0] + v[i][1] * v[i][1]) + (v[i][2] * v[i][2] + v[i][3] * v[i][3]);
    s = wave_sum(s, lane);
    return __builtin_amdgcn_rsqf(s * (1.f / D) + RMS_EPS);
}

__device__ __forceinline__ void assemble_x(KP p, int tid, int bid, int G) {
    const int lane = tid & 63, gw = bid * 8 + (tid >> 6), nw = G * 8;
    float* X = (float*)(p->ws + W_X); bf16_t* XN = (bf16_t*)(p->ws + W_XN);
    for (int row = gw; row < MP; row += nw) {
        f32x4 v[4];
        const float* src = nullptr;
        if (row < MPR) { const int b = row / TP, t = row - b * TP; src = t < NMETA ? p->in[6] + (size_t)t * D : p->in[0] + ((size_t)b * SEQP + (t - NMETA)) * D; }
        else if (row < MR) src = p->in[1] + (size_t)(row - MPR) * D;
#pragma unroll
        for (int i = 0; i < 4; ++i) { const float zf = __uint_as_float((unsigned)tid >> 31); v[i] = src ? *(const f32x4*)(src + lane * 4 + 256 * i) : (f32x4){zf, zf, zf, zf}; }
        float ssq = 0.f;
#pragma unroll
        for (int i = 0; i < 4; ++i) ssq += (v[i][0] * v[i][0] + v[i][1] * v[i][1]) + (v[i][2] * v[i][2] + v[i][3] * v[i][3]);
        ssq = wave_sum(ssq, lane);
#pragma unroll
        for (int i = 0; i < 4; ++i) { const int c = lane * 4 + 256 * i; *(f32x4*)(X + (size_t)row * D + c) = v[i]; store_bf4(XN + (size_t)row * D + c, v[i]); }
        float* rsq = (float*)(p->ws + W_RSQ);
        if (lane < 5) rsq[(size_t)lane * MP + row] = lane == 0 ? ssq : 0.f;
    }    for (int i = gw * 64 + lane; i < 64 * 1024; i += nw * 64) ((unsigned*)(p->ws + W_SKF))[i] = 0u;
    for (int i = gw * 64 + lane; i < 65536; i += nw * 64) ((float*)(p->ws + W_SKP) + (size_t)276 * 65536)[i] = 0.f;
}
__device__ __forceinline__ void norm_phase(KP p, const float* g, int tid, int bid, int G, bool copy_y = false) {
    const int lane = tid & 63, gw = bid * 8 + (tid >> 6), nw = G * 8;
    const float* X = (const float*)(p->ws + W_X); bf16_t* XN = (bf16_t*)(p->ws + W_XN);
    for (int row = gw; row < MP; row += nw) {
        f32x4 v[4];
#pragma unroll
        for (int i = 0; i < 4; ++i) v[i] = *(const f32x4*)(X + (size_t)row * D + lane * 4 + 256 * i);
        const float rs = row_rstd(v, lane);
#pragma unroll
        for (int i = 0; i < 4; ++i) { const int c = lane * 4 + 256 * i; store_bf4(XN + (size_t)row * D + c, v[i] * rs * *(const f32x4*)(g + c)); }
        if (copy_y && row < MR) {
            float* dp = nullptr;
            if (row < MPR) { const int b = row / TP, t = row - b * TP; if (t >= NMETA) dp = p->out + O_YP + ((size_t)b * SEQP + (t - NMETA)) * D; }
            else dp = p->out + O_YS + (size_t)(row - MPR) * D;
            if (dp) {
#pragma unroll
                for (int i = 0; i < 4; ++i) *(f32x4*)(dp + lane * 4 + 256 * i) = v[i];
            }
        }
    }
}
__device__ __forceinline__ void mixprep_phase(KP p, int tid, int bid, int G) {
    const int lane = tid & 63, gw = bid * 8 + (tid >> 6), nw = G * 8;
    const float* X = (const float*)(p->ws + W_X); bf16_t* A = (bf16_t*)(p->ws + W_AALL);
    const float* g = p->in[10]; const float* mu = p->in[11];
    for (int row = gw; row < MR; row += nw) {
        int grp, b, t; row_bt(row, grp, b, t);
        f32x4 v[4], pv[4];
#pragma unroll
        for (int i = 0; i < 4; ++i) v[i] = *(const f32x4*)(X + (size_t)row * D + lane * 4 + 256 * i);
        const float rs = row_rstd(v, lane);
        if (t > 0) {
#pragma unroll
            for (int i = 0; i < 4; ++i) pv[i] = *(const f32x4*)(X + (size_t)(row - 1) * D + lane * 4 + 256 * i);
            const float rp = row_rstd(pv, lane);
#pragma unroll
            for (int i = 0; i < 4; ++i) pv[i] = pv[i] * rp * *(const f32x4*)(g + lane * 4 + 256 * i);
        } else {
#pragma unroll
            for (int i = 0; i < 4; ++i) { const float zf = __uint_as_float((unsigned)tid >> 31); pv[i] = grp == 0 ? (f32x4){zf, zf, zf, zf} : *(const f32x4*)(p->in[3] + (size_t)b * D + lane * 4 + 256 * i); }
        }
        const bool last = t == (grp == 0 ? TP - 1 : TS - 1);
        float* sh = grp == 0 ? p->out + O_SHP + (size_t)b * D : p->out + O_SHS + (size_t)b * D;
#pragma unroll
        for (int i = 0; i < 4; ++i) {
            const int c = lane * 4 + 256 * i; const size_t o = (size_t)row * D + c;
            const f32x4 h = v[i] * rs * *(const f32x4*)(g + c), dx = pv[i] - h;
            store_bf4(A + o, h + dx * *(const f32x4*)(mu + c));
            store_bf4(A + (size_t)MP * D + o, h + dx * *(const f32x4*)(mu + 2 * D + c));
            store_bf4(A + (size_t)2 * MP * D + o, h + dx * *(const f32x4*)(mu + 3 * D + c));
            store_bf4(A + (size_t)3 * MP * D + o, h);
            store_bf4(A + (size_t)4 * MP * D + o, pv[i]);
            if (last) *(f32x4*)(sh + c) = h;
        }
    }
}
__device__ __forceinline__ void act_phase(KP p, int gtid, int nthr) {
    const float* L1 = (const float*)(p->ws + W_L1); bf16_t* A2 = (bf16_t*)(p->ws + W_A2);
    for (int i = gtid; i < MP * 64; i += nthr) {
        const int c = (i & 63) * 4;
        f32x4 v = *(const f32x4*)(L1 + (size_t)i * 4) + *(const f32x4*)(L1 + (size_t)MP * 256 + (size_t)i * 4);
        if (c < 64) {
#pragma unroll
            for (int j = 0; j < 4; ++j) v[j] = 1.f - 2.f * __builtin_amdgcn_rcpf(1.f + __expf(2.f * v[j]));
        } else if (c >= 128) {
#pragma unroll
            for (int j = 0; j < 4; ++j) v[j] = sigmoidf_(v[j]);
        }
        store_bf4(A2 + (size_t)i * 4, v);
    }
}

__device__ __forceinline__ float dpp_sum16(float x) {
    x += __builtin_bit_cast(float, __builtin_amdgcn_update_dpp(0, __builtin_bit_cast(int, x), 0xB1, 0xF, 0xF, true));
    x += __builtin_bit_cast(float, __builtin_amdgcn_update_dpp(0, __builtin_bit_cast(int, x), 0x4E, 0xF, 0xF, true));
    x += __builtin_bit_cast(float, __builtin_amdgcn_update_dpp(0, __builtin_bit_cast(int, x), 0x141, 0xF, 0xF, true));
    x += __builtin_bit_cast(float, __builtin_amdgcn_update_dpp(0, __builtin_bit_cast(int, x), 0x140, 0xF, 0xF, true));
    return x;
}
constexpr int SC_CH = 16, SC_STR = 400;
__device__ __forceinline__ void scan_phase(KP p, LAS float* buf, int tid, int bid, int G) {
    const int wid = tid >> 6, lane = tid & 63;
    const bf16_t* RKV = (const bf16_t*)(p->ws + W_RKV); const bf16_t* DEC = (const bf16_t*)(p->ws + W_DEC); const bf16_t* AA = (const bf16_t*)(p->ws + W_AA);
    float* SO = (float*)(p->ws + W_SO);
    const bool producer = wid >= 4;
    for (int u = bid; u < 768; u += G) {
        int bh, half, T, row0; const float* S0; float* Sout;
        if (u < 256) { bh = u >> 1; half = u & 1; T = TP; row0 = (bh >> 4) * TP; S0 = nullptr; Sout = p->out + O_SP + (size_t)bh * 4096; }
        else { const int v = u - 256; bh = v >> 1; half = v & 1; T = TS; row0 = MPR + (bh >> 4) * TS; S0 = p->in[2] + (size_t)bh * 4096; Sout = p->out + O_SS + (size_t)bh * 4096; }
        const int h = bh & 15, nchunk = T / SC_CH;
        if (producer) {
            const int t2 = tid - 256, pi = t2 >> 4, pj = t2 & 15, kc = h * 64 + 4 * pj;
            const f32x4 kkv = *(const f32x4*)(p->in[21] + kc), kav = *(const f32x4*)(p->in[22] + kc), w0v = *(const f32x4*)(p->in[13] + kc), a0v = *(const f32x4*)(p->in[16] + kc);
            u32x2 pr, pk, pvv, pa, pd;
#define SC_LOAD(c) do { const size_t o = (size_t)(row0 + (c) * SC_CH + pi) * D + kc; pr = *(const u32x2*)(RKV + o); pk = *(const u32x2*)(RKV + (size_t)MP * D + o); \
            pvv = *(const u32x2*)(RKV + (size_t)2 * MP * D + o); pa = *(const u32x2*)(AA + o); pd = *(const u32x2*)(DEC + o); } while (0)
#define SC_STORE(bi) do { LAS float* rec = buf + (bi) * (SC_CH * SC_STR) + pi * SC_STR; \
            const f32x4 r = (f32x4){bf_lo(pr.x), bf_hi(pr.x), bf_lo(pr.y), bf_hi(pr.y)}, k = (f32x4){bf_lo(pk.x), bf_hi(pk.x), bf_lo(pk.y), bf_hi(pk.y)}; \
            const f32x4 v = (f32x4){bf_lo(pvv.x), bf_hi(pvv.x), bf_lo(pvv.y), bf_hi(pvv.y)}; \
            f32x4 a = (f32x4){bf_lo(pa.x), bf_hi(pa.x), bf_lo(pa.y), bf_hi(pa.y)} + a0v; f32x4 w = (f32x4){bf_lo(pd.x), bf_hi(pd.x), bf_lo(pd.y), bf_hi(pd.y)} + w0v; \
            _Pragma("unroll") for (int j = 0; j < 4; ++j) { a[j] = sigmoidf_(a[j]); w[j] = __expf(-__expf(-softplusf_(-w[j]) - 0.5f)); } \
            const f32x4 q = k * kkv; float ss = (q[0] * q[0] + q[1] * q[1]) + (q[2] * q[2] + q[3] * q[3]); ss = dpp_sum16(ss); \
            const float inv = 1.f / fmaxf(sqrtf(ss), 1e-12f); const f32x4 nk = q * inv; \
            const f32x4 kp = k * (1.f + (a - 1.f) * kav), bb = nk * a; \
            float br = (bb[0] * r[0] + bb[1] * r[1]) + (bb[2] * r[2] + bb[3] * r[3]), kr = (kp[0] * r[0] + kp[1] * r[1]) + (kp[2] * r[2] + kp[3] * r[3]); \
            br = dpp_sum16(br); kr = dpp_sum16(kr); \
            *(LAS f32x4*)(rec + 4 * pj) = w; *(LAS f32x4*)(rec + 64 + 4 * pj) = nk; *(LAS f32x4*)(rec + 128 + 4 * pj) = bb; \
            *(LAS f32x4*)(rec + 192 + 4 * pj) = kp; *(LAS f32x4*)(rec + 256 + 4 * pj) = w * r; *(LAS f32x4*)(rec + 320 + 4 * pj) = v; \
            if (pj == 0) *(LAS f32x2*)(rec + 384) = (f32x2){br, kr}; } while (0)
            SC_LOAD(0); SC_STORE(0);
            if (nchunk > 1) SC_LOAD(1);
            __syncthreads();
            for (int c = 0; c < nchunk; ++c) {
                if (c + 1 < nchunk) { SC_STORE((c + 1) & 1); if (c + 2 < nchunk) SC_LOAD(c + 2); }
                __syncthreads();
            }
#undef SC_LOAD
#undef SC_STORE
        } else {
            const int rp = lane >> 4, kq = lane & 15, vA = half * 32 + wid * 8 + rp * 2;
            f32x4 sA = (f32x4){0.f, 0.f, 0.f, 0.f}, sB = sA;
            if (S0) { sA = *(const f32x4*)(S0 + vA * 64 + kq * 4); sB = *(const f32x4*)(S0 + (vA + 1) * 64 + kq * 4); }
            float* op = SO + (size_t)(row0 + kq) * D + h * 64 + vA;
            __syncthreads();
            for (int c = 0; c < nchunk; ++c) {
                const LAS float* cb = buf + (c & 1) * (SC_CH * SC_STR);
                float oA = 0.f, oB = 0.f;
#pragma unroll
                for (int i = 0; i < SC_CH; ++i) {
                    const LAS float* rec = cb + i * SC_STR;
                    const f32x4 wd = *(const LAS f32x4*)(rec + kq * 4), kk = *(const LAS f32x4*)(rec + 64 + kq * 4), bb = *(const LAS f32x4*)(rec + 128 + kq * 4),
                                kp = *(const LAS f32x4*)(rec + 192 + kq * 4), wr = *(const LAS f32x4*)(rec + 256 + kq * 4);
                    const f32x2 vv = *(const LAS f32x2*)(rec + 320 + vA), sc = *(const LAS f32x2*)(rec + 384);
                    const f32x2 t1A = sA.hi * kk.hi + sA.lo * kk.lo, t1B = sB.hi * kk.hi + sB.lo * kk.lo, t2A = sA.hi * wr.hi + sA.lo * wr.lo, t2B = sB.hi * wr.hi + sB.lo * wr.lo;
                    float d1A = t1A.x + t1A.y, d1B = t1B.x + t1B.y, d2A = t2A.x + t2A.y, d2B = t2B.x + t2B.y;
#define DPPR(ctl) "v_add_f32_dpp %0, %0, %0 " ctl " row_mask:0xf bank_mask:0xf bound_ctrl:1\n\tv_add_f32_dpp %1, %1, %1 " ctl " row_mask:0xf bank_mask:0xf bound_ctrl:1\n\t" \
                  "v_add_f32_dpp %2, %2, %2 " ctl " row_mask:0xf bank_mask:0xf bound_ctrl:1\n\tv_add_f32_dpp %3, %3, %3 " ctl " row_mask:0xf bank_mask:0xf bound_ctrl:1\n\t"
                    asm("s_nop 1\n\t" DPPR("quad_perm:[1,0,3,2]") DPPR("quad_perm:[2,3,0,1]") DPPR("row_half_mirror") DPPR("row_mirror") : "+v"(d1A), "+v"(d1B), "+v"(d2A), "+v"(d2B));
#undef DPPR
                    const float saA = -d1A, saB = -d1B;
                    const float tA = d2A + saA * sc.x + vv.x * sc.y, tB = d2B + saB * sc.x + vv.y * sc.y;
                    sA = sA * wd + bb * saA + kp * vv.x;
                    sB = sB * wd + bb * saB + kp * vv.y;
                    oA = kq == i ? tA : oA; oB = kq == i ? tB : oB;
                }
                *(f32x2*)(op + (size_t)c * SC_CH * D) = (f32x2){oA, oB};
                __syncthreads();
            }
            *(f32x4*)(Sout + vA * 64 + kq * 4) = sA; *(f32x4*)(Sout + (vA + 1) * 64 + kq * 4) = sB;
        }
    }
}
__device__ __forceinline__ void post_phase(KP p, int tid, int bid, int G) {
    const int lane = tid & 63, gw = bid * 8 + (tid >> 6), nw = G * 8;
    const bf16_t* RKV = (const bf16_t*)(p->ws + W_RKV); const bf16_t* AA = (const bf16_t*)(p->ws + W_AA); const bf16_t* GG = (const bf16_t*)(p->ws + W_GG);
    const float* SO = (const float*)(p->ws + W_SO); bf16_t* OG = (bf16_t*)(p->ws + W_OG);
    const float* k_a = p->in[22]; const float* a0p = p->in[16]; const float* r_k = p->in[23]; const float* gnw = p->in[24]; const float* gnb = p->in[25];
    const int c0 = lane * 16;
    for (int row = gw; row < MR; row += nw) {
        const size_t o = (size_t)row * D + c0;
        float ov[16], rv[16], kv[16], vv[16], av[16], gv[16];
#pragma unroll
        for (int q = 0; q < 4; ++q) { const f32x4 x = *(const f32x4*)(SO + o + 4 * q); ov[4 * q] = x[0]; ov[4 * q + 1] = x[1]; ov[4 * q + 2] = x[2]; ov[4 * q + 3] = x[3]; }
#define LD16(dst, ptr) do { const u32x4 a_ = *(const u32x4*)(ptr), b_ = *(const u32x4*)((ptr) + 8); \
        dst[0] = bf_lo(a_.x); dst[1] = bf_hi(a_.x); dst[2] = bf_lo(a_.y); dst[3] = bf_hi(a_.y); dst[4] = bf_lo(a_.z); dst[5] = bf_hi(a_.z); dst[6] = bf_lo(a_.w); dst[7] = bf_hi(a_.w); \
        dst[8] = bf_lo(b_.x); dst[9] = bf_hi(b_.x); dst[10] = bf_lo(b_.y); dst[11] = bf_hi(b_.y); dst[12] = bf_lo(b_.z); dst[13] = bf_hi(b_.z); dst[14] = bf_lo(b_.w); dst[15] = bf_hi(b_.w); } while (0)
        LD16(rv, RKV + o); LD16(kv, RKV + (size_t)MP * D + o); LD16(vv, RKV + (size_t)2 * MP * D + o); LD16(av, AA + o); LD16(gv, GG + o);
#undef LD16
        float sm = 0.f, rk = 0.f;
#pragma unroll
        for (int e = 0; e < 16; ++e) { sm += ov[e]; const float kp = kv[e] * (1.f + (sigmoidf_(a0p[c0 + e] + av[e]) - 1.f) * k_a[c0 + e]); rk += rv[e] * kp * r_k[c0 + e]; }
        sm += shx(sm, 1, lane); sm += shx(sm, 2, lane); rk += shx(rk, 1, lane); rk += shx(rk, 2, lane);
        const float mean = sm * (1.f / 64.f);
        float vs = 0.f;
#pragma unroll
        for (int e = 0; e < 16; ++e) { const float d = ov[e] - mean; vs += d * d; }
        vs += shx(vs, 1, lane); vs += shx(vs, 2, lane);
        const float rstd = __builtin_amdgcn_rsqf(vs * (1.f / 64.f) + GN_EPS);
        unsigned w[8];
#pragma unroll
        for (int e = 0; e < 16; e += 2) {
            const float y0 = ((ov[e] - mean) * rstd * gnw[c0 + e] + gnb[c0 + e] + rk * vv[e]) * gv[e];
            const float y1 = ((ov[e + 1] - mean) * rstd * gnw[c0 + e + 1] + gnb[c0 + e + 1] + rk * vv[e + 1]) * gv[e + 1];
            w[e >> 1] = cvt_pk(y0, y1);
        }
        *(u32x4*)(OG + o) = (u32x4){w[0], w[1], w[2], w[3]}; *(u32x4*)(OG + o + 8) = (u32x4){w[4], w[5], w[6], w[7]};
    }
}

__device__ __forceinline__ int crow(int r, int hi) { return (r & 3) + 8 * (r >> 2) + 4 * hi; }
__device__ __forceinline__ bf16x8 pack8(f32x4 a, f32x4 b) {
    u32x4 w; w.x = cvt_pk(a[0], a[1]); w.y = cvt_pk(a[2], a[3]); w.z = cvt_pk(b[0], b[1]); w.w = cvt_pk(b[2], b[3]);
    return __builtin_bit_cast(bf16x8, w);
}
__device__ __forceinline__ void attn_phase(KP p, int tid, int bid, int G) {
    const int lane = tid & 63, gw = bid * 8 + (tid >> 6), nw = G * 8;
    const bf16_t* QB = (const bf16_t*)(p->ws + W_QB); bf16_t* AO = (bf16_t*)(p->ws + W_OG);
    const int ql = lane & 31, hi = lane >> 5;
    constexpr int NU_P = BP * NH * 65;
    for (int u = gw; u < NU_P + BS * NH * 2; u += nw) {
        int bh, Q0, nq, npast, row_base, Tn; const float *kc, *vc, *kn, *vn;
        if (u < NU_P) { bh = u / 65; Q0 = (u - bh * 65) * 32; nq = min(32, TP - Q0); npast = 0; row_base = (bh >> 4) * TP; Tn = TP;
            kc = nullptr; vc = nullptr; kn = p->out + O_KP + (size_t)bh * TP * HD; vn = p->out + O_VP + (size_t)bh * TP * HD; }
        else { const int v = u - NU_P; bh = v >> 1; Q0 = (v & 1) * 32; nq = 32; npast = PAST; row_base = MPR + (bh >> 4) * TS; Tn = TS;
            kc = p->in[4] + (size_t)bh * PAST * HD; vc = p->in[5] + (size_t)bh * PAST * HD; kn = p->out + O_KS + (size_t)bh * TS * HD; vn = p->out + O_VS + (size_t)bh * TS * HD; }
        const int h = bh & 15, qpos0 = npast + Q0;
        bf16x8 qf[4];
        { const bf16_t* qp = QB + (size_t)(row_base + Q0 + min(ql, nq - 1)) * D + h * 64 + hi * 8;
#pragma unroll
          for (int s = 0; s < 4; ++s) qf[s] = *(const bf16x8*)(qp + 16 * s); }
        f32x16 o0, o1;
#pragma unroll
        for (int r = 0; r < 16; ++r) { o0[r] = 0.f; o1[r] = 0.f; }
        float carry = ql < nq ? 0.f : -1e30f;
        const int qpos = qpos0 + ql;
        f32x4 kc4[8];
#define ATT_TILE_PTRS(P0_, kb_, vb_, lim_) const bool inpast_ = (P0_) < npast; \
            const float* kb_ = inpast_ ? kc + (size_t)(P0_) * HD : kn + (size_t)((P0_) - npast) * HD; \
            const float* vb_ = inpast_ ? vc + (size_t)(P0_) * HD : vn + (size_t)((P0_) - npast) * HD; \
            const int lim_ = inpast_ ? 31 : min(31, Tn - 1 - ((P0_) - npast));
        { ATT_TILE_PTRS((qpos0 >> 5) * 32, kb0, vb0, lim0); (void)vb0;
          const float* kp = kb0 + (size_t)min(ql, lim0) * HD + hi * 8;
#pragma unroll
          for (int s = 0; s < 4; ++s) { kc4[2 * s] = *(const f32x4*)(kp + 16 * s); kc4[2 * s + 1] = *(const f32x4*)(kp + 16 * s + 4); } }
        for (int kt = qpos0 >> 5; kt >= 0; --kt) {
            const int P0 = kt * 32;
            ATT_TILE_PTRS(P0, kb, vb, lim); (void)kb;
            float x0[16], x1[16];
#pragma unroll
            for (int r = 0; r < 16; ++r) { const float* vp = vb + (size_t)min(crow(r, hi), lim) * HD + ql; x0[r] = vp[0]; x1[r] = vp[32]; }
            f32x4 kn4[8];
            { const int Pn = kt > 0 ? P0 - 32 : P0; ATT_TILE_PTRS(Pn, kbn, vbn, limn); (void)vbn;
              const float* kp = kbn + (size_t)min(ql, limn) * HD + hi * 8;
#pragma unroll
              for (int s = 0; s < 4; ++s) { kn4[2 * s] = *(const f32x4*)(kp + 16 * s); kn4[2 * s + 1] = *(const f32x4*)(kp + 16 * s + 4); } }
            f32x16 st;
#pragma unroll
            for (int r = 0; r < 16; ++r) st[r] = 0.f;
#pragma unroll
            for (int s = 0; s < 4; ++s) st = __builtin_amdgcn_mfma_f32_32x32x16_bf16(pack8(kc4[2 * s], kc4[2 * s + 1]), qf[s], st, 0, 0, 0);
            float L[16];
            float own[4];
#pragma unroll
            for (int g = 0; g < 4; ++g) { float sg = 0.f;
#pragma unroll
                for (int i = 0; i < 4; ++i) { const int r = 4 * g + i; const bool vis = (P0 + crow(r, hi)) < qpos; L[r] = vis ? -softplusf_(st[r]) : 0.f; sg += L[r]; }
                own[g] = sg; }
            float oth[4];
#pragma unroll
            for (int g = 0; g < 4; ++g) oth[g] = shx(own[g], 32, lane);
            float suf = carry;
            float A[16];
#pragma unroll
            for (int g = 3; g >= 0; --g) {
                float c = suf + (hi == 0 ? oth[g] : 0.f);
#pragma unroll
                for (int i = 3; i >= 0; --i) { const int r = 4 * g + i; c += L[r]; const bool vis = (P0 + crow(r, hi)) < qpos; A[r] = vis ? __expf(st[r] + c) : 0.f; }
                suf += own[g] + oth[g];
            }
            carry = suf;
            const bf16x8 pa0 = pack8((f32x4){A[0], A[1], A[2], A[3]}, (f32x4){A[4], A[5], A[6], A[7]});
            const bf16x8 pa1 = pack8((f32x4){A[8], A[9], A[10], A[11]}, (f32x4){A[12], A[13], A[14], A[15]});
            o0 = __builtin_amdgcn_mfma_f32_32x32x16_bf16(pa0, pack8((f32x4){x0[0], x0[1], x0[2], x0[3]}, (f32x4){x0[4], x0[5], x0[6], x0[7]}), o0, 0, 0, 0);
            o1 = __builtin_amdgcn_mfma_f32_32x32x16_bf16(pa0, pack8((f32x4){x1[0], x1[1], x1[2], x1[3]}, (f32x4){x1[4], x1[5], x1[6], x1[7]}), o1, 0, 0, 0);
            o0 = __builtin_amdgcn_mfma_f32_32x32x16_bf16(pa1, pack8((f32x4){x0[8], x0[9], x0[10], x0[11]}, (f32x4){x0[12], x0[13], x0[14], x0[15]}), o0, 0, 0, 0);
            o1 = __builtin_amdgcn_mfma_f32_32x32x16_bf16(pa1, pack8((f32x4){x1[8], x1[9], x1[10], x1[11]}, (f32x4){x1[12], x1[13], x1[14], x1[15]}), o1, 0, 0, 0);
#pragma unroll
            for (int e = 0; e < 8; ++e) kc4[e] = kn4[e];
            if (!__any(carry >= -104.f)) break;
        }
#undef ATT_TILE_PTRS
        bf16_t* op = AO + (size_t)(row_base + Q0) * D + h * 64 + ql;
#pragma unroll
        for (int r = 0; r < 16; ++r) { const int qr = crow(r, hi); if (qr < nq) { op[(size_t)qr * D] = (bf16_t)(cvt_pk(o0[r], 0.f) & 0xffffu); op[(size_t)qr * D + 32] = (bf16_t)(cvt_pk(o1[r], 0.f) & 0xffffu); } }
    }
}

__device__ __forceinline__ void fixup_phase(KP p, int ffn, int ns, int tid, int bid, int G) {
    float* X = (float*)(p->ws + W_X); bf16_t* XB = (bf16_t*)(p->ws + W_XN); const float* spl = (const float*)(p->ws + W_SKP);
    float* rsq = (float*)(p->ws + W_RSQ) + (size_t)(ffn == 1 ? 2 : (ffn == 2 ? 3 : (ffn == 4 ? 1 : 4))) * MP;
    const bool fold = ffn == 1 || ffn == 2 || ffn >= 4, fin = ffn == 3; const float scl = ffn >= 4 ? 1.0f : 0.5f;
    pg8::StaticOrder so; so.init(MP, D, 1, 0); so.nt0 = 0;
    const int ntail = so.nwg - G; if (ntail <= 0) return;
    const int wid = tid >> 6, lane = tid & 63, wr = wid >> 2, wc = wid & 3, fr = lane & 15, fq = lane >> 4;
    for (int B = bid; B < ntail * 32; B += G) {
        const int j = B >> 5, q = B & 31, n = q & 1, m = (q >> 1) & 3, bj = (q >> 3) & 1, ai = q >> 4;
        Unit u; so.next(G + j, u);
        f32x4 sum = (f32x4){0.f, 0.f, 0.f, 0.f};
        for (int ch = 0; ch < ns; ++ch) sum += *((const f32x4*)(spl + (size_t)(j * ns + ch) * 65536) + q * 512 + tid);
        const int row = u.pm * 256 + ai * 128 + wr * 64 + m * 16 + fr, col = u.pn * 256 + bj * 128 + wc * 32 + n * 16 + fq * 4;
        const size_t off = (size_t)row * D + col;
        const f32x4 x = *(const f32x4*)(X + off) + sum * scl;
        if (!fin) {
            *(f32x4*)(X + off) = x;
            if (fold) { store_bf4(XB + off, x); float ss = (x[0] * x[0] + x[1] * x[1]) + (x[2] * x[2] + x[3] * x[3]); ss += shx(ss, 16, lane); ss += shx(ss, 32, lane); if (fq == 0) unsafeAtomicAdd(rsq + row, ss); }
        } else if (row < MR) {
            float* dp = nullptr;
            if (row < MPR) { const int b = row / TP, t = row - b * TP; if (t >= NMETA) dp = p->out + O_YP + ((size_t)b * SEQP + (t - NMETA)) * D + col; }
            else dp = p->out + O_YS + (size_t)(row - MPR) * D + col;
            if (dp) *(f32x4*)dp = x;
        }
    }
}
#define XB_TMO      128
#define XB_XCNT(j)  (256  + 64 * (j))
#define XB_XSUB(j)  (1280 + 64 * (j))
#define XB_XGEN(j)  (2304 + 64 * (j))
#define XB_TOP      3328
#define XB_TOPGEN   3392
#define XCD_BAR_WORDS 3456
#define XB_SPIN_CAP (1u << 18)

__device__ __forceinline__ unsigned xb_ld(unsigned* p)              { return __hip_atomic_load(p, __ATOMIC_RELAXED, __HIP_MEMORY_SCOPE_AGENT); }
__device__ __forceinline__ unsigned xb_add(unsigned* p, unsigned v) { return __hip_atomic_fetch_add(p, v, __ATOMIC_RELAXED, __HIP_MEMORY_SCOPE_AGENT); }
__device__ __forceinline__ unsigned xb_xcc_id() { return (unsigned)__builtin_amdgcn_s_getreg((3 << 11) | 20) & 0xFu; }
#define XB_SPIN(cond, bar) do { unsigned _sp = 0; while (cond) { __builtin_amdgcn_s_sleep(1); \
    if ((++_sp & 255u) == 0u) { if (xb_ld(&(bar)[XB_TMO])) break; if (_sp > XB_SPIN_CAP) { atomicAdd(&(bar)[XB_TMO], 1u); break; } } } } while (0)

struct XcdBarrier {
    unsigned* bar; unsigned x;
    volatile LAS unsigned* st;
};

__device__ __forceinline__ XcdBarrier xcd_barrier_post(unsigned* bar, volatile LAS unsigned* st, bool xb_tid0) {
    XcdBarrier b; b.bar = bar; b.x = xb_xcc_id(); b.st = st;
    if (xb_tid0) (void)xb_add(&bar[XB_XCNT(b.x)], 1u);
    return b;
}
__device__ __forceinline__ void xcd_barrier_complete(unsigned* bar, unsigned x, unsigned& nloc, unsigned& nx) {
    const unsigned G = gridDim.x * gridDim.y * gridDim.z;
    unsigned sum, cnt, mine, sp = 0u;
    for (;;) {
        sum = 0u; cnt = 0u; mine = 0u;
#pragma unroll
        for (unsigned j = 0; j < 16; ++j) { const unsigned c = xb_ld(&bar[XB_XCNT(j)]); sum += c; cnt += (c > 0u) ? 1u : 0u; mine = (j == x) ? c : mine; }
        if (sum == G) break;
        __builtin_amdgcn_s_sleep(1);
        if ((++sp & 255u) == 0u) { if (xb_ld(&bar[XB_TMO])) break; if (sp > XB_SPIN_CAP) { atomicAdd(&bar[XB_TMO], 1u); break; } }
    }
    nloc = mine > 0u ? mine : 1u; nx = cnt > 0u ? cnt : 1u;
}

__device__ __forceinline__ void xcd_barrier(const XcdBarrier& b, bool xb_tid0) {
    asm volatile("s_waitcnt vmcnt(0)" ::: "memory");
    __syncthreads();
    if (xb_tid0) {
        unsigned* bar = b.bar;
        __builtin_amdgcn_s_waitcnt(0);
        unsigned nloc = b.st[0], nx = b.st[1];
        if (nloc == 0u) { xcd_barrier_complete(bar, b.x, nloc, nx); b.st[0] = nloc; b.st[1] = nx; }
        const unsigned old = xb_add(&bar[XB_XSUB(b.x)], 1u);
        const unsigned gen = old / nloc;
        if (old + 1u == (gen + 1u) * nloc) {
            __builtin_amdgcn_fence(__ATOMIC_RELEASE, "agent");
            asm volatile("s_waitcnt vmcnt(0)" ::: "memory");
            const unsigned og = xb_add(&bar[XB_TOP], 1u);
            const unsigned tg = og / nx;
            if (og + 1u == (tg + 1u) * nx) xb_add(&bar[XB_TOPGEN], 1u);
            else XB_SPIN(xb_ld(&bar[XB_TOPGEN]) == tg, bar);
            __builtin_amdgcn_fence(__ATOMIC_ACQUIRE, "agent");
            xb_add(&bar[XB_XGEN(b.x)], 1u);
            asm volatile("s_waitcnt vmcnt(0)" ::: "memory");
        } else {
            XB_SPIN(xb_ld(&bar[XB_XGEN(b.x)]) == gen, bar);
            __builtin_amdgcn_fence(__ATOMIC_ACQUIRE, "agent");
            asm volatile("s_waitcnt vmcnt(0)" ::: "memory");
        }
    }
    __syncthreads();
}
constexpr int NPHASE = 23;
#ifndef PHM
#define PHM 0xffff
#endif
#define EN(k) (((PHM) >> (k)) & 1)
constexpr int LDS_BYTES = 131072 + 8 * 576 * 4;
template <class Epi, class Sched>
__device__ __forceinline__ void run_gemm(LAS unsigned char* lds, int wb, const bf16_t* A, const bf16_t* Bt, int M, int N, int K, const Sched& S, const Epi& E, float* skp = nullptr, unsigned* skf = nullptr) {
    pg8::Gemm g{A, Bt, M, N, K, wb, skp, skf};
    pg8::gemm_phase<Epi, Sched, true, true>(lds, g, S, E);
}
__global__ void __launch_bounds__(512, 2) mega(Params p_unused) {
    LAS unsigned char* lds = (LAS unsigned char*)lds_raw;
    cg::grid_group grid = cg::this_grid();
    KP p = (KP)__builtin_amdgcn_kernarg_segment_ptr();
    const int ph_lo = p->ph_lo, ph_hi = p->ph_hi;
    const int wb = __builtin_amdgcn_readfirstlane((int)threadIdx.x) & ~63;
    { LAS unsigned* stw = (LAS unsigned*)(lds + 131072); if ((int)threadIdx.x < 2) stw[threadIdx.x] = 0u; __syncthreads(); }
    const XcdBarrier xbar = xcd_barrier_post((unsigned*)(p->ws + W_BAR), (volatile LAS unsigned*)(lds + 131072), threadIdx.x == 0);
    for (int pi_ = ph_lo; pi_ < ph_hi; ++pi_) {
        asm volatile("" ::: "v1","v2","v3","v4","v5","v6","v7","v8","v9","v10","v11","v12","v13","v14","v15","v16","v17","v18","v19","v20","v21","v22","v23","v24","v25","v26","v27","v28","v29","v30","v31","v32","v33","v34","v35","v36","v37","v38","v39","v40","v41","v42","v43","v44","v45","v46","v47","v48","v49","v50","v51","v52","v53","v54","v55","v56","v57","v58","v59","v60","v61","v62","v63","v64","v65","v66","v67","v68","v69","v70","v71","v72","v73","v74","v75","v76","v77","v78","v79","v80","v81","v82","v83","v84","v85","v86","v87","v88","v89","v90","v91","v92","v93","v94","v95","v96","v97","v98","v99","v100","v101","v102","v103","v104","v105","v106","v107","v108","v109","v110","v111","v112","v113","v114","v115","v116","v117","v118","v119","v120","v121","v122","v123","v124","v125","v126","v127","v128","v129","v130","v131","v132","v133","v134","v135","v136","v137","v138","v139","v140","v141","v142","v143","v144","v145","v146","v147","v148","v149","v150","v151","v152","v153","v154","v155","v156","v157","v158","v159","v160","v161","v162","v163","v164","v165","v166","v167","v168","v169","v170","v171","v172","v173","v174","v175","v176","v177","v178","v179","v180","v181","v182","v183","v184","v185","v186","v187","v188","v189","v190","v191","v192","v193","v194","v195","v196","v197","v198","v199","v200","v201","v202","v203","v204","v205","v206","v207","v208","v209","v210","v211","v212","v213","v214","v215","v216","v217","v218","v219","v220","v221","v222","v223","v224","v225","v226","v227","v228","v229","v230","v231","v232","v233","v234","v235","v236","v237","v238","v239","v240","v241","v242","v243","v244","v245","v246","v247","v248","v249");
        asm volatile("" : "+s"(p));
        const int phc = p->seq[pi_], ph = phc & 63; const bool dry = (phc & 64) != 0;
        int bid = blockIdx.x, G = gridDim.x;
        asm volatile("" : "+s"(bid), "+s"(G));
#define TID_HERE (wb + lane_now())
        int ffn = -1; bool ffn_in = false;
        if (ph == 1 || ph == 2) { ffn = 0; ffn_in = ph == 1; } else if (ph == 11 || ph == 12) { ffn = 1; ffn_in = ph == 11; }
        else if (ph == 14 || ph == 15) { ffn = 2; ffn_in = ph == 14; } else if (ph == 21 || ph == 22) { ffn = 3; ffn_in = ph == 21; }
        if (EN(0) && ph == 0) { { const int tid = TID_HERE; convert_weights(p, (LAS float*)lds, tid, bid, G); assemble_x(p, tid, bid, G); } }
        else if (EN(1) && ffn >= 0 && ffn_in) {
            pg8::StaticOrder S; S.init(MP, NIN, G, bid); S.nt0 = D / 64;
            unsigned char* ws = p->ws; EpiSwiGLU E{(bf16_t*)(ws + W_HB), (const float*)(ws + W_RSQ) + (size_t)(ffn == 0 ? 0 : (ffn == 1 ? 1 : (ffn == 2 ? 2 : 4))) * MP};
            run_gemm(lds, wb, (const bf16_t*)(ws + W_XN), (const bf16_t*)(ws + W_WIN + ffn * SZ_WIN1), MP, NIN, D, S, E);
        } else if (EN(2) && ffn >= 0) {
            TailSplitOrder S; S.init(MP, D, DFFP, G, bid, 11);
            unsigned char* ws = p->ws; const bool fold = (ffn == 1 || ffn == 2) && !dry;
            EpiRes E{(float*)(ws + W_X), dry ? 0.f : 0.5f, (ffn == 3 && !dry) ? p->out : nullptr, fold ? (bf16_t*)(ws + W_XN) : nullptr, (float*)(ws + W_RSQ) + (size_t)(ffn == 1 ? 2 : 3) * MP, (float*)(ws + W_SKP)};
            run_gemm(lds, wb, (const bf16_t*)(ws + W_HB), (const bf16_t*)(ws + W_WOUT + ffn * SZ_WOUT1), MP, D, DFFP, S, E, (float*)(ws + W_SKP), (unsigned*)(ws + W_SKF) + pi_ * 1024);
        }
        else if (ph >= 24 && ph < 30) { if (!dry) fixup_phase(p, ph - 24, ph < 28 ? 11 : 4, TID_HERE, bid, G); }
        else if (EN(3) && ph == 3) mixprep_phase(p, TID_HERE, bid, G);
        else if (EN(4) && ph == 4) {
            G1Order S{G, bid};
            unsigned char* ws = p->ws; EpiG1 E{(bf16_t*)(ws + W_RKV), (float*)(ws + W_L1)};
            run_gemm(lds, wb, (const bf16_t*)(ws + W_AALL), (const bf16_t*)(ws + W_WG1), 5 * MP, 3584, D, S, E);
        }
        else if (EN(5) && ph == 5) act_phase(p, bid * 512 + TID_HERE, G * 512);
        else if (EN(6) && ph == 6) {
            pg8::StaticOrder S; S.init(MP, 3072, G, bid); S.nt0 = 4;
            unsigned char* ws = p->ws; EpiG2 E{(bf16_t*)(ws + W_DEC)};
            run_gemm(lds, wb, (const bf16_t*)(ws + W_A2), (const bf16_t*)(ws + W_WL2), MP, 3072, 256, S, E);
        }
        else if (EN(7) && ph == 7) scan_phase(p, (LAS float*)lds, TID_HERE, bid, G);
        else if (EN(8) && ph == 8) post_phase(p, TID_HERE, bid, G);
        else if (EN(9) && (ph == 9 || ph == 19)) {
            TailSplitOrder S; S.init(MP, D, D, G, bid, 4);
            unsigned char* ws = p->ws; EpiRes E{(float*)(ws + W_X), dry ? 0.f : 1.0f, nullptr, dry ? nullptr : (bf16_t*)(ws + W_XN), (float*)(ws + W_RSQ) + (size_t)(ph == 9 ? 1 : 4) * MP, (float*)(ws + W_SKP)};
            run_gemm(lds, wb, (const bf16_t*)(ws + W_OG), (const bf16_t*)(ws + (ph == 9 ? W_WO1 : W_WO2)), MP, D, D, S, E, (float*)(ws + W_SKP), (unsigned*)(ws + W_SKF) + pi_ * 1024);
        }
        else if (EN(11) && ph == 17) {
            pg8::StaticOrder S; S.init(MP, 3 * D, G, bid); S.nt0 = D / 64;
            unsigned char* ws = p->ws; EpiQKV E{(bf16_t*)(ws + W_QB), p->out, p->in[28], p->in[29], (const float*)(ws + W_RSQ) + (size_t)3 * MP};
            run_gemm(lds, wb, (const bf16_t*)(ws + W_XN), (const bf16_t*)(ws + W_WQKV), MP, 3 * D, D, S, E);
        }
        else if (EN(12) && ph == 18) attn_phase(p, TID_HERE, bid, G);
        if (pi_ + 1 < ph_hi) { if (pi_ == ph_lo) grid.sync(); else xcd_barrier(xbar, (wb + lane_now()) == 0); }
    }
}

#ifndef ONE_LAUNCH
#define ONE_LAUNCH 1
#endif
extern "C" void kernel_launch(void* const* d_in, const int* in_sizes, int n_in, void* d_out, int out_size, void* d_ws, size_t ws_size, hipStream_t stream) {
    static int grid = 0;
    if (grid == 0) {
        if (n_in != 31 || (size_t)out_size != O_END || ws_size < W_END) { fprintf(stderr, "kernel_launch: unexpected sizes (n_in %d out %d ws %zu need %zu)\n", n_in, out_size, ws_size, (size_t)W_END); grid = -1; return; }
        int dev = 0, cus = 0, per_cu = 0;
        hipGetDevice(&dev); hipDeviceGetAttribute(&cus, hipDeviceAttributeMultiprocessorCount, dev);
        if (hipFuncSetAttribute((const void*)mega, hipFuncAttributeMaxDynamicSharedMemorySize, LDS_BYTES) != hipSuccess) { fprintf(stderr, "kernel_launch: hipFuncSetAttribute failed\n"); grid = -1; return; }
        hipOccupancyMaxActiveBlocksPerMultiprocessor(&per_cu, (const void*)mega, 512, LDS_BYTES);
        (void)hipGetLastError();
        if (per_cu < 1) per_cu = 1;
        grid = cus * per_cu;
    }
    if (grid < 0) return;
    Params p{};
    for (int i = 0; i < 31; ++i) p.in[i] = (const float*)d_in[i];
    p.out = (float*)d_out; p.ws = (unsigned char*)d_ws;
    int nseq = 0;
    for (int ph = 0; ph < NPHASE; ++ph) {
        if (ph == 10 || ph == 13 || ph == 16 || ph == 20) continue;
        p.seq[nseq++] = ph;
        if (ph == 2 || ph == 12 || ph == 15 || ph == 22) p.seq[nseq++] = 24 + (ph == 2 ? 0 : (ph == 12 ? 1 : (ph == 15 ? 2 : 3)));
        if (ph == 9 || ph == 19) p.seq[nseq++] = ph == 9 ? 28 : 29;
#ifdef REP_OF
        for (int r = 0; r < (REP_OF(ph)); ++r) p.seq[nseq++] = (ph | ((ph == 2 || ph == 9) ? 64 : 0));
#endif
    }
#if ONE_LAUNCH
    (void)hipMemsetAsync((unsigned char*)d_ws + W_BAR, 0, 16384, stream);
    p.ph_lo = 0; p.ph_hi = nseq;
    void* args[] = {&p};
    hipError_t e = hipLaunchCooperativeKernel((const void*)mega, dim3(grid), dim3(512), args, LDS_BYTES, stream);
    if (e != hipSuccess) fprintf(stderr, "cooperative launch failed: %s (grid %d)\n", hipGetErrorString(e), grid);
#else
    for (int ph = 0; ph < nseq; ++ph) { p.ph_lo = ph; p.ph_hi = ph + 1; hipLaunchKernelGGL(mega, dim3(grid), dim3(512), LDS_BYTES, stream, p); }
#endif
}
```

```cpp
#include <hip/hip_runtime.h>
#include <hip/hip_cooperative_groups.h>
#include <cstdio>
#include <cstdint>
namespace cg = cooperative_groups;
__device__ __forceinline__ int lane_now() { int l; asm volatile("v_mbcnt_lo_u32_b32 %0, -1, 0\n\tv_mbcnt_hi_u32_b32 %0, -1, %0" : "=v"(l)); return l; }
namespace pg8 {
#define PG8_LAS __attribute__((address_space(3)))
typedef unsigned short bf16_t;
typedef short bf16x8 __attribute__((ext_vector_type(8)));
typedef float f32x4 __attribute__((ext_vector_type(4)));
typedef unsigned u32x4 __attribute__((ext_vector_type(4)));
constexpr int BM = 256, BK = 64, HALF = 128, HTB = HALF * BK * 2  , STAGE_BYTES = 8 * HTB, NXCD = 8, WGM = 8;

__host__ __device__ __forceinline__ int lds_byte(int r, int c) { const int st = (r >> 4) * 2 + (c >> 5), rr = r & 15, cc = c & 31, ob = rr * 64 + cc * 2; return st * 1024 + (ob ^ (((ob >> 9) & 1) << 5)); }
__host__ __device__ __forceinline__ void stage_rc(int b, int& R, int& C) { const int st = b / 1024, sb = b % 1024, swz = sb ^ (((sb >> 9) & 1) << 5); R = (st >> 1) * 16 + swz / 64; C = (st & 1) * 32 + (swz % 64) / 2; }
__host__ __device__ __forceinline__ int perm32(int rho) { const int n = rho >> 4, i = rho & 15; return 8 * (i >> 2) + 4 * n + (i & 3); }

struct Unit { int pm, pn, kb, nt, fl, tl; };
struct Gemm { const bf16_t* A; const bf16_t* Bt; int M, N, K, wb; float* skp; unsigned* skf; };

struct StaticOrder {
    static constexpr bool STREAM = false; int nM, nN, nwg, G, c, nt0;
    __host__ __device__ void init(int M, int N, int G_, int c_) { nM = M / BM; nN = N / BM; nwg = nM * nN; G = G_; c = c_; }
    __host__ __device__ bool next(int i, Unit& u) const {
        const long L = (long)i * G + c; if (L >= nwg) return false;
        int wgid = (int)L; { const int q = nwg / NXCD, r = nwg % NXCD, xcd = wgid % NXCD, off = wgid / NXCD; wgid = (xcd < r ? xcd * (q + 1) : r * (q + 1) + (xcd - r) * q) + off; }
        const int nig = WGM * nN, gid = wgid / nig, fm = gid * WGM, gsz = (nM - fm) < WGM ? (nM - fm) : WGM;
        u.pm = fm + ((wgid % nig) % gsz); u.pn = (wgid % nig) / gsz; u.kb = 0; u.nt = nt0; u.fl = 0; u.tl = 0; return true;
    }
    __device__ __forceinline__ void a_ready(const Unit&) const {}
    __device__ __forceinline__ void done(const Unit&) const {}
};
typedef __attribute__((address_space(1))) f32x4 gf32x4;
typedef unsigned long long u64_t;
__device__ __forceinline__ void streamk_store(const f32x4 (&acc)[2][2][4][2], const Unit& u, float* skp, unsigned* skf, int tid) {
    u64_t* q = (u64_t*)(skp + (size_t)u.tl * 65536) + 2 * tid;
#pragma unroll
    for (int a = 0; a < 2; ++a)
#pragma unroll
        for (int b = 0; b < 2; ++b)
#pragma unroll
            for (int m = 0; m < 4; ++m)
#pragma unroll
                for (int n = 0; n < 2; ++n) { const f32x4 v = acc[a][b][m][n];
                    __hip_atomic_store(q, ((u64_t)__float_as_uint(v[1]) << 32) | __float_as_uint(v[0]), __ATOMIC_RELAXED, __HIP_MEMORY_SCOPE_AGENT);
                    __hip_atomic_store(q + 1, ((u64_t)__float_as_uint(v[3]) << 32) | __float_as_uint(v[2]), __ATOMIC_RELAXED, __HIP_MEMORY_SCOPE_AGENT);
                    q += 1024; asm volatile("" : "+v"(q) :: "memory"); }
    asm volatile("s_waitcnt vmcnt(0)" ::: "memory");
    __builtin_amdgcn_s_barrier();
    if (tid == 0) __hip_atomic_store(skf + u.tl, 1u, __ATOMIC_RELAXED, __HIP_MEMORY_SCOPE_AGENT);
}
__device__ __forceinline__ const float* streamk_wait(const Unit& u, float* skp, unsigned* skf, int tid) {
    if (u.fl == 2) {
        if (tid == 0) { while (__hip_atomic_load(skf + u.tl, __ATOMIC_RELAXED, __HIP_MEMORY_SCOPE_AGENT) == 0u) __builtin_amdgcn_s_sleep(2); }
        __builtin_amdgcn_s_barrier();
        __builtin_amdgcn_fence(__ATOMIC_ACQUIRE, "agent");
    } else __builtin_amdgcn_s_barrier();
    return skp + (size_t)u.tl * 65536;
}
__device__ __forceinline__ f32x4 streamk_part(const float* part, int idx, int tid) {
    const u64_t* q = (const u64_t*)part + (size_t)idx * 1024 + 2 * tid;
    const u64_t a = __hip_atomic_load(q, __ATOMIC_RELAXED, __HIP_MEMORY_SCOPE_AGENT), b = __hip_atomic_load(q + 1, __ATOMIC_RELAXED, __HIP_MEMORY_SCOPE_AGENT);
    return (f32x4){__uint_as_float((unsigned)a), __uint_as_float((unsigned)(a >> 32)), __uint_as_float((unsigned)b), __uint_as_float((unsigned)(b >> 32))};
}
template <class Epi, class Sched, bool ALIGN_EPI = false, bool SP2 = false>
__device__ __forceinline__ void gemm_phase(PG8_LAS unsigned char* lds, const Gemm g, const Sched& S, const Epi& E) {
    int tid = g.wb + lane_now(); asm volatile("" : "+v"(tid)); const int wid = __builtin_amdgcn_readfirstlane(tid >> 6), lane = tid & 63, wr = wid >> 2, wc = wid & 3, fr = lane & 15, fq = lane >> 4;
    const int K = g.K, nt = K / BK;
    unsigned voffA[2], voffB[2];
#pragma unroll
    for (int i = 0; i < 2; ++i) { int R, C; stage_rc(tid * 16 + i * 8192, R, C); const int Rb = Epi::PERM ? ((R & ~31) + perm32(R & 31)) : R;
        voffA[i] = (unsigned)(R * K + C) * 2u; voffB[i] = (unsigned)(Rb * K + C) * 2u; }
    const size_t kstep = (size_t)(BK * 2);
    const size_t hstep = (size_t)HALF * K * 2;
    const size_t tstep = 2 * hstep;
    const unsigned ldsw = (unsigned)wid * 1024u;
    const int aoff = lds_byte(wr * 64 + fr, fq * 8), boff = lds_byte(wc * 32 + fr, fq * 8);
#define PG8_SA(b, h) (((b) * 2 + (h)) * HTB)
#define PG8_SB(b, h) ((4 + (b) * 2 + (h)) * HTB)
#define PG8_STAGE(bufoff, gbase, voff) do { _Pragma("unroll") for (int _i = 0; _i < 2; ++_i) \
        __builtin_amdgcn_global_load_lds((const unsigned*)((const char*)(gbase) + (voff)[_i]), (PG8_LAS unsigned*)(lds + (bufoff) + ldsw + _i * 8192), 16, 0, 0); } while (0)
#define PG8_LDA(dst, b, h) do { _Pragma("unroll") for (int m = 0; m < 4; ++m) _Pragma("unroll") for (int k = 0; k < 2; ++k) dst[m][k] = *(const PG8_LAS bf16x8*)(lds + PG8_SA(b, h) + aoff + m * 2048 + k * 1024); } while (0)
#define PG8_LDB(dst, b, h) do { _Pragma("unroll") for (int n = 0; n < 2; ++n) _Pragma("unroll") for (int k = 0; k < 2; ++k) dst[n][k] = *(const PG8_LAS bf16x8*)(lds + PG8_SB(b, h) + boff + n * 2048 + k * 1024); } while (0)
#define PG8_MMA(ai, bj, At, Bt) do { __builtin_amdgcn_s_setprio(1); _Pragma("unroll") for (int m = 0; m < 4; ++m) _Pragma("unroll") for (int n = 0; n < 2; ++n) _Pragma("unroll") for (int k = 0; k < 2; ++k) \
        acc[ai][bj][m][n] = __builtin_amdgcn_mfma_f32_16x16x32_bf16(Bt[n][k], At[m][k], acc[ai][bj][m][n], 0, 0, 0); __builtin_amdgcn_s_setprio(0); } while (0)
#define PG8_WAIT_V(n) asm volatile("s_waitcnt vmcnt(" #n ")" ::: "memory")
#define PG8_WAIT_L(n) asm volatile("s_waitcnt lgkmcnt(" #n ")" ::: "memory")
#define PG8_BAR __builtin_amdgcn_s_barrier()
#define PG8_SCHED __builtin_amdgcn_sched_barrier(0)
    Unit cur, nxt; int ui = 0;
    if (!S.next(0, cur)) return;
    f32x4 acc[2][2][4][2];
#pragma unroll
    for (int a = 0; a < 2; ++a)
#pragma unroll
        for (int b = 0; b < 2; ++b)
#pragma unroll
            for (int m = 0; m < 4; ++m)
#pragma unroll
                for (int n = 0; n < 2; ++n) acc[a][b][m][n] = (f32x4){0.f, 0.f, 0.f, 0.f};
    bf16x8 At[4][2], B0[2][2], B1[2][2];
    const char* cA = (const char*)g.A + (size_t)cur.pm * tstep + cur.kb; const char* cB = (const char*)g.Bt + (size_t)cur.pn * tstep + cur.kb;
    S.a_ready(cur);
    if constexpr (SP2) {
        PG8_STAGE(PG8_SB(0, 0), cB, voffB); PG8_STAGE(PG8_SB(0, 1), cB + hstep, voffB); PG8_STAGE(PG8_SA(0, 0), cA, voffA); PG8_STAGE(PG8_SA(0, 1), cA + hstep, voffA);
        if (wr == 1) PG8_BAR;
        PG8_WAIT_V(2); PG8_BAR;
        PG8_STAGE(PG8_SB(1, 0), cB + kstep, voffB); PG8_STAGE(PG8_SA(1, 0), cA + kstep, voffA); PG8_STAGE(PG8_SB(1, 1), cB + hstep + kstep, voffB);
        PG8_WAIT_V(6); PG8_BAR;
    } else {
        PG8_STAGE(PG8_SB(0, 0), cB, voffB); PG8_STAGE(PG8_SA(0, 0), cA, voffA); PG8_STAGE(PG8_SB(0, 1), cB + hstep, voffB); PG8_STAGE(PG8_SA(0, 1), cA + hstep, voffA);
        if (wr == 1) PG8_BAR;
        PG8_WAIT_V(4); PG8_BAR;
        PG8_STAGE(PG8_SB(1, 0), cB + kstep, voffB); PG8_STAGE(PG8_SA(1, 0), cA + kstep, voffA); PG8_STAGE(PG8_SB(1, 1), cB + hstep + kstep, voffB);
        PG8_WAIT_V(6); PG8_BAR;
    }
    for (;;) {
        const bool has_next = S.next(ui + 1, nxt);
        const char* nA = has_next ? (const char*)g.A + (size_t)nxt.pm * tstep + nxt.kb : cA; const char* nB = has_next ? (const char*)g.Bt + (size_t)nxt.pn * tstep + nxt.kb : cB;
        const int ntu = cur.nt;
        for (int t = 0; t < ntu; t += 2) {
            const bool last = (t == ntu - 2);
            const char* a1 = cA + (size_t)(t + 1) * kstep;
            const char* a2 = last ? nA : cA + (size_t)(t + 2) * kstep; const char* b2 = last ? nB : cB + (size_t)(t + 2) * kstep;
            const char* a3 = a2 + kstep; const char* b3 = b2 + kstep;
            if (last && has_next) S.a_ready(nxt);
            if constexpr (SP2) {
            PG8_LDB(B0, 0, 0); PG8_LDB(B1, 0, 1); PG8_SCHED; PG8_LDA(At, 0, 0); PG8_STAGE(PG8_SA(1, 1), a1 + hstep, voffA);
            PG8_WAIT_V(8); PG8_WAIT_L(0); PG8_BAR; PG8_MMA(0, 0, At, B0); PG8_MMA(0, 1, At, B1); PG8_BAR; PG8_SCHED;
            PG8_LDA(At, 0, 1); PG8_STAGE(PG8_SB(0, 0), b2, voffB); PG8_STAGE(PG8_SB(0, 1), b2 + hstep, voffB); PG8_STAGE(PG8_SA(0, 0), a2, voffA);
            PG8_WAIT_V(8); PG8_WAIT_L(0); PG8_BAR; PG8_MMA(1, 0, At, B0); PG8_MMA(1, 1, At, B1); PG8_BAR; PG8_SCHED;
            PG8_LDB(B0, 1, 0); PG8_LDB(B1, 1, 1); PG8_SCHED; PG8_LDA(At, 1, 0); PG8_STAGE(PG8_SA(0, 1), a2 + hstep, voffA);
            PG8_WAIT_V(8); PG8_WAIT_L(0); PG8_BAR; PG8_MMA(0, 0, At, B0); PG8_MMA(0, 1, At, B1); PG8_BAR; PG8_SCHED;
            PG8_LDA(At, 1, 1); PG8_STAGE(PG8_SB(1, 0), b3, voffB); PG8_STAGE(PG8_SB(1, 1), b3 + hstep, voffB); PG8_STAGE(PG8_SA(1, 0), a3, voffA);
            PG8_WAIT_V(8); PG8_WAIT_L(0); PG8_BAR; PG8_MMA(1, 0, At, B0); PG8_MMA(1, 1, At, B1); PG8_BAR; PG8_SCHED;
            } else {
            PG8_LDB(B0, 0, 0); PG8_SCHED; PG8_LDA(At, 0, 0); PG8_STAGE(PG8_SA(1, 1), a1 + hstep, voffA);
            PG8_WAIT_L(8); PG8_BAR; PG8_WAIT_L(0); PG8_MMA(0, 0, At, B0); PG8_BAR; PG8_SCHED;
            PG8_LDB(B1, 0, 1); PG8_STAGE(PG8_SB(0, 0), b2, voffB);
            PG8_BAR; PG8_WAIT_L(0); PG8_MMA(0, 1, At, B1); PG8_BAR;
            PG8_LDA(At, 0, 1); PG8_STAGE(PG8_SA(0, 0), a2, voffA);
            PG8_BAR; PG8_WAIT_L(0); PG8_MMA(1, 0, At, B0); PG8_BAR; PG8_SCHED;
            PG8_STAGE(PG8_SB(0, 1), b2 + hstep, voffB);
            PG8_WAIT_V(6); PG8_BAR; PG8_MMA(1, 1, At, B1); PG8_BAR;
            PG8_LDB(B0, 1, 0); PG8_SCHED; PG8_LDA(At, 1, 0); PG8_STAGE(PG8_SA(0, 1), a2 + hstep, voffA);
            PG8_WAIT_L(8); PG8_BAR; PG8_WAIT_L(0); PG8_MMA(0, 0, At, B0); PG8_BAR; PG8_SCHED;
            PG8_LDB(B1, 1, 1); PG8_STAGE(PG8_SB(1, 0), b3, voffB);
            PG8_BAR; PG8_WAIT_L(0); PG8_MMA(0, 1, At, B1); PG8_BAR;
            PG8_LDA(At, 1, 1); PG8_STAGE(PG8_SA(1, 0), a3, voffA);
            PG8_BAR; PG8_WAIT_L(0); PG8_MMA(1, 0, At, B0); PG8_BAR; PG8_SCHED;
            PG8_STAGE(PG8_SB(1, 1), b3 + hstep, voffB);
            PG8_WAIT_V(6); PG8_BAR; PG8_MMA(1, 1, At, B1); PG8_BAR;
            }
        }
        if constexpr (ALIGN_EPI) { if (wr == 0) PG8_BAR; }
        if constexpr (!Epi::AFTER_DRAIN) { int t_ = g.wb + lane_now(); asm volatile("" : "+v"(t_)); const int fr_ = t_ & 15, fq_ = (t_ >> 4) & 3; if constexpr (!Sched::STREAM) E(acc, cur, wr, wc, fr_, fq_); else { if (cur.fl == 1) streamk_store(acc, cur, g.skp, g.skf, t_); else { const float* part_ = streamk_wait(cur, g.skp, g.skf, t_); int t2_ = g.wb + lane_now(); asm volatile("" : "+v"(t2_)); E(acc, cur, wr, wc, t2_ & 15, (t2_ >> 4) & 3, part_, t2_); } } S.done(cur); }
        if (!has_next) break;
#pragma unroll
        for (int a = 0; a < 2; ++a)
#pragma unroll
            for (int b = 0; b < 2; ++b)
#pragma unroll
                for (int m = 0; m < 4; ++m)
#pragma unroll
                    for (int n = 0; n < 2; ++n) acc[a][b][m][n] = (f32x4){0.f, 0.f, 0.f, 0.f};
        cur = nxt; cA = nA; cB = nB; ++ui;
        if constexpr (ALIGN_EPI) { if (wr == 1) PG8_BAR; }
    }
    PG8_WAIT_V(0);
    if constexpr (!ALIGN_EPI) { if (wr == 0) PG8_BAR; }
    PG8_BAR;
    if constexpr (Epi::AFTER_DRAIN) { E.fused(acc, cur, wr, wc, fr, fq, lds, wid, lane); S.done(cur); }
#undef PG8_SA
#undef PG8_SB
#undef PG8_STAGE
#undef PG8_LDA
#undef PG8_LDB
#undef PG8_MMA
#undef PG8_WAIT_V
#undef PG8_WAIT_L
#undef PG8_BAR
#undef PG8_SCHED
}
}

#define LAS __attribute__((address_space(3)))
typedef unsigned short bf16_t;
typedef short bf16x8 __attribute__((ext_vector_type(8)));
typedef float f32x4 __attribute__((ext_vector_type(4)));
typedef float f32x2 __attribute__((ext_vector_type(2)));
typedef float f32x16 __attribute__((ext_vector_type(16)));
typedef unsigned u32x4 __attribute__((ext_vector_type(4)));
typedef unsigned u32x2 __attribute__((ext_vector_type(2)));

constexpr int D = 1024, NH = 16, HD = 64;
constexpr int BP = 8, TP = 2064, SEQP = 2048, NMETA = 16, BS = 16, TS = 64, PAST = 4096;
constexpr int MPR = BP * TP;
constexpr int MR = MPR + BS * TS;
constexpr int MP = 17664;
constexpr int NTM = 69;
constexpr int DFF = 2752, DFFP = 2816, NIN = 5632;
constexpr float RMS_EPS = 1e-6f, GN_EPS = 64e-5f;
constexpr float LOG2E = 1.4426950408889634f;

constexpr size_t O_YP = 0, O_YS = 16777216, O_SP = 17825792, O_SHP = 18350080, O_KP = 18358272, O_VP = 35266560,
                 O_SS = 52174848, O_SHS = 53223424, O_KS = 53239808, O_VS = 54288384, O_END = 55336960;

constexpr size_t SZ_ROWBF = (size_t)MP * D * 2, SZ_ROWF = (size_t)MP * D * 4;
constexpr size_t W_X = 0;
constexpr size_t W_XN = W_X + SZ_ROWF;
constexpr size_t W_HB = W_XN + SZ_ROWBF;
constexpr size_t W_WIN = W_HB + (size_t)MP * DFFP * 2;
constexpr size_t SZ_WIN1 = (size_t)NIN * D * 2, SZ_WOUT1 = (size_t)D * DFFP * 2;
constexpr size_t W_WOUT = W_WIN + 4 * SZ_WIN1;
constexpr size_t W_WG1 = W_WOUT + 4 * SZ_WOUT1;
constexpr size_t W_WL2 = W_WG1 + (size_t)3584 * D * 2;
constexpr size_t W_WO1 = W_WL2 + (size_t)3072 * 256 * 2;
constexpr size_t W_WQKV = W_WO1 + (size_t)D * D * 2;
constexpr size_t W_WO2 = W_WQKV + (size_t)3 * D * D * 2;
constexpr size_t W_AALL = W_WO2 + (size_t)D * D * 2;
constexpr size_t W_RKV = W_AALL + 5 * SZ_ROWBF;
constexpr size_t W_L1 = W_RKV + 3 * SZ_ROWBF;
constexpr size_t W_A2 = W_L1 + (size_t)2 * MP * 256 * 4;
constexpr size_t W_DEC = W_A2 + (size_t)MP * 256 * 2;
constexpr size_t W_AA = W_DEC + SZ_ROWBF;
constexpr size_t W_GG = W_AA + SZ_ROWBF;
constexpr size_t W_SO = W_GG + SZ_ROWBF;
constexpr size_t W_OG = W_SO + SZ_ROWF;
constexpr size_t W_QB = W_OG + SZ_ROWBF;
constexpr size_t W_RSQ = W_QB + SZ_ROWBF;
constexpr size_t W_SKF = W_RSQ + (size_t)5 * MP * 4;
constexpr size_t W_SKP = W_SKF + 64 * 1024 * 4;
constexpr size_t W_BAR = W_SKP + (size_t)277 * 262144;
constexpr size_t W_END = W_BAR + 16384;

struct Params { const float* in[31]; float* out; unsigned char* ws; int ph_lo, ph_hi; int seq[64]; };
typedef const Params __attribute__((address_space(4)))* KP;

__device__ __forceinline__ unsigned cvt_pk(float lo, float hi) { unsigned r; asm("v_cvt_pk_bf16_f32 %0, %1, %2" : "=v"(r) : "v"(lo), "v"(hi)); return r; }
__device__ __forceinline__ void store_bf4(bf16_t* p, f32x4 v) { u32x2 w; w.x = cvt_pk(v[0], v[1]); w.y = cvt_pk(v[2], v[3]); *(u32x2*)p = w; }
__device__ __forceinline__ float bf_lo(unsigned w) { return __uint_as_float(w << 16); }
__device__ __forceinline__ float bf_hi(unsigned w) { return __uint_as_float(w & 0xffff0000u); }
__device__ __forceinline__ float sigmoidf_(float x) { return __builtin_amdgcn_rcpf(1.f + __expf(-x)); }
__device__ __forceinline__ float softplusf_(float x) { return fmaxf(x, 0.f) + __logf(1.f + __expf(-fabsf(x))); }
__device__ __forceinline__ float shx(float v, int o, int lane) { return __builtin_bit_cast(float, __builtin_amdgcn_ds_bpermute((lane ^ o) << 2, __builtin_bit_cast(int, v))); }
__device__ __forceinline__ float wave_sum(float v, int lane) {
#pragma unroll
    for (int o = 1; o < 64; o <<= 1) v += shx(v, o, lane);
    return v;
}
__device__ __forceinline__ void row_bt(int row, int& grp, int& b, int& t) { if (row < MPR) { grp = 0; b = row / TP; t = row - b * TP; } else { grp = 1; const int r = row - MPR; b = r >> 6; t = r & 63; } }

using pg8::Unit;
extern __shared__ __attribute__((aligned(16))) unsigned char lds_raw[];
struct EpiSwiGLU {
    static constexpr bool PERM = true, AFTER_DRAIN = false;
    bf16_t* HB; const float* rsq;
    __device__ __forceinline__ void operator()(const f32x4 (&acc)[2][2][4][2], const Unit& u, int wr, int wc, int fr, int fq) const {
        const int row0 = u.pm * 256 + wr * 64 + fr, col0 = u.pn * 128 + wc * 32 + 8 * fq;
#pragma unroll
        for (int ai = 0; ai < 2; ++ai)
#pragma unroll
            for (int m = 0; m < 4; ++m) {
                bf16_t* rowp = HB + (size_t)(row0 + ai * 128 + m * 16) * DFFP + col0;
                const float rs = __builtin_amdgcn_rsqf(rsq[row0 + ai * 128 + m * 16] * (1.f / D) + RMS_EPS);
                float hv[8];
#pragma unroll
                for (int n = 0; n < 2; ++n)
#pragma unroll
                    for (int j = 0; j < 4; ++j) { const float g = acc[ai][0][m][n][j] * rs, up = acc[ai][1][m][n][j] * rs; hv[n * 4 + j] = g * sigmoidf_(g) * up; }
                u32x4 w; w.x = cvt_pk(hv[0], hv[1]); w.y = cvt_pk(hv[2], hv[3]); w.z = cvt_pk(hv[4], hv[5]); w.w = cvt_pk(hv[6], hv[7]);
                *(u32x4*)rowp = w;
            }
    }
};
struct EpiRes {
    static constexpr bool PERM = false, AFTER_DRAIN = false;
    float* X; float scale; float* out; bf16_t* XB; float* rsq; float* spl;
    __device__ __forceinline__ void operator()(const f32x4 (&acc)[2][2][4][2], const Unit& u, int wr, int wc, int fr, int fq, const float* part = nullptr, int tid = 0) const {
        const bool hasp = u.fl == 2;
        if (u.fl == 1 && spl != nullptr) {
            const int t_ = (wr * 4 + wc) * 64 + fq * 16 + fr;
            f32x4* q = (f32x4*)(spl + (size_t)u.tl * 65536) + t_;
#pragma unroll
            for (int ai = 0; ai < 2; ++ai)
#pragma unroll
                for (int bj = 0; bj < 2; ++bj)
#pragma unroll
                    for (int m = 0; m < 4; ++m)
#pragma unroll
                        for (int n = 0; n < 2; ++n) q[(((ai * 2 + bj) * 4 + m) * 2 + n) * 512] = acc[ai][bj][m][n];
            return;
        }
        float* const X_ = X; float* const out_ = out; bf16_t* const XB_ = XB; float* const rsq_ = rsq; const float sc_ = scale;
        const int row0 = u.pm * 256 + wr * 64 + fr, col0 = u.pn * 256 + wc * 32 + 4 * fq, ln = fq * 16 + fr;
#pragma unroll
        for (int ai = 0; ai < 2; ++ai)
#pragma unroll
            for (int m = 0; m < 4; ++m) {
                const int row = row0 + ai * 128 + m * 16;
                const unsigned off = (unsigned)row * D + col0;
                if (out_ == nullptr) {
                    float ss = 0.f;
#pragma unroll
                    for (int bj = 0; bj < 2; ++bj)
#pragma unroll
                        for (int n = 0; n < 2; ++n) { f32x4* q = (f32x4*)(X_ + off + bj * 128 + n * 16); f32x4 av = acc[ai][bj][m][n]; if (hasp) av += pg8::streamk_part(part, ((ai * 2 + bj) * 4 + m) * 2 + n, tid); const f32x4 x = *q + av * sc_; *q = x;
                            if (XB_) { store_bf4(XB_ + off + bj * 128 + n * 16, x); ss += (x[0] * x[0] + x[1] * x[1]) + (x[2] * x[2] + x[3] * x[3]); } }
                    if (XB_) { ss += shx(ss, 16, ln); ss += shx(ss, 32, ln); if (fq == 0) unsafeAtomicAdd(rsq_ + row, ss); }
                } else if (row < MR) {
                    float* dp = nullptr;
                    if (row < MPR) { const int b = row / TP, t = row - b * TP; if (t >= NMETA) dp = out_ + O_YP + ((size_t)b * SEQP + (t - NMETA)) * D + col0; }
                    else dp = out_ + O_YS + (size_t)(row - MPR) * D + col0;
                    if (dp) {
#pragma unroll
                        for (int bj = 0; bj < 2; ++bj)
#pragma unroll
                            for (int n = 0; n < 2; ++n) { f32x4 av = acc[ai][bj][m][n]; if (hasp) av += pg8::streamk_part(part, ((ai * 2 + bj) * 4 + m) * 2 + n, tid); *(f32x4*)(dp + bj * 128 + n * 16) = *(const f32x4*)(X_ + off + bj * 128 + n * 16) + av * sc_; }
                    }
                }
                asm volatile("" ::: "memory");
            }
    }
};
struct TailSplitOrder {
    static constexpr bool STREAM = false;
    pg8::StaticOrder so; int G, c, ns, ntsplit;
    __device__ void init(int M, int N, int K, int G_, int c_, int ns_) { so.init(M, N, 1, 0); so.nt0 = K / 64; G = G_; c = c_; ns = ns_; ntsplit = so.nt0 / ns_; }
    __device__ bool next(int i, Unit& u) const {
        const int L = i * G + c;
        if (L < G && L < so.nwg) return so.next(L, u);
        const int L2 = L - G; if (so.nwg <= G || L2 < 0 || L2 >= (so.nwg - G) * ns) return false;
        const int j = L2 / ns, ch = L2 - j * ns;
        so.next(G + j, u); u.kb = ch * ntsplit * 128; u.nt = ntsplit; u.fl = 1; u.tl = L2; return true;
    }
    __device__ __forceinline__ void a_ready(const Unit&) const {}
    __device__ __forceinline__ void done(const Unit&) const {}
};
struct StreamOrder {
    static constexpr bool STREAM = true;
    int nN, ppt, c; long s, e;
    __device__ void init(int M, int N, int K, int G, int c_) {
        nN = N / 256; ppt = K / 128;
        c = (G % 8 == 0) ? (c_ % 8) * (G / 8) + c_ / 8 : c_;
        const long P = (long)(M / 256) * nN * ppt;
        s = (long)c * P / G; e = (long)(c + 1) * P / G;
    }
    __device__ bool next(int i, Unit& u) const {
        const int t = (int)(s / ppt) + i; const long t0 = (long)t * ppt;
        if (t0 >= e) return false;
        const long lo = s > t0 ? s : t0, hi = e < t0 + ppt ? e : t0 + ppt;
        u.pm = t / nN; u.pn = t - u.pm * nN; u.tl = t;
        u.kb = (int)(lo - t0) * 256; u.nt = (int)(hi - lo) * 2;
        u.fl = lo > t0 ? 1 : (hi < t0 + ppt ? 2 : 0);
        return true;
    }
    __device__ __forceinline__ void a_ready(const Unit&) const {}
    __device__ __forceinline__ void done(const Unit&) const {}
};
struct EpiG1 {
    static constexpr bool PERM = true, AFTER_DRAIN = false;
    bf16_t* RKV; float* L1;
    __device__ __forceinline__ void operator()(const f32x4 (&acc)[2][2][4][2], const Unit& u, int wr, int wc, int fr, int fq) const {
        const unsigned row0 = (unsigned)((u.pm % NTM) * 256 + wr * 64 + fr), cw = wc * 32 + 8 * fq;
        if (u.pn < 12) {
            bf16_t* base = RKV + (size_t)(u.pn >> 2) * MP * D;
            const unsigned off0 = row0 * D + (u.pn & 3) * 256 + cw;
#pragma unroll
            for (int ai = 0; ai < 2; ++ai)
#pragma unroll
                for (int m = 0; m < 4; ++m)
#pragma unroll
                    for (int bj = 0; bj < 2; ++bj) { const f32x4 v0 = acc[ai][bj][m][0], v1 = acc[ai][bj][m][1];
                        u32x4 w; w.x = cvt_pk(v0[0], v0[1]); w.y = cvt_pk(v0[2], v0[3]); w.z = cvt_pk(v1[0], v1[1]); w.w = cvt_pk(v1[2], v1[3]);
                        *(u32x4*)(base + (off0 + (unsigned)((ai * 128 + m * 16) * D + bj * 128))) = w; }
        } else {
            float* base = L1 + (size_t)(u.pn - 12) * MP * 256;
            const unsigned off0 = row0 * 256 + cw;
#pragma unroll
            for (int ai = 0; ai < 2; ++ai)
#pragma unroll
                for (int m = 0; m < 4; ++m)
#pragma unroll
                    for (int bj = 0; bj < 2; ++bj)
#pragma unroll
                        for (int n = 0; n < 2; ++n) *(f32x4*)(base + (off0 + (unsigned)((ai * 128 + m * 16) * 256 + bj * 128 + n * 4))) = acc[ai][bj][m][n];
        }
    }
};
struct EpiG2 {
    static constexpr bool PERM = true, AFTER_DRAIN = false;
    bf16_t* LW;
    __device__ __forceinline__ void operator()(const f32x4 (&acc)[2][2][4][2], const Unit& u, int wr, int wc, int fr, int fq) const {
        bf16_t* base = LW + (size_t)(u.pn >> 2) * MP * D;
        const unsigned off0 = (unsigned)(u.pm * 256 + wr * 64 + fr) * D + (u.pn & 3) * 256 + wc * 32 + 8 * fq;
#pragma unroll
        for (int ai = 0; ai < 2; ++ai)
#pragma unroll
            for (int m = 0; m < 4; ++m)
#pragma unroll
                for (int bj = 0; bj < 2; ++bj) { const f32x4 v0 = acc[ai][bj][m][0], v1 = acc[ai][bj][m][1];
                    u32x4 w; w.x = cvt_pk(v0[0], v0[1]); w.y = cvt_pk(v0[2], v0[3]); w.z = cvt_pk(v1[0], v1[1]); w.w = cvt_pk(v1[2], v1[3]);
                    *(u32x4*)(base + (off0 + (unsigned)((ai * 128 + m * 16) * D + bj * 128))) = w; }
    }
};
struct EpiQKV {
    static constexpr bool PERM = false, AFTER_DRAIN = false;
    bf16_t* QB; float* out; const float* qg; const float* kg; const float* rsq;
    __device__ __forceinline__ void operator()(const f32x4 (&acc)[2][2][4][2], const Unit& u, int wr, int wc, int fr, int fq) const {
        const int sec = u.pn >> 2, head = (u.pn & 3) * 4 + wc, row0 = u.pm * 256 + wr * 64 + fr;
        f32x4 gn[2][2];
#pragma unroll
        for (int bj = 0; bj < 2; ++bj)
#pragma unroll
            for (int n = 0; n < 2; ++n) { const int d = 32 * bj + 16 * n + 4 * fq;
                gn[bj][n] = sec == 0 ? *(const f32x4*)(qg + d) * 0.125f : (sec == 1 ? *(const f32x4*)(kg + d) : (f32x4){1.f, 1.f, 1.f, 1.f}); }
#pragma unroll
        for (int ai = 0; ai < 2; ++ai)
#pragma unroll
            for (int m = 0; m < 4; ++m) {
                const int row = row0 + ai * 128 + m * 16;
                const float rx = __builtin_amdgcn_rsqf(rsq[row] * (1.f / D) + RMS_EPS);
                float ss = 0.f;
#pragma unroll
                for (int bj = 0; bj < 2; ++bj)
#pragma unroll
                    for (int n = 0; n < 2; ++n) { const f32x4 x = acc[ai][bj][m][n]; ss += (x[0] * x[0] + x[1] * x[1]) + (x[2] * x[2] + x[3] * x[3]); }
                { const int ln = fq * 16 + fr; ss += shx(ss, 16, ln); ss += shx(ss, 32, ln); }
                const float rs = rx * (sec == 2 ? 1.f : __builtin_amdgcn_rsqf(ss * rx * rx * (1.f / 64.f) + RMS_EPS));
                if (row < MR) {
                    if (sec == 0) {
                        bf16_t* qp = QB + (size_t)row * D + head * 64 + 4 * fq;
#pragma unroll
                        for (int bj = 0; bj < 2; ++bj)
#pragma unroll
                            for (int n = 0; n < 2; ++n) { const f32x4 x = acc[ai][bj][m][n] * rs * gn[bj][n]; u32x2 w; w.x = cvt_pk(x[0], x[1]); w.y = cvt_pk(x[2], x[3]); *(u32x2*)(qp + 32 * bj + 16 * n) = w; }
                    } else {
                        int grp, b, t; row_bt(row, grp, b, t);
                        float* dp = grp == 0 ? out + (sec == 1 ? O_KP : O_VP) + (((size_t)b * NH + head) * TP + t) * HD
                                             : out + (sec == 1 ? O_KS : O_VS) + (((size_t)b * NH + head) * TS + t) * HD;
                        dp += 4 * fq;
#pragma unroll
                        for (int bj = 0; bj < 2; ++bj)
#pragma unroll
                            for (int n = 0; n < 2; ++n) *(f32x4*)(dp + 32 * bj + 16 * n) = acc[ai][bj][m][n] * rs * gn[bj][n];
                    }
                }
            }
    }
};
struct G1Order {
    static constexpr bool STREAM = false;
    int G, c;
    __device__ bool next(int i, Unit& u) const {
        const long L = (long)i * G + c; if (L >= 966) return false;
        int w = (int)L; { const int q = 966 / 8, r = 966 % 8, xcd = w % 8, off = w / 8; w = (xcd < r ? xcd * (q + 1) : r * (q + 1) + (xcd - r) * q) + off; }
        const int pm = w / 14, q = w % 14;
        if (q < 12) { u.pm = (q >> 2) * NTM + pm; u.pn = q; } else { u.pm = (q - 9) * NTM + pm; u.pn = q; }
        u.kb = 0; u.nt = 16; u.fl = 0; u.tl = 0;
        return true;
    }
    __device__ __forceinline__ void a_ready(const Unit&) const {}
    __device__ __forceinline__ void done(const Unit&) const {}
};

struct Job { const float* src; bf16_t* dst; const float* mu; int ld, Ksrc, koff, Kdst, rows, map, smode; };
__device__ __forceinline__ int srccol(int map, int n, int ld) {
    if (map == 0) return n < ld ? n : -1;
    if (map == 1) { const int pn = n >> 8, c = n & 255, bj = c >> 7, j = c & 127, hc = pn * 128 + j; return hc < DFF ? (bj ? DFF + hc : hc) : -1; }
    { const int t = n >> 8, c = n & 255, bj = c >> 7, wc = (c & 127) >> 5, i = c & 31; return t * 256 + 64 * wc + 32 * bj + i; }
}
__device__ __forceinline__ Job get_job(KP p, int j) {
    Job J; J.mu = nullptr; J.koff = 0; J.map = 0; J.smode = 0;
    unsigned char* ws = p->ws;
    if (j < 4) { J.src = p->in[8] + (size_t)j * D * 2 * DFF; J.dst = (bf16_t*)(ws + W_WIN + j * SZ_WIN1); J.ld = 2 * DFF; J.Ksrc = D; J.Kdst = D; J.rows = NIN; J.map = 1; J.mu = p->in[7] + (size_t)j * D; J.smode = 2; }
    else if (j < 8) { const int i = j - 4; J.src = p->in[9] + (size_t)i * DFF * D; J.dst = (bf16_t*)(ws + W_WOUT + i * SZ_WOUT1); J.ld = D; J.Ksrc = DFF; J.Kdst = DFFP; J.rows = D; }
    else if (j < 11) { const int g = j - 8; J.src = p->in[12] + (size_t)g * D * D; J.dst = (bf16_t*)(ws + W_WG1) + (size_t)g * D * D; J.ld = D; J.Ksrc = D; J.Kdst = D; J.rows = D; }
    else if (j < 17) { const int idx = j - 11, part = idx / 3, which = idx % 3;
        J.src = which == 0 ? p->in[14] : (which == 1 ? p->in[17] : p->in[19]); J.ld = which == 2 ? 128 : 64; J.rows = J.ld;
        J.mu = p->in[11] + (which == 0 ? 1 : (which == 1 ? 4 : 5)) * D; J.smode = part + 1;
        J.dst = (bf16_t*)(ws + W_WG1) + (size_t)(3072 + part * 256 + which * 64) * D; J.Ksrc = D; J.Kdst = D; }
    else if (j < 20) { const int which = j - 17; J.src = which == 0 ? p->in[15] : (which == 1 ? p->in[18] : p->in[20]); J.ld = D; J.rows = D;
        J.Ksrc = which == 2 ? 128 : 64; J.koff = which * 64; J.Kdst = 256; J.dst = (bf16_t*)(ws + W_WL2) + (size_t)which * D * 256; }
    else if (j == 20) { J.src = p->in[26]; J.dst = (bf16_t*)(ws + W_WO1); J.ld = D; J.Ksrc = D; J.Kdst = D; J.rows = D; }
    else if (j == 21) { J.src = p->in[27]; J.dst = (bf16_t*)(ws + W_WQKV); J.ld = 3 * D; J.Ksrc = D; J.Kdst = D; J.rows = 3 * D; J.map = 2; J.mu = p->in[10] + D; J.smode = 2; }
    else { J.src = p->in[30]; J.dst = (bf16_t*)(ws + W_WO2); J.ld = D; J.Ksrc = D; J.Kdst = D; J.rows = D; }
    return J;
}
__device__ __forceinline__ void convert_weights(KP p, LAS float* tl, int tid, int bid, int G) {
    int rot = 0;
    for (int j = 0; j < 23; ++j) {
        const Job J = get_job(p, j);
        const int nkt = J.Kdst >> 6, nnt = (J.rows + 255) >> 8, ntile = nnt * nkt;
        int first = bid - rot; if (first < 0) first += G;
        for (int t = first; t < ntile; t += G) {
            const int n0 = (t / nkt) << 8, k0 = (t % nkt) << 6;
            const bool inside = k0 >= J.koff && k0 < J.koff + J.Ksrc;
            if (inside) {
                const int nn = tid & 255, kh = tid >> 8;
                const int sc = (n0 + nn) < J.rows ? srccol(J.map, n0 + nn, J.ld) : -1;
                const float* sp = J.src + (size_t)(k0 - J.koff + kh) * J.ld + (sc >= 0 ? sc : 0);
                float v[32];
#pragma unroll
                for (int it = 0; it < 32; ++it) v[it] = sc >= 0 ? sp[(size_t)(2 * it) * J.ld] : 0.f;
                if (J.smode) {
#pragma unroll
                    for (int it = 0; it < 32; ++it) { const float m = J.mu[k0 - J.koff + kh + 2 * it]; v[it] *= J.smode == 1 ? 1.f - m : m; }
                }
#pragma unroll
                for (int it = 0; it < 32; ++it) tl[(kh + 2 * it) * 257 + nn] = v[it];
            }
            __syncthreads();
            {
                const int nn = tid >> 1, kh = (tid & 1) * 32;
                if (n0 + nn < J.rows) {
                    bf16_t* dp = J.dst + (size_t)(n0 + nn) * J.Kdst + k0 + kh;
#pragma unroll
                    for (int q = 0; q < 4; ++q) {
                        const unsigned z_ = (unsigned)tid >> 31;
                        u32x4 w = (u32x4){z_, z_, z_, z_};
                        if (inside) { float v[8];
#pragma unroll
                            for (int e = 0; e < 8; ++e) v[e] = tl[(kh + q * 8 + e) * 257 + nn];
                            w.x = cvt_pk(v[0], v[1]); w.y = cvt_pk(v[2], v[3]); w.z = cvt_pk(v[4], v[5]); w.w = cvt_pk(v[6], v[7]); }
                        *(u32x4*)(dp + q * 8) = w;
                    }
                }
            }
            __syncthreads();
        }
        rot = (rot + ntile) % G;
    }
}
__device__ __forceinline__ float row_rstd(const f32x4 (&v)[4], int lane) {
    float s = 0.f;
#pragma unroll
    for (int i = 0; i < 4; ++i) s += (v[i][0] * v[i][0] + v[i][1] * v[i][1]) + (v[i][2] * v[i][2] + v[i][3] * v[i][3]);
    s = wave_sum(s, lane);
    return __builtin_amdgcn_rsqf(s * (1.f / D) + RMS_EPS);
}

__device__ __forceinline__ void assemble_x(KP p, int tid, int bid, int G) {
    const int lane = tid & 63, gw = bid * 8 + (tid >> 6), nw = G * 8;
    float* X = (float*)(p->ws + W_X); bf16_t* XN = (bf16_t*)(p->ws + W_XN);
    for (int row = gw; row < MP; row += nw) {
        f32x4 v[4];
        const float* src = nullptr;
        if (row < MPR) { const int b = row / TP, t = row - b * TP; src = t < NMETA ? p->in[6] + (size_t)t * D : p->in[0] + ((size_t)b * SEQP + (t - NMETA)) * D; }
        else if (row < MR) src = p->in[1] + (size_t)(row - MPR) * D;
#pragma unroll
        for (int i = 0; i < 4; ++i) { const float zf = __uint_as_float((unsigned)tid >> 31); v[i] = src ? *(const f32x4*)(src + lane * 4 + 256 * i) : (f32x4){zf, zf, zf, zf}; }
        float ssq = 0.f;
#pragma unroll
        for (int i = 0; i < 4; ++i) ssq += (v[i][0] * v[i][0] + v[i][1] * v[i][1]) + (v[i][2] * v[i][2] + v[i][3] * v[i][3]);
        ssq = wave_sum(ssq, lane);
#pragma unroll
        for (int i = 0; i < 4; ++i) { const int c = lane * 4 + 256 * i; *(f32x4*)(X + (size_t)row * D + c) = v[i]; store_bf4(XN + (size_t)row * D + c, v[i]); }
        float* rsq = (float*)(p->ws + W_RSQ);
        if (lane < 5) rsq[(size_t)lane * MP + row] = lane == 0 ? ssq : 0.f;
    }    for (int i = gw * 64 + lane; i < 64 * 1024; i += nw * 64) ((unsigned*)(p->ws + W_SKF))[i] = 0u;
    for (int i = gw * 64 + lane; i < 65536; i += nw * 64) ((float*)(p->ws + W_SKP) + (size_t)276 * 65536)[i] = 0.f;
}
__device__ __forceinline__ void norm_phase(KP p, const float* g, int tid, int bid, int G, bool copy_y = false) {
    const int lane = tid & 63, gw = bid * 8 + (tid >> 6), nw = G * 8;
    const float* X = (const float*)(p->ws + W_X); bf16_t* XN = (bf16_t*)(p->ws + W_XN);
    for (int row = gw; row < MP; row += nw) {
        f32x4 v[4];
#pragma unroll
        for (int i = 0; i < 4; ++i) v[i] = *(const f32x4*)(X + (size_t)row * D + lane * 4 + 256 * i);
        const float rs = row_rstd(v, lane);
#pragma unroll
        for (int i = 0; i < 4; ++i) { const int c = lane * 4 + 256 * i; store_bf4(XN + (size_t)row * D + c, v[i] * rs * *(const f32x4*)(g + c)); }
        if (copy_y && row < MR) {
            float* dp = nullptr;
            if (row < MPR) { const int b = row / TP, t = row - b * TP; if (t >= NMETA) dp = p->out + O_YP + ((size_t)b * SEQP + (t - NMETA)) * D; }
            else dp = p->out + O_YS + (size_t)(row - MPR) * D;
            if (dp) {
#pragma unroll
                for (int i = 0; i < 4; ++i) *(f32x4*)(dp + lane * 4 + 256 * i) = v[i];
            }
        }
    }
}
__device__ __forceinline__ void mixprep_phase(KP p, int tid, int bid, int G) {
    const int lane = tid & 63, gw = bid * 8 + (tid >> 6), nw = G * 8;
    const float* X = (const float*)(p->ws + W_X); bf16_t* A = (bf16_t*)(p->ws + W_AALL);
    const float* g = p->in[10]; const float* mu = p->in[11];
    for (int row = gw; row < MR; row += nw) {
        int grp, b, t; row_bt(row, grp, b, t);
        f32x4 v[4], pv[4];
#pragma unroll
        for (int i = 0; i < 4; ++i) v[i] = *(const f32x4*)(X + (size_t)row * D + lane * 4 + 256 * i);
        const float rs = row_rstd(v, lane);
        if (t > 0) {
#pragma unroll
            for (int i = 0; i < 4; ++i) pv[i] = *(const f32x4*)(X + (size_t)(row - 1) * D + lane * 4 + 256 * i);
            const float rp = row_rstd(pv, lane);
#pragma unroll
            for (int i = 0; i < 4; ++i) pv[i] = pv[i] * rp * *(const f32x4*)(g + lane * 4 + 256 * i);
        } else {
#pragma unroll
            for (int i = 0; i < 4; ++i) { const float zf = __uint_as_float((unsigned)tid >> 31); pv[i] = grp == 0 ? (f32x4){zf, zf, zf, zf} : *(const f32x4*)(p->in[3] + (size_t)b * D + lane * 4 + 256 * i); }
        }
        const bool last = t == (grp == 0 ? TP - 1 : TS - 1);
        float* sh = grp == 0 ? p->out + O_SHP + (size_t)b * D : p->out + O_SHS + (size_t)b * D;
#pragma unroll
        for (int i = 0; i < 4; ++i) {
            const int c = lane * 4 + 256 * i; const size_t o = (size_t)row * D + c;
            const f32x4 h = v[i] * rs * *(const f32x4*)(g + c), dx = pv[i] - h;
            store_bf4(A + o, h + dx * *(const f32x4*)(mu + c));
            store_bf4(A + (size_t)MP * D + o, h + dx * *(const f32x4*)(mu + 2 * D + c));
            store_bf4(A + (size_t)2 * MP * D + o, h + dx * *(const f32x4*)(mu + 3 * D + c));
            store_bf4(A + (size_t)3 * MP * D + o, h);
            store_bf4(A + (size_t)4 * MP * D + o, pv[i]);
            if (last) *(f32x4*)(sh + c) = h;
        }
    }
}
__device__ __forceinline__ void act_phase(KP p, int gtid, int nthr) {
    const float* L1 = (const float*)(p->ws + W_L1); bf16_t* A2 = (bf16_t*)(p->ws + W_A2);
    for (int i = gtid; i < MP * 64; i += nthr) {
        const int c = (i & 63) * 4;
        f32x4 v = *(const f32x4*)(L1 + (size_t)i * 4) + *(const f32x4*)(L1 + (size_t)MP * 256 + (size_t)i * 4);
        if (c < 64) {
#pragma unroll
            for (int j = 0; j < 4; ++j) v[j] = 1.f - 2.f * __builtin_amdgcn_rcpf(1.f + __expf(2.f * v[j]));
        } else if (c >= 128) {
#pragma unroll
            for (int j = 0; j < 4; ++j) v[j] = sigmoidf_(v[j]);
        }
        store_bf4(A2 + (size_t)i * 4, v);
    }
}

__device__ __forceinline__ float dpp_sum16(float x) {
    x += __builtin_bit_cast(float, __builtin_amdgcn_update_dpp(0, __builtin_bit_cast(int, x), 0xB1, 0xF, 0xF, true));
    x += __builtin_bit_cast(float, __builtin_amdgcn_update_dpp(0, __builtin_bit_cast(int, x), 0x4E, 0xF, 0xF, true));
    x += __builtin_bit_cast(float, __builtin_amdgcn_update_dpp(0, __builtin_bit_cast(int, x), 0x141, 0xF, 0xF, true));
    x += __builtin_bit_cast(float, __builtin_amdgcn_update_dpp(0, __builtin_bit_cast(int, x), 0x140, 0xF, 0xF, true));
    return x;
}
constexpr int SC_CH = 16, SC_STR = 400;
__device__ __forceinline__ void scan_phase(KP p, LAS float* buf, int tid, int bid, int G) {
    const int wid = tid >> 6, lane = tid & 63;
    const bf16_t* RKV = (const bf16_t*)(p->ws + W_RKV); const bf16_t* DEC = (const bf16_t*)(p->ws + W_DEC); const bf16_t* AA = (const bf16_t*)(p->ws + W_AA);
    float* SO = (float*)(p->ws + W_SO);
    const bool producer = wid >= 4;
    for (int u = bid; u < 768; u += G) {
        int bh, half, T, row0; const float* S0; float* Sout;
        if (u < 256) { bh = u >> 1; half = u & 1; T = TP; row0 = (bh >> 4) * TP; S0 = nullptr; Sout = p->out + O_SP + (size_t)bh * 4096; }
        else { const int v = u - 256; bh = v >> 1; half = v & 1; T = TS; row0 = MPR + (bh >> 4) * TS; S0 = p->in[2] + (size_t)bh * 4096; Sout = p->out + O_SS + (size_t)bh * 4096; }
        const int h = bh & 15, nchunk = T / SC_CH;
        if (producer) {
            const int t2 = tid - 256, pi = t2 >> 4, pj = t2 & 15, kc = h * 64 + 4 * pj;
            const f32x4 kkv = *(const f32x4*)(p->in[21] + kc), kav = *(const f32x4*)(p->in[22] + kc), w0v = *(const f32x4*)(p->in[13] + kc), a0v = *(const f32x4*)(p->in[16] + kc);
            u32x2 pr, pk, pvv, pa, pd;
#define SC_LOAD(c) do { const size_t o = (size_t)(row0 + (c) * SC_CH + pi) * D + kc; pr = *(const u32x2*)(RKV + o); pk = *(const u32x2*)(RKV + (size_t)MP * D + o); \
            pvv = *(const u32x2*)(RKV + (size_t)2 * MP * D + o); pa = *(const u32x2*)(AA + o); pd = *(const u32x2*)(DEC + o); } while (0)
#define SC_STORE(bi) do { LAS float* rec = buf + (bi) * (SC_CH * SC_STR) + pi * SC_STR; \
            const f32x4 r = (f32x4){bf_lo(pr.x), bf_hi(pr.x), bf_lo(pr.y), bf_hi(pr.y)}, k = (f32x4){bf_lo(pk.x), bf_hi(pk.x), bf_lo(pk.y), bf_hi(pk.y)}; \
            const f32x4 v = (f32x4){bf_lo(pvv.x), bf_hi(pvv.x), bf_lo(pvv.y), bf_hi(pvv.y)}; \
            f32x4 a = (f32x4){bf_lo(pa.x), bf_hi(pa.x), bf_lo(pa.y), bf_hi(pa.y)} + a0v; f32x4 w = (f32x4){bf_lo(pd.x), bf_hi(pd.x), bf_lo(pd.y), bf_hi(pd.y)} + w0v; \
            _Pragma("unroll") for (int j = 0; j < 4; ++j) { a[j] = sigmoidf_(a[j]); w[j] = __expf(-__expf(-softplusf_(-w[j]) - 0.5f)); } \
            const f32x4 q = k * kkv; float ss = (q[0] * q[0] + q[1] * q[1]) + (q[2] * q[2] + q[3] * q[3]); ss = dpp_sum16(ss); \
            const float inv = 1.f / fmaxf(sqrtf(ss), 1e-12f); const f32x4 nk = q * inv; \
            const f32x4 kp = k * (1.f + (a - 1.f) * kav), bb = nk * a; \
            float br = (bb[0] * r[0] + bb[1] * r[1]) + (bb[2] * r[2] + bb[3] * r[3]), kr = (kp[0] * r[0] + kp[1] * r[1]) + (kp[2] * r[2] + kp[3] * r[3]); \
            br = dpp_sum16(br); kr = dpp_sum16(kr); \
            *(LAS f32x4*)(rec + 4 * pj) = w; *(LAS f32x4*)(rec + 64 + 4 * pj) = nk; *(LAS f32x4*)(rec + 128 + 4 * pj) = bb; \
            *(LAS f32x4*)(rec + 192 + 4 * pj) = kp; *(LAS f32x4*)(rec + 256 + 4 * pj) = w * r; *(LAS f32x4*)(rec + 320 + 4 * pj) = v; \
            if (pj == 0) *(LAS f32x2*)(rec + 384) = (f32x2){br, kr}; } while (0)
            SC_LOAD(0); SC_STORE(0);
            if (nchunk > 1) SC_LOAD(1);
            __syncthreads();
            for (int c = 0; c < nchunk; ++c) {
                if (c + 1 < nchunk) { SC_STORE((c + 1) & 1); if (c + 2 < nchunk) SC_LOAD(c + 2); }
                __syncthreads();
            }
#undef SC_LOAD
#undef SC_STORE
        } else {
            const int rp = lane >> 4, kq = lane & 15, vA = half * 32 + wid * 8 + rp * 2;
            f32x4 sA = (f32x4){0.f, 0.f, 0.f, 0.f}, sB = sA;
            if (S0) { sA = *(const f32x4*)(S0 + vA * 64 + kq * 4); sB = *(const f32x4*)(S0 + (vA + 1) * 64 + kq * 4); }
            float* op = SO + (size_t)(row0 + kq) * D + h * 64 + vA;
            __syncthreads();
            for (int c = 0; c < nchunk; ++c) {
                const LAS float* cb = buf + (c & 1) * (SC_CH * SC_STR);
                float oA = 0.f, oB = 0.f;
#pragma unroll
                for (int i = 0; i < SC_CH; ++i) {
                    const LAS float* rec = cb + i * SC_STR;
                    const f32x4 wd = *(const LAS f32x4*)(rec + kq * 4), kk = *(const LAS f32x4*)(rec + 64 + kq * 4), bb = *(const LAS f32x4*)(rec + 128 + kq * 4),
                                kp = *(const LAS f32x4*)(rec + 192 + kq * 4), wr = *(const LAS f32x4*)(rec + 256 + kq * 4);
                    const f32x2 vv = *(const LAS f32x2*)(rec + 320 + vA), sc = *(const LAS f32x2*)(rec + 384);
                    const f32x2 t1A = sA.hi * kk.hi + sA.lo * kk.lo, t1B = sB.hi * kk.hi + sB.lo * kk.lo, t2A = sA.hi * wr.hi + sA.lo * wr.lo, t2B = sB.hi * wr.hi + sB.lo * wr.lo;
                    float d1A = t1A.x + t1A.y, d1B = t1B.x + t1B.y, d2A = t2A.x + t2A.y, d2B = t2B.x + t2B.y;
#define DPPR(ctl) "v_add_f32_dpp %0, %0, %0 " ctl " row_mask:0xf bank_mask:0xf bound_ctrl:1\n\tv_add_f32_dpp %1, %1, %1 " ctl " row_mask:0xf bank_mask:0xf bound_ctrl:1\n\t" \
                  "v_add_f32_dpp %2, %2, %2 " ctl " row_mask:0xf bank_mask:0xf bound_ctrl:1\n\tv_add_f32_dpp %3, %3, %3 " ctl " row_mask:0xf bank_mask:0xf bound_ctrl:1\n\t"
                    asm("s_nop 1\n\t" DPPR("quad_perm:[1,0,3,2]") DPPR("quad_perm:[2,3,0,1]") DPPR("row_half_mirror") DPPR("row_mirror") : "+v"(d1A), "+v"(d1B), "+v"(d2A), "+v"(d2B));
#undef DPPR
                    const float saA = -d1A, saB = -d1B;
                    const float tA = d2A + saA * sc.x + vv.x * sc.y, tB = d2B + saB * sc.x + vv.y * sc.y;
                    sA = sA * wd + bb * saA + kp * vv.x;
                    sB = sB * wd + bb * saB + kp * vv.y;
                    oA = kq == i ? tA : oA; oB = kq == i ? tB : oB;
                }
                *(f32x2*)(op + (size_t)c * SC_CH * D) = (f32x2){oA, oB};
                __syncthreads();
            }
            *(f32x4*)(Sout + vA * 64 + kq * 4) = sA; *(f32x4*)(Sout + (vA + 1) * 64 + kq * 4) = sB;
        }
    }
}
__device__ __forceinline__ void post_phase(KP p, int tid, int bid, int G) {
    const int lane = tid & 63, gw = bid * 8 + (tid >> 6), nw = G * 8;
    const bf16_t* RKV = (const bf16_t*)(p->ws + W_RKV); const bf16_t* AA = (const bf16_t*)(p->ws + W_AA); const bf16_t* GG = (const bf16_t*)(p->ws + W_GG);
    const float* SO = (const float*)(p->ws + W_SO); bf16_t* OG = (bf16_t*)(p->ws + W_OG);
    const float* k_a = p->in[22]; const float* a0p = p->in[16]; const float* r_k = p->in[23]; const float* gnw = p->in[24]; const float* gnb = p->in[25];
    const int c0 = lane * 16;
    for (int row = gw; row < MR; row += nw) {
        const size_t o = (size_t)row * D + c0;
        float ov[16], rv[16], kv[16], vv[16], av[16], gv[16];
#pragma unroll
        for (int q = 0; q < 4; ++q) { const f32x4 x = *(const f32x4*)(SO + o + 4 * q); ov[4 * q] = x[0]; ov[4 * q + 1] = x[1]; ov[4 * q + 2] = x[2]; ov[4 * q + 3] = x[3]; }
#define LD16(dst, ptr) do { const u32x4 a_ = *(const u32x4*)(ptr), b_ = *(const u32x4*)((ptr) + 8); \
        dst[0] = bf_lo(a_.x); dst[1] = bf_hi(a_.x); dst[2] = bf_lo(a_.y); dst[3] = bf_hi(a_.y); dst[4] = bf_lo(a_.z); dst[5] = bf_hi(a_.z); dst[6] = bf_lo(a_.w); dst[7] = bf_hi(a_.w); \
        dst[8] = bf_lo(b_.x); dst[9] = bf_hi(b_.x); dst[10] = bf_lo(b_.y); dst[11] = bf_hi(b_.y); dst[12] = bf_lo(b_.z); dst[13] = bf_hi(b_.z); dst[14] = bf_lo(b_.w); dst[15] = bf_hi(b_.w); } while (0)
        LD16(rv, RKV + o); LD16(kv, RKV + (size_t)MP * D + o); LD16(vv, RKV + (size_t)2 * MP * D + o); LD16(av, AA + o); LD16(gv, GG + o);
#undef LD16
        float sm = 0.f, rk = 0.f;
#pragma unroll
        for (int e = 0; e < 16; ++e) { sm += ov[e]; const float kp = kv[e] * (1.f + (sigmoidf_(a0p[c0 + e] + av[e]) - 1.f) * k_a[c0 + e]); rk += rv[e] * kp * r_k[c0 + e]; }
        sm += shx(sm, 1, lane); sm += shx(sm, 2, lane); rk += shx(rk, 1, lane); rk += shx(rk, 2, lane);
        const float mean = sm * (1.f / 64.f);
        float vs = 0.f;
#pragma unroll
        for (int e = 0; e < 16; ++e) { const float d = ov[e] - mean; vs += d * d; }
        vs += shx(vs, 1, lane); vs += shx(vs, 2, lane);
        const float rstd = __builtin_amdgcn_rsqf(vs * (1.f / 64.f) + GN_EPS);
        unsigned w[8];
#pragma unroll
        for (int e = 0; e < 16; e += 2) {
            const float y0 = ((ov[e] - mean) * rstd * gnw[c0 + e] + gnb[c0 + e] + rk * vv[e]) * gv[e];
            const float y1 = ((ov[e + 1] - mean) * rstd * gnw[c0 + e + 1] + gnb[c0 + e + 1] + rk * vv[e + 1]) * gv[e + 1];
            w[e >> 1] = cvt_pk(y0, y1);
        }
        *(u32x4*)(OG + o) = (u32x4){w[0], w[1], w[2], w[3]}; *(u32x4*)(OG + o + 8) = (u32x4){w[4], w[5], w[6], w[7]};
    }
}

__device__ __forceinline__ int crow(int r, int hi) { return (r & 3) + 8 * (r >> 2) + 4 * hi; }
__device__ __forceinline__ bf16x8 pack8(f32x4 a, f32x4 b) {
    u32x4 w; w.x = cvt_pk(a[0], a[1]); w.y = cvt_pk(a[2], a[3]); w.z = cvt_pk(b[0], b[1]); w.w = cvt_pk(b[2], b[3]);
    return __builtin_bit_cast(bf16x8, w);
}
__device__ __forceinline__ void attn_phase(KP p, int tid, int bid, int G) {
    const int lane = tid & 63, gw = bid * 8 + (tid >> 6), nw = G * 8;
    const bf16_t* QB = (const bf16_t*)(p->ws + W_QB); bf16_t* AO = (bf16_t*)(p->ws + W_OG);
    const int ql = lane & 31, hi = lane >> 5;
    constexpr int NU_P = BP * NH * 65;
    for (int u = gw; u < NU_P + BS * NH * 2; u += nw) {
        int bh, Q0, nq, npast, row_base, Tn; const float *kc, *vc, *kn, *vn;
        if (u < NU_P) { bh = u / 65; Q0 = (u - bh * 65) * 32; nq = min(32, TP - Q0); npast = 0; row_base = (bh >> 4) * TP; Tn = TP;
            kc = nullptr; vc = nullptr; kn = p->out + O_KP + (size_t)bh * TP * HD; vn = p->out + O_VP + (size_t)bh * TP * HD; }
        else { const int v = u - NU_P; bh = v >> 1; Q0 = (v & 1) * 32; nq = 32; npast = PAST; row_base = MPR + (bh >> 4) * TS; Tn = TS;
            kc = p->in[4] + (size_t)bh * PAST * HD; vc = p->in[5] + (size_t)bh * PAST * HD; kn = p->out + O_KS + (size_t)bh * TS * HD; vn = p->out + O_VS + (size_t)bh * TS * HD; }
        const int h = bh & 15, qpos0 = npast + Q0;
        bf16x8 qf[4];
        { const bf16_t* qp = QB + (size_t)(row_base + Q0 + min(ql, nq - 1)) * D + h * 64 + hi * 8;
#pragma unroll
          for (int s = 0; s < 4; ++s) qf[s] = *(const bf16x8*)(qp + 16 * s); }
        f32x16 o0, o1;
#pragma unroll
        for (int r = 0; r < 16; ++r) { o0[r] = 0.f; o1[r] = 0.f; }
        float carry = ql < nq ? 0.f : -1e30f;
        const int qpos = qpos0 + ql;
        f32x4 kc4[8];
#define ATT_TILE_PTRS(P0_, kb_, vb_, lim_) const bool inpast_ = (P0_) < npast; \
            const float* kb_ = inpast_ ? kc + (size_t)(P0_) * HD : kn + (size_t)((P0_) - npast) * HD; \
            const float* vb_ = inpast_ ? vc + (size_t)(P0_) * HD : vn + (size_t)((P0_) - npast) * HD; \
            const int lim_ = inpast_ ? 31 : min(31, Tn - 1 - ((P0_) - npast));
        { ATT_TILE_PTRS((qpos0 >> 5) * 32, kb0, vb0, lim0); (void)vb0;
          const float* kp = kb0 + (size_t)min(ql, lim0) * HD + hi * 8;
#pragma unroll
          for (int s = 0; s < 4; ++s) { kc4[2 * s] = *(const f32x4*)(kp + 16 * s); kc4[2 * s + 1] = *(const f32x4*)(kp + 16 * s + 4); } }
        for (int kt = qpos0 >> 5; kt >= 0; --kt) {
            const int P0 = kt * 32;
            ATT_TILE_PTRS(P0, kb, vb, lim); (void)kb;
            float x0[16], x1[16];
#pragma unroll
            for (int r = 0; r < 16; ++r) { const float* vp = vb + (size_t)min(crow(r, hi), lim) * HD + ql; x0[r] = vp[0]; x1[r] = vp[32]; }
            f32x4 kn4[8];
            { const int Pn = kt > 0 ? P0 - 32 : P0; ATT_TILE_PTRS(Pn, kbn, vbn, limn); (void)vbn;
              const float* kp = kbn + (size_t)min(ql, limn) * HD + hi * 8;
#pragma unroll
              for (int s = 0; s < 4; ++s) { kn4[2 * s] = *(const f32x4*)(kp + 16 * s); kn4[2 * s + 1] = *(const f32x4*)(kp + 16 * s + 4); } }
            f32x16 st;
#pragma unroll
            for (int r = 0; r < 16; ++r) st[r] = 0.f;
#pragma unroll
            for (int s = 0; s < 4; ++s) st = __builtin_amdgcn_mfma_f32_32x32x16_bf16(pack8(kc4[2 * s], kc4[2 * s + 1]), qf[s], st, 0, 0, 0);
            float L[16];
            float own[4];
#pragma unroll
            for (int g = 0; g < 4; ++g) { float sg = 0.f;
#pragma unroll
                for (int i = 0; i < 4; ++i) { const int r = 4 * g + i; const bool vis = (P0 + crow(r, hi)) < qpos; L[r] = vis ? -softplusf_(st[r]) : 0.f; sg += L[r]; }
                own[g] = sg; }
            float oth[4];
#pragma unroll
            for (int g = 0; g < 4; ++g) oth[g] = shx(own[g], 32, lane);
            float suf = carry;
            float A[16];
#pragma unroll
            for (int g = 3; g >= 0; --g) {
                float c = suf + (hi == 0 ? oth[g] : 0.f);
#pragma unroll
                for (int i = 3; i >= 0; --i) { const int r = 4 * g + i; c += L[r]; const bool vis = (P0 + crow(r, hi)) < qpos; A[r] = vis ? __expf(st[r] + c) : 0.f; }
                suf += own[g] + oth[g];
            }
            carry = suf;
            const bf16x8 pa0 = pack8((f32x4){A[0], A[1], A[2], A[3]}, (f32x4){A[4], A[5], A[6], A[7]});
            const bf16x8 pa1 = pack8((f32x4){A[8], A[9], A[10], A[11]}, (f32x4){A[12], A[13], A[14], A[15]});
            o0 = __builtin_amdgcn_mfma_f32_32x32x16_bf16(pa0, pack8((f32x4){x0[0], x0[1], x0[2], x0[3]}, (f32x4){x0[4], x0[5], x0[6], x0[7]}), o0, 0, 0, 0);
            o1 = __builtin_amdgcn_mfma_f32_32x32x16_bf16(pa0, pack8((f32x4){x1[0], x1[1], x1[2], x1[3]}, (f32x4){x1[4], x1[5], x1[6], x1[7]}), o1, 0, 0, 0);
            o0 = __builtin_amdgcn_mfma_f32_32x32x16_bf16(pa1, pack8((f32x4){x0[8], x0[9], x0[10], x0[11]}, (f32x4){x0[12], x0[13], x0[14], x0[15]}), o0, 0, 0, 0);
            o1 = __builtin_amdgcn_mfma_f32_32x32x16_bf16(pa1, pack8((f32x4){x1[8], x1[9], x1[10], x1[11]}, (f32x4){x1[12], x1[13], x1[14], x1[15]}), o1, 0, 0, 0);
#pragma unroll
            for (int e = 0; e < 8; ++e) kc4[e] = kn4[e];
            if (!__any(carry >= -104.f)) break;
        }
#undef ATT_TILE_PTRS
        bf16_t* op = AO + (size_t)(row_base + Q0) * D + h * 64 + ql;
#pragma unroll
        for (int r = 0; r < 16; ++r) { const int qr = crow(r, hi); if (qr < nq) { op[(size_t)qr * D] = (bf16_t)(cvt_pk(o0[r], 0.f) & 0xffffu); op[(size_t)qr * D + 32] = (bf16_t)(cvt_pk(o1[r], 0.f) & 0xffffu); } }
    }
}

__device__ __forceinline__ void fixup_phase(KP p, int ffn, int ns, int tid, int bid, int G) {
    float* X = (float*)(p->ws + W_X); bf16_t* XB = (bf16_t*)(p->ws + W_XN); const float* spl = (const float*)(p->ws + W_SKP);
    float* rsq = (float*)(p->ws + W_RSQ) + (size_t)(ffn == 1 ? 2 : (ffn == 2 ? 3 : (ffn == 4 ? 1 : 4))) * MP;
    const bool fold = ffn == 1 || ffn == 2 || ffn >= 4, fin = ffn == 3; const float scl = ffn >= 4 ? 1.0f : 0.5f;
    pg8::StaticOrder so; so.init(MP, D, 1, 0); so.nt0 = 0;
    const int ntail = so.nwg - G; if (ntail <= 0) return;
    const int wid = tid >> 6, lane = tid & 63, wr = wid >> 2, wc = wid & 3, fr = lane & 15, fq = lane >> 4;
    for (int B = bid; B < ntail * 32; B += G) {
        const int j = B >> 5, q = B & 31, n = q & 1, m = (q >> 1) & 3, bj = (q >> 3) & 1, ai = q >> 4;
        Unit u; so.next(G + j, u);
        f32x4 sum = (f32x4){0.f, 0.f, 0.f, 0.f};
        for (int ch = 0; ch < ns; ++ch) sum += *((const f32x4*)(spl + (size_t)(j * ns + ch) * 65536) + q * 512 + tid);
        const int row = u.pm * 256 + ai * 128 + wr * 64 + m * 16 + fr, col = u.pn * 256 + bj * 128 + wc * 32 + n * 16 + fq * 4;
        const size_t off = (size_t)row * D + col;
        const f32x4 x = *(const f32x4*)(X + off) + sum * scl;
        if (!fin) {
            *(f32x4*)(X + off) = x;
            if (fold) { store_bf4(XB + off, x); float ss = (x[0] * x[0] + x[1] * x[1]) + (x[2] * x[2] + x[3] * x[3]); ss += shx(ss, 16, lane); ss += shx(ss, 32, lane); if (fq == 0) unsafeAtomicAdd(rsq + row, ss); }
        } else if (row < MR) {
            float* dp = nullptr;
            if (row < MPR) { const int b = row / TP, t = row - b * TP; if (t >= NMETA) dp = p->out + O_YP + ((size_t)b * SEQP + (t - NMETA)) * D + col; }
            else dp = p->out + O_YS + (size_t)(row - MPR) * D + col;
            if (dp) *(f32x4*)dp = x;
        }
    }
}
#define XB_TMO      128
#define XB_XCNT(j)  (256  + 64 * (j))
#define XB_XSUB(j)  (1280 + 64 * (j))
#define XB_XGEN(j)  (2304 + 64 * (j))
#define XB_TOP      3328
#define XB_TOPGEN   3392
#define XCD_BAR_WORDS 3456
#define XB_SPIN_CAP (1u << 18)

__device__ __forceinline__ unsigned xb_ld(unsigned* p)              { return __hip_atomic_load(p, __ATOMIC_RELAXED, __HIP_MEMORY_SCOPE_AGENT); }
__device__ __forceinline__ unsigned xb_add(unsigned* p, unsigned v) { return __hip_atomic_fetch_add(p, v, __ATOMIC_RELAXED, __HIP_MEMORY_SCOPE_AGENT); }
__device__ __forceinline__ unsigned xb_xcc_id() { return (unsigned)__builtin_amdgcn_s_getreg((3 << 11) | 20) & 0xFu; }
#define XB_SPIN(cond, bar) do { unsigned _sp = 0; while (cond) { __builtin_amdgcn_s_sleep(1); \
    if ((++_sp & 255u) == 0u) { if (xb_ld(&(bar)[XB_TMO])) break; if (_sp > XB_SPIN_CAP) { atomicAdd(&(bar)[XB_TMO], 1u); break; } } } } while (0)

struct XcdBarrier {
    unsigned* bar; unsigned x;
    volatile LAS unsigned* st;
};

__device__ __forceinline__ XcdBarrier xcd_barrier_post(unsigned* bar, volatile LAS unsigned* st, bool xb_tid0) {
    XcdBarrier b; b.bar = bar; b.x = xb_xcc_id(); b.st = st;
    if (xb_tid0) (void)xb_add(&bar[XB_XCNT(b.x)], 1u);
    return b;
}
__device__ __forceinline__ void xcd_barrier_complete(unsigned* bar, unsigned x, unsigned& nloc, unsigned& nx) {
    const unsigned G = gridDim.x * gridDim.y * gridDim.z;
    unsigned sum, cnt, mine, sp = 0u;
    for (;;) {
        sum = 0u; cnt = 0u; mine = 0u;
#pragma unroll
        for (unsigned j = 0; j < 16; ++j) { const unsigned c = xb_ld(&bar[XB_XCNT(j)]); sum += c; cnt += (c > 0u) ? 1u : 0u; mine = (j == x) ? c : mine; }
        if (sum == G) break;
        __builtin_amdgcn_s_sleep(1);
        if ((++sp & 255u) == 0u) { if (xb_ld(&bar[XB_TMO])) break; if (sp > XB_SPIN_CAP) { atomicAdd(&bar[XB_TMO], 1u); break; } }
    }
    nloc = mine > 0u ? mine : 1u; nx = cnt > 0u ? cnt : 1u;
}

__device__ __forceinline__ void xcd_barrier(const XcdBarrier& b, bool xb_tid0) {
    asm volatile("s_waitcnt vmcnt(0)" ::: "memory");
    __syncthreads();
    if (xb_tid0) {
        unsigned* bar = b.bar;
        __builtin_amdgcn_s_waitcnt(0);
        unsigned nloc = b.st[0], nx = b.st[1];
        if (nloc == 0u) { xcd_barrier_complete(bar, b.x, nloc, nx); b.st[0] = nloc; b.st[1] = nx; }
        const unsigned old = xb_add(&bar[XB_XSUB(b.x)], 1u);
        const unsigned gen = old / nloc;
        if (old + 1u == (gen + 1u) * nloc) {
            __builtin_amdgcn_fence(__ATOMIC_RELEASE, "agent");
            asm volatile("s_waitcnt vmcnt(0)" ::: "memory");
            const unsigned og = xb_add(&bar[XB_TOP], 1u);
            const unsigned tg = og / nx;
            if (og + 1u == (tg + 1u) * nx) xb_add(&bar[XB_TOPGEN], 1u);
            else XB_SPIN(xb_ld(&bar[XB_TOPGEN]) == tg, bar);
            __builtin_amdgcn_fence(__ATOMIC_ACQUIRE, "agent");
            xb_add(&bar[XB_XGEN(b.x)], 1u);
            asm volatile("s_waitcnt vmcnt(0)" ::: "memory");
        } else {
            XB_SPIN(xb_ld(&bar[XB_XGEN(b.x)]) == gen, bar);
            __builtin_amdgcn_fence(__ATOMIC_ACQUIRE, "agent");
            asm volatile("s_waitcnt vmcnt(0)" ::: "memory");
        }
    }
    __syncthreads();
}
constexpr int NPHASE = 23;
#ifndef PHM
#define PHM 0xffff
#endif
#define EN(k) (((PHM) >> (k)) & 1)
constexpr int LDS_BYTES = 131072 + 8 * 576 * 4;
template <class Epi, class Sched>
__device__ __forceinline__ void run_gemm(LAS unsigned char* lds, int wb, const bf16_t* A, const bf16_t* Bt, int M, int N, int K, const Sched& S, const Epi& E, float* skp = nullptr, unsigned* skf = nullptr) {
    pg8::Gemm g{A, Bt, M, N, K, wb, skp, skf};
    pg8::gemm_phase<Epi, Sched, true, true>(lds, g, S, E);
}
__global__ void __launch_bounds__(512, 2) mega(Params p_unused) {
    LAS unsigned char* lds = (LAS unsigned char*)lds_raw;
    cg::grid_group grid = cg::this_grid();
    KP p = (KP)__builtin_amdgcn_kernarg_segment_ptr();
    const int ph_lo = p->ph_lo, ph_hi = p->ph_hi;
    const int wb = __builtin_amdgcn_readfirstlane((int)threadIdx.x) & ~63;
    { LAS unsigned* stw = (LAS unsigned*)(lds + 131072); if ((int)threadIdx.x < 2) stw[threadIdx.x] = 0u; __syncthreads(); }
    const XcdBarrier xbar = xcd_barrier_post((unsigned*)(p->ws + W_BAR), (volatile LAS unsigned*)(lds + 131072), threadIdx.x == 0);
    for (int pi_ = ph_lo; pi_ < ph_hi; ++pi_) {
        asm volatile("" ::: "v1","v2","v3","v4","v5","v6","v7","v8","v9","v10","v11","v12","v13","v14","v15","v16","v17","v18","v19","v20","v21","v22","v23","v24","v25","v26","v27","v28","v29","v30","v31","v32","v33","v34","v35","v36","v37","v38","v39","v40","v41","v42","v43","v44","v45","v46","v47","v48","v49","v50","v51","v52","v53","v54","v55","v56","v57","v58","v59","v60","v61","v62","v63","v64","v65","v66","v67","v68","v69","v70","v71","v72","v73","v74","v75","v76","v77","v78","v79","v80","v81","v82","v83","v84","v85","v86","v87","v88","v89","v90","v91","v92","v93","v94","v95","v96","v97","v98","v99","v100","v101","v102","v103","v104","v105","v106","v107","v108","v109","v110","v111","v112","v113","v114","v115","v116","v117","v118","v119","v120","v121","v122","v123","v124","v125","v126","v127","v128","v129","v130","v131","v132","v133","v134","v135","v136","v137","v138","v139","v140","v141","v142","v143","v144","v145","v146","v147","v148","v149","v150","v151","v152","v153","v154","v155","v156","v157","v158","v159","v160","v161","v162","v163","v164","v165","v166","v167","v168","v169","v170","v171","v172","v173","v174","v175","v176","v177","v178","v179","v180","v181","v182","v183","v184","v185","v186","v187","v188","v189","v190","v191","v192","v193","v194","v195","v196","v197","v198","v199","v200","v201","v202","v203","v204","v205","v206","v207","v208","v209","v210","v211","v212","v213","v214","v215","v216","v217","v218","v219","v220","v221","v222","v223","v224","v225","v226","v227","v228","v229","v230","v231","v232","v233","v234","v235","v236","v237","v238","v239","v240","v241","v242","v243","v244","v245","v246","v247","v248","v249");
        asm volatile("" : "+s"(p));
        const int phc = p->seq[pi_], ph = phc & 63; const bool dry = (phc & 64) != 0;
        int bid = blockIdx.x, G = gridDim.x;
        asm volatile("" : "+s"(bid), "+s"(G));
#define TID_HERE (wb + lane_now())
        int ffn = -1; bool ffn_in = false;
        if (ph == 1 || ph == 2) { ffn = 0; ffn_in = ph == 1; } else if (ph == 11 || ph == 12) { ffn = 1; ffn_in = ph == 11; }
        else if (ph == 14 || ph == 15) { ffn = 2; ffn_in = ph == 14; } else if (ph == 21 || ph == 22) { ffn = 3; ffn_in = ph == 21; }
        if (EN(0) && ph == 0) { { const int tid = TID_HERE; convert_weights(p, (LAS float*)lds, tid, bid, G); assemble_x(p, tid, bid, G); } }
        else if (EN(1) && ffn >= 0 && ffn_in) {
            pg8::StaticOrder S; S.init(MP, NIN, G, bid); S.nt0 = D / 64;
            unsigned char* ws = p->ws; EpiSwiGLU E{(bf16_t*)(ws + W_HB), (const float*)(ws + W_RSQ) + (size_t)(ffn == 0 ? 0 : (ffn == 1 ? 1 : (ffn == 2 ? 2 : 4))) * MP};
            run_gemm(lds, wb, (const bf16_t*)(ws + W_XN), (const bf16_t*)(ws + W_WIN + ffn * SZ_WIN1), MP, NIN, D, S, E);
        } else if (EN(2) && ffn >= 0) {
            TailSplitOrder S; S.init(MP, D, DFFP, G, bid, 11);
            unsigned char* ws = p->ws; const bool fold = (ffn == 1 || ffn == 2) && !dry;
            EpiRes E{(float*)(ws + W_X), dry ? 0.f : 0.5f, (ffn == 3 && !dry) ? p->out : nullptr, fold ? (bf16_t*)(ws + W_XN) : nullptr, (float*)(ws + W_RSQ) + (size_t)(ffn == 1 ? 2 : 3) * MP, (float*)(ws + W_SKP)};
            run_gemm(lds, wb, (const bf16_t*)(ws + W_HB), (const bf16_t*)(ws + W_WOUT + ffn * SZ_WOUT1), MP, D, DFFP, S, E, (float*)(ws + W_SKP), (unsigned*)(ws + W_SKF) + pi_ * 1024);
        }
        else if (ph >= 24 && ph < 30) { if (!dry) fixup_phase(p, ph - 24, ph < 28 ? 11 : 4, TID_HERE, bid, G); }
        else if (EN(3) && ph == 3) mixprep_phase(p, TID_HERE, bid, G);
        else if (EN(4) && ph == 4) {
            G1Order S{G, bid};
            unsigned char* ws = p->ws; EpiG1 E{(bf16_t*)(ws + W_RKV), (float*)(ws + W_L1)};
            run_gemm(lds, wb, (const bf16_t*)(ws + W_AALL), (const bf16_t*)(ws + W_WG1), 5 * MP, 3584, D, S, E);
        }
        else if (EN(5) && ph == 5) act_phase(p, bid * 512 + TID_HERE, G * 512);
        else if (EN(6) && ph == 6) {
            pg8::StaticOrder S; S.init(MP, 3072, G, bid); S.nt0 = 4;
            unsigned char* ws = p->ws; EpiG2 E{(bf16_t*)(ws + W_DEC)};
            run_gemm(lds, wb, (const bf16_t*)(ws + W_A2), (const bf16_t*)(ws + W_WL2), MP, 3072, 256, S, E);
        }
        else if (EN(7) && ph == 7) scan_phase(p, (LAS float*)lds, TID_HERE, bid, G);
        else if (EN(8) && ph == 8) post_phase(p, TID_HERE, bid, G);
        else if (EN(9) && (ph == 9 || ph == 19)) {
            TailSplitOrder S; S.init(MP, D, D, G, bid, 4);
            unsigned char* ws = p->ws; EpiRes E{(float*)(ws + W_X), dry ? 0.f : 1.0f, nullptr, dry ? nullptr : (bf16_t*)(ws + W_XN), (float*)(ws + W_RSQ) + (size_t)(ph == 9 ? 1 : 4) * MP, (float*)(ws + W_SKP)};
            run_gemm(lds, wb, (const bf16_t*)(ws + W_OG), (const bf16_t*)(ws + (ph == 9 ? W_WO1 : W_WO2)), MP, D, D, S, E, (float*)(ws + W_SKP), (unsigned*)(ws + W_SKF) + pi_ * 1024);
        }
        else if (EN(11) && ph == 17) {
            pg8::StaticOrder S; S.init(MP, 3 * D, G, bid); S.nt0 = D / 64;
            unsigned char* ws = p->ws; EpiQKV E{(bf16_t*)(ws + W_QB), p->out, p->in[28], p->in[29], (const float*)(ws + W_RSQ) + (size_t)3 * MP};
            run_gemm(lds, wb, (const bf16_t*)(ws + W_XN), (const bf16_t*)(ws + W_WQKV), MP, 3 * D, D, S, E);
        }
        else if (EN(12) && ph == 18) attn_phase(p, TID_HERE, bid, G);
        if (pi_ + 1 < ph_hi) { if (pi_ < 0) grid.sync(); else xcd_barrier(xbar, (wb + lane_now()) == 0); }
    }
}

#ifndef ONE_LAUNCH
#define ONE_LAUNCH 1
#endif
extern "C" void kernel_launch(void* const* d_in, const int* in_sizes, int n_in, void* d_out, int out_size, void* d_ws, size_t ws_size, hipStream_t stream) {
    static int grid = 0;
    if (grid == 0) {
        if (n_in != 31 || (size_t)out_size != O_END || ws_size < W_END) { fprintf(stderr, "kernel_launch: unexpected sizes (n_in %d out %d ws %zu need %zu)\n", n_in, out_size, ws_size, (size_t)W_END); grid = -1; return; }
        int dev = 0, cus = 0, per_cu = 0;
        hipGetDevice(&dev); hipDeviceGetAttribute(&cus, hipDeviceAttributeMultiprocessorCount, dev);
        if (hipFuncSetAttribute((const void*)mega, hipFuncAttributeMaxDynamicSharedMemorySize, LDS_BYTES) != hipSuccess) { fprintf(stderr, "kernel_launch: hipFuncSetAttribute failed\n"); grid = -1; return; }
        hipOccupancyMaxActiveBlocksPerMultiprocessor(&per_cu, (const void*)mega, 512, LDS_BYTES);
        (void)hipGetLastError();
        if (per_cu < 1) per_cu = 1;
        grid = cus * per_cu;
    }
    if (grid < 0) return;
    Params p{};
    for (int i = 0; i < 31; ++i) p.in[i] = (const float*)d_in[i];
    p.out = (float*)d_out; p.ws = (unsigned char*)d_ws;
    int nseq = 0;
    for (int ph = 0; ph < NPHASE; ++ph) {
        if (ph == 10 || ph == 13 || ph == 16 || ph == 20) continue;
        p.seq[nseq++] = ph;
        if (ph == 2 || ph == 12 || ph == 15 || ph == 22) p.seq[nseq++] = 24 + (ph == 2 ? 0 : (ph == 12 ? 1 : (ph == 15 ? 2 : 3)));
        if (ph == 9 || ph == 19) p.seq[nseq++] = ph == 9 ? 28 : 29;
#ifdef REP_OF
        for (int r = 0; r < (REP_OF(ph)); ++r) p.seq[nseq++] = (ph | ((ph == 2 || ph == 9) ? 64 : 0));
#endif
    }
#if ONE_LAUNCH
    (void)hipMemsetAsync((unsigned char*)d_ws + W_BAR, 0, 16384, stream);
    p.ph_lo = 0; p.ph_hi = nseq;
    void* args[] = {&p};
    hipError_t e = hipLaunchCooperativeKernel((const void*)mega, dim3(grid), dim3(512), args, LDS_BYTES, stream);
    if (e != hipSuccess) fprintf(stderr, "cooperative launch failed: %s (grid %d)\n", hipGetErrorString(e), grid);
#else
    for (int ph = 0; ph < nseq; ++ph) { p.ph_lo = ph; p.ph_hi = ph + 1; hipLaunchKernelGGL(mega, dim3(grid), dim3(512), LDS_BYTES, stream, p); }
#endif
}
```

```cpp
#include <hip/hip_runtime.h>
#include <hip/hip_cooperative_groups.h>
#include <cstdio>
#include <cstdint>
namespace cg = cooperative_groups;
#ifndef GP_SP2
#define GP_SP2 true
#endif
#ifndef GP_ALIGN
#define GP_ALIGN true
#endif
#ifndef WGM_SET
#define WGM_SET 8
#endif
__device__ __forceinline__ int lane_now() { int l; asm volatile("v_mbcnt_lo_u32_b32 %0, -1, 0\n\tv_mbcnt_hi_u32_b32 %0, -1, %0" : "=v"(l)); return l; }
namespace pg8 {
#define PG8_LAS __attribute__((address_space(3)))
typedef unsigned short bf16_t;
typedef short bf16x8 __attribute__((ext_vector_type(8)));
typedef float f32x4 __attribute__((ext_vector_type(4)));
typedef unsigned u32x4 __attribute__((ext_vector_type(4)));
constexpr int BM = 256, BK = 64, HALF = 128, HTB = HALF * BK * 2  , STAGE_BYTES = 8 * HTB, NXCD = 8, WGM = WGM_SET;

__host__ __device__ __forceinline__ int lds_byte(int r, int c) { const int st = (r >> 4) * 2 + (c >> 5), rr = r & 15, cc = c & 31, ob = rr * 64 + cc * 2; return st * 1024 + (ob ^ (((ob >> 9) & 1) << 5)); }
__host__ __device__ __forceinline__ void stage_rc(int b, int& R, int& C) { const int st = b / 1024, sb = b % 1024, swz = sb ^ (((sb >> 9) & 1) << 5); R = (st >> 1) * 16 + swz / 64; C = (st & 1) * 32 + (swz % 64) / 2; }
__host__ __device__ __forceinline__ int perm32(int rho) { const int n = rho >> 4, i = rho & 15; return 8 * (i >> 2) + 4 * n + (i & 3); }

struct Unit { int pm, pn, kb, nt, fl, tl; };
struct Gemm { const bf16_t* A; const bf16_t* Bt; int M, N, K, wb; float* skp; unsigned* skf; };

struct StaticOrder {
    static constexpr bool STREAM = false; int nM, nN, nwg, G, c, nt0;
    __host__ __device__ void init(int M, int N, int G_, int c_) { nM = M / BM; nN = N / BM; nwg = nM * nN; G = G_; c = c_; }
    __host__ __device__ bool next(int i, Unit& u) const {
        const long L = (long)i * G + c; if (L >= nwg) return false;
        int wgid = (int)L; { const int q = nwg / NXCD, r = nwg % NXCD, xcd = wgid % NXCD, off = wgid / NXCD; wgid = (xcd < r ? xcd * (q + 1) : r * (q + 1) + (xcd - r) * q) + off; }
        const int nig = WGM * nN, gid = wgid / nig, fm = gid * WGM, gsz = (nM - fm) < WGM ? (nM - fm) : WGM;
        u.pm = fm + ((wgid % nig) % gsz); u.pn = (wgid % nig) / gsz; u.kb = 0; u.nt = nt0; u.fl = 0; u.tl = 0; return true;
    }
    __device__ __forceinline__ void a_ready(const Unit&) const {}
    __device__ __forceinline__ void done(const Unit&) const {}
};
typedef __attribute__((address_space(1))) f32x4 gf32x4;
typedef unsigned long long u64_t;
__device__ __forceinline__ void streamk_store(const f32x4 (&acc)[2][2][4][2], const Unit& u, float* skp, unsigned* skf, int tid) {
    u64_t* q = (u64_t*)(skp + (size_t)u.tl * 65536) + 2 * tid;
#pragma unroll
    for (int a = 0; a < 2; ++a)
#pragma unroll
        for (int b = 0; b < 2; ++b)
#pragma unroll
            for (int m = 0; m < 4; ++m)
#pragma unroll
                for (int n = 0; n < 2; ++n) { const f32x4 v = acc[a][b][m][n];
                    __hip_atomic_store(q, ((u64_t)__float_as_uint(v[1]) << 32) | __float_as_uint(v[0]), __ATOMIC_RELAXED, __HIP_MEMORY_SCOPE_AGENT);
                    __hip_atomic_store(q + 1, ((u64_t)__float_as_uint(v[3]) << 32) | __float_as_uint(v[2]), __ATOMIC_RELAXED, __HIP_MEMORY_SCOPE_AGENT);
                    q += 1024; asm volatile("" : "+v"(q) :: "memory"); }
    asm volatile("s_waitcnt vmcnt(0)" ::: "memory");
    __builtin_amdgcn_s_barrier();
    if (tid == 0) __hip_atomic_store(skf + u.tl, 1u, __ATOMIC_RELAXED, __HIP_MEMORY_SCOPE_AGENT);
}
__device__ __forceinline__ const float* streamk_wait(const Unit& u, float* skp, unsigned* skf, int tid) {
    if (u.fl == 2) {
        if (tid == 0) { while (__hip_atomic_load(skf + u.tl, __ATOMIC_RELAXED, __HIP_MEMORY_SCOPE_AGENT) == 0u) __builtin_amdgcn_s_sleep(2); }
        __builtin_amdgcn_s_barrier();
        __builtin_amdgcn_fence(__ATOMIC_ACQUIRE, "agent");
    } else __builtin_amdgcn_s_barrier();
    return skp + (size_t)u.tl * 65536;
}
__device__ __forceinline__ f32x4 streamk_part(const float* part, int idx, int tid) {
    const u64_t* q = (const u64_t*)part + (size_t)idx * 1024 + 2 * tid;
    const u64_t a = __hip_atomic_load(q, __ATOMIC_RELAXED, __HIP_MEMORY_SCOPE_AGENT), b = __hip_atomic_load(q + 1, __ATOMIC_RELAXED, __HIP_MEMORY_SCOPE_AGENT);
    return (f32x4){__uint_as_float((unsigned)a), __uint_as_float((unsigned)(a >> 32)), __uint_as_float((unsigned)b), __uint_as_float((unsigned)(b >> 32))};
}
template <class Epi, class Sched, bool ALIGN_EPI = false, bool SP2 = false>
__device__ __forceinline__ void gemm_phase(PG8_LAS unsigned char* lds, const Gemm g, const Sched& S, const Epi& E) {
    int tid = g.wb + lane_now(); asm volatile("" : "+v"(tid)); const int wid = __builtin_amdgcn_readfirstlane(tid >> 6), lane = tid & 63, wr = wid >> 2, wc = wid & 3, fr = lane & 15, fq = lane >> 4;
    const int K = g.K, nt = K / BK;
    unsigned voffA[2], voffB[2];
#pragma unroll
    for (int i = 0; i < 2; ++i) { int R, C; stage_rc(tid * 16 + i * 8192, R, C); const int Rb = Epi::PERM ? ((R & ~31) + perm32(R & 31)) : R;
        voffA[i] = (unsigned)(R * K + C) * 2u; voffB[i] = (unsigned)(Rb * K + C) * 2u; }
    const size_t kstep = (size_t)(BK * 2);
    const size_t hstep = (size_t)HALF * K * 2;
    const size_t tstep = 2 * hstep;
    const unsigned ldsw = (unsigned)wid * 1024u;
    const int aoff = lds_byte(wr * 64 + fr, fq * 8), boff = lds_byte(wc * 32 + fr, fq * 8);
#define PG8_SA(b, h) (((b) * 2 + (h)) * HTB)
#define PG8_SB(b, h) ((4 + (b) * 2 + (h)) * HTB)
#define PG8_STAGE(bufoff, gbase, voff) do { _Pragma("unroll") for (int _i = 0; _i < 2; ++_i) \
        __builtin_amdgcn_global_load_lds((const unsigned*)((const char*)(gbase) + (voff)[_i]), (PG8_LAS unsigned*)(lds + (bufoff) + ldsw + _i * 8192), 16, 0, 0); } while (0)
#define PG8_LDA(dst, b, h) do { _Pragma("unroll") for (int m = 0; m < 4; ++m) _Pragma("unroll") for (int k = 0; k < 2; ++k) dst[m][k] = *(const PG8_LAS bf16x8*)(lds + PG8_SA(b, h) + aoff + m * 2048 + k * 1024); } while (0)
#define PG8_LDB(dst, b, h) do { _Pragma("unroll") for (int n = 0; n < 2; ++n) _Pragma("unroll") for (int k = 0; k < 2; ++k) dst[n][k] = *(const PG8_LAS bf16x8*)(lds + PG8_SB(b, h) + boff + n * 2048 + k * 1024); } while (0)
#define PG8_MMA(ai, bj, At, Bt) do { __builtin_amdgcn_s_setprio(1); _Pragma("unroll") for (int m = 0; m < 4; ++m) _Pragma("unroll") for (int n = 0; n < 2; ++n) _Pragma("unroll") for (int k = 0; k < 2; ++k) \
        acc[ai][bj][m][n] = __builtin_amdgcn_mfma_f32_16x16x32_bf16(Bt[n][k], At[m][k], acc[ai][bj][m][n], 0, 0, 0); __builtin_amdgcn_s_setprio(0); } while (0)
#define PG8_WAIT_V(n) asm volatile("s_waitcnt vmcnt(" #n ")" ::: "memory")
#define PG8_WAIT_L(n) asm volatile("s_waitcnt lgkmcnt(" #n ")" ::: "memory")
#define PG8_BAR __builtin_amdgcn_s_barrier()
#define PG8_SCHED __builtin_amdgcn_sched_barrier(0)
    Unit cur, nxt; int ui = 0;
    if (!S.next(0, cur)) return;
    f32x4 acc[2][2][4][2];
#pragma unroll
    for (int a = 0; a < 2; ++a)
#pragma unroll
        for (int b = 0; b < 2; ++b)
#pragma unroll
            for (int m = 0; m < 4; ++m)
#pragma unroll
                for (int n = 0; n < 2; ++n) acc[a][b][m][n] = (f32x4){0.f, 0.f, 0.f, 0.f};
    bf16x8 At[4][2], B0[2][2], B1[2][2];
    const char* cA = (const char*)g.A + (size_t)cur.pm * tstep + cur.kb; const char* cB = (const char*)g.Bt + (size_t)cur.pn * tstep + cur.kb;
    S.a_ready(cur);
    if constexpr (SP2) {
        PG8_STAGE(PG8_SB(0, 0), cB, voffB); PG8_STAGE(PG8_SB(0, 1), cB + hstep, voffB); PG8_STAGE(PG8_SA(0, 0), cA, voffA); PG8_STAGE(PG8_SA(0, 1), cA + hstep, voffA);
        if (wr == 1) PG8_BAR;
        PG8_WAIT_V(2); PG8_BAR;
        PG8_STAGE(PG8_SB(1, 0), cB + kstep, voffB); PG8_STAGE(PG8_SA(1, 0), cA + kstep, voffA); PG8_STAGE(PG8_SB(1, 1), cB + hstep + kstep, voffB);
        PG8_WAIT_V(6); PG8_BAR;
    } else {
        PG8_STAGE(PG8_SB(0, 0), cB, voffB); PG8_STAGE(PG8_SA(0, 0), cA, voffA); PG8_STAGE(PG8_SB(0, 1), cB + hstep, voffB); PG8_STAGE(PG8_SA(0, 1), cA + hstep, voffA);
        if (wr == 1) PG8_BAR;
        PG8_WAIT_V(4); PG8_BAR;
        PG8_STAGE(PG8_SB(1, 0), cB + kstep, voffB); PG8_STAGE(PG8_SA(1, 0), cA + kstep, voffA); PG8_STAGE(PG8_SB(1, 1), cB + hstep + kstep, voffB);
        PG8_WAIT_V(6); PG8_BAR;
    }
    for (;;) {
        const bool has_next = S.next(ui + 1, nxt);
        const char* nA = has_next ? (const char*)g.A + (size_t)nxt.pm * tstep + nxt.kb : cA; const char* nB = has_next ? (const char*)g.Bt + (size_t)nxt.pn * tstep + nxt.kb : cB;
        const int ntu = cur.nt;
        for (int t = 0; t < ntu; t += 2) {
            const bool last = (t == ntu - 2);
            const char* a1 = cA + (size_t)(t + 1) * kstep;
            const char* a2 = last ? nA : cA + (size_t)(t + 2) * kstep; const char* b2 = last ? nB : cB + (size_t)(t + 2) * kstep;
            const char* a3 = a2 + kstep; const char* b3 = b2 + kstep;
            if (last && has_next) S.a_ready(nxt);
            if constexpr (SP2) {
            PG8_LDB(B0, 0, 0); PG8_LDB(B1, 0, 1); PG8_SCHED; PG8_LDA(At, 0, 0); PG8_STAGE(PG8_SA(1, 1), a1 + hstep, voffA);
            PG8_WAIT_V(8); PG8_WAIT_L(0); PG8_BAR; PG8_MMA(0, 0, At, B0); PG8_MMA(0, 1, At, B1); PG8_BAR; PG8_SCHED;
            PG8_LDA(At, 0, 1); PG8_STAGE(PG8_SB(0, 0), b2, voffB); PG8_STAGE(PG8_SB(0, 1), b2 + hstep, voffB); PG8_STAGE(PG8_SA(0, 0), a2, voffA);
            PG8_WAIT_V(8); PG8_WAIT_L(0); PG8_BAR; PG8_MMA(1, 0, At, B0); PG8_MMA(1, 1, At, B1); PG8_BAR; PG8_SCHED;
            PG8_LDB(B0, 1, 0); PG8_LDB(B1, 1, 1); PG8_SCHED; PG8_LDA(At, 1, 0); PG8_STAGE(PG8_SA(0, 1), a2 + hstep, voffA);
            PG8_WAIT_V(8); PG8_WAIT_L(0); PG8_BAR; PG8_MMA(0, 0, At, B0); PG8_MMA(0, 1, At, B1); PG8_BAR; PG8_SCHED;
            PG8_LDA(At, 1, 1); PG8_STAGE(PG8_SB(1, 0), b3, voffB); PG8_STAGE(PG8_SB(1, 1), b3 + hstep, voffB); PG8_STAGE(PG8_SA(1, 0), a3, voffA);
            PG8_WAIT_V(8); PG8_WAIT_L(0); PG8_BAR; PG8_MMA(1, 0, At, B0); PG8_MMA(1, 1, At, B1); PG8_BAR; PG8_SCHED;
            } else {
            PG8_LDB(B0, 0, 0); PG8_SCHED; PG8_LDA(At, 0, 0); PG8_STAGE(PG8_SA(1, 1), a1 + hstep, voffA);
            PG8_WAIT_L(8); PG8_BAR; PG8_WAIT_L(0); PG8_MMA(0, 0, At, B0); PG8_BAR; PG8_SCHED;
            PG8_LDB(B1, 0, 1); PG8_STAGE(PG8_SB(0, 0), b2, voffB);
            PG8_BAR; PG8_WAIT_L(0); PG8_MMA(0, 1, At, B1); PG8_BAR;
            PG8_LDA(At, 0, 1); PG8_STAGE(PG8_SA(0, 0), a2, voffA);
            PG8_BAR; PG8_WAIT_L(0); PG8_MMA(1, 0, At, B0); PG8_BAR; PG8_SCHED;
            PG8_STAGE(PG8_SB(0, 1), b2 + hstep, voffB);
            PG8_WAIT_V(6); PG8_BAR; PG8_MMA(1, 1, At, B1); PG8_BAR;
            PG8_LDB(B0, 1, 0); PG8_SCHED; PG8_LDA(At, 1, 0); PG8_STAGE(PG8_SA(0, 1), a2 + hstep, voffA);
            PG8_WAIT_L(8); PG8_BAR; PG8_WAIT_L(0); PG8_MMA(0, 0, At, B0); PG8_BAR; PG8_SCHED;
            PG8_LDB(B1, 1, 1); PG8_STAGE(PG8_SB(1, 0), b3, voffB);
            PG8_BAR; PG8_WAIT_L(0); PG8_MMA(0, 1, At, B1); PG8_BAR;
            PG8_LDA(At, 1, 1); PG8_STAGE(PG8_SA(1, 0), a3, voffA);
            PG8_BAR; PG8_WAIT_L(0); PG8_MMA(1, 0, At, B0); PG8_BAR; PG8_SCHED;
            PG8_STAGE(PG8_SB(1, 1), b3 + hstep, voffB);
            PG8_WAIT_V(6); PG8_BAR; PG8_MMA(1, 1, At, B1); PG8_BAR;
            }
        }
        if constexpr (ALIGN_EPI) { if (wr == 0) PG8_BAR; }
        if constexpr (!Epi::AFTER_DRAIN) { int t_ = g.wb + lane_now(); asm volatile("" : "+v"(t_)); const int fr_ = t_ & 15, fq_ = (t_ >> 4) & 3; if constexpr (!Sched::STREAM) E(acc, cur, wr, wc, fr_, fq_); else { if (cur.fl == 1) streamk_store(acc, cur, g.skp, g.skf, t_); else { const float* part_ = streamk_wait(cur, g.skp, g.skf, t_); int t2_ = g.wb + lane_now(); asm volatile("" : "+v"(t2_)); E(acc, cur, wr, wc, t2_ & 15, (t2_ >> 4) & 3, part_, t2_); } } S.done(cur); }
        if (!has_next) break;
#pragma unroll
        for (int a = 0; a < 2; ++a)
#pragma unroll
            for (int b = 0; b < 2; ++b)
#pragma unroll
                for (int m = 0; m < 4; ++m)
#pragma unroll
                    for (int n = 0; n < 2; ++n) acc[a][b][m][n] = (f32x4){0.f, 0.f, 0.f, 0.f};
        cur = nxt; cA = nA; cB = nB; ++ui;
        if constexpr (ALIGN_EPI) { if (wr == 1) PG8_BAR; }
    }
    PG8_WAIT_V(0);
    if constexpr (!ALIGN_EPI) { if (wr == 0) PG8_BAR; }
    PG8_BAR;
    if constexpr (Epi::AFTER_DRAIN) { E.fused(acc, cur, wr, wc, fr, fq, lds, wid, lane); S.done(cur); }
#undef PG8_SA
#undef PG8_SB
#undef PG8_STAGE
#undef PG8_LDA
#undef PG8_LDB
#undef PG8_MMA
#undef PG8_WAIT_V
#undef PG8_WAIT_L
#undef PG8_BAR
#undef PG8_SCHED
}
}

#define LAS __attribute__((address_space(3)))
typedef unsigned short bf16_t;
typedef short bf16x8 __attribute__((ext_vector_type(8)));
typedef float f32x4 __attribute__((ext_vector_type(4)));
typedef float f32x2 __attribute__((ext_vector_type(2)));
typedef float f32x16 __attribute__((ext_vector_type(16)));
typedef unsigned u32x4 __attribute__((ext_vector_type(4)));
typedef unsigned u32x2 __attribute__((ext_vector_type(2)));

constexpr int D = 1024, NH = 16, HD = 64;
constexpr int BP = 8, TP = 2064, SEQP = 2048, NMETA = 16, BS = 16, TS = 64, PAST = 4096;
constexpr int MPR = BP * TP;
constexpr int MR = MPR + BS * TS;
constexpr int MP = 17664;
constexpr int NTM = 69;
constexpr int DFF = 2752, DFFP = 2816, NIN = 5632;
constexpr float RMS_EPS = 1e-6f, GN_EPS = 64e-5f;
constexpr float LOG2E = 1.4426950408889634f;

constexpr size_t O_YP = 0, O_YS = 16777216, O_SP = 17825792, O_SHP = 18350080, O_KP = 18358272, O_VP = 35266560,
                 O_SS = 52174848, O_SHS = 53223424, O_KS = 53239808, O_VS = 54288384, O_END = 55336960;

constexpr size_t SZ_ROWBF = (size_t)MP * D * 2, SZ_ROWF = (size_t)MP * D * 4;
constexpr size_t W_X = 0;
constexpr size_t W_XN = W_X + SZ_ROWF;
constexpr size_t W_HB = W_XN + SZ_ROWBF;
constexpr size_t W_WIN = W_HB + (size_t)MP * DFFP * 2;
constexpr size_t SZ_WIN1 = (size_t)NIN * D * 2, SZ_WOUT1 = (size_t)D * DFFP * 2;
constexpr size_t W_WOUT = W_WIN + 4 * SZ_WIN1;
constexpr size_t W_WG1 = W_WOUT + 4 * SZ_WOUT1;
constexpr size_t W_WL2 = W_WG1 + (size_t)3584 * D * 2;
constexpr size_t W_WO1 = W_WL2 + (size_t)3072 * 256 * 2;
constexpr size_t W_WQKV = W_WO1 + (size_t)D * D * 2;
constexpr size_t W_WO2 = W_WQKV + (size_t)3 * D * D * 2;
constexpr size_t W_AALL = W_WO2 + (size_t)D * D * 2;
constexpr size_t W_RKV = W_AALL + 5 * SZ_ROWBF;
constexpr size_t W_L1 = W_RKV + 3 * SZ_ROWBF;
constexpr size_t W_A2 = W_L1 + (size_t)2 * MP * 256 * 4;
constexpr size_t W_DEC = W_A2 + (size_t)MP * 256 * 2;
constexpr size_t W_AA = W_DEC + SZ_ROWBF;
constexpr size_t W_GG = W_AA + SZ_ROWBF;
constexpr size_t W_SO = W_GG + SZ_ROWBF;
constexpr size_t W_OG = W_SO + SZ_ROWF;
constexpr size_t W_QB = W_OG + SZ_ROWBF;
constexpr size_t W_RSQ = W_QB + SZ_ROWBF;
constexpr size_t W_SKF = W_RSQ + (size_t)5 * MP * 4;
constexpr size_t W_SKP = W_SKF + 64 * 1024 * 4;
constexpr size_t W_BAR = W_SKP + (size_t)277 * 262144;
constexpr size_t W_END = W_BAR + 16384;

struct Params { const float* in[31]; float* out; unsigned char* ws; int ph_lo, ph_hi; int seq[64]; };
typedef const Params __attribute__((address_space(4)))* KP;

__device__ __forceinline__ unsigned cvt_pk(float lo, float hi) { unsigned r; asm("v_cvt_pk_bf16_f32 %0, %1, %2" : "=v"(r) : "v"(lo), "v"(hi)); return r; }
__device__ __forceinline__ void store_bf4(bf16_t* p, f32x4 v) { u32x2 w; w.x = cvt_pk(v[0], v[1]); w.y = cvt_pk(v[2], v[3]); *(u32x2*)p = w; }
__device__ __forceinline__ float bf_lo(unsigned w) { return __uint_as_float(w << 16); }
__device__ __forceinline__ float bf_hi(unsigned w) { return __uint_as_float(w & 0xffff0000u); }
__device__ __forceinline__ float sigmoidf_(float x) { return __builtin_amdgcn_rcpf(1.f + __expf(-x)); }
__device__ __forceinline__ float softplusf_(float x) { return fmaxf(x, 0.f) + __logf(1.f + __expf(-fabsf(x))); }
__device__ __forceinline__ float shx(float v, int o, int lane) { return __builtin_bit_cast(float, __builtin_amdgcn_ds_bpermute((lane ^ o) << 2, __builtin_bit_cast(int, v))); }
__device__ __forceinline__ float wave_sum(float v, int lane) {
#pragma unroll
    for (int o = 1; o < 64; o <<= 1) v += shx(v, o, lane);
    return v;
}
__device__ __forceinline__ void row_bt(int row, int& grp, int& b, int& t) { if (row < MPR) { grp = 0; b = row / TP; t = row - b * TP; } else { grp = 1; const int r = row - MPR; b = r >> 6; t = r & 63; } }

using pg8::Unit;
extern __shared__ __attribute__((aligned(16))) unsigned char lds_raw[];
struct EpiSwiGLU {
    static constexpr bool PERM = true, AFTER_DRAIN = false;
    bf16_t* HB; const float* rsq;
    __device__ __forceinline__ void operator()(const f32x4 (&acc)[2][2][4][2], const Unit& u, int wr, int wc, int fr, int fq) const {
        const int row0 = u.pm * 256 + wr * 64 + fr, col0 = u.pn * 128 + wc * 32 + 8 * fq;
#pragma unroll
        for (int ai = 0; ai < 2; ++ai)
#pragma unroll
            for (int m = 0; m < 4; ++m) {
                bf16_t* rowp = HB + (size_t)(row0 + ai * 128 + m * 16) * DFFP + col0;
                const float rs = __builtin_amdgcn_rsqf(rsq[row0 + ai * 128 + m * 16] * (1.f / D) + RMS_EPS);
                float hv[8];
#pragma unroll
                for (int n = 0; n < 2; ++n)
#pragma unroll
                    for (int j = 0; j < 4; ++j) { const float g = acc[ai][0][m][n][j] * rs, up = acc[ai][1][m][n][j] * rs; hv[n * 4 + j] = g * sigmoidf_(g) * up; }
                u32x4 w; w.x = cvt_pk(hv[0], hv[1]); w.y = cvt_pk(hv[2], hv[3]); w.z = cvt_pk(hv[4], hv[5]); w.w = cvt_pk(hv[6], hv[7]);
                *(u32x4*)rowp = w;
            }
    }
};
struct EpiRes {
    static constexpr bool PERM = false, AFTER_DRAIN = false;
    float* X; float scale; float* out; bf16_t* XB; float* rsq; float* spl;
    __device__ __forceinline__ void operator()(const f32x4 (&acc)[2][2][4][2], const Unit& u, int wr, int wc, int fr, int fq, const float* part = nullptr, int tid = 0) const {
        const bool hasp = u.fl == 2;
        if (u.fl == 1 && spl != nullptr) {
            const int t_ = (wr * 4 + wc) * 64 + fq * 16 + fr;
            f32x4* q = (f32x4*)(spl + (size_t)u.tl * 65536) + t_;
#pragma unroll
            for (int ai = 0; ai < 2; ++ai)
#pragma unroll
                for (int bj = 0; bj < 2; ++bj)
#pragma unroll
                    for (int m = 0; m < 4; ++m)
#pragma unroll
                        for (int n = 0; n < 2; ++n) q[(((ai * 2 + bj) * 4 + m) * 2 + n) * 512] = acc[ai][bj][m][n];
            return;
        }
        float* const X_ = X; float* const out_ = out; bf16_t* const XB_ = XB; float* const rsq_ = rsq; const float sc_ = scale;
        const int row0 = u.pm * 256 + wr * 64 + fr, col0 = u.pn * 256 + wc * 32 + 4 * fq, ln = fq * 16 + fr;
#pragma unroll
        for (int ai = 0; ai < 2; ++ai)
#pragma unroll
            for (int m = 0; m < 4; ++m) {
                const int row = row0 + ai * 128 + m * 16;
                const unsigned off = (unsigned)row * D + col0;
                if (out_ == nullptr) {
                    float ss = 0.f;
#pragma unroll
                    for (int bj = 0; bj < 2; ++bj)
#pragma unroll
                        for (int n = 0; n < 2; ++n) { f32x4* q = (f32x4*)(X_ + off + bj * 128 + n * 16); f32x4 av = acc[ai][bj][m][n]; if (hasp) av += pg8::streamk_part(part, ((ai * 2 + bj) * 4 + m) * 2 + n, tid); const f32x4 x = *q + av * sc_; *q = x;
                            if (XB_) { store_bf4(XB_ + off + bj * 128 + n * 16, x); ss += (x[0] * x[0] + x[1] * x[1]) + (x[2] * x[2] + x[3] * x[3]); } }
                    if (XB_) { ss += shx(ss, 16, ln); ss += shx(ss, 32, ln); if (fq == 0) unsafeAtomicAdd(rsq_ + row, ss); }
                } else if (row < MR) {
                    float* dp = nullptr;
                    if (row < MPR) { const int b = row / TP, t = row - b * TP; if (t >= NMETA) dp = out_ + O_YP + ((size_t)b * SEQP + (t - NMETA)) * D + col0; }
                    else dp = out_ + O_YS + (size_t)(row - MPR) * D + col0;
                    if (dp) {
#pragma unroll
                        for (int bj = 0; bj < 2; ++bj)
#pragma unroll
                            for (int n = 0; n < 2; ++n) { f32x4 av = acc[ai][bj][m][n]; if (hasp) av += pg8::streamk_part(part, ((ai * 2 + bj) * 4 + m) * 2 + n, tid); *(f32x4*)(dp + bj * 128 + n * 16) = *(const f32x4*)(X_ + off + bj * 128 + n * 16) + av * sc_; }
                    }
                }
                asm volatile("" ::: "memory");
            }
    }
};
struct TailSplitOrder {
    static constexpr bool STREAM = false;
    pg8::StaticOrder so; int G, c, ns, ntsplit;
    __device__ void init(int M, int N, int K, int G_, int c_, int ns_) { so.init(M, N, 1, 0); so.nt0 = K / 64; G = G_; c = c_; ns = ns_; ntsplit = so.nt0 / ns_; }
    __device__ bool next(int i, Unit& u) const {
        const int L = i * G + c;
        if (L < G && L < so.nwg) return so.next(L, u);
        const int L2 = L - G; if (so.nwg <= G || L2 < 0 || L2 >= (so.nwg - G) * ns) return false;
        const int j = L2 / ns, ch = L2 - j * ns;
        so.next(G + j, u); u.kb = ch * ntsplit * 128; u.nt = ntsplit; u.fl = 1; u.tl = L2; return true;
    }
    __device__ __forceinline__ void a_ready(const Unit&) const {}
    __device__ __forceinline__ void done(const Unit&) const {}
};
struct StreamOrder {
    static constexpr bool STREAM = true;
    int nN, ppt, c; long s, e;
    __device__ void init(int M, int N, int K, int G, int c_) {
        nN = N / 256; ppt = K / 128;
        c = (G % 8 == 0) ? (c_ % 8) * (G / 8) + c_ / 8 : c_;
        const long P = (long)(M / 256) * nN * ppt;
        s = (long)c * P / G; e = (long)(c + 1) * P / G;
    }
    __device__ bool next(int i, Unit& u) const {
        const int t = (int)(s / ppt) + i; const long t0 = (long)t * ppt;
        if (t0 >= e) return false;
        const long lo = s > t0 ? s : t0, hi = e < t0 + ppt ? e : t0 + ppt;
        u.pm = t / nN; u.pn = t - u.pm * nN; u.tl = t;
        u.kb = (int)(lo - t0) * 256; u.nt = (int)(hi - lo) * 2;
        u.fl = lo > t0 ? 1 : (hi < t0 + ppt ? 2 : 0);
        return true;
    }
    __device__ __forceinline__ void a_ready(const Unit&) const {}
    __device__ __forceinline__ void done(const Unit&) const {}
};
struct EpiG1 {
    static constexpr bool PERM = true, AFTER_DRAIN = false;
    bf16_t* RKV; float* L1;
    __device__ __forceinline__ void operator()(const f32x4 (&acc)[2][2][4][2], const Unit& u, int wr, int wc, int fr, int fq) const {
        const unsigned row0 = (unsigned)((u.pm % NTM) * 256 + wr * 64 + fr), cw = wc * 32 + 8 * fq;
        if (u.pn < 12) {
            bf16_t* base = RKV + (size_t)(u.pn >> 2) * MP * D;
            const unsigned off0 = row0 * D + (u.pn & 3) * 256 + cw;
#pragma unroll
            for (int ai = 0; ai < 2; ++ai)
#pragma unroll
                for (int m = 0; m < 4; ++m)
#pragma unroll
                    for (int bj = 0; bj < 2; ++bj) { const f32x4 v0 = acc[ai][bj][m][0], v1 = acc[ai][bj][m][1];
                        u32x4 w; w.x = cvt_pk(v0[0], v0[1]); w.y = cvt_pk(v0[2], v0[3]); w.z = cvt_pk(v1[0], v1[1]); w.w = cvt_pk(v1[2], v1[3]);
                        *(u32x4*)(base + (off0 + (unsigned)((ai * 128 + m * 16) * D + bj * 128))) = w; }
        } else {
            float* base = L1 + (size_t)(u.pn - 12) * MP * 256;
            const unsigned off0 = row0 * 256 + cw;
#pragma unroll
            for (int ai = 0; ai < 2; ++ai)
#pragma unroll
                for (int m = 0; m < 4; ++m)
#pragma unroll
                    for (int bj = 0; bj < 2; ++bj)
#pragma unroll
                        for (int n = 0; n < 2; ++n) *(f32x4*)(base + (off0 + (unsigned)((ai * 128 + m * 16) * 256 + bj * 128 + n * 4))) = acc[ai][bj][m][n];
        }
    }
};
struct EpiG2 {
    static constexpr bool PERM = true, AFTER_DRAIN = false;
    bf16_t* LW;
    __device__ __forceinline__ void operator()(const f32x4 (&acc)[2][2][4][2], const Unit& u, int wr, int wc, int fr, int fq) const {
        bf16_t* base = LW + (size_t)(u.pn >> 2) * MP * D;
        const unsigned off0 = (unsigned)(u.pm * 256 + wr * 64 + fr) * D + (u.pn & 3) * 256 + wc * 32 + 8 * fq;
#pragma unroll
        for (int ai = 0; ai < 2; ++ai)
#pragma unroll
            for (int m = 0; m < 4; ++m)
#pragma unroll
                for (int bj = 0; bj < 2; ++bj) { const f32x4 v0 = acc[ai][bj][m][0], v1 = acc[ai][bj][m][1];
                    u32x4 w; w.x = cvt_pk(v0[0], v0[1]); w.y = cvt_pk(v0[2], v0[3]); w.z = cvt_pk(v1[0], v1[1]); w.w = cvt_pk(v1[2], v1[3]);
                    *(u32x4*)(base + (off0 + (unsigned)((ai * 128 + m * 16) * D + bj * 128))) = w; }
    }
};
struct EpiQKV {
    static constexpr bool PERM = false, AFTER_DRAIN = false;
    bf16_t* QB; float* out; const float* qg; const float* kg; const float* rsq;
    __device__ __forceinline__ void operator()(const f32x4 (&acc)[2][2][4][2], const Unit& u, int wr, int wc, int fr, int fq) const {
        const int sec = u.pn >> 2, head = (u.pn & 3) * 4 + wc, row0 = u.pm * 256 + wr * 64 + fr;
        f32x4 gn[2][2];
#pragma unroll
        for (int bj = 0; bj < 2; ++bj)
#pragma unroll
            for (int n = 0; n < 2; ++n) { const int d = 32 * bj + 16 * n + 4 * fq;
                gn[bj][n] = sec == 0 ? *(const f32x4*)(qg + d) * 0.125f : (sec == 1 ? *(const f32x4*)(kg + d) : (f32x4){1.f, 1.f, 1.f, 1.f}); }
#pragma unroll
        for (int ai = 0; ai < 2; ++ai)
#pragma unroll
            for (int m = 0; m < 4; ++m) {
                const int row = row0 + ai * 128 + m * 16;
                const float rx = __builtin_amdgcn_rsqf(rsq[row] * (1.f / D) + RMS_EPS);
                float ss = 0.f;
#pragma unroll
                for (int bj = 0; bj < 2; ++bj)
#pragma unroll
                    for (int n = 0; n < 2; ++n) { const f32x4 x = acc[ai][bj][m][n]; ss += (x[0] * x[0] + x[1] * x[1]) + (x[2] * x[2] + x[3] * x[3]); }
                { const int ln = fq * 16 + fr; ss += shx(ss, 16, ln); ss += shx(ss, 32, ln); }
                const float rs = rx * (sec == 2 ? 1.f : __builtin_amdgcn_rsqf(ss * rx * rx * (1.f / 64.f) + RMS_EPS));
                if (row < MR) {
                    if (sec == 0) {
                        bf16_t* qp = QB + (size_t)row * D + head * 64 + 4 * fq;
#pragma unroll
                        for (int bj = 0; bj < 2; ++bj)
#pragma unroll
                            for (int n = 0; n < 2; ++n) { const f32x4 x = acc[ai][bj][m][n] * rs * gn[bj][n]; u32x2 w; w.x = cvt_pk(x[0], x[1]); w.y = cvt_pk(x[2], x[3]); *(u32x2*)(qp + 32 * bj + 16 * n) = w; }
                    } else {
                        int grp, b, t; row_bt(row, grp, b, t);
                        float* dp = grp == 0 ? out + (sec == 1 ? O_KP : O_VP) + (((size_t)b * NH + head) * TP + t) * HD
                                             : out + (sec == 1 ? O_KS : O_VS) + (((size_t)b * NH + head) * TS + t) * HD;
                        dp += 4 * fq;
#pragma unroll
                        for (int bj = 0; bj < 2; ++bj)
#pragma unroll
                            for (int n = 0; n < 2; ++n) *(f32x4*)(dp + 32 * bj + 16 * n) = acc[ai][bj][m][n] * rs * gn[bj][n];
                    }
                }
            }
    }
};
struct G1Order {
    static constexpr bool STREAM = false;
    int G, c;
    __device__ bool next(int i, Unit& u) const {
        const long L = (long)i * G + c; if (L >= 966) return false;
        int w = (int)L; { const int q = 966 / 8, r = 966 % 8, xcd = w % 8, off = w / 8; w = (xcd < r ? xcd * (q + 1) : r * (q + 1) + (xcd - r) * q) + off; }
        const int pm = w / 14, q = w % 14;
        if (q < 12) { u.pm = (q >> 2) * NTM + pm; u.pn = q; } else { u.pm = (q - 9) * NTM + pm; u.pn = q; }
        u.kb = 0; u.nt = 16; u.fl = 0; u.tl = 0;
        return true;
    }
    __device__ __forceinline__ void a_ready(const Unit&) const {}
    __device__ __forceinline__ void done(const Unit&) const {}
};

struct Job { const float* src; bf16_t* dst; const float* mu; int ld, Ksrc, koff, Kdst, rows, map, smode; };
__device__ __forceinline__ int srccol(int map, int n, int ld) {
    if (map == 0) return n < ld ? n : -1;
    if (map == 1) { const int pn = n >> 8, c = n & 255, bj = c >> 7, j = c & 127, hc = pn * 128 + j; return hc < DFF ? (bj ? DFF + hc : hc) : -1; }
    { const int t = n >> 8, c = n & 255, bj = c >> 7, wc = (c & 127) >> 5, i = c & 31; return t * 256 + 64 * wc + 32 * bj + i; }
}
__device__ __forceinline__ Job get_job(KP p, int j) {
    Job J; J.mu = nullptr; J.koff = 0; J.map = 0; J.smode = 0;
    unsigned char* ws = p->ws;
    if (j < 4) { J.src = p->in[8] + (size_t)j * D * 2 * DFF; J.dst = (bf16_t*)(ws + W_WIN + j * SZ_WIN1); J.ld = 2 * DFF; J.Ksrc = D; J.Kdst = D; J.rows = NIN; J.map = 1; J.mu = p->in[7] + (size_t)j * D; J.smode = 2; }
    else if (j < 8) { const int i = j - 4; J.src = p->in[9] + (size_t)i * DFF * D; J.dst = (bf16_t*)(ws + W_WOUT + i * SZ_WOUT1); J.ld = D; J.Ksrc = DFF; J.Kdst = DFFP; J.rows = D; }
    else if (j < 11) { const int g = j - 8; J.src = p->in[12] + (size_t)g * D * D; J.dst = (bf16_t*)(ws + W_WG1) + (size_t)g * D * D; J.ld = D; J.Ksrc = D; J.Kdst = D; J.rows = D; }
    else if (j < 17) { const int idx = j - 11, part = idx / 3, which = idx % 3;
        J.src = which == 0 ? p->in[14] : (which == 1 ? p->in[17] : p->in[19]); J.ld = which == 2 ? 128 : 64; J.rows = J.ld;
        J.mu = p->in[11] + (which == 0 ? 1 : (which == 1 ? 4 : 5)) * D; J.smode = part + 1;
        J.dst = (bf16_t*)(ws + W_WG1) + (size_t)(3072 + part * 256 + which * 64) * D; J.Ksrc = D; J.Kdst = D; }
    else if (j < 20) { const int which = j - 17; J.src = which == 0 ? p->in[15] : (which == 1 ? p->in[18] : p->in[20]); J.ld = D; J.rows = D;
        J.Ksrc = which == 2 ? 128 : 64; J.koff = which * 64; J.Kdst = 256; J.dst = (bf16_t*)(ws + W_WL2) + (size_t)which * D * 256; }
    else if (j == 20) { J.src = p->in[26]; J.dst = (bf16_t*)(ws + W_WO1); J.ld = D; J.Ksrc = D; J.Kdst = D; J.rows = D; }
    else if (j == 21) { J.src = p->in[27]; J.dst = (bf16_t*)(ws + W_WQKV); J.ld = 3 * D; J.Ksrc = D; J.Kdst = D; J.rows = 3 * D; J.map = 2; J.mu = p->in[10] + D; J.smode = 2; }
    else { J.src = p->in[30]; J.dst = (bf16_t*)(ws + W_WO2); J.ld = D; J.Ksrc = D; J.Kdst = D; J.rows = D; }
    return J;
}
__device__ __forceinline__ void convert_weights(KP p, LAS float* tl, int tid, int bid, int G) {
    int rot = 0;
    for (int j = 0; j < 23; ++j) {
        const Job J = get_job(p, j);
        const int nkt = J.Kdst >> 6, nnt = (J.rows + 255) >> 8, ntile = nnt * nkt;
        int first = bid - rot; if (first < 0) first += G;
        for (int t = first; t < ntile; t += G) {
            const int n0 = (t / nkt) << 8, k0 = (t % nkt) << 6;
            const bool inside = k0 >= J.koff && k0 < J.koff + J.Ksrc;
            if (inside) {
                const int nn = tid & 255, kh = tid >> 8;
                const int sc = (n0 + nn) < J.rows ? srccol(J.map, n0 + nn, J.ld) : -1;
                const float* sp = J.src + (size_t)(k0 - J.koff + kh) * J.ld + (sc >= 0 ? sc : 0);
                float v[32];
#pragma unroll
                for (int it = 0; it < 32; ++it) v[it] = sc >= 0 ? sp[(size_t)(2 * it) * J.ld] : 0.f;
                if (J.smode) {
#pragma unroll
                    for (int it = 0; it < 32; ++it) { const float m = J.mu[k0 - J.koff + kh + 2 * it]; v[it] *= J.smode == 1 ? 1.f - m : m; }
                }
#pragma unroll
                for (int it = 0; it < 32; ++it) tl[(kh + 2 * it) * 257 + nn] = v[it];
            }
            __syncthreads();
            {
                const int nn = tid >> 1, kh = (tid & 1) * 32;
                if (n0 + nn < J.rows) {
                    bf16_t* dp = J.dst + (size_t)(n0 + nn) * J.Kdst + k0 + kh;
#pragma unroll
                    for (int q = 0; q < 4; ++q) {
                        const unsigned z_ = (unsigned)tid >> 31;
                        u32x4 w = (u32x4){z_, z_, z_, z_};
                        if (inside) { float v[8];
#pragma unroll
                            for (int e = 0; e < 8; ++e) v[e] = tl[(kh + q * 8 + e) * 257 + nn];
                            w.x = cvt_pk(v[0], v[1]); w.y = cvt_pk(v[2], v[3]); w.z = cvt_pk(v[4], v[5]); w.w = cvt_pk(v[6], v[7]); }
                        *(u32x4*)(dp + q * 8) = w;
                    }
                }
            }
            __syncthreads();
        }
        rot = (rot + ntile) % G;
    }
}
__device__ __forceinline__ float row_rstd(const f32x4 (&v)[4], int lane) {
    float s = 0.f;
#pragma unroll
    for (int i = 0; i < 4; ++i) s += (v[i][0] * v[i][0] + v[i][1] * v[i][1]) + (v[i][2] * v[i][2] + v[i][3] * v[i][3]);
    s = wave_sum(s, lane);
    return __builtin_amdgcn_rsqf(s * (1.f / D) + RMS_EPS);
}

__device__ __forceinline__ void assemble_x(KP p, int tid, int bid, int G) {
    const int lane = tid & 63, gw = bid * 8 + (tid >> 6), nw = G * 8;
    float* X = (float*)(p->ws + W_X); bf16_t* XN = (bf16_t*)(p->ws + W_XN);
    for (int row = gw; row < MP; row += nw) {
        f32x4 v[4];
        const float* src = nullptr;
        if (row < MPR) { const int b = row / TP, t = row - b * TP; src = t < NMETA ? p->in[6] + (size_t)t * D : p->in[0] + ((size_t)b * SEQP + (t - NMETA)) * D; }
        else if (row < MR) src = p->in[1] + (size_t)(row - MPR) * D;
#pragma unroll
        for (int i = 0; i < 4; ++i) { const float zf = __uint_as_float((unsigned)tid >> 31); v[i] = src ? *(const f32x4*)(src + lane * 4 + 256 * i) : (f32x4){zf, zf, zf, zf}; }
        float ssq = 0.f;
#pragma unroll
        for (int i = 0; i < 4; ++i) ssq += (v[i][0] * v[i][0] + v[i][1] * v[i][1]) + (v[i][2] * v[i][2] + v[i][3] * v[i][3]);
        ssq = wave_sum(ssq, lane);
#pragma unroll
        for (int i = 0; i < 4; ++i) { const int c = lane * 4 + 256 * i; *(f32x4*)(X + (size_t)row * D + c) = v[i]; store_bf4(XN + (size_t)row * D + c, v[i]); }
        float* rsq = (float*)(p->ws + W_RSQ);
        if (lane < 5) rsq[(size_t)lane * MP + row] = lane == 0 ? ssq : 0.f;
    }    for (int i = gw * 64 + lane; i < 64 * 1024; i += nw * 64) ((unsigned*)(p->ws + W_SKF))[i] = 0u;
    for (int i = gw * 64 + lane; i < 65536; i += nw * 64) ((float*)(p->ws + W_SKP) + (size_t)276 * 65536)[i] = 0.f;
}
__device__ __forceinline__ void norm_phase(KP p, const float* g, int tid, int bid, int G, bool copy_y = false) {
    const int lane = tid & 63, gw = bid * 8 + (tid >> 6), nw = G * 8;
    const float* X = (const float*)(p->ws + W_X); bf16_t* XN = (bf16_t*)(p->ws + W_XN);
    for (int row = gw; row < MP; row += nw) {
        f32x4 v[4];
#pragma unroll
        for (int i = 0; i < 4; ++i) v[i] = *(const f32x4*)(X + (size_t)row * D + lane * 4 + 256 * i);
        const float rs = row_rstd(v, lane);
#pragma unroll
        for (int i = 0; i < 4; ++i) { const int c = lane * 4 + 256 * i; store_bf4(XN + (size_t)row * D + c, v[i] * rs * *(const f32x4*)(g + c)); }
        if (copy_y && row < MR) {
            float* dp = nullptr;
            if (row < MPR) { const int b = row / TP, t = row - b * TP; if (t >= NMETA) dp = p->out + O_YP + ((size_t)b * SEQP + (t - NMETA)) * D; }
            else dp = p->out + O_YS + (size_t)(row - MPR) * D;
            if (dp) {
#pragma unroll
                for (int i = 0; i < 4; ++i) *(f32x4*)(dp + lane * 4 + 256 * i) = v[i];
            }
        }
    }
}
__device__ __forceinline__ void mixprep_phase(KP p, int tid, int bid, int G) {
    const int lane = tid & 63, gw = bid * 8 + (tid >> 6), nw = G * 8;
    const float* X = (const float*)(p->ws + W_X); bf16_t* A = (bf16_t*)(p->ws + W_AALL);
    const float* g = p->in[10]; const float* mu = p->in[11];
    const int rb = (MR + nw - 1) / nw;
    f32x4 hl[4];
    for (int row = gw * rb, k = 0; k < rb && row < MR; ++row, ++k) {
        int grp, b, t; row_bt(row, grp, b, t);
        f32x4 v[4], pv[4];
#pragma unroll
        for (int i = 0; i < 4; ++i) v[i] = *(const f32x4*)(X + (size_t)row * D + lane * 4 + 256 * i);
        const float rs = row_rstd(v, lane);
        if (t > 0) {
            if (k == 0) {
#pragma unroll
                for (int i = 0; i < 4; ++i) pv[i] = *(const f32x4*)(X + (size_t)(row - 1) * D + lane * 4 + 256 * i);
                const float rp = row_rstd(pv, lane);
#pragma unroll
                for (int i = 0; i < 4; ++i) pv[i] = pv[i] * rp * *(const f32x4*)(g + lane * 4 + 256 * i);
            } else {
#pragma unroll
                for (int i = 0; i < 4; ++i) pv[i] = hl[i];
            }
        } else {
#pragma unroll
            for (int i = 0; i < 4; ++i) { const float zf = __uint_as_float((unsigned)tid >> 31); pv[i] = grp == 0 ? (f32x4){zf, zf, zf, zf} : *(const f32x4*)(p->in[3] + (size_t)b * D + lane * 4 + 256 * i); }
        }
        const bool last = t == (grp == 0 ? TP - 1 : TS - 1);
        float* sh = grp == 0 ? p->out + O_SHP + (size_t)b * D : p->out + O_SHS + (size_t)b * D;
#pragma unroll
        for (int i = 0; i < 4; ++i) {
            const int c = lane * 4 + 256 * i; const size_t o = (size_t)row * D + c;
            const f32x4 h = v[i] * rs * *(const f32x4*)(g + c), dx = pv[i] - h;
            store_bf4(A + o, h + dx * *(const f32x4*)(mu + c));
            store_bf4(A + (size_t)MP * D + o, h + dx * *(const f32x4*)(mu + 2 * D + c));
            store_bf4(A + (size_t)2 * MP * D + o, h + dx * *(const f32x4*)(mu + 3 * D + c));
            store_bf4(A + (size_t)3 * MP * D + o, h);
            store_bf4(A + (size_t)4 * MP * D + o, pv[i]);
            if (last) *(f32x4*)(sh + c) = h;
            hl[i] = h;
        }
    }
}
__device__ __forceinline__ void act_phase(KP p, int gtid, int nthr) {
    const float* L1 = (const float*)(p->ws + W_L1); bf16_t* A2 = (bf16_t*)(p->ws + W_A2);
    for (int i = gtid; i < MP * 64; i += nthr) {
        const int c = (i & 63) * 4;
        f32x4 v = *(const f32x4*)(L1 + (size_t)i * 4) + *(const f32x4*)(L1 + (size_t)MP * 256 + (size_t)i * 4);
        if (c < 64) {
#pragma unroll
            for (int j = 0; j < 4; ++j) v[j] = 1.f - 2.f * __builtin_amdgcn_rcpf(1.f + __expf(2.f * v[j]));
        } else if (c >= 128) {
#pragma unroll
            for (int j = 0; j < 4; ++j) v[j] = sigmoidf_(v[j]);
        }
        store_bf4(A2 + (size_t)i * 4, v);
    }
}

__device__ __forceinline__ float dpp_sum16(float x) {
    x += __builtin_bit_cast(float, __builtin_amdgcn_update_dpp(0, __builtin_bit_cast(int, x), 0xB1, 0xF, 0xF, true));
    x += __builtin_bit_cast(float, __builtin_amdgcn_update_dpp(0, __builtin_bit_cast(int, x), 0x4E, 0xF, 0xF, true));
    x += __builtin_bit_cast(float, __builtin_amdgcn_update_dpp(0, __builtin_bit_cast(int, x), 0x141, 0xF, 0xF, true));
    x += __builtin_bit_cast(float, __builtin_amdgcn_update_dpp(0, __builtin_bit_cast(int, x), 0x140, 0xF, 0xF, true));
    return x;
}
constexpr int SC_CH = 16, SC_STR = 400;
__device__ __forceinline__ void scan_phase(KP p, LAS float* buf, int tid, int bid, int G) {
    const int wid = tid >> 6, lane = tid & 63;
    const bf16_t* RKV = (const bf16_t*)(p->ws + W_RKV); const bf16_t* DEC = (const bf16_t*)(p->ws + W_DEC); const bf16_t* AA = (const bf16_t*)(p->ws + W_AA);
    bf16_t* SO = (bf16_t*)(p->ws + W_SO);
    const bool producer = wid >= 4;
    for (int u = bid; u < 768; u += G) {
        int bh, half, T, row0; const float* S0; float* Sout;
        if (u < 256) { bh = u >> 1; half = u & 1; T = TP; row0 = (bh >> 4) * TP; S0 = nullptr; Sout = p->out + O_SP + (size_t)bh * 4096; }
        else { const int v = u - 256; bh = v >> 1; half = v & 1; T = TS; row0 = MPR + (bh >> 4) * TS; S0 = p->in[2] + (size_t)bh * 4096; Sout = p->out + O_SS + (size_t)bh * 4096; }
        const int h = bh & 15, nchunk = T / SC_CH;
        if (producer) {
            const int t2 = tid - 256, pi = t2 >> 4, pj = t2 & 15, kc = h * 64 + 4 * pj;
            const f32x4 kkv = *(const f32x4*)(p->in[21] + kc), kav = *(const f32x4*)(p->in[22] + kc), w0v = *(const f32x4*)(p->in[13] + kc), a0v = *(const f32x4*)(p->in[16] + kc);
            u32x2 pr, pk, pvv, pa, pd;
#define SC_LOAD(c) do { const size_t o = (size_t)(row0 + (c) * SC_CH + pi) * D + kc; pr = *(const u32x2*)(RKV + o); pk = *(const u32x2*)(RKV + (size_t)MP * D + o); \
            pvv = *(const u32x2*)(RKV + (size_t)2 * MP * D + o); pa = *(const u32x2*)(AA + o); pd = *(const u32x2*)(DEC + o); } while (0)
#define SC_STORE(bi) do { LAS float* rec = buf + (bi) * (SC_CH * SC_STR) + pi * SC_STR; \
            const f32x4 r = (f32x4){bf_lo(pr.x), bf_hi(pr.x), bf_lo(pr.y), bf_hi(pr.y)}, k = (f32x4){bf_lo(pk.x), bf_hi(pk.x), bf_lo(pk.y), bf_hi(pk.y)}; \
            const f32x4 v = (f32x4){bf_lo(pvv.x), bf_hi(pvv.x), bf_lo(pvv.y), bf_hi(pvv.y)}; \
            f32x4 a = (f32x4){bf_lo(pa.x), bf_hi(pa.x), bf_lo(pa.y), bf_hi(pa.y)} + a0v; f32x4 w = (f32x4){bf_lo(pd.x), bf_hi(pd.x), bf_lo(pd.y), bf_hi(pd.y)} + w0v; \
            _Pragma("unroll") for (int j = 0; j < 4; ++j) { a[j] = sigmoidf_(a[j]); w[j] = __expf(-__expf(-softplusf_(-w[j]) - 0.5f)); } \
            const f32x4 q = k * kkv; float ss = (q[0] * q[0] + q[1] * q[1]) + (q[2] * q[2] + q[3] * q[3]); ss = dpp_sum16(ss); \
            const float inv = 1.f / fmaxf(sqrtf(ss), 1e-12f); const f32x4 nk = q * inv; \
            const f32x4 kp = k * (1.f + (a - 1.f) * kav), bb = nk * a; \
            float br = (bb[0] * r[0] + bb[1] * r[1]) + (bb[2] * r[2] + bb[3] * r[3]), kr = (kp[0] * r[0] + kp[1] * r[1]) + (kp[2] * r[2] + kp[3] * r[3]); \
            br = dpp_sum16(br); kr = dpp_sum16(kr); \
            *(LAS f32x4*)(rec + 4 * pj) = w; *(LAS f32x4*)(rec + 64 + 4 * pj) = nk; *(LAS f32x4*)(rec + 128 + 4 * pj) = bb; \
            *(LAS f32x4*)(rec + 192 + 4 * pj) = kp; *(LAS f32x4*)(rec + 256 + 4 * pj) = w * r; *(LAS f32x4*)(rec + 320 + 4 * pj) = v; \
            if (pj == 0) *(LAS f32x2*)(rec + 384) = (f32x2){br, kr}; } while (0)
            SC_LOAD(0); SC_STORE(0);
            if (nchunk > 1) SC_LOAD(1);
            __syncthreads();
            for (int c = 0; c < nchunk; ++c) {
                if (c + 1 < nchunk) { SC_STORE((c + 1) & 1); if (c + 2 < nchunk) SC_LOAD(c + 2); }
                __syncthreads();
            }
#undef SC_LOAD
#undef SC_STORE
        } else {
            const int rp = lane >> 4, kq = lane & 15, vA = half * 32 + wid * 8 + rp * 2;
            f32x4 sA = (f32x4){0.f, 0.f, 0.f, 0.f}, sB = sA;
            if (S0) { sA = *(const f32x4*)(S0 + vA * 64 + kq * 4); sB = *(const f32x4*)(S0 + (vA + 1) * 64 + kq * 4); }
            bf16_t* op = SO + (size_t)(row0 + kq) * D + h * 64 + vA;
            __syncthreads();
            for (int c = 0; c < nchunk; ++c) {
                const LAS float* cb = buf + (c & 1) * (SC_CH * SC_STR);
                float oA = 0.f, oB = 0.f;
#pragma unroll
                for (int i = 0; i < SC_CH; ++i) {
                    const LAS float* rec = cb + i * SC_STR;
                    const f32x4 wd = *(const LAS f32x4*)(rec + kq * 4), kk = *(const LAS f32x4*)(rec + 64 + kq * 4), bb = *(const LAS f32x4*)(rec + 128 + kq * 4),
                                kp = *(const LAS f32x4*)(rec + 192 + kq * 4), wr = *(const LAS f32x4*)(rec + 256 + kq * 4);
                    const f32x2 vv = *(const LAS f32x2*)(rec + 320 + vA), sc = *(const LAS f32x2*)(rec + 384);
                    const f32x2 t1A = sA.hi * kk.hi + sA.lo * kk.lo, t1B = sB.hi * kk.hi + sB.lo * kk.lo, t2A = sA.hi * wr.hi + sA.lo * wr.lo, t2B = sB.hi * wr.hi + sB.lo * wr.lo;
                    float d1A = t1A.x + t1A.y, d1B = t1B.x + t1B.y, d2A = t2A.x + t2A.y, d2B = t2B.x + t2B.y;
#define DPPR(ctl) "v_add_f32_dpp %0, %0, %0 " ctl " row_mask:0xf bank_mask:0xf bound_ctrl:1\n\tv_add_f32_dpp %1, %1, %1 " ctl " row_mask:0xf bank_mask:0xf bound_ctrl:1\n\t" \
                  "v_add_f32_dpp %2, %2, %2 " ctl " row_mask:0xf bank_mask:0xf bound_ctrl:1\n\tv_add_f32_dpp %3, %3, %3 " ctl " row_mask:0xf bank_mask:0xf bound_ctrl:1\n\t"
                    asm("s_nop 1\n\t" DPPR("quad_perm:[1,0,3,2]") DPPR("quad_perm:[2,3,0,1]") DPPR("row_half_mirror") DPPR("row_mirror") : "+v"(d1A), "+v"(d1B), "+v"(d2A), "+v"(d2B));
#undef DPPR
                    const float saA = -d1A, saB = -d1B;
                    const float tA = d2A + saA * sc.x + vv.x * sc.y, tB = d2B + saB * sc.x + vv.y * sc.y;
                    sA = sA * wd + bb * saA + kp * vv.x;
                    sB = sB * wd + bb * saB + kp * vv.y;
                    oA = kq == i ? tA : oA; oB = kq == i ? tB : oB;
                }
                *(unsigned*)(op + (size_t)c * SC_CH * D) = cvt_pk(oA, oB);
                __syncthreads();
            }
            *(f32x4*)(Sout + vA * 64 + kq * 4) = sA; *(f32x4*)(Sout + (vA + 1) * 64 + kq * 4) = sB;
        }
    }
}
__device__ __forceinline__ void post_phase(KP p, int tid, int bid, int G) {
    const int lane = tid & 63, gw = bid * 8 + (tid >> 6), nw = G * 8;
    const bf16_t* RKV = (const bf16_t*)(p->ws + W_RKV); const bf16_t* AA = (const bf16_t*)(p->ws + W_AA); const bf16_t* GG = (const bf16_t*)(p->ws + W_GG);
    const bf16_t* SO = (const bf16_t*)(p->ws + W_SO); bf16_t* OG = (bf16_t*)(p->ws + W_OG);
    const float* k_a = p->in[22]; const float* a0p = p->in[16]; const float* r_k = p->in[23]; const float* gnw = p->in[24]; const float* gnb = p->in[25];
    const int c0 = lane * 16;
    for (int row = gw; row < MR; row += nw) {
        const size_t o = (size_t)row * D + c0;
        float ov[16], rv[16], kv[16], vv[16], av[16], gv[16];
#pragma unroll
#define LD16(dst, ptr) do { const u32x4 a_ = *(const u32x4*)(ptr), b_ = *(const u32x4*)((ptr) + 8); \
        dst[0] = bf_lo(a_.x); dst[1] = bf_hi(a_.x); dst[2] = bf_lo(a_.y); dst[3] = bf_hi(a_.y); dst[4] = bf_lo(a_.z); dst[5] = bf_hi(a_.z); dst[6] = bf_lo(a_.w); dst[7] = bf_hi(a_.w); \
        dst[8] = bf_lo(b_.x); dst[9] = bf_hi(b_.x); dst[10] = bf_lo(b_.y); dst[11] = bf_hi(b_.y); dst[12] = bf_lo(b_.z); dst[13] = bf_hi(b_.z); dst[14] = bf_lo(b_.w); dst[15] = bf_hi(b_.w); } while (0)
        LD16(ov, SO + o); LD16(rv, RKV + o); LD16(kv, RKV + (size_t)MP * D + o); LD16(vv, RKV + (size_t)2 * MP * D + o); LD16(av, AA + o); LD16(gv, GG + o);
#undef LD16
        float sm = 0.f, rk = 0.f;
#pragma unroll
        for (int e = 0; e < 16; ++e) { sm += ov[e]; const float kp = kv[e] * (1.f + (sigmoidf_(a0p[c0 + e] + av[e]) - 1.f) * k_a[c0 + e]); rk += rv[e] * kp * r_k[c0 + e]; }
        sm += shx(sm, 1, lane); sm += shx(sm, 2, lane); rk += shx(rk, 1, lane); rk += shx(rk, 2, lane);
        const float mean = sm * (1.f / 64.f);
        float vs = 0.f;
#pragma unroll
        for (int e = 0; e < 16; ++e) { const float d = ov[e] - mean; vs += d * d; }
        vs += shx(vs, 1, lane); vs += shx(vs, 2, lane);
        const float rstd = __builtin_amdgcn_rsqf(vs * (1.f / 64.f) + GN_EPS);
        unsigned w[8];
#pragma unroll
        for (int e = 0; e < 16; e += 2) {
            const float y0 = ((ov[e] - mean) * rstd * gnw[c0 + e] + gnb[c0 + e] + rk * vv[e]) * gv[e];
            const float y1 = ((ov[e + 1] - mean) * rstd * gnw[c0 + e + 1] + gnb[c0 + e + 1] + rk * vv[e + 1]) * gv[e + 1];
            w[e >> 1] = cvt_pk(y0, y1);
        }
        *(u32x4*)(OG + o) = (u32x4){w[0], w[1], w[2], w[3]}; *(u32x4*)(OG + o + 8) = (u32x4){w[4], w[5], w[6], w[7]};
    }
}

__device__ __forceinline__ int crow(int r, int hi) { return (r & 3) + 8 * (r >> 2) + 4 * hi; }
__device__ __forceinline__ bf16x8 pack8(f32x4 a, f32x4 b) {
    u32x4 w; w.x = cvt_pk(a[0], a[1]); w.y = cvt_pk(a[2], a[3]); w.z = cvt_pk(b[0], b[1]); w.w = cvt_pk(b[2], b[3]);
    return __builtin_bit_cast(bf16x8, w);
}
__device__ __forceinline__ void attn_phase(KP p, int tid, int bid, int G) {
    const int lane = tid & 63, gw = bid * 8 + (tid >> 6), nw = G * 8;
    const bf16_t* QB = (const bf16_t*)(p->ws + W_QB); bf16_t* AO = (bf16_t*)(p->ws + W_OG);
    const int ql = lane & 31, hi = lane >> 5;
    constexpr int NU_P = BP * NH * 65;
    for (int u = gw; u < NU_P + BS * NH * 2; u += nw) {
        int bh, Q0, nq, npast, row_base, Tn; const float *kc, *vc, *kn, *vn;
        if (u < NU_P) { bh = u / 65; Q0 = (u - bh * 65) * 32; nq = min(32, TP - Q0); npast = 0; row_base = (bh >> 4) * TP; Tn = TP;
            kc = nullptr; vc = nullptr; kn = p->out + O_KP + (size_t)bh * TP * HD; vn = p->out + O_VP + (size_t)bh * TP * HD; }
        else { const int v = u - NU_P; bh = v >> 1; Q0 = (v & 1) * 32; nq = 32; npast = PAST; row_base = MPR + (bh >> 4) * TS; Tn = TS;
            kc = p->in[4] + (size_t)bh * PAST * HD; vc = p->in[5] + (size_t)bh * PAST * HD; kn = p->out + O_KS + (size_t)bh * TS * HD; vn = p->out + O_VS + (size_t)bh * TS * HD; }
        const int h = bh & 15, qpos0 = npast + Q0;
        bf16x8 qf[4];
        { const bf16_t* qp = QB + (size_t)(row_base + Q0 + min(ql, nq - 1)) * D + h * 64 + hi * 8;
#pragma unroll
          for (int s = 0; s < 4; ++s) qf[s] = *(const bf16x8*)(qp + 16 * s); }
        f32x16 o0, o1;
#pragma unroll
        for (int r = 0; r < 16; ++r) { o0[r] = 0.f; o1[r] = 0.f; }
        float carry = ql < nq ? 0.f : -1e30f;
        const int qpos = qpos0 + ql;
        f32x4 kc4[8];
#define ATT_TILE_PTRS(P0_, kb_, vb_, lim_) const bool inpast_ = (P0_) < npast; \
            const float* kb_ = inpast_ ? kc + (size_t)(P0_) * HD : kn + (size_t)((P0_) - npast) * HD; \
            const float* vb_ = inpast_ ? vc + (size_t)(P0_) * HD : vn + (size_t)((P0_) - npast) * HD; \
            const int lim_ = inpast_ ? 31 : min(31, Tn - 1 - ((P0_) - npast));
        { ATT_TILE_PTRS((qpos0 >> 5) * 32, kb0, vb0, lim0); (void)vb0;
          const float* kp = kb0 + (size_t)min(ql, lim0) * HD + hi * 8;
#pragma unroll
          for (int s = 0; s < 4; ++s) { kc4[2 * s] = *(const f32x4*)(kp + 16 * s); kc4[2 * s + 1] = *(const f32x4*)(kp + 16 * s + 4); } }
        for (int kt = qpos0 >> 5; kt >= 0; --kt) {
            const int P0 = kt * 32;
            ATT_TILE_PTRS(P0, kb, vb, lim); (void)kb;
            float x0[16], x1[16];
#pragma unroll
            for (int r = 0; r < 16; ++r) { const float* vp = vb + (size_t)min(crow(r, hi), lim) * HD + ql; x0[r] = vp[0]; x1[r] = vp[32]; }
            f32x4 kn4[8];
            { const int Pn = kt > 0 ? P0 - 32 : P0; ATT_TILE_PTRS(Pn, kbn, vbn, limn); (void)vbn;
              const float* kp = kbn + (size_t)min(ql, limn) * HD + hi * 8;
#pragma unroll
              for (int s = 0; s < 4; ++s) { kn4[2 * s] = *(const f32x4*)(kp + 16 * s); kn4[2 * s + 1] = *(const f32x4*)(kp + 16 * s + 4); } }
            f32x16 st;
#pragma unroll
            for (int r = 0; r < 16; ++r) st[r] = 0.f;
#pragma unroll
            for (int s = 0; s < 4; ++s) st = __builtin_amdgcn_mfma_f32_32x32x16_bf16(pack8(kc4[2 * s], kc4[2 * s + 1]), qf[s], st, 0, 0, 0);
            float L[16];
            float own[4];
#pragma unroll
            for (int g = 0; g < 4; ++g) { float sg = 0.f;
#pragma unroll
                for (int i = 0; i < 4; ++i) { const int r = 4 * g + i; const bool vis = (P0 + crow(r, hi)) < qpos; L[r] = vis ? -softplusf_(st[r]) : 0.f; sg += L[r]; }
                own[g] = sg; }
            float oth[4];
#pragma unroll
            for (int g = 0; g < 4; ++g) oth[g] = shx(own[g], 32, lane);
            float suf = carry;
            float A[16];
#pragma unroll
            for (int g = 3; g >= 0; --g) {
                float c = suf + (hi == 0 ? oth[g] : 0.f);
#pragma unroll
                for (int i = 3; i >= 0; --i) { const int r = 4 * g + i; c += L[r]; const bool vis = (P0 + crow(r, hi)) < qpos; A[r] = vis ? __expf(st[r] + c) : 0.f; }
                suf += own[g] + oth[g];
            }
            carry = suf;
            const bf16x8 pa0 = pack8((f32x4){A[0], A[1], A[2], A[3]}, (f32x4){A[4], A[5], A[6], A[7]});
            const bf16x8 pa1 = pack8((f32x4){A[8], A[9], A[10], A[11]}, (f32x4){A[12], A[13], A[14], A[15]});
            o0 = __builtin_amdgcn_mfma_f32_32x32x16_bf16(pa0, pack8((f32x4){x0[0], x0[1], x0[2], x0[3]}, (f32x4){x0[4], x0[5], x0[6], x0[7]}), o0, 0, 0, 0);
            o1 = __builtin_amdgcn_mfma_f32_32x32x16_bf16(pa0, pack8((f32x4){x1[0], x1[1], x1[2], x1[3]}, (f32x4){x1[4], x1[5], x1[6], x1[7]}), o1, 0, 0, 0);
            o0 = __builtin_amdgcn_mfma_f32_32x32x16_bf16(pa1, pack8((f32x4){x0[8], x0[9], x0[10], x0[11]}, (f32x4){x0[12], x0[13], x0[14], x0[15]}), o0, 0, 0, 0);
            o1 = __builtin_amdgcn_mfma_f32_32x32x16_bf16(pa1, pack8((f32x4){x1[8], x1[9], x1[10], x1[11]}, (f32x4){x1[12], x1[13], x1[14], x1[15]}), o1, 0, 0, 0);
#pragma unroll
            for (int e = 0; e < 8; ++e) kc4[e] = kn4[e];
            if (!__any(carry >= -104.f)) break;
        }
#undef ATT_TILE_PTRS
        bf16_t* op = AO + (size_t)(row_base + Q0) * D + h * 64 + ql;
#pragma unroll
        for (int r = 0; r < 16; ++r) { const int qr = crow(r, hi); if (qr < nq) { op[(size_t)qr * D] = (bf16_t)(cvt_pk(o0[r], 0.f) & 0xffffu); op[(size_t)qr * D + 32] = (bf16_t)(cvt_pk(o1[r], 0.f) & 0xffffu); } }
    }
}

template <int NS> __device__ __forceinline__ void fixup_phase(KP p, int ffn, int tid, int bid, int G) {
    float* X = (float*)(p->ws + W_X); bf16_t* XB = (bf16_t*)(p->ws + W_XN); const float* spl = (const float*)(p->ws + W_SKP);
    float* rsq = (float*)(p->ws + W_RSQ) + (size_t)(ffn == 1 ? 2 : (ffn == 2 ? 3 : (ffn == 4 ? 1 : 4))) * MP;
    const bool fold = ffn == 1 || ffn == 2 || ffn >= 4, fin = ffn == 3; const float scl = ffn >= 4 ? 1.0f : 0.5f;
    pg8::StaticOrder so; so.init(MP, D, 1, 0); so.nt0 = 0;
    const int ntail = so.nwg - G; if (ntail <= 0) return;
    const int wid = tid >> 6, lane = tid & 63, wr = wid >> 2, wc = wid & 3, fr = lane & 15, fq = lane >> 4;
    for (int B = bid; B < ntail * 32; B += G) {
        const int j = B >> 5, q = B & 31, n = q & 1, m = (q >> 1) & 3, bj = (q >> 3) & 1, ai = q >> 4;
        Unit u; so.next(G + j, u);
        f32x4 pv_[NS];
#pragma unroll
        for (int ch = 0; ch < NS; ++ch) pv_[ch] = *((const f32x4*)(spl + (size_t)(j * NS + ch) * 65536) + q * 512 + tid);
        f32x4 sum = pv_[0];
#pragma unroll
        for (int ch = 1; ch < NS; ++ch) sum += pv_[ch];
        const int row = u.pm * 256 + ai * 128 + wr * 64 + m * 16 + fr, col = u.pn * 256 + bj * 128 + wc * 32 + n * 16 + fq * 4;
        const size_t off = (size_t)row * D + col;
        const f32x4 x = *(const f32x4*)(X + off) + sum * scl;
        if (!fin) {
            *(f32x4*)(X + off) = x;
            if (fold) { store_bf4(XB + off, x); float ss = (x[0] * x[0] + x[1] * x[1]) + (x[2] * x[2] + x[3] * x[3]); ss += shx(ss, 16, lane); ss += shx(ss, 32, lane); if (fq == 0) unsafeAtomicAdd(rsq + row, ss); }
        } else if (row < MR) {
            float* dp = nullptr;
            if (row < MPR) { const int b = row / TP, t = row - b * TP; if (t >= NMETA) dp = p->out + O_YP + ((size_t)b * SEQP + (t - NMETA)) * D + col; }
            else dp = p->out + O_YS + (size_t)(row - MPR) * D + col;
            if (dp) *(f32x4*)dp = x;
        }
    }
}
#define XB_TMO      128
#define XB_XCNT(j)  (256  + 64 * (j))
#define XB_XSUB(j)  (1280 + 64 * (j))
#define XB_XGEN(j)  (2304 + 64 * (j))
#define XB_TOP      3328
#define XB_TOPGEN   3392
#define XCD_BAR_WORDS 3456
#define XB_SPIN_CAP (1u << 18)

__device__ __forceinline__ unsigned xb_ld(unsigned* p)              { return __hip_atomic_load(p, __ATOMIC_RELAXED, __HIP_MEMORY_SCOPE_AGENT); }
__device__ __forceinline__ unsigned xb_add(unsigned* p, unsigned v) { return __hip_atomic_fetch_add(p, v, __ATOMIC_RELAXED, __HIP_MEMORY_SCOPE_AGENT); }
__device__ __forceinline__ unsigned xb_xcc_id() { return (unsigned)__builtin_amdgcn_s_getreg((3 << 11) | 20) & 0xFu; }
#define XB_SPIN(cond, bar) do { unsigned _sp = 0; while (cond) { __builtin_amdgcn_s_sleep(1); \
    if ((++_sp & 255u) == 0u) { if (xb_ld(&(bar)[XB_TMO])) break; if (_sp > XB_SPIN_CAP) { atomicAdd(&(bar)[XB_TMO], 1u); break; } } } } while (0)

struct XcdBarrier {
    unsigned* bar; unsigned x;
    volatile LAS unsigned* st;
};

__device__ __forceinline__ XcdBarrier xcd_barrier_post(unsigned* bar, volatile LAS unsigned* st, bool xb_tid0) {
    XcdBarrier b; b.bar = bar; b.x = xb_xcc_id(); b.st = st;
    if (xb_tid0) (void)xb_add(&bar[XB_XCNT(b.x)], 1u);
    return b;
}
__device__ __forceinline__ void xcd_barrier_complete(unsigned* bar, unsigned x, unsigned& nloc, unsigned& nx) {
    const unsigned G = gridDim.x * gridDim.y * gridDim.z;
    unsigned sum, cnt, mine, sp = 0u;
    for (;;) {
        sum = 0u; cnt = 0u; mine = 0u;
#pragma unroll
        for (unsigned j = 0; j < 16; ++j) { const unsigned c = xb_ld(&bar[XB_XCNT(j)]); sum += c; cnt += (c > 0u) ? 1u : 0u; mine = (j == x) ? c : mine; }
        if (sum == G) break;
        __builtin_amdgcn_s_sleep(1);
        if ((++sp & 255u) == 0u) { if (xb_ld(&bar[XB_TMO])) break; if (sp > XB_SPIN_CAP) { atomicAdd(&bar[XB_TMO], 1u); break; } }
    }
    nloc = mine > 0u ? mine : 1u; nx = cnt > 0u ? cnt : 1u;
}

__device__ __forceinline__ void xcd_barrier(const XcdBarrier& b, bool xb_tid0) {
    asm volatile("s_waitcnt vmcnt(0)" ::: "memory");
    __syncthreads();
    if (xb_tid0) {
        unsigned* bar = b.bar;
        __builtin_amdgcn_s_waitcnt(0);
        unsigned nloc = b.st[0], nx = b.st[1];
        if (nloc == 0u) { xcd_barrier_complete(bar, b.x, nloc, nx); b.st[0] = nloc; b.st[1] = nx; }
        const unsigned old = xb_add(&bar[XB_XSUB(b.x)], 1u);
        const unsigned gen = old / nloc;
        if (old + 1u == (gen + 1u) * nloc) {
            __builtin_amdgcn_fence(__ATOMIC_RELEASE, "agent");
            asm volatile("s_waitcnt vmcnt(0)" ::: "memory");
            const unsigned og = xb_add(&bar[XB_TOP], 1u);
            const unsigned tg = og / nx;
            if (og + 1u == (tg + 1u) * nx) xb_add(&bar[XB_TOPGEN], 1u);
            else XB_SPIN(xb_ld(&bar[XB_TOPGEN]) == tg, bar);
            __builtin_amdgcn_fence(__ATOMIC_ACQUIRE, "agent");
            xb_add(&bar[XB_XGEN(b.x)], 1u);
            asm volatile("s_waitcnt vmcnt(0)" ::: "memory");
        } else {
            XB_SPIN(xb_ld(&bar[XB_XGEN(b.x)]) == gen, bar);
            __builtin_amdgcn_fence(__ATOMIC_ACQUIRE, "agent");
            asm volatile("s_waitcnt vmcnt(0)" ::: "memory");
        }
    }
    __syncthreads();
}
constexpr int NPHASE = 23;
#ifndef PHM
#define PHM 0xffff
#endif
#define EN(k) (((PHM) >> (k)) & 1)
constexpr int LDS_BYTES = 131072 + 8 * 576 * 4;
template <class Epi, class Sched>
__device__ __forceinline__ void run_gemm(LAS unsigned char* lds, int wb, const bf16_t* A, const bf16_t* Bt, int M, int N, int K, const Sched& S, const Epi& E, float* skp = nullptr, unsigned* skf = nullptr) {
    pg8::Gemm g{A, Bt, M, N, K, wb, skp, skf};
    pg8::gemm_phase<Epi, Sched, GP_ALIGN, GP_SP2>(lds, g, S, E);
}
__global__ void __launch_bounds__(512, 2) mega(Params p_unused) {
    LAS unsigned char* lds = (LAS unsigned char*)lds_raw;
    cg::grid_group grid = cg::this_grid();
    KP p = (KP)__builtin_amdgcn_kernarg_segment_ptr();
    const int ph_lo = p->ph_lo, ph_hi = p->ph_hi;
    const int wb = __builtin_amdgcn_readfirstlane((int)threadIdx.x) & ~63;
    { LAS unsigned* stw = (LAS unsigned*)(lds + 131072); if ((int)threadIdx.x < 2) stw[threadIdx.x] = 0u; __syncthreads(); }
    const XcdBarrier xbar = xcd_barrier_post((unsigned*)(p->ws + W_BAR), (volatile LAS unsigned*)(lds + 131072), threadIdx.x == 0);
    for (int pi_ = ph_lo; pi_ < ph_hi; ++pi_) {
        asm volatile("" ::: "v1","v2","v3","v4","v5","v6","v7","v8","v9","v10","v11","v12","v13","v14","v15","v16","v17","v18","v19","v20","v21","v22","v23","v24","v25","v26","v27","v28","v29","v30","v31","v32","v33","v34","v35","v36","v37","v38","v39","v40","v41","v42","v43","v44","v45","v46","v47","v48","v49","v50","v51","v52","v53","v54","v55","v56","v57","v58","v59","v60","v61","v62","v63","v64","v65","v66","v67","v68","v69","v70","v71","v72","v73","v74","v75","v76","v77","v78","v79","v80","v81","v82","v83","v84","v85","v86","v87","v88","v89","v90","v91","v92","v93","v94","v95","v96","v97","v98","v99","v100","v101","v102","v103","v104","v105","v106","v107","v108","v109","v110","v111","v112","v113","v114","v115","v116","v117","v118","v119","v120","v121","v122","v123","v124","v125","v126","v127","v128","v129","v130","v131","v132","v133","v134","v135","v136","v137","v138","v139","v140","v141","v142","v143","v144","v145","v146","v147","v148","v149","v150","v151","v152","v153","v154","v155","v156","v157","v158","v159","v160","v161","v162","v163","v164","v165","v166","v167","v168","v169","v170","v171","v172","v173","v174","v175","v176","v177","v178","v179","v180","v181","v182","v183","v184","v185","v186","v187","v188","v189","v190","v191","v192","v193","v194","v195","v196","v197","v198","v199","v200","v201","v202","v203","v204","v205","v206","v207","v208","v209","v210","v211","v212","v213","v214","v215","v216","v217","v218","v219","v220","v221","v222","v223","v224","v225","v226","v227","v228","v229","v230","v231","v232","v233","v234","v235","v236","v237","v238","v239","v240","v241","v242","v243","v244","v245","v246","v247","v248","v249");
        asm volatile("" : "+s"(p));
        const int phc = p->seq[pi_], ph = phc & 63; const bool dry = (phc & 64) != 0;
        int bid = blockIdx.x, G = gridDim.x;
        asm volatile("" : "+s"(bid), "+s"(G));
#define TID_HERE (wb + lane_now())
        int ffn = -1; bool ffn_in = false;
        if (ph == 1 || ph == 2) { ffn = 0; ffn_in = ph == 1; } else if (ph == 11 || ph == 12) { ffn = 1; ffn_in = ph == 11; }
        else if (ph == 14 || ph == 15) { ffn = 2; ffn_in = ph == 14; } else if (ph == 21 || ph == 22) { ffn = 3; ffn_in = ph == 21; }
        if (EN(0) && ph == 0) { { const int tid = TID_HERE; convert_weights(p, (LAS float*)lds, tid, bid, G); assemble_x(p, tid, bid, G); } }
        else if (EN(1) && ffn >= 0 && ffn_in) {
            pg8::StaticOrder S; S.init(MP, NIN, G, bid); S.nt0 = D / 64;
            unsigned char* ws = p->ws; EpiSwiGLU E{(bf16_t*)(ws + W_HB), (const float*)(ws + W_RSQ) + (size_t)(ffn == 0 ? 0 : (ffn == 1 ? 1 : (ffn == 2 ? 2 : 4))) * MP};
            run_gemm(lds, wb, (const bf16_t*)(ws + W_XN), (const bf16_t*)(ws + W_WIN + ffn * SZ_WIN1), MP, NIN, D, S, E);
        } else if (EN(2) && ffn >= 0) {
            TailSplitOrder S; S.init(MP, D, DFFP, G, bid, 11);
            unsigned char* ws = p->ws; const bool fold = (ffn == 1 || ffn == 2) && !dry;
            EpiRes E{(float*)(ws + W_X), dry ? 0.f : 0.5f, (ffn == 3 && !dry) ? p->out : nullptr, fold ? (bf16_t*)(ws + W_XN) : nullptr, (float*)(ws + W_RSQ) + (size_t)(ffn == 1 ? 2 : 3) * MP, (float*)(ws + W_SKP)};
            run_gemm(lds, wb, (const bf16_t*)(ws + W_HB), (const bf16_t*)(ws + W_WOUT + ffn * SZ_WOUT1), MP, D, DFFP, S, E, (float*)(ws + W_SKP), (unsigned*)(ws + W_SKF) + pi_ * 1024);
        }
        else if (ph >= 24 && ph < 28) { if (!dry) fixup_phase<11>(p, ph - 24, TID_HERE, bid, G); }
        else if (ph >= 28 && ph < 30) { if (!dry) fixup_phase<4>(p, ph - 24, TID_HERE, bid, G); }
        else if (EN(3) && ph == 3) mixprep_phase(p, TID_HERE, bid, G);
        else if (EN(4) && ph == 4) {
            G1Order S{G, bid};
            unsigned char* ws = p->ws; EpiG1 E{(bf16_t*)(ws + W_RKV), (float*)(ws + W_L1)};
            run_gemm(lds, wb, (const bf16_t*)(ws + W_AALL), (const bf16_t*)(ws + W_WG1), 5 * MP, 3584, D, S, E);
        }
        else if (EN(5) && ph == 5) act_phase(p, bid * 512 + TID_HERE, G * 512);
        else if (EN(6) && ph == 6) {
            pg8::StaticOrder S; S.init(MP, 3072, G, bid); S.nt0 = 4;
            unsigned char* ws = p->ws; EpiG2 E{(bf16_t*)(ws + W_DEC)};
            run_gemm(lds, wb, (const bf16_t*)(ws + W_A2), (const bf16_t*)(ws + W_WL2), MP, 3072, 256, S, E);
        }
        else if (EN(7) && ph == 7) scan_phase(p, (LAS float*)lds, TID_HERE, bid, G);
        else if (EN(8) && ph == 8) post_phase(p, TID_HERE, bid, G);
        else if (EN(9) && (ph == 9 || ph == 19)) {
            TailSplitOrder S; S.init(MP, D, D, G, bid, 4);
            unsigned char* ws = p->ws; EpiRes E{(float*)(ws + W_X), dry ? 0.f : 1.0f, nullptr, dry ? nullptr : (bf16_t*)(ws + W_XN), (float*)(ws + W_RSQ) + (size_t)(ph == 9 ? 1 : 4) * MP, (float*)(ws + W_SKP)};
            run_gemm(lds, wb, (const bf16_t*)(ws + W_OG), (const bf16_t*)(ws + (ph == 9 ? W_WO1 : W_WO2)), MP, D, D, S, E, (float*)(ws + W_SKP), (unsigned*)(ws + W_SKF) + pi_ * 1024);
        }
        else if (EN(11) && ph == 17) {
            pg8::StaticOrder S; S.init(MP, 3 * D, G, bid); S.nt0 = D / 64;
            unsigned char* ws = p->ws; EpiQKV E{(bf16_t*)(ws + W_QB), p->out, p->in[28], p->in[29], (const float*)(ws + W_RSQ) + (size_t)3 * MP};
            run_gemm(lds, wb, (const bf16_t*)(ws + W_XN), (const bf16_t*)(ws + W_WQKV), MP, 3 * D, D, S, E);
        }
        else if (EN(12) && ph == 18) attn_phase(p, TID_HERE, bid, G);
        if (pi_ + 1 < ph_hi) { if (pi_ < 0) grid.sync(); else xcd_barrier(xbar, (wb + lane_now()) == 0); }
    }
}

#ifndef ONE_LAUNCH
#define ONE_LAUNCH 1
#endif
extern "C" void kernel_launch(void* const* d_in, const int* in_sizes, int n_in, void* d_out, int out_size, void* d_ws, size_t ws_size, hipStream_t stream) {
    static int grid = 0;
    if (grid == 0) {
        if (n_in != 31 || (size_t)out_size != O_END || ws_size < W_END) { fprintf(stderr, "kernel_launch: unexpected sizes (n_in %d out %d ws %zu need %zu)\n", n_in, out_size, ws_size, (size_t)W_END); grid = -1; return; }
        int dev = 0, cus = 0, per_cu = 0;
        hipGetDevice(&dev); hipDeviceGetAttribute(&cus, hipDeviceAttributeMultiprocessorCount, dev);
        if (hipFuncSetAttribute((const void*)mega, hipFuncAttributeMaxDynamicSharedMemorySize, LDS_BYTES) != hipSuccess) { fprintf(stderr, "kernel_launch: hipFuncSetAttribute failed\n"); grid = -1; return; }
        hipOccupancyMaxActiveBlocksPerMultiprocessor(&per_cu, (const void*)mega, 512, LDS_BYTES);
        (void)hipGetLastError();
        if (per_cu < 1) per_cu = 1;
        grid = cus * per_cu;
    }
    if (grid < 0) return;
    Params p{};
    for (int i = 0; i < 31; ++i) p.in[i] = (const float*)d_in[i];
    p.out = (float*)d_out; p.ws = (unsigned char*)d_ws;
    int nseq = 0;
    for (int ph = 0; ph < NPHASE; ++ph) {
        if (ph == 10 || ph == 13 || ph == 16 || ph == 20) continue;
        p.seq[nseq++] = ph;
        if (ph == 2 || ph == 12 || ph == 15 || ph == 22) p.seq[nseq++] = 24 + (ph == 2 ? 0 : (ph == 12 ? 1 : (ph == 15 ? 2 : 3)));
        if (ph == 9 || ph == 19) p.seq[nseq++] = ph == 9 ? 28 : 29;
#ifdef REP_OF
        for (int r = 0; r < (REP_OF(ph)); ++r) p.seq[nseq++] = (ph | ((ph == 2 || ph == 9) ? 64 : 0));
#endif
    }
#if ONE_LAUNCH
    (void)hipMemsetAsync((unsigned char*)d_ws + W_BAR, 0, 16384, stream);
    p.ph_lo = 0; p.ph_hi = nseq;
    void* args[] = {&p};
    hipError_t e = hipLaunchCooperativeKernel((const void*)mega, dim3(grid), dim3(512), args, LDS_BYTES, stream);
    if (e != hipSuccess) fprintf(stderr, "cooperative launch failed: %s (grid %d)\n", hipGetErrorString(e), grid);
#else
    for (int ph = 0; ph < nseq; ++ph) { p.ph_lo = ph; p.ph_hi = ph + 1; hipLaunchKernelGGL(mega, dim3(grid), dim3(512), LDS_BYTES, stream, p); }
#endif
}
```

```cpp
#include <hip/hip_runtime.h>
#include <hip/hip_cooperative_groups.h>
#include <cstdio>
#include <cstdint>
namespace cg = cooperative_groups;
#ifndef GP_SP2
#define GP_SP2 true
#endif
#ifndef GP_ALIGN
#define GP_ALIGN true
#endif
#ifndef WO_NS
#define WO_NS 4
#endif
#ifndef WGM_SET
#define WGM_SET 8
#endif
__device__ __forceinline__ int lane_now() { int l; asm volatile("v_mbcnt_lo_u32_b32 %0, -1, 0\n\tv_mbcnt_hi_u32_b32 %0, -1, %0" : "=v"(l)); return l; }
namespace pg8 {
#define PG8_LAS __attribute__((address_space(3)))
typedef unsigned short bf16_t;
typedef short bf16x8 __attribute__((ext_vector_type(8)));
typedef float f32x4 __attribute__((ext_vector_type(4)));
typedef unsigned u32x4 __attribute__((ext_vector_type(4)));
constexpr int BM = 256, BK = 64, HALF = 128, HTB = HALF * BK * 2  , STAGE_BYTES = 8 * HTB, NXCD = 8, WGM = WGM_SET;

__host__ __device__ __forceinline__ int lds_byte(int r, int c) { const int st = (r >> 4) * 2 + (c >> 5), rr = r & 15, cc = c & 31, ob = rr * 64 + cc * 2; return st * 1024 + (ob ^ (((ob >> 9) & 1) << 5)); }
__host__ __device__ __forceinline__ void stage_rc(int b, int& R, int& C) { const int st = b / 1024, sb = b % 1024, swz = sb ^ (((sb >> 9) & 1) << 5); R = (st >> 1) * 16 + swz / 64; C = (st & 1) * 32 + (swz % 64) / 2; }
__host__ __device__ __forceinline__ int perm32(int rho) { const int n = rho >> 4, i = rho & 15; return 8 * (i >> 2) + 4 * n + (i & 3); }

struct Unit { int pm, pn, kb, nt, fl, tl; };
struct Gemm { const bf16_t* A; const bf16_t* Bt; int M, N, K, wb; float* skp; unsigned* skf; };

struct StaticOrder {
    static constexpr bool STREAM = false; int nM, nN, nwg, G, c, nt0;
    __host__ __device__ void init(int M, int N, int G_, int c_) { nM = M / BM; nN = N / BM; nwg = nM * nN; G = G_; c = c_; }
    __host__ __device__ bool next(int i, Unit& u) const {
        const long L = (long)i * G + c; if (L >= nwg) return false;
        int wgid = (int)L; { const int q = nwg / NXCD, r = nwg % NXCD, xcd = wgid % NXCD, off = wgid / NXCD; wgid = (xcd < r ? xcd * (q + 1) : r * (q + 1) + (xcd - r) * q) + off; }
        const int nig = WGM * nN, gid = wgid / nig, fm = gid * WGM, gsz = (nM - fm) < WGM ? (nM - fm) : WGM;
        u.pm = fm + ((wgid % nig) % gsz); u.pn = (wgid % nig) / gsz; u.kb = 0; u.nt = nt0; u.fl = 0; u.tl = 0; return true;
    }
    __device__ __forceinline__ void a_ready(const Unit&) const {}
    __device__ __forceinline__ void done(const Unit&) const {}
};
typedef __attribute__((address_space(1))) f32x4 gf32x4;
typedef unsigned long long u64_t;
__device__ __forceinline__ void streamk_store(const f32x4 (&acc)[2][2][4][2], const Unit& u, float* skp, unsigned* skf, int tid) {
    u64_t* q = (u64_t*)(skp + (size_t)u.tl * 65536) + 2 * tid;
#pragma unroll
    for (int a = 0; a < 2; ++a)
#pragma unroll
        for (int b = 0; b < 2; ++b)
#pragma unroll
            for (int m = 0; m < 4; ++m)
#pragma unroll
                for (int n = 0; n < 2; ++n) { const f32x4 v = acc[a][b][m][n];
                    __hip_atomic_store(q, ((u64_t)__float_as_uint(v[1]) << 32) | __float_as_uint(v[0]), __ATOMIC_RELAXED, __HIP_MEMORY_SCOPE_AGENT);
                    __hip_atomic_store(q + 1, ((u64_t)__float_as_uint(v[3]) << 32) | __float_as_uint(v[2]), __ATOMIC_RELAXED, __HIP_MEMORY_SCOPE_AGENT);
                    q += 1024; asm volatile("" : "+v"(q) :: "memory"); }
    asm volatile("s_waitcnt vmcnt(0)" ::: "memory");
    __builtin_amdgcn_s_barrier();
    if (tid == 0) __hip_atomic_store(skf + u.tl, 1u, __ATOMIC_RELAXED, __HIP_MEMORY_SCOPE_AGENT);
}
__device__ __forceinline__ const float* streamk_wait(const Unit& u, float* skp, unsigned* skf, int tid) {
    if (u.fl == 2) {
        if (tid == 0) { while (__hip_atomic_load(skf + u.tl, __ATOMIC_RELAXED, __HIP_MEMORY_SCOPE_AGENT) == 0u) __builtin_amdgcn_s_sleep(2); }
        __builtin_amdgcn_s_barrier();
        __builtin_amdgcn_fence(__ATOMIC_ACQUIRE, "agent");
    } else __builtin_amdgcn_s_barrier();
    return skp + (size_t)u.tl * 65536;
}
__device__ __forceinline__ f32x4 streamk_part(const float* part, int idx, int tid) {
    const u64_t* q = (const u64_t*)part + (size_t)idx * 1024 + 2 * tid;
    const u64_t a = __hip_atomic_load(q, __ATOMIC_RELAXED, __HIP_MEMORY_SCOPE_AGENT), b = __hip_atomic_load(q + 1, __ATOMIC_RELAXED, __HIP_MEMORY_SCOPE_AGENT);
    return (f32x4){__uint_as_float((unsigned)a), __uint_as_float((unsigned)(a >> 32)), __uint_as_float((unsigned)b), __uint_as_float((unsigned)(b >> 32))};
}
template <class Epi, class Sched, bool ALIGN_EPI = false, bool SP2 = false>
__device__ __forceinline__ void gemm_phase(PG8_LAS unsigned char* lds, const Gemm g, const Sched& S, const Epi& E) {
    int tid = g.wb + lane_now(); asm volatile("" : "+v"(tid)); const int wid = __builtin_amdgcn_readfirstlane(tid >> 6), lane = tid & 63, wr = wid >> 2, wc = wid & 3, fr = lane & 15, fq = lane >> 4;
    const int K = g.K, nt = K / BK;
    unsigned voffA[2], voffB[2];
#pragma unroll
    for (int i = 0; i < 2; ++i) { int R, C; stage_rc(tid * 16 + i * 8192, R, C); const int Rb = Epi::PERM ? ((R & ~31) + perm32(R & 31)) : R;
        voffA[i] = (unsigned)(R * K + C) * 2u; voffB[i] = (unsigned)(Rb * K + C) * 2u; }
    const size_t kstep = (size_t)(BK * 2);
    const size_t hstep = (size_t)HALF * K * 2;
    const size_t tstep = 2 * hstep;
    const unsigned ldsw = (unsigned)wid * 1024u;
    const int aoff = lds_byte(wr * 64 + fr, fq * 8), boff = lds_byte(wc * 32 + fr, fq * 8);
#define PG8_SA(b, h) (((b) * 2 + (h)) * HTB)
#define PG8_SB(b, h) ((4 + (b) * 2 + (h)) * HTB)
#define PG8_STAGE(bufoff, gbase, voff) do { _Pragma("unroll") for (int _i = 0; _i < 2; ++_i) \
        __builtin_amdgcn_global_load_lds((const unsigned*)((const char*)(gbase) + (voff)[_i]), (PG8_LAS unsigned*)(lds + (bufoff) + ldsw + _i * 8192), 16, 0, 0); } while (0)
#define PG8_LDA(dst, b, h) do { _Pragma("unroll") for (int m = 0; m < 4; ++m) _Pragma("unroll") for (int k = 0; k < 2; ++k) dst[m][k] = *(const PG8_LAS bf16x8*)(lds + PG8_SA(b, h) + aoff + m * 2048 + k * 1024); } while (0)
#define PG8_LDB(dst, b, h) do { _Pragma("unroll") for (int n = 0; n < 2; ++n) _Pragma("unroll") for (int k = 0; k < 2; ++k) dst[n][k] = *(const PG8_LAS bf16x8*)(lds + PG8_SB(b, h) + boff + n * 2048 + k * 1024); } while (0)
#define PG8_MMA(ai, bj, At, Bt) do { __builtin_amdgcn_s_setprio(1); _Pragma("unroll") for (int m = 0; m < 4; ++m) _Pragma("unroll") for (int n = 0; n < 2; ++n) _Pragma("unroll") for (int k = 0; k < 2; ++k) \
        acc[ai][bj][m][n] = __builtin_amdgcn_mfma_f32_16x16x32_bf16(Bt[n][k], At[m][k], acc[ai][bj][m][n], 0, 0, 0); __builtin_amdgcn_s_setprio(0); } while (0)
#define PG8_WAIT_V(n) asm volatile("s_waitcnt vmcnt(" #n ")" ::: "memory")
#define PG8_WAIT_L(n) asm volatile("s_waitcnt lgkmcnt(" #n ")" ::: "memory")
#define PG8_BAR __builtin_amdgcn_s_barrier()
#define PG8_SCHED __builtin_amdgcn_sched_barrier(0)
    Unit cur, nxt; int ui = 0;
    if (!S.next(0, cur)) return;
    f32x4 acc[2][2][4][2];
#pragma unroll
    for (int a = 0; a < 2; ++a)
#pragma unroll
        for (int b = 0; b < 2; ++b)
#pragma unroll
            for (int m = 0; m < 4; ++m)
#pragma unroll
                for (int n = 0; n < 2; ++n) acc[a][b][m][n] = (f32x4){0.f, 0.f, 0.f, 0.f};
    bf16x8 At[4][2], B0[2][2], B1[2][2];
    const char* cA = (const char*)g.A + (size_t)cur.pm * tstep + cur.kb; const char* cB = (const char*)g.Bt + (size_t)cur.pn * tstep + cur.kb;
    S.a_ready(cur);
    if constexpr (SP2) {
        PG8_STAGE(PG8_SB(0, 0), cB, voffB); PG8_STAGE(PG8_SB(0, 1), cB + hstep, voffB); PG8_STAGE(PG8_SA(0, 0), cA, voffA); PG8_STAGE(PG8_SA(0, 1), cA + hstep, voffA);
        if (wr == 1) PG8_BAR;
        PG8_WAIT_V(2); PG8_BAR;
        PG8_STAGE(PG8_SB(1, 0), cB + kstep, voffB); PG8_STAGE(PG8_SA(1, 0), cA + kstep, voffA); PG8_STAGE(PG8_SB(1, 1), cB + hstep + kstep, voffB);
        PG8_WAIT_V(6); PG8_BAR;
    } else {
        PG8_STAGE(PG8_SB(0, 0), cB, voffB); PG8_STAGE(PG8_SA(0, 0), cA, voffA); PG8_STAGE(PG8_SB(0, 1), cB + hstep, voffB); PG8_STAGE(PG8_SA(0, 1), cA + hstep, voffA);
        if (wr == 1) PG8_BAR;
        PG8_WAIT_V(4); PG8_BAR;
        PG8_STAGE(PG8_SB(1, 0), cB + kstep, voffB); PG8_STAGE(PG8_SA(1, 0), cA + kstep, voffA); PG8_STAGE(PG8_SB(1, 1), cB + hstep + kstep, voffB);
        PG8_WAIT_V(6); PG8_BAR;
    }
    for (;;) {
        const bool has_next = S.next(ui + 1, nxt);
        const char* nA = has_next ? (const char*)g.A + (size_t)nxt.pm * tstep + nxt.kb : cA; const char* nB = has_next ? (const char*)g.Bt + (size_t)nxt.pn * tstep + nxt.kb : cB;
        const int ntu = cur.nt;
        for (int t = 0; t < ntu; t += 2) {
            const bool last = (t == ntu - 2);
            const char* a1 = cA + (size_t)(t + 1) * kstep;
            const char* a2 = last ? nA : cA + (size_t)(t + 2) * kstep; const char* b2 = last ? nB : cB + (size_t)(t + 2) * kstep;
            const char* a3 = a2 + kstep; const char* b3 = b2 + kstep;
            if (last && has_next) S.a_ready(nxt);
            if constexpr (SP2) {
            PG8_LDB(B0, 0, 0); PG8_LDB(B1, 0, 1); PG8_SCHED; PG8_LDA(At, 0, 0); PG8_STAGE(PG8_SA(1, 1), a1 + hstep, voffA);
            PG8_WAIT_V(8); PG8_WAIT_L(0); PG8_BAR; PG8_MMA(0, 0, At, B0); PG8_MMA(0, 1, At, B1); PG8_BAR; PG8_SCHED;
            PG8_LDA(At, 0, 1); PG8_STAGE(PG8_SB(0, 0), b2, voffB); PG8_STAGE(PG8_SB(0, 1), b2 + hstep, voffB); PG8_STAGE(PG8_SA(0, 0), a2, voffA);
            PG8_WAIT_V(8); PG8_WAIT_L(0); PG8_BAR; PG8_MMA(1, 0, At, B0); PG8_MMA(1, 1, At, B1); PG8_BAR; PG8_SCHED;
            PG8_LDB(B0, 1, 0); PG8_LDB(B1, 1, 1); PG8_SCHED; PG8_LDA(At, 1, 0); PG8_STAGE(PG8_SA(0, 1), a2 + hstep, voffA);
            PG8_WAIT_V(8); PG8_WAIT_L(0); PG8_BAR; PG8_MMA(0, 0, At, B0); PG8_MMA(0, 1, At, B1); PG8_BAR; PG8_SCHED;
            PG8_LDA(At, 1, 1); PG8_STAGE(PG8_SB(1, 0), b3, voffB); PG8_STAGE(PG8_SB(1, 1), b3 + hstep, voffB); PG8_STAGE(PG8_SA(1, 0), a3, voffA);
            PG8_WAIT_V(8); PG8_WAIT_L(0); PG8_BAR; PG8_MMA(1, 0, At, B0); PG8_MMA(1, 1, At, B1); PG8_BAR; PG8_SCHED;
            } else {
            PG8_LDB(B0, 0, 0); PG8_SCHED; PG8_LDA(At, 0, 0); PG8_STAGE(PG8_SA(1, 1), a1 + hstep, voffA);
            PG8_WAIT_L(8); PG8_BAR; PG8_WAIT_L(0); PG8_MMA(0, 0, At, B0); PG8_BAR; PG8_SCHED;
            PG8_LDB(B1, 0, 1); PG8_STAGE(PG8_SB(0, 0), b2, voffB);
            PG8_BAR; PG8_WAIT_L(0); PG8_MMA(0, 1, At, B1); PG8_BAR;
            PG8_LDA(At, 0, 1); PG8_STAGE(PG8_SA(0, 0), a2, voffA);
            PG8_BAR; PG8_WAIT_L(0); PG8_MMA(1, 0, At, B0); PG8_BAR; PG8_SCHED;
            PG8_STAGE(PG8_SB(0, 1), b2 + hstep, voffB);
            PG8_WAIT_V(6); PG8_BAR; PG8_MMA(1, 1, At, B1); PG8_BAR;
            PG8_LDB(B0, 1, 0); PG8_SCHED; PG8_LDA(At, 1, 0); PG8_STAGE(PG8_SA(0, 1), a2 + hstep, voffA);
            PG8_WAIT_L(8); PG8_BAR; PG8_WAIT_L(0); PG8_MMA(0, 0, At, B0); PG8_BAR; PG8_SCHED;
            PG8_LDB(B1, 1, 1); PG8_STAGE(PG8_SB(1, 0), b3, voffB);
            PG8_BAR; PG8_WAIT_L(0); PG8_MMA(0, 1, At, B1); PG8_BAR;
            PG8_LDA(At, 1, 1); PG8_STAGE(PG8_SA(1, 0), a3, voffA);
            PG8_BAR; PG8_WAIT_L(0); PG8_MMA(1, 0, At, B0); PG8_BAR; PG8_SCHED;
            PG8_STAGE(PG8_SB(1, 1), b3 + hstep, voffB);
            PG8_WAIT_V(6); PG8_BAR; PG8_MMA(1, 1, At, B1); PG8_BAR;
            }
        }
        if constexpr (ALIGN_EPI) { if (wr == 0) PG8_BAR; }
        if constexpr (!Epi::AFTER_DRAIN) { int t_ = g.wb + lane_now(); asm volatile("" : "+v"(t_)); const int fr_ = t_ & 15, fq_ = (t_ >> 4) & 3; if constexpr (!Sched::STREAM) E(acc, cur, wr, wc, fr_, fq_); else { if (cur.fl == 1) streamk_store(acc, cur, g.skp, g.skf, t_); else { const float* part_ = streamk_wait(cur, g.skp, g.skf, t_); int t2_ = g.wb + lane_now(); asm volatile("" : "+v"(t2_)); E(acc, cur, wr, wc, t2_ & 15, (t2_ >> 4) & 3, part_, t2_); } } S.done(cur); }
        if (!has_next) break;
#pragma unroll
        for (int a = 0; a < 2; ++a)
#pragma unroll
            for (int b = 0; b < 2; ++b)
#pragma unroll
                for (int m = 0; m < 4; ++m)
#pragma unroll
                    for (int n = 0; n < 2; ++n) acc[a][b][m][n] = (f32x4){0.f, 0.f, 0.f, 0.f};
        cur = nxt; cA = nA; cB = nB; ++ui;
        if constexpr (ALIGN_EPI) { if (wr == 1) PG8_BAR; }
    }
    PG8_WAIT_V(0);
    if constexpr (!ALIGN_EPI) { if (wr == 0) PG8_BAR; }
    PG8_BAR;
    if constexpr (Epi::AFTER_DRAIN) { E.fused(acc, cur, wr, wc, fr, fq, lds, wid, lane); S.done(cur); }
#undef PG8_SA
#undef PG8_SB
#undef PG8_STAGE
#undef PG8_LDA
#undef PG8_LDB
#undef PG8_MMA
#undef PG8_WAIT_V
#undef PG8_WAIT_L
#undef PG8_BAR
#undef PG8_SCHED
}
}

#define LAS __attribute__((address_space(3)))
typedef unsigned short bf16_t;
typedef short bf16x8 __attribute__((ext_vector_type(8)));
typedef float f32x4 __attribute__((ext_vector_type(4)));
typedef float f32x2 __attribute__((ext_vector_type(2)));
typedef float f32x16 __attribute__((ext_vector_type(16)));
typedef unsigned u32x4 __attribute__((ext_vector_type(4)));
typedef unsigned u32x2 __attribute__((ext_vector_type(2)));

constexpr int D = 1024, NH = 16, HD = 64;
constexpr int BP = 8, TP = 2064, SEQP = 2048, NMETA = 16, BS = 16, TS = 64, PAST = 4096;
constexpr int MPR = BP * TP;
constexpr int MR = MPR + BS * TS;
constexpr int MP = 17664;
constexpr int NTM = 69;
constexpr int DFF = 2752, DFFP = 2816, NIN = 5632;
constexpr float RMS_EPS = 1e-6f, GN_EPS = 64e-5f;
constexpr float LOG2E = 1.4426950408889634f;

constexpr size_t O_YP = 0, O_YS = 16777216, O_SP = 17825792, O_SHP = 18350080, O_KP = 18358272, O_VP = 35266560,
                 O_SS = 52174848, O_SHS = 53223424, O_KS = 53239808, O_VS = 54288384, O_END = 55336960;

constexpr size_t SZ_ROWBF = (size_t)MP * D * 2, SZ_ROWF = (size_t)MP * D * 4;
constexpr size_t W_X = 0;
constexpr size_t W_XN = W_X + SZ_ROWF;
constexpr size_t W_HB = W_XN + SZ_ROWBF;
constexpr size_t W_WIN = W_HB + (size_t)MP * DFFP * 2;
constexpr size_t SZ_WIN1 = (size_t)NIN * D * 2, SZ_WOUT1 = (size_t)D * DFFP * 2;
constexpr size_t W_WOUT = W_WIN + 4 * SZ_WIN1;
constexpr size_t W_WG1 = W_WOUT + 4 * SZ_WOUT1;
constexpr size_t W_WL2 = W_WG1 + (size_t)3584 * D * 2;
constexpr size_t W_WO1 = W_WL2 + (size_t)3072 * 256 * 2;
constexpr size_t W_WQKV = W_WO1 + (size_t)D * D * 2;
constexpr size_t W_WO2 = W_WQKV + (size_t)3 * D * D * 2;
constexpr size_t W_AALL = W_WO2 + (size_t)D * D * 2;
constexpr size_t W_RKV = W_AALL + 5 * SZ_ROWBF;
constexpr size_t W_L1 = W_RKV + 3 * SZ_ROWBF;
constexpr size_t W_A2 = W_L1 + (size_t)2 * MP * 256 * 4;
constexpr size_t W_DEC = W_A2 + (size_t)MP * 256 * 2;
constexpr size_t W_AA = W_DEC + SZ_ROWBF;
constexpr size_t W_GG = W_AA + SZ_ROWBF;
constexpr size_t W_SO = W_GG + SZ_ROWBF;
constexpr size_t W_OG = W_SO + SZ_ROWF;
constexpr size_t W_QB = W_OG + SZ_ROWBF;
constexpr size_t W_RSQ = W_QB + SZ_ROWBF;
constexpr size_t W_SKF = W_RSQ + (size_t)5 * MP * 4;
constexpr size_t W_SKP = W_SKF + 64 * 1024 * 4;
constexpr size_t W_BAR = W_SKP + (size_t)277 * 262144;
constexpr size_t W_END = W_BAR + 16384;

struct Params { const float* in[31]; float* out; unsigned char* ws; int ph_lo, ph_hi; int seq[64]; };
typedef const Params __attribute__((address_space(4)))* KP;

__device__ __forceinline__ unsigned cvt_pk(float lo, float hi) { unsigned r; asm("v_cvt_pk_bf16_f32 %0, %1, %2" : "=v"(r) : "v"(lo), "v"(hi)); return r; }
__device__ __forceinline__ void store_bf4(bf16_t* p, f32x4 v) { u32x2 w; w.x = cvt_pk(v[0], v[1]); w.y = cvt_pk(v[2], v[3]); *(u32x2*)p = w; }
__device__ __forceinline__ float bf_lo(unsigned w) { return __uint_as_float(w << 16); }
__device__ __forceinline__ float bf_hi(unsigned w) { return __uint_as_float(w & 0xffff0000u); }
__device__ __forceinline__ float sigmoidf_(float x) { return __builtin_amdgcn_rcpf(1.f + __expf(-x)); }
__device__ __forceinline__ float softplusf_(float x) { return fmaxf(x, 0.f) + __logf(1.f + __expf(-fabsf(x))); }
__device__ __forceinline__ float shx(float v, int o, int lane) { return __builtin_bit_cast(float, __builtin_amdgcn_ds_bpermute((lane ^ o) << 2, __builtin_bit_cast(int, v))); }
__device__ __forceinline__ float wave_sum(float v, int lane) {
#pragma unroll
    for (int o = 1; o < 64; o <<= 1) v += shx(v, o, lane);
    return v;
}
__device__ __forceinline__ void row_bt(int row, int& grp, int& b, int& t) { if (row < MPR) { grp = 0; b = row / TP; t = row - b * TP; } else { grp = 1; const int r = row - MPR; b = r >> 6; t = r & 63; } }

using pg8::Unit;
extern __shared__ __attribute__((aligned(16))) unsigned char lds_raw[];
struct EpiSwiGLU {
    static constexpr bool PERM = true, AFTER_DRAIN = false;
    bf16_t* HB; const float* rsq;
    __device__ __forceinline__ void operator()(const f32x4 (&acc)[2][2][4][2], const Unit& u, int wr, int wc, int fr, int fq) const {
        const int row0 = u.pm * 256 + wr * 64 + fr, col0 = u.pn * 128 + wc * 32 + 8 * fq;
#pragma unroll
        for (int ai = 0; ai < 2; ++ai)
#pragma unroll
            for (int m = 0; m < 4; ++m) {
                bf16_t* rowp = HB + (size_t)(row0 + ai * 128 + m * 16) * DFFP + col0;
                const float rs = __builtin_amdgcn_rsqf(rsq[row0 + ai * 128 + m * 16] * (1.f / D) + RMS_EPS);
                float hv[8];
#pragma unroll
                for (int n = 0; n < 2; ++n)
#pragma unroll
                    for (int j = 0; j < 4; ++j) { const float g = acc[ai][0][m][n][j] * rs, up = acc[ai][1][m][n][j] * rs; hv[n * 4 + j] = g * sigmoidf_(g) * up; }
                u32x4 w; w.x = cvt_pk(hv[0], hv[1]); w.y = cvt_pk(hv[2], hv[3]); w.z = cvt_pk(hv[4], hv[5]); w.w = cvt_pk(hv[6], hv[7]);
                *(u32x4*)rowp = w;
            }
    }
};
struct EpiRes {
    static constexpr bool PERM = false, AFTER_DRAIN = false;
    float* X; float scale; float* out; bf16_t* XB; float* rsq; float* spl;
    __device__ __forceinline__ void operator()(const f32x4 (&acc)[2][2][4][2], const Unit& u, int wr, int wc, int fr, int fq, const float* part = nullptr, int tid = 0) const {
        const bool hasp = u.fl == 2;
        if (u.fl == 1 && spl != nullptr) {
            const int t_ = (wr * 4 + wc) * 64 + fq * 16 + fr;
            f32x4* q = (f32x4*)(spl + (size_t)u.tl * 65536) + t_;
#pragma unroll
            for (int ai = 0; ai < 2; ++ai)
#pragma unroll
                for (int bj = 0; bj < 2; ++bj)
#pragma unroll
                    for (int m = 0; m < 4; ++m)
#pragma unroll
                        for (int n = 0; n < 2; ++n) q[(((ai * 2 + bj) * 4 + m) * 2 + n) * 512] = acc[ai][bj][m][n];
            return;
        }
        float* const X_ = X; float* const out_ = out; bf16_t* const XB_ = XB; float* const rsq_ = rsq; const float sc_ = scale;
        const int row0 = u.pm * 256 + wr * 64 + fr, col0 = u.pn * 256 + wc * 32 + 4 * fq, ln = fq * 16 + fr;
#pragma unroll
        for (int ai = 0; ai < 2; ++ai)
#pragma unroll
            for (int m = 0; m < 4; ++m) {
                const int row = row0 + ai * 128 + m * 16;
                const unsigned off = (unsigned)row * D + col0;
                if (out_ == nullptr) {
                    float ss = 0.f;
#pragma unroll
                    for (int bj = 0; bj < 2; ++bj)
#pragma unroll
                        for (int n = 0; n < 2; ++n) { f32x4* q = (f32x4*)(X_ + off + bj * 128 + n * 16); f32x4 av = acc[ai][bj][m][n]; if (hasp) av += pg8::streamk_part(part, ((ai * 2 + bj) * 4 + m) * 2 + n, tid); const f32x4 x = *q + av * sc_; *q = x;
                            if (XB_) { store_bf4(XB_ + off + bj * 128 + n * 16, x); ss += (x[0] * x[0] + x[1] * x[1]) + (x[2] * x[2] + x[3] * x[3]); } }
                    if (XB_) { ss += shx(ss, 16, ln); ss += shx(ss, 32, ln); if (fq == 0) unsafeAtomicAdd(rsq_ + row, ss); }
                } else if (row < MR) {
                    float* dp = nullptr;
                    if (row < MPR) { const int b = row / TP, t = row - b * TP; if (t >= NMETA) dp = out_ + O_YP + ((size_t)b * SEQP + (t - NMETA)) * D + col0; }
                    else dp = out_ + O_YS + (size_t)(row - MPR) * D + col0;
                    if (dp) {
#pragma unroll
                        for (int bj = 0; bj < 2; ++bj)
#pragma unroll
                            for (int n = 0; n < 2; ++n) { f32x4 av = acc[ai][bj][m][n]; if (hasp) av += pg8::streamk_part(part, ((ai * 2 + bj) * 4 + m) * 2 + n, tid); *(f32x4*)(dp + bj * 128 + n * 16) = *(const f32x4*)(X_ + off + bj * 128 + n * 16) + av * sc_; }
                    }
                }
                asm volatile("" ::: "memory");
            }
    }
};
struct G2Order {
    static constexpr bool STREAM = false;
    pg8::StaticOrder so;
    __device__ void init(int G, int c) { so.init(MP, 3072, G, c); so.nt0 = 2; }
    __device__ bool next(int i, Unit& u) const { if (!so.next(i, u)) return false; u.kb = (u.pn >> 2) * 128; return true; }
    __device__ __forceinline__ void a_ready(const Unit&) const {}
    __device__ __forceinline__ void done(const Unit&) const {}
};
struct TailSplitOrder {
    static constexpr bool STREAM = false;
    pg8::StaticOrder so; int G, c, ns, ntsplit;
    __device__ void init(int M, int N, int K, int G_, int c_, int ns_) { so.init(M, N, 1, 0); so.nt0 = K / 64; G = G_; c = c_; ns = ns_; ntsplit = so.nt0 / ns_; }
    __device__ bool next(int i, Unit& u) const {
        const int L = i * G + c;
        if (L < G && L < so.nwg) return so.next(L, u);
        const int L2 = L - G; if (so.nwg <= G || L2 < 0 || L2 >= (so.nwg - G) * ns) return false;
        const int j = L2 / ns, ch = L2 - j * ns;
        so.next(G + j, u); u.kb = ch * ntsplit * 128; u.nt = ntsplit; u.fl = 1; u.tl = L2; return true;
    }
    __device__ __forceinline__ void a_ready(const Unit&) const {}
    __device__ __forceinline__ void done(const Unit&) const {}
};
struct StreamOrder {
    static constexpr bool STREAM = true;
    int nN, ppt, c; long s, e;
    __device__ void init(int M, int N, int K, int G, int c_) {
        nN = N / 256; ppt = K / 128;
        c = (G % 8 == 0) ? (c_ % 8) * (G / 8) + c_ / 8 : c_;
        const long P = (long)(M / 256) * nN * ppt;
        s = (long)c * P / G; e = (long)(c + 1) * P / G;
    }
    __device__ bool next(int i, Unit& u) const {
        const int t = (int)(s / ppt) + i; const long t0 = (long)t * ppt;
        if (t0 >= e) return false;
        const long lo = s > t0 ? s : t0, hi = e < t0 + ppt ? e : t0 + ppt;
        u.pm = t / nN; u.pn = t - u.pm * nN; u.tl = t;
        u.kb = (int)(lo - t0) * 256; u.nt = (int)(hi - lo) * 2;
        u.fl = lo > t0 ? 1 : (hi < t0 + ppt ? 2 : 0);
        return true;
    }
    __device__ __forceinline__ void a_ready(const Unit&) const {}
    __device__ __forceinline__ void done(const Unit&) const {}
};
struct EpiG1 {
    static constexpr bool PERM = true, AFTER_DRAIN = false;
    bf16_t* RKV; float* L1;
    __device__ __forceinline__ void operator()(const f32x4 (&acc)[2][2][4][2], const Unit& u, int wr, int wc, int fr, int fq) const {
        const unsigned row0 = (unsigned)((u.pm % NTM) * 256 + wr * 64 + fr), cw = wc * 32 + 8 * fq;
        if (u.pn < 12) {
            bf16_t* base = RKV + (size_t)(u.pn >> 2) * MP * D;
            const unsigned off0 = row0 * D + (u.pn & 3) * 256 + cw;
#pragma unroll
            for (int ai = 0; ai < 2; ++ai)
#pragma unroll
                for (int m = 0; m < 4; ++m)
#pragma unroll
                    for (int bj = 0; bj < 2; ++bj) { const f32x4 v0 = acc[ai][bj][m][0], v1 = acc[ai][bj][m][1];
                        u32x4 w; w.x = cvt_pk(v0[0], v0[1]); w.y = cvt_pk(v0[2], v0[3]); w.z = cvt_pk(v1[0], v1[1]); w.w = cvt_pk(v1[2], v1[3]);
                        *(u32x4*)(base + (off0 + (unsigned)((ai * 128 + m * 16) * D + bj * 128))) = w; }
        } else {
            float* base = L1 + (size_t)(u.pn - 12) * MP * 256;
            const unsigned off0 = row0 * 256 + cw;
#pragma unroll
            for (int ai = 0; ai < 2; ++ai)
#pragma unroll
                for (int m = 0; m < 4; ++m)
#pragma unroll
                    for (int bj = 0; bj < 2; ++bj)
#pragma unroll
                        for (int n = 0; n < 2; ++n) *(f32x4*)(base + (off0 + (unsigned)((ai * 128 + m * 16) * 256 + bj * 128 + n * 4))) = acc[ai][bj][m][n];
        }
    }
};
struct EpiG2 {
    static constexpr bool PERM = true, AFTER_DRAIN = false;
    bf16_t* LW;
    __device__ __forceinline__ void operator()(const f32x4 (&acc)[2][2][4][2], const Unit& u, int wr, int wc, int fr, int fq) const {
        bf16_t* base = LW + (size_t)(u.pn >> 2) * MP * D;
        const unsigned off0 = (unsigned)(u.pm * 256 + wr * 64 + fr) * D + (u.pn & 3) * 256 + wc * 32 + 8 * fq;
#pragma unroll
        for (int ai = 0; ai < 2; ++ai)
#pragma unroll
            for (int m = 0; m < 4; ++m)
#pragma unroll
                for (int bj = 0; bj < 2; ++bj) { const f32x4 v0 = acc[ai][bj][m][0], v1 = acc[ai][bj][m][1];
                    u32x4 w; w.x = cvt_pk(v0[0], v0[1]); w.y = cvt_pk(v0[2], v0[3]); w.z = cvt_pk(v1[0], v1[1]); w.w = cvt_pk(v1[2], v1[3]);
                    *(u32x4*)(base + (off0 + (unsigned)((ai * 128 + m * 16) * D + bj * 128))) = w; }
    }
};
struct EpiQKV {
    static constexpr bool PERM = false, AFTER_DRAIN = false;
    bf16_t* QB; float* out; const float* qg; const float* kg; const float* rsq;
    __device__ __forceinline__ void operator()(const f32x4 (&acc)[2][2][4][2], const Unit& u, int wr, int wc, int fr, int fq) const {
        const int sec = u.pn >> 2, head = (u.pn & 3) * 4 + wc, row0 = u.pm * 256 + wr * 64 + fr;
        f32x4 gn[2][2];
#pragma unroll
        for (int bj = 0; bj < 2; ++bj)
#pragma unroll
            for (int n = 0; n < 2; ++n) { const int d = 32 * bj + 16 * n + 4 * fq;
                gn[bj][n] = sec == 0 ? *(const f32x4*)(qg + d) * 0.125f : (sec == 1 ? *(const f32x4*)(kg + d) : (f32x4){1.f, 1.f, 1.f, 1.f}); }
#pragma unroll
        for (int ai = 0; ai < 2; ++ai)
#pragma unroll
            for (int m = 0; m < 4; ++m) {
                const int row = row0 + ai * 128 + m * 16;
                const float rx = __builtin_amdgcn_rsqf(rsq[row] * (1.f / D) + RMS_EPS);
                float ss = 0.f;
#pragma unroll
                for (int bj = 0; bj < 2; ++bj)
#pragma unroll
                    for (int n = 0; n < 2; ++n) { const f32x4 x = acc[ai][bj][m][n]; ss += (x[0] * x[0] + x[1] * x[1]) + (x[2] * x[2] + x[3] * x[3]); }
                { const int ln = fq * 16 + fr; ss += shx(ss, 16, ln); ss += shx(ss, 32, ln); }
                const float rs = rx * (sec == 2 ? 1.f : __builtin_amdgcn_rsqf(ss * rx * rx * (1.f / 64.f) + RMS_EPS));
                if (row < MR) {
                    if (sec == 0) {
                        bf16_t* qp = QB + (size_t)row * D + head * 64 + 4 * fq;
#pragma unroll
                        for (int bj = 0; bj < 2; ++bj)
#pragma unroll
                            for (int n = 0; n < 2; ++n) { const f32x4 x = acc[ai][bj][m][n] * rs * gn[bj][n]; u32x2 w; w.x = cvt_pk(x[0], x[1]); w.y = cvt_pk(x[2], x[3]); *(u32x2*)(qp + 32 * bj + 16 * n) = w; }
                    } else {
                        int grp, b, t; row_bt(row, grp, b, t);
                        float* dp = grp == 0 ? out + (sec == 1 ? O_KP : O_VP) + (((size_t)b * NH + head) * TP + t) * HD
                                             : out + (sec == 1 ? O_KS : O_VS) + (((size_t)b * NH + head) * TS + t) * HD;
                        dp += 4 * fq;
#pragma unroll
                        for (int bj = 0; bj < 2; ++bj)
#pragma unroll
                            for (int n = 0; n < 2; ++n) *(f32x4*)(dp + 32 * bj + 16 * n) = acc[ai][bj][m][n] * rs * gn[bj][n];
                    }
                }
            }
    }
};
struct G1Order {
    static constexpr bool STREAM = false;
    int G, c;
    __device__ bool next(int i, Unit& u) const {
        const long L = (long)i * G + c; if (L >= 966) return false;
        int w = (int)L; { const int q = 966 / 8, r = 966 % 8, xcd = w % 8, off = w / 8; w = (xcd < r ? xcd * (q + 1) : r * (q + 1) + (xcd - r) * q) + off; }
        const int pm = w / 14, q = w % 14;
        if (q < 12) { u.pm = (q >> 2) * NTM + pm; u.pn = q; } else { u.pm = (q - 9) * NTM + pm; u.pn = q; }
        u.kb = 0; u.nt = 16; u.fl = 0; u.tl = 0;
        return true;
    }
    __device__ __forceinline__ void a_ready(const Unit&) const {}
    __device__ __forceinline__ void done(const Unit&) const {}
};

struct Job { const float* src; bf16_t* dst; const float* mu; int ld, Ksrc, koff, Kdst, rows, map, smode; };
__device__ __forceinline__ int srccol(int map, int n, int ld) {
    if (map == 0) return n < ld ? n : -1;
    if (map == 1) { const int pn = n >> 8, c = n & 255, bj = c >> 7, j = c & 127, hc = pn * 128 + j; return hc < DFF ? (bj ? DFF + hc : hc) : -1; }
    { const int t = n >> 8, c = n & 255, bj = c >> 7, wc = (c & 127) >> 5, i = c & 31; return t * 256 + 64 * wc + 32 * bj + i; }
}
__device__ __forceinline__ Job get_job(KP p, int j) {
    Job J; J.mu = nullptr; J.koff = 0; J.map = 0; J.smode = 0;
    unsigned char* ws = p->ws;
    if (j < 4) { J.src = p->in[8] + (size_t)j * D * 2 * DFF; J.dst = (bf16_t*)(ws + W_WIN + j * SZ_WIN1); J.ld = 2 * DFF; J.Ksrc = D; J.Kdst = D; J.rows = NIN; J.map = 1; J.mu = p->in[7] + (size_t)j * D; J.smode = 2; }
    else if (j < 8) { const int i = j - 4; J.src = p->in[9] + (size_t)i * DFF * D; J.dst = (bf16_t*)(ws + W_WOUT + i * SZ_WOUT1); J.ld = D; J.Ksrc = DFF; J.Kdst = DFFP; J.rows = D; }
    else if (j < 11) { const int g = j - 8; J.src = p->in[12] + (size_t)g * D * D; J.dst = (bf16_t*)(ws + W_WG1) + (size_t)g * D * D; J.ld = D; J.Ksrc = D; J.Kdst = D; J.rows = D; }
    else if (j < 17) { const int idx = j - 11, part = idx / 3, which = idx % 3;
        J.src = which == 0 ? p->in[14] : (which == 1 ? p->in[17] : p->in[19]); J.ld = which == 2 ? 128 : 64; J.rows = J.ld;
        J.mu = p->in[11] + (which == 0 ? 1 : (which == 1 ? 4 : 5)) * D; J.smode = part + 1;
        J.dst = (bf16_t*)(ws + W_WG1) + (size_t)(3072 + part * 256 + which * 64) * D; J.Ksrc = D; J.Kdst = D; }
    else if (j < 20) { const int which = j - 17; J.src = which == 0 ? p->in[15] : (which == 1 ? p->in[18] : p->in[20]); J.ld = D; J.rows = D;
        J.Ksrc = which == 2 ? 128 : 64; J.koff = which * 64; J.Kdst = 256; J.dst = (bf16_t*)(ws + W_WL2) + (size_t)which * D * 256; }
    else if (j == 20) { J.src = p->in[26]; J.dst = (bf16_t*)(ws + W_WO1); J.ld = D; J.Ksrc = D; J.Kdst = D; J.rows = D; }
    else if (j == 21) { J.src = p->in[27]; J.dst = (bf16_t*)(ws + W_WQKV); J.ld = 3 * D; J.Ksrc = D; J.Kdst = D; J.rows = 3 * D; J.map = 2; J.mu = p->in[10] + D; J.smode = 2; }
    else { J.src = p->in[30]; J.dst = (bf16_t*)(ws + W_WO2); J.ld = D; J.Ksrc = D; J.Kdst = D; J.rows = D; }
    return J;
}
__device__ __forceinline__ void convert_weights(KP p, LAS float* tl, int tid, int bid, int G) {
    int rot = 0;
    for (int j = 0; j < 23; ++j) {
        const Job J = get_job(p, j);
        const int nkt = J.Kdst >> 6, nnt = (J.rows + 255) >> 8, ntile = nnt * nkt;
        int first = bid - rot; if (first < 0) first += G;
        for (int t = first; t < ntile; t += G) {
            const int n0 = (t / nkt) << 8, k0 = (t % nkt) << 6;
            const bool inside = k0 >= J.koff && k0 < J.koff + J.Ksrc;
            if (inside) {
                const int nn = tid & 255, kh = tid >> 8;
                const int sc = (n0 + nn) < J.rows ? srccol(J.map, n0 + nn, J.ld) : -1;
                const float* sp = J.src + (size_t)(k0 - J.koff + kh) * J.ld + (sc >= 0 ? sc : 0);
                float v[32];
#pragma unroll
                for (int it = 0; it < 32; ++it) v[it] = sc >= 0 ? sp[(size_t)(2 * it) * J.ld] : 0.f;
                if (J.smode) {
#pragma unroll
                    for (int it = 0; it < 32; ++it) { const float m = J.mu[k0 - J.koff + kh + 2 * it]; v[it] *= J.smode == 1 ? 1.f - m : m; }
                }
#pragma unroll
                for (int it = 0; it < 32; ++it) tl[(kh + 2 * it) * 257 + nn] = v[it];
            }
            __syncthreads();
            {
                const int nn = tid >> 1, kh = (tid & 1) * 32;
                if (n0 + nn < J.rows) {
                    bf16_t* dp = J.dst + (size_t)(n0 + nn) * J.Kdst + k0 + kh;
#pragma unroll
                    for (int q = 0; q < 4; ++q) {
                        const unsigned z_ = (unsigned)tid >> 31;
                        u32x4 w = (u32x4){z_, z_, z_, z_};
                        if (inside) { float v[8];
#pragma unroll
                            for (int e = 0; e < 8; ++e) v[e] = tl[(kh + q * 8 + e) * 257 + nn];
                            w.x = cvt_pk(v[0], v[1]); w.y = cvt_pk(v[2], v[3]); w.z = cvt_pk(v[4], v[5]); w.w = cvt_pk(v[6], v[7]); }
                        *(u32x4*)(dp + q * 8) = w;
                    }
                }
            }
            __syncthreads();
        }
        rot = (rot + ntile) % G;
    }
}
__device__ __forceinline__ float row_rstd(const f32x4 (&v)[4], int lane) {
    float s = 0.f;
#pragma unroll
    for (int i = 0; i < 4; ++i) s += (v[i][0] * v[i][0] + v[i][1] * v[i][1]) + (v[i][2] * v[i][2] + v[i][3] * v[i][3]);
    s = wave_sum(s, lane);
    return __builtin_amdgcn_rsqf(s * (1.f / D) + RMS_EPS);
}

__device__ __forceinline__ void assemble_x(KP p, int tid, int bid, int G) {
    const int lane = tid & 63, gw = bid * 8 + (tid >> 6), nw = G * 8;
    float* X = (float*)(p->ws + W_X); bf16_t* XN = (bf16_t*)(p->ws + W_XN);
    for (int row = gw; row < MP; row += nw) {
        f32x4 v[4];
        const float* src = nullptr;
        if (row < MPR) { const int b = row / TP, t = row - b * TP; src = t < NMETA ? p->in[6] + (size_t)t * D : p->in[0] + ((size_t)b * SEQP + (t - NMETA)) * D; }
        else if (row < MR) src = p->in[1] + (size_t)(row - MPR) * D;
#pragma unroll
        for (int i = 0; i < 4; ++i) { const float zf = __uint_as_float((unsigned)tid >> 31); v[i] = src ? *(const f32x4*)(src + lane * 4 + 256 * i) : (f32x4){zf, zf, zf, zf}; }
        float ssq = 0.f;
#pragma unroll
        for (int i = 0; i < 4; ++i) ssq += (v[i][0] * v[i][0] + v[i][1] * v[i][1]) + (v[i][2] * v[i][2] + v[i][3] * v[i][3]);
        ssq = wave_sum(ssq, lane);
#pragma unroll
        for (int i = 0; i < 4; ++i) { const int c = lane * 4 + 256 * i; *(f32x4*)(X + (size_t)row * D + c) = v[i]; store_bf4(XN + (size_t)row * D + c, v[i]); }
        float* rsq = (float*)(p->ws + W_RSQ);
        if (lane < 5) rsq[(size_t)lane * MP + row] = lane == 0 ? ssq : 0.f;
    }    for (int i = gw * 64 + lane; i < 64 * 1024; i += nw * 64) ((unsigned*)(p->ws + W_SKF))[i] = 0u;
    for (int i = gw * 64 + lane; i < 65536; i += nw * 64) ((float*)(p->ws + W_SKP) + (size_t)276 * 65536)[i] = 0.f;
}
__device__ __forceinline__ void norm_phase(KP p, const float* g, int tid, int bid, int G, bool copy_y = false) {
    const int lane = tid & 63, gw = bid * 8 + (tid >> 6), nw = G * 8;
    const float* X = (const float*)(p->ws + W_X); bf16_t* XN = (bf16_t*)(p->ws + W_XN);
    for (int row = gw; row < MP; row += nw) {
        f32x4 v[4];
#pragma unroll
        for (int i = 0; i < 4; ++i) v[i] = *(const f32x4*)(X + (size_t)row * D + lane * 4 + 256 * i);
        const float rs = row_rstd(v, lane);
#pragma unroll
        for (int i = 0; i < 4; ++i) { const int c = lane * 4 + 256 * i; store_bf4(XN + (size_t)row * D + c, v[i] * rs * *(const f32x4*)(g + c)); }
        if (copy_y && row < MR) {
            float* dp = nullptr;
            if (row < MPR) { const int b = row / TP, t = row - b * TP; if (t >= NMETA) dp = p->out + O_YP + ((size_t)b * SEQP + (t - NMETA)) * D; }
            else dp = p->out + O_YS + (size_t)(row - MPR) * D;
            if (dp) {
#pragma unroll
                for (int i = 0; i < 4; ++i) *(f32x4*)(dp + lane * 4 + 256 * i) = v[i];
            }
        }
    }
}
__device__ __forceinline__ void mixprep_phase(KP p, int tid, int bid, int G) {
    const int lane = tid & 63, gw = bid * 8 + (tid >> 6), nw = G * 8;
    const float* X = (const float*)(p->ws + W_X); bf16_t* A = (bf16_t*)(p->ws + W_AALL);
    const float* g = p->in[10]; const float* mu = p->in[11];
    const int rb = (MR + nw - 1) / nw;
    f32x4 hl[4];
    for (int row = gw * rb, k = 0; k < rb && row < MR; ++row, ++k) {
        int grp, b, t; row_bt(row, grp, b, t);
        f32x4 v[4], pv[4];
#pragma unroll
        for (int i = 0; i < 4; ++i) v[i] = *(const f32x4*)(X + (size_t)row * D + lane * 4 + 256 * i);
        const float rs = row_rstd(v, lane);
        if (t > 0) {
            if (k == 0) {
#pragma unroll
                for (int i = 0; i < 4; ++i) pv[i] = *(const f32x4*)(X + (size_t)(row - 1) * D + lane * 4 + 256 * i);
                const float rp = row_rstd(pv, lane);
#pragma unroll
                for (int i = 0; i < 4; ++i) pv[i] = pv[i] * rp * *(const f32x4*)(g + lane * 4 + 256 * i);
            } else {
#pragma unroll
                for (int i = 0; i < 4; ++i) pv[i] = hl[i];
            }
        } else {
#pragma unroll
            for (int i = 0; i < 4; ++i) { const float zf = __uint_as_float((unsigned)tid >> 31); pv[i] = grp == 0 ? (f32x4){zf, zf, zf, zf} : *(const f32x4*)(p->in[3] + (size_t)b * D + lane * 4 + 256 * i); }
        }
        const bool last = t == (grp == 0 ? TP - 1 : TS - 1);
        float* sh = grp == 0 ? p->out + O_SHP + (size_t)b * D : p->out + O_SHS + (size_t)b * D;
#pragma unroll
        for (int i = 0; i < 4; ++i) {
            const int c = lane * 4 + 256 * i; const size_t o = (size_t)row * D + c;
            const f32x4 h = v[i] * rs * *(const f32x4*)(g + c), dx = pv[i] - h;
            store_bf4(A + o, h + dx * *(const f32x4*)(mu + c));
            store_bf4(A + (size_t)MP * D + o, h + dx * *(const f32x4*)(mu + 2 * D + c));
            store_bf4(A + (size_t)2 * MP * D + o, h + dx * *(const f32x4*)(mu + 3 * D + c));
            store_bf4(A + (size_t)3 * MP * D + o, h);
            store_bf4(A + (size_t)4 * MP * D + o, pv[i]);
            if (last) *(f32x4*)(sh + c) = h;
            hl[i] = h;
        }
    }
}
__device__ __forceinline__ void act_phase(KP p, int gtid, int nthr) {
    const float* L1 = (const float*)(p->ws + W_L1); bf16_t* A2 = (bf16_t*)(p->ws + W_A2);
    for (int i = gtid; i < MP * 64; i += nthr) {
        const int c = (i & 63) * 4;
        f32x4 v = *(const f32x4*)(L1 + (size_t)i * 4) + *(const f32x4*)(L1 + (size_t)MP * 256 + (size_t)i * 4);
        if (c < 64) {
#pragma unroll
            for (int j = 0; j < 4; ++j) v[j] = 1.f - 2.f * __builtin_amdgcn_rcpf(1.f + __expf(2.f * v[j]));
        } else if (c >= 128) {
#pragma unroll
            for (int j = 0; j < 4; ++j) v[j] = sigmoidf_(v[j]);
        }
        store_bf4(A2 + (size_t)i * 4, v);
    }
}

__device__ __forceinline__ float dpp_sum16(float x) {
    x += __builtin_bit_cast(float, __builtin_amdgcn_update_dpp(0, __builtin_bit_cast(int, x), 0xB1, 0xF, 0xF, true));
    x += __builtin_bit_cast(float, __builtin_amdgcn_update_dpp(0, __builtin_bit_cast(int, x), 0x4E, 0xF, 0xF, true));
    x += __builtin_bit_cast(float, __builtin_amdgcn_update_dpp(0, __builtin_bit_cast(int, x), 0x141, 0xF, 0xF, true));
    x += __builtin_bit_cast(float, __builtin_amdgcn_update_dpp(0, __builtin_bit_cast(int, x), 0x140, 0xF, 0xF, true));
    return x;
}
constexpr int SC_CH = 16, SC_STR = 400;
__device__ __forceinline__ void scan_phase(KP p, LAS float* buf, int tid, int bid, int G) {
    const int wid = tid >> 6, lane = tid & 63;
    const bf16_t* RKV = (const bf16_t*)(p->ws + W_RKV); const bf16_t* DEC = (const bf16_t*)(p->ws + W_DEC); const bf16_t* AA = (const bf16_t*)(p->ws + W_AA);
    bf16_t* SO = (bf16_t*)(p->ws + W_SO);
    const bool producer = wid >= 4;
    for (int u = bid; u < 768; u += G) {
        int bh, half, T, row0; const float* S0; float* Sout;
        if (u < 256) { bh = u >> 1; half = u & 1; T = TP; row0 = (bh >> 4) * TP; S0 = nullptr; Sout = p->out + O_SP + (size_t)bh * 4096; }
        else { const int v = u - 256; bh = v >> 1; half = v & 1; T = TS; row0 = MPR + (bh >> 4) * TS; S0 = p->in[2] + (size_t)bh * 4096; Sout = p->out + O_SS + (size_t)bh * 4096; }
        const int h = bh & 15, nchunk = T / SC_CH;
        if (producer) {
            const int t2 = tid - 256, pi = t2 >> 4, pj = t2 & 15, kc = h * 64 + 4 * pj;
            const f32x4 kkv = *(const f32x4*)(p->in[21] + kc), kav = *(const f32x4*)(p->in[22] + kc), w0v = *(const f32x4*)(p->in[13] + kc), a0v = *(const f32x4*)(p->in[16] + kc);
            u32x2 pr, pk, pvv, pa, pd;
#define SC_LOAD(c) do { const size_t o = (size_t)(row0 + (c) * SC_CH + pi) * D + kc; pr = *(const u32x2*)(RKV + o); pk = *(const u32x2*)(RKV + (size_t)MP * D + o); \
            pvv = *(const u32x2*)(RKV + (size_t)2 * MP * D + o); pa = *(const u32x2*)(AA + o); pd = *(const u32x2*)(DEC + o); } while (0)
#define SC_STORE(bi) do { LAS float* rec = buf + (bi) * (SC_CH * SC_STR) + pi * SC_STR; \
            const f32x4 r = (f32x4){bf_lo(pr.x), bf_hi(pr.x), bf_lo(pr.y), bf_hi(pr.y)}, k = (f32x4){bf_lo(pk.x), bf_hi(pk.x), bf_lo(pk.y), bf_hi(pk.y)}; \
            const f32x4 v = (f32x4){bf_lo(pvv.x), bf_hi(pvv.x), bf_lo(pvv.y), bf_hi(pvv.y)}; \
            f32x4 a = (f32x4){bf_lo(pa.x), bf_hi(pa.x), bf_lo(pa.y), bf_hi(pa.y)} + a0v; f32x4 w = (f32x4){bf_lo(pd.x), bf_hi(pd.x), bf_lo(pd.y), bf_hi(pd.y)} + w0v; \
            _Pragma("unroll") for (int j = 0; j < 4; ++j) { a[j] = sigmoidf_(a[j]); w[j] = __expf(-__expf(-softplusf_(-w[j]) - 0.5f)); } \
            const f32x4 q = k * kkv; float ss = (q[0] * q[0] + q[1] * q[1]) + (q[2] * q[2] + q[3] * q[3]); ss = dpp_sum16(ss); \
            const float inv = 1.f / fmaxf(sqrtf(ss), 1e-12f); const f32x4 nk = q * inv; \
            const f32x4 kp = k * (1.f + (a - 1.f) * kav), bb = nk * a; \
            float br = (bb[0] * r[0] + bb[1] * r[1]) + (bb[2] * r[2] + bb[3] * r[3]), kr = (kp[0] * r[0] + kp[1] * r[1]) + (kp[2] * r[2] + kp[3] * r[3]); \
            br = dpp_sum16(br); kr = dpp_sum16(kr); \
            *(LAS f32x4*)(rec + 4 * pj) = w; *(LAS f32x4*)(rec + 64 + 4 * pj) = nk; *(LAS f32x4*)(rec + 128 + 4 * pj) = bb; \
            *(LAS f32x4*)(rec + 192 + 4 * pj) = kp; *(LAS f32x4*)(rec + 256 + 4 * pj) = w * r; *(LAS f32x4*)(rec + 320 + 4 * pj) = v; \
            if (pj == 0) *(LAS f32x2*)(rec + 384) = (f32x2){br, kr}; } while (0)
            SC_LOAD(0); SC_STORE(0);
            if (nchunk > 1) SC_LOAD(1);
            __syncthreads();
            for (int c = 0; c < nchunk; ++c) {
                if (c + 1 < nchunk) { SC_STORE((c + 1) & 1); if (c + 2 < nchunk) SC_LOAD(c + 2); }
                __syncthreads();
            }
#undef SC_LOAD
#undef SC_STORE
        } else {
            const int rp = lane >> 4, kq = lane & 15, vA = half * 32 + wid * 8 + rp * 2;
            f32x4 sA = (f32x4){0.f, 0.f, 0.f, 0.f}, sB = sA;
            if (S0) { sA = *(const f32x4*)(S0 + vA * 64 + kq * 4); sB = *(const f32x4*)(S0 + (vA + 1) * 64 + kq * 4); }
            bf16_t* op = SO + (size_t)(row0 + kq) * D + h * 64 + vA;
            __syncthreads();
            for (int c = 0; c < nchunk; ++c) {
                const LAS float* cb = buf + (c & 1) * (SC_CH * SC_STR);
                float oA = 0.f, oB = 0.f;
#pragma unroll
                for (int i = 0; i < SC_CH; ++i) {
                    const LAS float* rec = cb + i * SC_STR;
                    const f32x4 wd = *(const LAS f32x4*)(rec + kq * 4), kk = *(const LAS f32x4*)(rec + 64 + kq * 4), bb = *(const LAS f32x4*)(rec + 128 + kq * 4),
                                kp = *(const LAS f32x4*)(rec + 192 + kq * 4), wr = *(const LAS f32x4*)(rec + 256 + kq * 4);
                    const f32x2 vv = *(const LAS f32x2*)(rec + 320 + vA), sc = *(const LAS f32x2*)(rec + 384);
                    const f32x2 t1A = sA.hi * kk.hi + sA.lo * kk.lo, t1B = sB.hi * kk.hi + sB.lo * kk.lo, t2A = sA.hi * wr.hi + sA.lo * wr.lo, t2B = sB.hi * wr.hi + sB.lo * wr.lo;
                    float d1A = t1A.x + t1A.y, d1B = t1B.x + t1B.y, d2A = t2A.x + t2A.y, d2B = t2B.x + t2B.y;
#define DPPR(ctl) "v_add_f32_dpp %0, %0, %0 " ctl " row_mask:0xf bank_mask:0xf bound_ctrl:1\n\tv_add_f32_dpp %1, %1, %1 " ctl " row_mask:0xf bank_mask:0xf bound_ctrl:1\n\t" \
                  "v_add_f32_dpp %2, %2, %2 " ctl " row_mask:0xf bank_mask:0xf bound_ctrl:1\n\tv_add_f32_dpp %3, %3, %3 " ctl " row_mask:0xf bank_mask:0xf bound_ctrl:1\n\t"
                    asm("s_nop 1\n\t" DPPR("quad_perm:[1,0,3,2]") DPPR("quad_perm:[2,3,0,1]") DPPR("row_half_mirror") DPPR("row_mirror") : "+v"(d1A), "+v"(d1B), "+v"(d2A), "+v"(d2B));
#undef DPPR
                    const float saA = -d1A, saB = -d1B;
                    const float tA = d2A + saA * sc.x + vv.x * sc.y, tB = d2B + saB * sc.x + vv.y * sc.y;
                    sA = sA * wd + bb * saA + kp * vv.x;
                    sB = sB * wd + bb * saB + kp * vv.y;
                    oA = kq == i ? tA : oA; oB = kq == i ? tB : oB;
                }
                *(unsigned*)(op + (size_t)c * SC_CH * D) = cvt_pk(oA, oB);
                __syncthreads();
            }
            *(f32x4*)(Sout + vA * 64 + kq * 4) = sA; *(f32x4*)(Sout + (vA + 1) * 64 + kq * 4) = sB;
        }
    }
}
__device__ __forceinline__ void post_phase(KP p, int tid, int bid, int G) {
    const int lane = tid & 63, gw = bid * 8 + (tid >> 6), nw = G * 8;
    const bf16_t* RKV = (const bf16_t*)(p->ws + W_RKV); const bf16_t* AA = (const bf16_t*)(p->ws + W_AA); const bf16_t* GG = (const bf16_t*)(p->ws + W_GG);
    const bf16_t* SO = (const bf16_t*)(p->ws + W_SO); bf16_t* OG = (bf16_t*)(p->ws + W_OG);
    const float* k_a = p->in[22]; const float* a0p = p->in[16]; const float* r_k = p->in[23]; const float* gnw = p->in[24]; const float* gnb = p->in[25];
    const int c0 = lane * 16;
    for (int row = gw; row < MR; row += nw) {
        const size_t o = (size_t)row * D + c0;
        float ov[16], rv[16], kv[16], vv[16], av[16], gv[16];
#pragma unroll
#define LD16(dst, ptr) do { const u32x4 a_ = *(const u32x4*)(ptr), b_ = *(const u32x4*)((ptr) + 8); \
        dst[0] = bf_lo(a_.x); dst[1] = bf_hi(a_.x); dst[2] = bf_lo(a_.y); dst[3] = bf_hi(a_.y); dst[4] = bf_lo(a_.z); dst[5] = bf_hi(a_.z); dst[6] = bf_lo(a_.w); dst[7] = bf_hi(a_.w); \
        dst[8] = bf_lo(b_.x); dst[9] = bf_hi(b_.x); dst[10] = bf_lo(b_.y); dst[11] = bf_hi(b_.y); dst[12] = bf_lo(b_.z); dst[13] = bf_hi(b_.z); dst[14] = bf_lo(b_.w); dst[15] = bf_hi(b_.w); } while (0)
        LD16(ov, SO + o); LD16(rv, RKV + o); LD16(kv, RKV + (size_t)MP * D + o); LD16(vv, RKV + (size_t)2 * MP * D + o); LD16(av, AA + o); LD16(gv, GG + o);
#undef LD16
        float sm = 0.f, rk = 0.f;
#pragma unroll
        for (int e = 0; e < 16; ++e) { sm += ov[e]; const float kp = kv[e] * (1.f + (sigmoidf_(a0p[c0 + e] + av[e]) - 1.f) * k_a[c0 + e]); rk += rv[e] * kp * r_k[c0 + e]; }
        sm += shx(sm, 1, lane); sm += shx(sm, 2, lane); rk += shx(rk, 1, lane); rk += shx(rk, 2, lane);
        const float mean = sm * (1.f / 64.f);
        float vs = 0.f;
#pragma unroll
        for (int e = 0; e < 16; ++e) { const float d = ov[e] - mean; vs += d * d; }
        vs += shx(vs, 1, lane); vs += shx(vs, 2, lane);
        const float rstd = __builtin_amdgcn_rsqf(vs * (1.f / 64.f) + GN_EPS);
        unsigned w[8];
#pragma unroll
        for (int e = 0; e < 16; e += 2) {
            const float y0 = ((ov[e] - mean) * rstd * gnw[c0 + e] + gnb[c0 + e] + rk * vv[e]) * gv[e];
            const float y1 = ((ov[e + 1] - mean) * rstd * gnw[c0 + e + 1] + gnb[c0 + e + 1] + rk * vv[e + 1]) * gv[e + 1];
            w[e >> 1] = cvt_pk(y0, y1);
        }
        *(u32x4*)(OG + o) = (u32x4){w[0], w[1], w[2], w[3]}; *(u32x4*)(OG + o + 8) = (u32x4){w[4], w[5], w[6], w[7]};
    }
}

__device__ __forceinline__ int crow(int r, int hi) { return (r & 3) + 8 * (r >> 2) + 4 * hi; }
__device__ __forceinline__ bf16x8 pack8(f32x4 a, f32x4 b) {
    u32x4 w; w.x = cvt_pk(a[0], a[1]); w.y = cvt_pk(a[2], a[3]); w.z = cvt_pk(b[0], b[1]); w.w = cvt_pk(b[2], b[3]);
    return __builtin_bit_cast(bf16x8, w);
}
__device__ __forceinline__ void attn_phase(KP p, int tid, int bid, int G) {
    const int lane = tid & 63, gw = bid * 8 + (tid >> 6), nw = G * 8;
    const bf16_t* QB = (const bf16_t*)(p->ws + W_QB); bf16_t* AO = (bf16_t*)(p->ws + W_OG);
    const int ql = lane & 31, hi = lane >> 5;
    constexpr int NU_P = BP * NH * 65;
    for (int u = gw; u < NU_P + BS * NH * 2; u += nw) {
        int bh, Q0, nq, npast, row_base, Tn; const float *kc, *vc, *kn, *vn;
        if (u < NU_P) { bh = u / 65; Q0 = (u - bh * 65) * 32; nq = min(32, TP - Q0); npast = 0; row_base = (bh >> 4) * TP; Tn = TP;
            kc = nullptr; vc = nullptr; kn = p->out + O_KP + (size_t)bh * TP * HD; vn = p->out + O_VP + (size_t)bh * TP * HD; }
        else { const int v = u - NU_P; bh = v >> 1; Q0 = (v & 1) * 32; nq = 32; npast = PAST; row_base = MPR + (bh >> 4) * TS; Tn = TS;
            kc = p->in[4] + (size_t)bh * PAST * HD; vc = p->in[5] + (size_t)bh * PAST * HD; kn = p->out + O_KS + (size_t)bh * TS * HD; vn = p->out + O_VS + (size_t)bh * TS * HD; }
        const int h = bh & 15, qpos0 = npast + Q0;
        bf16x8 qf[4];
        { const bf16_t* qp = QB + (size_t)(row_base + Q0 + min(ql, nq - 1)) * D + h * 64 + hi * 8;
#pragma unroll
          for (int s = 0; s < 4; ++s) qf[s] = *(const bf16x8*)(qp + 16 * s); }
        f32x16 o0, o1;
#pragma unroll
        for (int r = 0; r < 16; ++r) { o0[r] = 0.f; o1[r] = 0.f; }
        float carry = ql < nq ? 0.f : -1e30f;
        const int qpos = qpos0 + ql;
        f32x4 kc4[8];
#define ATT_TILE_PTRS(P0_, kb_, vb_, lim_) const bool inpast_ = (P0_) < npast; \
            const float* kb_ = inpast_ ? kc + (size_t)(P0_) * HD : kn + (size_t)((P0_) - npast) * HD; \
            const float* vb_ = inpast_ ? vc + (size_t)(P0_) * HD : vn + (size_t)((P0_) - npast) * HD; \
            const int lim_ = inpast_ ? 31 : min(31, Tn - 1 - ((P0_) - npast));
        { ATT_TILE_PTRS((qpos0 >> 5) * 32, kb0, vb0, lim0); (void)vb0;
          const float* kp = kb0 + (size_t)min(ql, lim0) * HD + hi * 8;
#pragma unroll
          for (int s = 0; s < 4; ++s) { kc4[2 * s] = *(const f32x4*)(kp + 16 * s); kc4[2 * s + 1] = *(const f32x4*)(kp + 16 * s + 4); } }
        for (int kt = qpos0 >> 5; kt >= 0; --kt) {
            const int P0 = kt * 32;
            ATT_TILE_PTRS(P0, kb, vb, lim); (void)kb;
            float x0[16], x1[16];
#pragma unroll
            for (int r = 0; r < 16; ++r) { const float* vp = vb + (size_t)min(crow(r, hi), lim) * HD + ql; x0[r] = vp[0]; x1[r] = vp[32]; }
            f32x4 kn4[8];
            { const int Pn = kt > 0 ? P0 - 32 : P0; ATT_TILE_PTRS(Pn, kbn, vbn, limn); (void)vbn;
              const float* kp = kbn + (size_t)min(ql, limn) * HD + hi * 8;
#pragma unroll
              for (int s = 0; s < 4; ++s) { kn4[2 * s] = *(const f32x4*)(kp + 16 * s); kn4[2 * s + 1] = *(const f32x4*)(kp + 16 * s + 4); } }
            f32x16 st;
#pragma unroll
            for (int r = 0; r < 16; ++r) st[r] = 0.f;
#pragma unroll
            for (int s = 0; s < 4; ++s) st = __builtin_amdgcn_mfma_f32_32x32x16_bf16(pack8(kc4[2 * s], kc4[2 * s + 1]), qf[s], st, 0, 0, 0);
            float L[16];
            float own[4];
#pragma unroll
            for (int g = 0; g < 4; ++g) { float sg = 0.f;
#pragma unroll
                for (int i = 0; i < 4; ++i) { const int r = 4 * g + i; const bool vis = (P0 + crow(r, hi)) < qpos; L[r] = vis ? -softplusf_(st[r]) : 0.f; sg += L[r]; }
                own[g] = sg; }
            float oth[4];
#pragma unroll
            for (int g = 0; g < 4; ++g) oth[g] = shx(own[g], 32, lane);
            float suf = carry;
            float A[16];
#pragma unroll
            for (int g = 3; g >= 0; --g) {
                float c = suf + (hi == 0 ? oth[g] : 0.f);
#pragma unroll
                for (int i = 3; i >= 0; --i) { const int r = 4 * g + i; c += L[r]; const bool vis = (P0 + crow(r, hi)) < qpos; A[r] = vis ? __expf(st[r] + c) : 0.f; }
                suf += own[g] + oth[g];
            }
            carry = suf;
            const bf16x8 pa0 = pack8((f32x4){A[0], A[1], A[2], A[3]}, (f32x4){A[4], A[5], A[6], A[7]});
            const bf16x8 pa1 = pack8((f32x4){A[8], A[9], A[10], A[11]}, (f32x4){A[12], A[13], A[14], A[15]});
            o0 = __builtin_amdgcn_mfma_f32_32x32x16_bf16(pa0, pack8((f32x4){x0[0], x0[1], x0[2], x0[3]}, (f32x4){x0[4], x0[5], x0[6], x0[7]}), o0, 0, 0, 0);
            o1 = __builtin_amdgcn_mfma_f32_32x32x16_bf16(pa0, pack8((f32x4){x1[0], x1[1], x1[2], x1[3]}, (f32x4){x1[4], x1[5], x1[6], x1[7]}), o1, 0, 0, 0);
            o0 = __builtin_amdgcn_mfma_f32_32x32x16_bf16(pa1, pack8((f32x4){x0[8], x0[9], x0[10], x0[11]}, (f32x4){x0[12], x0[13], x0[14], x0[15]}), o0, 0, 0, 0);
            o1 = __builtin_amdgcn_mfma_f32_32x32x16_bf16(pa1, pack8((f32x4){x1[8], x1[9], x1[10], x1[11]}, (f32x4){x1[12], x1[13], x1[14], x1[15]}), o1, 0, 0, 0);
#pragma unroll
            for (int e = 0; e < 8; ++e) kc4[e] = kn4[e];
            if (!__any(carry >= -104.f)) break;
        }
#undef ATT_TILE_PTRS
        bf16_t* op = AO + (size_t)(row_base + Q0) * D + h * 64 + ql;
#pragma unroll
        for (int r = 0; r < 16; ++r) { const int qr = crow(r, hi); if (qr < nq) { op[(size_t)qr * D] = (bf16_t)(cvt_pk(o0[r], 0.f) & 0xffffu); op[(size_t)qr * D + 32] = (bf16_t)(cvt_pk(o1[r], 0.f) & 0xffffu); } }
    }
}

template <int NS> __device__ __forceinline__ void fixup_phase(KP p, int ffn, int tid, int bid, int G) {
    float* X = (float*)(p->ws + W_X); bf16_t* XB = (bf16_t*)(p->ws + W_XN); const float* spl = (const float*)(p->ws + W_SKP);
    float* rsq = (float*)(p->ws + W_RSQ) + (size_t)(ffn == 1 ? 2 : (ffn == 2 ? 3 : (ffn == 4 ? 1 : 4))) * MP;
    const bool fold = ffn == 1 || ffn == 2 || ffn >= 4, fin = ffn == 3; const float scl = ffn >= 4 ? 1.0f : 0.5f;
    pg8::StaticOrder so; so.init(MP, D, 1, 0); so.nt0 = 0;
    const int ntail = so.nwg - G; if (ntail <= 0) return;
    const int wid = tid >> 6, lane = tid & 63, wr = wid >> 2, wc = wid & 3, fr = lane & 15, fq = lane >> 4;
    for (int B = bid; B < ntail * 32; B += G) {
        const int j = B >> 5, q = B & 31, n = q & 1, m = (q >> 1) & 3, bj = (q >> 3) & 1, ai = q >> 4;
        Unit u; so.next(G + j, u);
        f32x4 pv_[NS];
#pragma unroll
        for (int ch = 0; ch < NS; ++ch) pv_[ch] = *((const f32x4*)(spl + (size_t)(j * NS + ch) * 65536) + q * 512 + tid);
        f32x4 sum = pv_[0];
#pragma unroll
        for (int ch = 1; ch < NS; ++ch) sum += pv_[ch];
        const int row = u.pm * 256 + ai * 128 + wr * 64 + m * 16 + fr, col = u.pn * 256 + bj * 128 + wc * 32 + n * 16 + fq * 4;
        const size_t off = (size_t)row * D + col;
        const f32x4 x = *(const f32x4*)(X + off) + sum * scl;
        if (!fin) {
            *(f32x4*)(X + off) = x;
            if (fold) { store_bf4(XB + off, x); float ss = (x[0] * x[0] + x[1] * x[1]) + (x[2] * x[2] + x[3] * x[3]); ss += shx(ss, 16, lane); ss += shx(ss, 32, lane); if (fq == 0) unsafeAtomicAdd(rsq + row, ss); }
        } else if (row < MR) {
            float* dp = nullptr;
            if (row < MPR) { const int b = row / TP, t = row - b * TP; if (t >= NMETA) dp = p->out + O_YP + ((size_t)b * SEQP + (t - NMETA)) * D + col; }
            else dp = p->out + O_YS + (size_t)(row - MPR) * D + col;
            if (dp) *(f32x4*)dp = x;
        }
    }
}
#define XB_TMO      128
#define XB_XCNT(j)  (256  + 64 * (j))
#define XB_XSUB(j)  (1280 + 64 * (j))
#define XB_XGEN(j)  (2304 + 64 * (j))
#define XB_TOP      3328
#define XB_TOPGEN   3392
#define XCD_BAR_WORDS 3456
#define XB_SPIN_CAP (1u << 18)

__device__ __forceinline__ unsigned xb_ld(unsigned* p)              { return __hip_atomic_load(p, __ATOMIC_RELAXED, __HIP_MEMORY_SCOPE_AGENT); }
__device__ __forceinline__ unsigned xb_add(unsigned* p, unsigned v) { return __hip_atomic_fetch_add(p, v, __ATOMIC_RELAXED, __HIP_MEMORY_SCOPE_AGENT); }
__device__ __forceinline__ unsigned xb_xcc_id() { return (unsigned)__builtin_amdgcn_s_getreg((3 << 11) | 20) & 0xFu; }
#define XB_SPIN(cond, bar) do { unsigned _sp = 0; while (cond) { __builtin_amdgcn_s_sleep(1); \
    if ((++_sp & 255u) == 0u) { if (xb_ld(&(bar)[XB_TMO])) break; if (_sp > XB_SPIN_CAP) { atomicAdd(&(bar)[XB_TMO], 1u); break; } } } } while (0)

struct XcdBarrier {
    unsigned* bar; unsigned x;
    volatile LAS unsigned* st;
};

__device__ __forceinline__ XcdBarrier xcd_barrier_post(unsigned* bar, volatile LAS unsigned* st, bool xb_tid0) {
    XcdBarrier b; b.bar = bar; b.x = xb_xcc_id(); b.st = st;
    if (xb_tid0) (void)xb_add(&bar[XB_XCNT(b.x)], 1u);
    return b;
}
__device__ __forceinline__ void xcd_barrier_complete(unsigned* bar, unsigned x, unsigned& nloc, unsigned& nx) {
    const unsigned G = gridDim.x * gridDim.y * gridDim.z;
    unsigned sum, cnt, mine, sp = 0u;
    for (;;) {
        sum = 0u; cnt = 0u; mine = 0u;
#pragma unroll
        for (unsigned j = 0; j < 16; ++j) { const unsigned c = xb_ld(&bar[XB_XCNT(j)]); sum += c; cnt += (c > 0u) ? 1u : 0u; mine = (j == x) ? c : mine; }
        if (sum == G) break;
        __builtin_amdgcn_s_sleep(1);
        if ((++sp & 255u) == 0u) { if (xb_ld(&bar[XB_TMO])) break; if (sp > XB_SPIN_CAP) { atomicAdd(&bar[XB_TMO], 1u); break; } }
    }
    nloc = mine > 0u ? mine : 1u; nx = cnt > 0u ? cnt : 1u;
}

__device__ __forceinline__ void xcd_barrier(const XcdBarrier& b, bool xb_tid0) {
    asm volatile("s_waitcnt vmcnt(0)" ::: "memory");
    __syncthreads();
    if (xb_tid0) {
        unsigned* bar = b.bar;
        __builtin_amdgcn_s_waitcnt(0);
        unsigned nloc = b.st[0], nx = b.st[1];
        if (nloc == 0u) { xcd_barrier_complete(bar, b.x, nloc, nx); b.st[0] = nloc; b.st[1] = nx; }
        const unsigned old = xb_add(&bar[XB_XSUB(b.x)], 1u);
        const unsigned gen = old / nloc;
        if (old + 1u == (gen + 1u) * nloc) {
            __builtin_amdgcn_fence(__ATOMIC_RELEASE, "agent");
            asm volatile("s_waitcnt vmcnt(0)" ::: "memory");
            const unsigned og = xb_add(&bar[XB_TOP], 1u);
            const unsigned tg = og / nx;
            if (og + 1u == (tg + 1u) * nx) xb_add(&bar[XB_TOPGEN], 1u);
            else XB_SPIN(xb_ld(&bar[XB_TOPGEN]) == tg, bar);
            __builtin_amdgcn_fence(__ATOMIC_ACQUIRE, "agent");
            xb_add(&bar[XB_XGEN(b.x)], 1u);
            asm volatile("s_waitcnt vmcnt(0)" ::: "memory");
        } else {
            XB_SPIN(xb_ld(&bar[XB_XGEN(b.x)]) == gen, bar);
            __builtin_amdgcn_fence(__ATOMIC_ACQUIRE, "agent");
            asm volatile("s_waitcnt vmcnt(0)" ::: "memory");
        }
    }
    __syncthreads();
}
constexpr int NPHASE = 23;
#ifndef PHM
#define PHM 0xffff
#endif
#define EN(k) (((PHM) >> (k)) & 1)
constexpr int LDS_BYTES = 131072 + 8 * 576 * 4;
template <class Epi, class Sched>
__device__ __forceinline__ void run_gemm(LAS unsigned char* lds, int wb, const bf16_t* A, const bf16_t* Bt, int M, int N, int K, const Sched& S, const Epi& E, float* skp = nullptr, unsigned* skf = nullptr) {
    pg8::Gemm g{A, Bt, M, N, K, wb, skp, skf};
    pg8::gemm_phase<Epi, Sched, GP_ALIGN, GP_SP2>(lds, g, S, E);
}
__global__ void __launch_bounds__(512, 2) mega(Params p_unused) {
    LAS unsigned char* lds = (LAS unsigned char*)lds_raw;
    cg::grid_group grid = cg::this_grid();
    KP p = (KP)__builtin_amdgcn_kernarg_segment_ptr();
    const int ph_lo = p->ph_lo, ph_hi = p->ph_hi;
    const int wb = __builtin_amdgcn_readfirstlane((int)threadIdx.x) & ~63;
    { LAS unsigned* stw = (LAS unsigned*)(lds + 131072); if ((int)threadIdx.x < 2) stw[threadIdx.x] = 0u; __syncthreads(); }
    const XcdBarrier xbar = xcd_barrier_post((unsigned*)(p->ws + W_BAR), (volatile LAS unsigned*)(lds + 131072), threadIdx.x == 0);
    for (int pi_ = ph_lo; pi_ < ph_hi; ++pi_) {
        asm volatile("" ::: "v1","v2","v3","v4","v5","v6","v7","v8","v9","v10","v11","v12","v13","v14","v15","v16","v17","v18","v19","v20","v21","v22","v23","v24","v25","v26","v27","v28","v29","v30","v31","v32","v33","v34","v35","v36","v37","v38","v39","v40","v41","v42","v43","v44","v45","v46","v47","v48","v49","v50","v51","v52","v53","v54","v55","v56","v57","v58","v59","v60","v61","v62","v63","v64","v65","v66","v67","v68","v69","v70","v71","v72","v73","v74","v75","v76","v77","v78","v79","v80","v81","v82","v83","v84","v85","v86","v87","v88","v89","v90","v91","v92","v93","v94","v95","v96","v97","v98","v99","v100","v101","v102","v103","v104","v105","v106","v107","v108","v109","v110","v111","v112","v113","v114","v115","v116","v117","v118","v119","v120","v121","v122","v123","v124","v125","v126","v127","v128","v129","v130","v131","v132","v133","v134","v135","v136","v137","v138","v139","v140","v141","v142","v143","v144","v145","v146","v147","v148","v149","v150","v151","v152","v153","v154","v155","v156","v157","v158","v159","v160","v161","v162","v163","v164","v165","v166","v167","v168","v169","v170","v171","v172","v173","v174","v175","v176","v177","v178","v179","v180","v181","v182","v183","v184","v185","v186","v187","v188","v189","v190","v191","v192","v193","v194","v195","v196","v197","v198","v199","v200","v201","v202","v203","v204","v205","v206","v207","v208","v209","v210","v211","v212","v213","v214","v215","v216","v217","v218","v219","v220","v221","v222","v223","v224","v225","v226","v227","v228","v229","v230","v231","v232","v233","v234","v235","v236","v237","v238","v239","v240","v241","v242","v243","v244","v245","v246","v247","v248","v249");
        asm volatile("" : "+s"(p));
        const int phc = p->seq[pi_], ph = phc & 63; const bool dry = (phc & 64) != 0;
        int bid = blockIdx.x, G = gridDim.x;
        asm volatile("" : "+s"(bid), "+s"(G));
#define TID_HERE (wb + lane_now())
        int ffn = -1; bool ffn_in = false;
        if (ph == 1 || ph == 2) { ffn = 0; ffn_in = ph == 1; } else if (ph == 11 || ph == 12) { ffn = 1; ffn_in = ph == 11; }
        else if (ph == 14 || ph == 15) { ffn = 2; ffn_in = ph == 14; } else if (ph == 21 || ph == 22) { ffn = 3; ffn_in = ph == 21; }
        if (EN(0) && ph == 0) { { const int tid = TID_HERE; convert_weights(p, (LAS float*)lds, tid, bid, G); assemble_x(p, tid, bid, G); } }
        else if (EN(1) && ffn >= 0 && ffn_in) {
            pg8::StaticOrder S; S.init(MP, NIN, G, bid); S.nt0 = D / 64;
            unsigned char* ws = p->ws; EpiSwiGLU E{(bf16_t*)(ws + W_HB), (const float*)(ws + W_RSQ) + (size_t)(ffn == 0 ? 0 : (ffn == 1 ? 1 : (ffn == 2 ? 2 : 4))) * MP};
            run_gemm(lds, wb, (const bf16_t*)(ws + W_XN), (const bf16_t*)(ws + W_WIN + ffn * SZ_WIN1), MP, NIN, D, S, E);
        } else if (EN(2) && ffn >= 0) {
            TailSplitOrder S; S.init(MP, D, DFFP, G, bid, 11);
            unsigned char* ws = p->ws; const bool fold = (ffn == 1 || ffn == 2) && !dry;
            EpiRes E{(float*)(ws + W_X), dry ? 0.f : 0.5f, (ffn == 3 && !dry) ? p->out : nullptr, fold ? (bf16_t*)(ws + W_XN) : nullptr, (float*)(ws + W_RSQ) + (size_t)(ffn == 1 ? 2 : 3) * MP, (float*)(ws + W_SKP)};
            run_gemm(lds, wb, (const bf16_t*)(ws + W_HB), (const bf16_t*)(ws + W_WOUT + ffn * SZ_WOUT1), MP, D, DFFP, S, E, (float*)(ws + W_SKP), (unsigned*)(ws + W_SKF) + pi_ * 1024);
        }
        else if (ph >= 24 && ph < 28) { if (!dry) fixup_phase<11>(p, ph - 24, TID_HERE, bid, G); }
        else if (ph >= 28 && ph < 30) { if (!dry) fixup_phase<WO_NS>(p, ph - 24, TID_HERE, bid, G); }
        else if (EN(3) && ph == 3) mixprep_phase(p, TID_HERE, bid, G);
        else if (EN(4) && ph == 4) {
            G1Order S{G, bid};
            unsigned char* ws = p->ws; EpiG1 E{(bf16_t*)(ws + W_RKV), (float*)(ws + W_L1)};
            run_gemm(lds, wb, (const bf16_t*)(ws + W_AALL), (const bf16_t*)(ws + W_WG1), 5 * MP, 3584, D, S, E);
        }
        else if (EN(5) && ph == 5) act_phase(p, bid * 512 + TID_HERE, G * 512);
        else if (EN(6) && ph == 6) {
            G2Order S; S.init(G, bid);
            unsigned char* ws = p->ws; EpiG2 E{(bf16_t*)(ws + W_DEC)};
            run_gemm(lds, wb, (const bf16_t*)(ws + W_A2), (const bf16_t*)(ws + W_WL2), MP, 3072, 256, S, E);
        }
        else if (EN(7) && ph == 7) scan_phase(p, (LAS float*)lds, TID_HERE, bid, G);
        else if (EN(8) && ph == 8) post_phase(p, TID_HERE, bid, G);
        else if (EN(9) && (ph == 9 || ph == 19)) {
            TailSplitOrder S; S.init(MP, D, D, G, bid, WO_NS);
            unsigned char* ws = p->ws; EpiRes E{(float*)(ws + W_X), dry ? 0.f : 1.0f, nullptr, dry ? nullptr : (bf16_t*)(ws + W_XN), (float*)(ws + W_RSQ) + (size_t)(ph == 9 ? 1 : 4) * MP, (float*)(ws + W_SKP)};
            run_gemm(lds, wb, (const bf16_t*)(ws + W_OG), (const bf16_t*)(ws + (ph == 9 ? W_WO1 : W_WO2)), MP, D, D, S, E, (float*)(ws + W_SKP), (unsigned*)(ws + W_SKF) + pi_ * 1024);
        }
        else if (EN(11) && ph == 17) {
            pg8::StaticOrder S; S.init(MP, 3 * D, G, bid); S.nt0 = D / 64;
            unsigned char* ws = p->ws; EpiQKV E{(bf16_t*)(ws + W_QB), p->out, p->in[28], p->in[29], (const float*)(ws + W_RSQ) + (size_t)3 * MP};
            run_gemm(lds, wb, (const bf16_t*)(ws + W_XN), (const bf16_t*)(ws + W_WQKV), MP, 3 * D, D, S, E);
        }
        else if (EN(12) && ph == 18) attn_phase(p, TID_HERE, bid, G);
        if (pi_ + 1 < ph_hi) { if (pi_ < 0) grid.sync(); else xcd_barrier(xbar, (wb + lane_now()) == 0); }
    }
}

#ifndef ONE_LAUNCH
#define ONE_LAUNCH 1
#endif
extern "C" void kernel_launch(void* const* d_in, const int* in_sizes, int n_in, void* d_out, int out_size, void* d_ws, size_t ws_size, hipStream_t stream) {
    static int grid = 0;
    if (grid == 0) {
        if (n_in != 31 || (size_t)out_size != O_END || ws_size < W_END) { fprintf(stderr, "kernel_launch: unexpected sizes (n_in %d out %d ws %zu need %zu)\n", n_in, out_size, ws_size, (size_t)W_END); grid = -1; return; }
        int dev = 0, cus = 0, per_cu = 0;
        hipGetDevice(&dev); hipDeviceGetAttribute(&cus, hipDeviceAttributeMultiprocessorCount, dev);
        if (hipFuncSetAttribute((const void*)mega, hipFuncAttributeMaxDynamicSharedMemorySize, LDS_BYTES) != hipSuccess) { fprintf(stderr, "kernel_launch: hipFuncSetAttribute failed\n"); grid = -1; return; }
        hipOccupancyMaxActiveBlocksPerMultiprocessor(&per_cu, (const void*)mega, 512, LDS_BYTES);
        (void)hipGetLastError();
        if (per_cu < 1) per_cu = 1;
        grid = cus * per_cu;
    }
    if (grid < 0) return;
    Params p{};
    for (int i = 0; i < 31; ++i) p.in[i] = (const float*)d_in[i];
    p.out = (float*)d_out; p.ws = (unsigned char*)d_ws;
    int nseq = 0;
    for (int ph = 0; ph < NPHASE; ++ph) {
        if (ph == 10 || ph == 13 || ph == 16 || ph == 20) continue;
        p.seq[nseq++] = ph;
        if (ph == 2 || ph == 12 || ph == 15 || ph == 22) p.seq[nseq++] = 24 + (ph == 2 ? 0 : (ph == 12 ? 1 : (ph == 15 ? 2 : 3)));
        if (ph == 9 || ph == 19) p.seq[nseq++] = ph == 9 ? 28 : 29;
#ifdef REP_OF
        for (int r = 0; r < (REP_OF(ph)); ++r) p.seq[nseq++] = (ph | ((ph == 2 || ph == 9) ? 64 : 0));
#endif
    }
#if ONE_LAUNCH
    (void)hipMemsetAsync((unsigned char*)d_ws + W_BAR, 0, 16384, stream);
    p.ph_lo = 0; p.ph_hi = nseq;
    void* args[] = {&p};
    hipError_t e = hipLaunchCooperativeKernel((const void*)mega, dim3(grid), dim3(512), args, LDS_BYTES, stream);
    if (e != hipSuccess) fprintf(stderr, "cooperative launch failed: %s (grid %d)\n", hipGetErrorString(e), grid);
#else
    for (int ph = 0; ph < nseq; ++ph) { p.ph_lo = ph; p.ph_hi = ph + 1; hipLaunchKernelGGL(mega, dim3(grid), dim3(512), LDS_BYTES, stream, p); }
#endif
}
```

```cpp
#include <hip/hip_runtime.h>
#include <hip/hip_cooperative_groups.h>
#include <cstdio>
#include <cstdint>
namespace cg = cooperative_groups;
#ifndef GP_SP2
#define GP_SP2 true
#endif
#ifndef GP_ALIGN
#define GP_ALIGN true
#endif
#ifndef WO_NS
#define WO_NS 4
#endif
#ifndef WGM_SET
#define WGM_SET 8
#endif
__device__ __forceinline__ int lane_now() { int l; asm volatile("v_mbcnt_lo_u32_b32 %0, -1, 0\n\tv_mbcnt_hi_u32_b32 %0, -1, %0" : "=v"(l)); return l; }
namespace pg8 {
#define PG8_LAS __attribute__((address_space(3)))
typedef unsigned short bf16_t;
typedef short bf16x8 __attribute__((ext_vector_type(8)));
typedef float f32x4 __attribute__((ext_vector_type(4)));
typedef unsigned u32x4 __attribute__((ext_vector_type(4)));
constexpr int BM = 256, BK = 64, HALF = 128, HTB = HALF * BK * 2  , STAGE_BYTES = 8 * HTB, NXCD = 8, WGM = WGM_SET;

__host__ __device__ __forceinline__ int lds_byte(int r, int c) { const int st = (r >> 4) * 2 + (c >> 5), rr = r & 15, cc = c & 31, ob = rr * 64 + cc * 2; return st * 1024 + (ob ^ (((ob >> 9) & 1) << 5)); }
__host__ __device__ __forceinline__ void stage_rc(int b, int& R, int& C) { const int st = b / 1024, sb = b % 1024, swz = sb ^ (((sb >> 9) & 1) << 5); R = (st >> 1) * 16 + swz / 64; C = (st & 1) * 32 + (swz % 64) / 2; }
__host__ __device__ __forceinline__ int perm32(int rho) { const int n = rho >> 4, i = rho & 15; return 8 * (i >> 2) + 4 * n + (i & 3); }

struct Unit { int pm, pn, kb, nt, fl, tl; };
struct Gemm { const bf16_t* A; const bf16_t* Bt; int M, N, K, wb; float* skp; unsigned* skf; };

struct StaticOrder {
    static constexpr bool STREAM = false; int nM, nN, nwg, G, c, nt0;
    __host__ __device__ void init(int M, int N, int G_, int c_) { nM = M / BM; nN = N / BM; nwg = nM * nN; G = G_; c = c_; }
    __host__ __device__ bool next(int i, Unit& u) const {
        const long L = (long)i * G + c; if (L >= nwg) return false;
        int wgid = (int)L; { const int q = nwg / NXCD, r = nwg % NXCD, xcd = wgid % NXCD, off = wgid / NXCD; wgid = (xcd < r ? xcd * (q + 1) : r * (q + 1) + (xcd - r) * q) + off; }
        const int nig = WGM * nN, gid = wgid / nig, fm = gid * WGM, gsz = (nM - fm) < WGM ? (nM - fm) : WGM;
        u.pm = fm + ((wgid % nig) % gsz); u.pn = (wgid % nig) / gsz; u.kb = 0; u.nt = nt0; u.fl = 0; u.tl = 0; return true;
    }
    __device__ __forceinline__ void a_ready(const Unit&) const {}
    __device__ __forceinline__ void done(const Unit&) const {}
};
typedef __attribute__((address_space(1))) f32x4 gf32x4;
typedef unsigned long long u64_t;
__device__ __forceinline__ void streamk_store(const f32x4 (&acc)[2][2][4][2], const Unit& u, float* skp, unsigned* skf, int tid) {
    u64_t* q = (u64_t*)(skp + (size_t)u.tl * 65536) + 2 * tid;
#pragma unroll
    for (int a = 0; a < 2; ++a)
#pragma unroll
        for (int b = 0; b < 2; ++b)
#pragma unroll
            for (int m = 0; m < 4; ++m)
#pragma unroll
                for (int n = 0; n < 2; ++n) { const f32x4 v = acc[a][b][m][n];
                    __hip_atomic_store(q, ((u64_t)__float_as_uint(v[1]) << 32) | __float_as_uint(v[0]), __ATOMIC_RELAXED, __HIP_MEMORY_SCOPE_AGENT);
                    __hip_atomic_store(q + 1, ((u64_t)__float_as_uint(v[3]) << 32) | __float_as_uint(v[2]), __ATOMIC_RELAXED, __HIP_MEMORY_SCOPE_AGENT);
                    q += 1024; asm volatile("" : "+v"(q) :: "memory"); }
    asm volatile("s_waitcnt vmcnt(0)" ::: "memory");
    __builtin_amdgcn_s_barrier();
    if (tid == 0) __hip_atomic_store(skf + u.tl, 1u, __ATOMIC_RELAXED, __HIP_MEMORY_SCOPE_AGENT);
}
__device__ __forceinline__ const float* streamk_wait(const Unit& u, float* skp, unsigned* skf, int tid) {
    if (u.fl == 2) {
        if (tid == 0) { while (__hip_atomic_load(skf + u.tl, __ATOMIC_RELAXED, __HIP_MEMORY_SCOPE_AGENT) == 0u) __builtin_amdgcn_s_sleep(2); }
        __builtin_amdgcn_s_barrier();
        __builtin_amdgcn_fence(__ATOMIC_ACQUIRE, "agent");
    } else __builtin_amdgcn_s_barrier();
    return skp + (size_t)u.tl * 65536;
}
__device__ __forceinline__ f32x4 streamk_part(const float* part, int idx, int tid) {
    const u64_t* q = (const u64_t*)part + (size_t)idx * 1024 + 2 * tid;
    const u64_t a = __hip_atomic_load(q, __ATOMIC_RELAXED, __HIP_MEMORY_SCOPE_AGENT), b = __hip_atomic_load(q + 1, __ATOMIC_RELAXED, __HIP_MEMORY_SCOPE_AGENT);
    return (f32x4){__uint_as_float((unsigned)a), __uint_as_float((unsigned)(a >> 32)), __uint_as_float((unsigned)b), __uint_as_float((unsigned)(b >> 32))};
}
template <class Epi, class Sched, bool ALIGN_EPI = false, bool SP2 = false>
__device__ __forceinline__ void gemm_phase(PG8_LAS unsigned char* lds, const Gemm g, const Sched& S, const Epi& E) {
    int tid = g.wb + lane_now(); asm volatile("" : "+v"(tid)); const int wid = __builtin_amdgcn_readfirstlane(tid >> 6), lane = tid & 63, wr = wid >> 2, wc = wid & 3, fr = lane & 15, fq = lane >> 4;
    const int K = g.K, nt = K / BK;
    unsigned voffA[2], voffB[2];
#pragma unroll
    for (int i = 0; i < 2; ++i) { int R, C; stage_rc(tid * 16 + i * 8192, R, C); const int Rb = Epi::PERM ? ((R & ~31) + perm32(R & 31)) : R;
        voffA[i] = (unsigned)(R * K + C) * 2u; voffB[i] = (unsigned)(Rb * K + C) * 2u; }
    const size_t kstep = (size_t)(BK * 2);
    const size_t hstep = (size_t)HALF * K * 2;
    const size_t tstep = 2 * hstep;
    const unsigned ldsw = (unsigned)wid * 1024u;
    const int aoff = lds_byte(wr * 64 + fr, fq * 8), boff = lds_byte(wc * 32 + fr, fq * 8);
#define PG8_SA(b, h) (((b) * 2 + (h)) * HTB)
#define PG8_SB(b, h) ((4 + (b) * 2 + (h)) * HTB)
#define PG8_STAGE(bufoff, gbase, voff) do { _Pragma("unroll") for (int _i = 0; _i < 2; ++_i) \
        __builtin_amdgcn_global_load_lds((const unsigned*)((const char*)(gbase) + (voff)[_i]), (PG8_LAS unsigned*)(lds + (bufoff) + ldsw + _i * 8192), 16, 0, 0); } while (0)
#define PG8_LDA(dst, b, h) do { _Pragma("unroll") for (int m = 0; m < 4; ++m) _Pragma("unroll") for (int k = 0; k < 2; ++k) dst[m][k] = *(const PG8_LAS bf16x8*)(lds + PG8_SA(b, h) + aoff + m * 2048 + k * 1024); } while (0)
#define PG8_LDB(dst, b, h) do { _Pragma("unroll") for (int n = 0; n < 2; ++n) _Pragma("unroll") for (int k = 0; k < 2; ++k) dst[n][k] = *(const PG8_LAS bf16x8*)(lds + PG8_SB(b, h) + boff + n * 2048 + k * 1024); } while (0)
#define PG8_MMA(ai, bj, At, Bt) do { __builtin_amdgcn_s_setprio(1); _Pragma("unroll") for (int m = 0; m < 4; ++m) _Pragma("unroll") for (int n = 0; n < 2; ++n) _Pragma("unroll") for (int k = 0; k < 2; ++k) \
        acc[ai][bj][m][n] = __builtin_amdgcn_mfma_f32_16x16x32_bf16(Bt[n][k], At[m][k], acc[ai][bj][m][n], 0, 0, 0); __builtin_amdgcn_s_setprio(0); } while (0)
#define PG8_WAIT_V(n) asm volatile("s_waitcnt vmcnt(" #n ")" ::: "memory")
#define PG8_WAIT_L(n) asm volatile("s_waitcnt lgkmcnt(" #n ")" ::: "memory")
#define PG8_BAR __builtin_amdgcn_s_barrier()
#define PG8_SCHED __builtin_amdgcn_sched_barrier(0)
    Unit cur, nxt; int ui = 0;
    if (!S.next(0, cur)) return;
    f32x4 acc[2][2][4][2];
#pragma unroll
    for (int a = 0; a < 2; ++a)
#pragma unroll
        for (int b = 0; b < 2; ++b)
#pragma unroll
            for (int m = 0; m < 4; ++m)
#pragma unroll
                for (int n = 0; n < 2; ++n) acc[a][b][m][n] = (f32x4){0.f, 0.f, 0.f, 0.f};
    bf16x8 At[4][2], B0[2][2], B1[2][2];
    const char* cA = (const char*)g.A + (size_t)cur.pm * tstep + cur.kb; const char* cB = (const char*)g.Bt + (size_t)cur.pn * tstep + cur.kb;
    S.a_ready(cur);
    if constexpr (SP2) {
        PG8_STAGE(PG8_SB(0, 0), cB, voffB); PG8_STAGE(PG8_SB(0, 1), cB + hstep, voffB); PG8_STAGE(PG8_SA(0, 0), cA, voffA); PG8_STAGE(PG8_SA(0, 1), cA + hstep, voffA);
        if (wr == 1) PG8_BAR;
        PG8_WAIT_V(2); PG8_BAR;
        PG8_STAGE(PG8_SB(1, 0), cB + kstep, voffB); PG8_STAGE(PG8_SA(1, 0), cA + kstep, voffA); PG8_STAGE(PG8_SB(1, 1), cB + hstep + kstep, voffB);
        PG8_WAIT_V(6); PG8_BAR;
    } else {
        PG8_STAGE(PG8_SB(0, 0), cB, voffB); PG8_STAGE(PG8_SA(0, 0), cA, voffA); PG8_STAGE(PG8_SB(0, 1), cB + hstep, voffB); PG8_STAGE(PG8_SA(0, 1), cA + hstep, voffA);
        if (wr == 1) PG8_BAR;
        PG8_WAIT_V(4); PG8_BAR;
        PG8_STAGE(PG8_SB(1, 0), cB + kstep, voffB); PG8_STAGE(PG8_SA(1, 0), cA + kstep, voffA); PG8_STAGE(PG8_SB(1, 1), cB + hstep + kstep, voffB);
        PG8_WAIT_V(6); PG8_BAR;
    }
    for (;;) {
        const bool has_next = S.next(ui + 1, nxt);
        const char* nA = has_next ? (const char*)g.A + (size_t)nxt.pm * tstep + nxt.kb : cA; const char* nB = has_next ? (const char*)g.Bt + (size_t)nxt.pn * tstep + nxt.kb : cB;
        const int ntu = cur.nt;
        for (int t = 0; t < ntu; t += 2) {
            const bool last = (t == ntu - 2);
            const char* a1 = cA + (size_t)(t + 1) * kstep;
            const char* a2 = last ? nA : cA + (size_t)(t + 2) * kstep; const char* b2 = last ? nB : cB + (size_t)(t + 2) * kstep;
            const char* a3 = a2 + kstep; const char* b3 = b2 + kstep;
            if (last && has_next) S.a_ready(nxt);
            if constexpr (SP2) {
            PG8_LDB(B0, 0, 0); PG8_LDB(B1, 0, 1); PG8_SCHED; PG8_LDA(At, 0, 0); PG8_STAGE(PG8_SA(1, 1), a1 + hstep, voffA);
            PG8_WAIT_V(8); PG8_WAIT_L(0); PG8_BAR; PG8_MMA(0, 0, At, B0); PG8_MMA(0, 1, At, B1); PG8_BAR; PG8_SCHED;
            PG8_LDA(At, 0, 1); PG8_STAGE(PG8_SB(0, 0), b2, voffB); PG8_STAGE(PG8_SB(0, 1), b2 + hstep, voffB); PG8_STAGE(PG8_SA(0, 0), a2, voffA);
            PG8_WAIT_V(8); PG8_WAIT_L(0); PG8_BAR; PG8_MMA(1, 0, At, B0); PG8_MMA(1, 1, At, B1); PG8_BAR; PG8_SCHED;
            PG8_LDB(B0, 1, 0); PG8_LDB(B1, 1, 1); PG8_SCHED; PG8_LDA(At, 1, 0); PG8_STAGE(PG8_SA(0, 1), a2 + hstep, voffA);
            PG8_WAIT_V(8); PG8_WAIT_L(0); PG8_BAR; PG8_MMA(0, 0, At, B0); PG8_MMA(0, 1, At, B1); PG8_BAR; PG8_SCHED;
            PG8_LDA(At, 1, 1); PG8_STAGE(PG8_SB(1, 0), b3, voffB); PG8_STAGE(PG8_SB(1, 1), b3 + hstep, voffB); PG8_STAGE(PG8_SA(1, 0), a3, voffA);
            PG8_WAIT_V(8); PG8_WAIT_L(0); PG8_BAR; PG8_MMA(1, 0, At, B0); PG8_MMA(1, 1, At, B1); PG8_BAR; PG8_SCHED;
            } else {
            PG8_LDB(B0, 0, 0); PG8_SCHED; PG8_LDA(At, 0, 0); PG8_STAGE(PG8_SA(1, 1), a1 + hstep, voffA);
            PG8_WAIT_L(8); PG8_BAR; PG8_WAIT_L(0); PG8_MMA(0, 0, At, B0); PG8_BAR; PG8_SCHED;
            PG8_LDB(B1, 0, 1); PG8_STAGE(PG8_SB(0, 0), b2, voffB);
            PG8_BAR; PG8_WAIT_L(0); PG8_MMA(0, 1, At, B1); PG8_BAR;
            PG8_LDA(At, 0, 1); PG8_STAGE(PG8_SA(0, 0), a2, voffA);
            PG8_BAR; PG8_WAIT_L(0); PG8_MMA(1, 0, At, B0); PG8_BAR; PG8_SCHED;
            PG8_STAGE(PG8_SB(0, 1), b2 + hstep, voffB);
            PG8_WAIT_V(6); PG8_BAR; PG8_MMA(1, 1, At, B1); PG8_BAR;
            PG8_LDB(B0, 1, 0); PG8_SCHED; PG8_LDA(At, 1, 0); PG8_STAGE(PG8_SA(0, 1), a2 + hstep, voffA);
            PG8_WAIT_L(8); PG8_BAR; PG8_WAIT_L(0); PG8_MMA(0, 0, At, B0); PG8_BAR; PG8_SCHED;
            PG8_LDB(B1, 1, 1); PG8_STAGE(PG8_SB(1, 0), b3, voffB);
            PG8_BAR; PG8_WAIT_L(0); PG8_MMA(0, 1, At, B1); PG8_BAR;
            PG8_LDA(At, 1, 1); PG8_STAGE(PG8_SA(1, 0), a3, voffA);
            PG8_BAR; PG8_WAIT_L(0); PG8_MMA(1, 0, At, B0); PG8_BAR; PG8_SCHED;
            PG8_STAGE(PG8_SB(1, 1), b3 + hstep, voffB);
            PG8_WAIT_V(6); PG8_BAR; PG8_MMA(1, 1, At, B1); PG8_BAR;
            }
        }
        if constexpr (ALIGN_EPI) { if (wr == 0) PG8_BAR; }
        if constexpr (!Epi::AFTER_DRAIN) { int t_ = g.wb + lane_now(); asm volatile("" : "+v"(t_)); const int fr_ = t_ & 15, fq_ = (t_ >> 4) & 3; if constexpr (!Sched::STREAM) E(acc, cur, wr, wc, fr_, fq_); else { if (cur.fl == 1) streamk_store(acc, cur, g.skp, g.skf, t_); else { const float* part_ = streamk_wait(cur, g.skp, g.skf, t_); int t2_ = g.wb + lane_now(); asm volatile("" : "+v"(t2_)); E(acc, cur, wr, wc, t2_ & 15, (t2_ >> 4) & 3, part_, t2_); } } S.done(cur); }
        if (!has_next) break;
#pragma unroll
        for (int a = 0; a < 2; ++a)
#pragma unroll
            for (int b = 0; b < 2; ++b)
#pragma unroll
                for (int m = 0; m < 4; ++m)
#pragma unroll
                    for (int n = 0; n < 2; ++n) acc[a][b][m][n] = (f32x4){0.f, 0.f, 0.f, 0.f};
        cur = nxt; cA = nA; cB = nB; ++ui;
        if constexpr (ALIGN_EPI) { if (wr == 1) PG8_BAR; }
    }
    PG8_WAIT_V(0);
    if constexpr (!ALIGN_EPI) { if (wr == 0) PG8_BAR; }
    PG8_BAR;
    if constexpr (Epi::AFTER_DRAIN) { E.fused(acc, cur, wr, wc, fr, fq, lds, wid, lane); S.done(cur); }
#undef PG8_SA
#undef PG8_SB
#undef PG8_STAGE
#undef PG8_LDA
#undef PG8_LDB
#undef PG8_MMA
#undef PG8_WAIT_V
#undef PG8_WAIT_L
#undef PG8_BAR
#undef PG8_SCHED
}
}

#define LAS __attribute__((address_space(3)))
typedef unsigned short bf16_t;
typedef short bf16x8 __attribute__((ext_vector_type(8)));
typedef float f32x4 __attribute__((ext_vector_type(4)));
typedef float f32x2 __attribute__((ext_vector_type(2)));
typedef float f32x16 __attribute__((ext_vector_type(16)));
typedef unsigned u32x4 __attribute__((ext_vector_type(4)));
typedef unsigned u32x2 __attribute__((ext_vector_type(2)));

constexpr int D = 1024, NH = 16, HD = 64;
constexpr int BP = 8, TP = 2064, SEQP = 2048, NMETA = 16, BS = 16, TS = 64, PAST = 4096;
constexpr int MPR = BP * TP;
constexpr int MR = MPR + BS * TS;
constexpr int MP = 17664;
constexpr int NTM = 69;
constexpr int DFF = 2752, DFFP = 2816, NIN = 5632;
constexpr float RMS_EPS = 1e-6f, GN_EPS = 64e-5f;
constexpr float LOG2E = 1.4426950408889634f;

constexpr size_t O_YP = 0, O_YS = 16777216, O_SP = 17825792, O_SHP = 18350080, O_KP = 18358272, O_VP = 35266560,
                 O_SS = 52174848, O_SHS = 53223424, O_KS = 53239808, O_VS = 54288384, O_END = 55336960;

constexpr size_t SZ_ROWBF = (size_t)MP * D * 2, SZ_ROWF = (size_t)MP * D * 4;
constexpr size_t W_X = 0;
constexpr size_t W_XN = W_X + SZ_ROWF;
constexpr size_t W_HB = W_XN + SZ_ROWBF;
constexpr size_t W_WIN = W_HB + (size_t)MP * DFFP * 2;
constexpr size_t SZ_WIN1 = (size_t)NIN * D * 2, SZ_WOUT1 = (size_t)D * DFFP * 2;
constexpr size_t W_WOUT = W_WIN + 4 * SZ_WIN1;
constexpr size_t W_WG1 = W_WOUT + 4 * SZ_WOUT1;
constexpr size_t W_WL2 = W_WG1 + (size_t)3584 * D * 2;
constexpr size_t W_WO1 = W_WL2 + (size_t)3072 * 256 * 2;
constexpr size_t W_WQKV = W_WO1 + (size_t)D * D * 2;
constexpr size_t W_WO2 = W_WQKV + (size_t)3 * D * D * 2;
constexpr size_t W_AALL = W_WO2 + (size_t)D * D * 2;
constexpr size_t W_RKV = W_AALL + 5 * SZ_ROWBF;
constexpr size_t W_L1 = W_RKV + 3 * SZ_ROWBF;
constexpr size_t W_A2 = W_L1 + (size_t)2 * MP * 256 * 4;
constexpr size_t W_DEC = W_A2 + (size_t)MP * 256 * 2;
constexpr size_t W_AA = W_DEC + SZ_ROWBF;
constexpr size_t W_GG = W_AA + SZ_ROWBF;
constexpr size_t W_SO = W_GG + SZ_ROWBF;
constexpr size_t W_OG = W_SO + SZ_ROWF;
constexpr size_t W_QB = W_OG + SZ_ROWBF;
constexpr size_t W_RSQ = W_QB + SZ_ROWBF;
constexpr size_t W_SKF = W_RSQ + (size_t)5 * MP * 4;
constexpr size_t W_SKP = W_SKF + 64 * 1024 * 4;
constexpr size_t W_BAR = W_SKP + (size_t)277 * 262144;
constexpr size_t W_END = W_BAR + 16384;

struct Params { const float* in[31]; float* out; unsigned char* ws; int ph_lo, ph_hi; int seq[64]; };
typedef const Params __attribute__((address_space(4)))* KP;

__device__ __forceinline__ unsigned cvt_pk(float lo, float hi) { unsigned r; asm("v_cvt_pk_bf16_f32 %0, %1, %2" : "=v"(r) : "v"(lo), "v"(hi)); return r; }
__device__ __forceinline__ void store_bf4(bf16_t* p, f32x4 v) { u32x2 w; w.x = cvt_pk(v[0], v[1]); w.y = cvt_pk(v[2], v[3]); *(u32x2*)p = w; }
__device__ __forceinline__ float bf_lo(unsigned w) { return __uint_as_float(w << 16); }
__device__ __forceinline__ float bf_hi(unsigned w) { return __uint_as_float(w & 0xffff0000u); }
__device__ __forceinline__ float sigmoidf_(float x) { return __builtin_amdgcn_rcpf(1.f + __expf(-x)); }
__device__ __forceinline__ float softplusf_(float x) { return fmaxf(x, 0.f) + __logf(1.f + __expf(-fabsf(x))); }
__device__ __forceinline__ float shx(float v, int o, int lane) { return __builtin_bit_cast(float, __builtin_amdgcn_ds_bpermute((lane ^ o) << 2, __builtin_bit_cast(int, v))); }
__device__ __forceinline__ float wave_sum(float v, int lane) {
#pragma unroll
    for (int o = 1; o < 64; o <<= 1) v += shx(v, o, lane);
    return v;
}
__device__ __forceinline__ void row_bt(int row, int& grp, int& b, int& t) { if (row < MPR) { grp = 0; b = row / TP; t = row - b * TP; } else { grp = 1; const int r = row - MPR; b = r >> 6; t = r & 63; } }

using pg8::Unit;
extern __shared__ __attribute__((aligned(16))) unsigned char lds_raw[];
struct EpiSwiGLU {
    static constexpr bool PERM = true, AFTER_DRAIN = false;
    bf16_t* HB; const float* rsq;
    __device__ __forceinline__ void operator()(const f32x4 (&acc)[2][2][4][2], const Unit& u, int wr, int wc, int fr, int fq) const {
        const int row0 = u.pm * 256 + wr * 64 + fr, col0 = u.pn * 128 + wc * 32 + 8 * fq;
#pragma unroll
        for (int ai = 0; ai < 2; ++ai)
#pragma unroll
            for (int m = 0; m < 4; ++m) {
                bf16_t* rowp = HB + (size_t)(row0 + ai * 128 + m * 16) * DFFP + col0;
                const float rs = __builtin_amdgcn_rsqf(rsq[row0 + ai * 128 + m * 16] * (1.f / D) + RMS_EPS);
                float hv[8];
#pragma unroll
                for (int n = 0; n < 2; ++n)
#pragma unroll
                    for (int j = 0; j < 4; ++j) { const float g = acc[ai][0][m][n][j] * rs, up = acc[ai][1][m][n][j] * rs; hv[n * 4 + j] = g * sigmoidf_(g) * up; }
                u32x4 w; w.x = cvt_pk(hv[0], hv[1]); w.y = cvt_pk(hv[2], hv[3]); w.z = cvt_pk(hv[4], hv[5]); w.w = cvt_pk(hv[6], hv[7]);
                *(u32x4*)rowp = w;
            }
    }
};
struct EpiRes {
    static constexpr bool PERM = false, AFTER_DRAIN = false;
    float* X; float scale; float* out; bf16_t* XB; float* rsq; float* spl;
    __device__ __forceinline__ void operator()(const f32x4 (&acc)[2][2][4][2], const Unit& u, int wr, int wc, int fr, int fq, const float* part = nullptr, int tid = 0) const {
        const bool hasp = u.fl == 2;
        if (u.fl == 1 && spl != nullptr) {
            const int t_ = (wr * 4 + wc) * 64 + fq * 16 + fr;
            f32x4* q = (f32x4*)(spl + (size_t)u.tl * 65536) + t_;
#pragma unroll
            for (int ai = 0; ai < 2; ++ai)
#pragma unroll
                for (int bj = 0; bj < 2; ++bj)
#pragma unroll
                    for (int m = 0; m < 4; ++m)
#pragma unroll
                        for (int n = 0; n < 2; ++n) q[(((ai * 2 + bj) * 4 + m) * 2 + n) * 512] = acc[ai][bj][m][n];
            return;
        }
        float* const X_ = X; float* const out_ = out; bf16_t* const XB_ = XB; float* const rsq_ = rsq; const float sc_ = scale;
        const int row0 = u.pm * 256 + wr * 64 + fr, col0 = u.pn * 256 + wc * 32 + 4 * fq, ln = fq * 16 + fr;
#pragma unroll
        for (int ai = 0; ai < 2; ++ai)
#pragma unroll
            for (int m = 0; m < 4; ++m) {
                const int row = row0 + ai * 128 + m * 16;
                const unsigned off = (unsigned)row * D + col0;
                if (out_ == nullptr) {
                    float ss = 0.f;
#pragma unroll
                    for (int bj = 0; bj < 2; ++bj)
#pragma unroll
                        for (int n = 0; n < 2; ++n) { f32x4* q = (f32x4*)(X_ + off + bj * 128 + n * 16); f32x4 av = acc[ai][bj][m][n]; if (hasp) av += pg8::streamk_part(part, ((ai * 2 + bj) * 4 + m) * 2 + n, tid); const f32x4 x = *q + av * sc_; *q = x;
                            if (XB_) { store_bf4(XB_ + off + bj * 128 + n * 16, x); ss += (x[0] * x[0] + x[1] * x[1]) + (x[2] * x[2] + x[3] * x[3]); } }
                    if (XB_) { ss += shx(ss, 16, ln); ss += shx(ss, 32, ln); if (fq == 0) unsafeAtomicAdd(rsq_ + row, ss); }
                } else if (row < MR) {
                    float* dp = nullptr;
                    if (row < MPR) { const int b = row / TP, t = row - b * TP; if (t >= NMETA) dp = out_ + O_YP + ((size_t)b * SEQP + (t - NMETA)) * D + col0; }
                    else dp = out_ + O_YS + (size_t)(row - MPR) * D + col0;
                    if (dp) {
#pragma unroll
                        for (int bj = 0; bj < 2; ++bj)
#pragma unroll
                            for (int n = 0; n < 2; ++n) { f32x4 av = acc[ai][bj][m][n]; if (hasp) av += pg8::streamk_part(part, ((ai * 2 + bj) * 4 + m) * 2 + n, tid); *(f32x4*)(dp + bj * 128 + n * 16) = *(const f32x4*)(X_ + off + bj * 128 + n * 16) + av * sc_; }
                    }
                }
                asm volatile("" ::: "memory");
            }
    }
};
struct G2Order {
    static constexpr bool STREAM = false;
    pg8::StaticOrder so;
    __device__ void init(int G, int c) { so.init(MP, 3072, G, c); so.nt0 = 2; }
    __device__ bool next(int i, Unit& u) const { if (!so.next(i, u)) return false; u.kb = (u.pn >> 2) * 128; return true; }
    __device__ __forceinline__ void a_ready(const Unit&) const {}
    __device__ __forceinline__ void done(const Unit&) const {}
};
struct TailSplitOrder {
    static constexpr bool STREAM = false;
    pg8::StaticOrder so; int G, c, ns, ntsplit;
    __device__ void init(int M, int N, int K, int G_, int c_, int ns_) { so.init(M, N, 1, 0); so.nt0 = K / 64; G = G_; c = c_; ns = ns_; ntsplit = so.nt0 / ns_; }
    __device__ bool next(int i, Unit& u) const {
        const int L = i * G + c;
        if (L < G && L < so.nwg) return so.next(L, u);
        const int L2 = L - G; if (so.nwg <= G || L2 < 0 || L2 >= (so.nwg - G) * ns) return false;
        const int j = L2 / ns, ch = L2 - j * ns;
        so.next(G + j, u); u.kb = ch * ntsplit * 128; u.nt = ntsplit; u.fl = 1; u.tl = L2; return true;
    }
    __device__ __forceinline__ void a_ready(const Unit&) const {}
    __device__ __forceinline__ void done(const Unit&) const {}
};
struct StreamOrder {
    static constexpr bool STREAM = true;
    int nN, ppt, c; long s, e;
    __device__ void init(int M, int N, int K, int G, int c_) {
        nN = N / 256; ppt = K / 128;
        c = (G % 8 == 0) ? (c_ % 8) * (G / 8) + c_ / 8 : c_;
        const long P = (long)(M / 256) * nN * ppt;
        s = (long)c * P / G; e = (long)(c + 1) * P / G;
    }
    __device__ bool next(int i, Unit& u) const {
        const int t = (int)(s / ppt) + i; const long t0 = (long)t * ppt;
        if (t0 >= e) return false;
        const long lo = s > t0 ? s : t0, hi = e < t0 + ppt ? e : t0 + ppt;
        u.pm = t / nN; u.pn = t - u.pm * nN; u.tl = t;
        u.kb = (int)(lo - t0) * 256; u.nt = (int)(hi - lo) * 2;
        u.fl = lo > t0 ? 1 : (hi < t0 + ppt ? 2 : 0);
        return true;
    }
    __device__ __forceinline__ void a_ready(const Unit&) const {}
    __device__ __forceinline__ void done(const Unit&) const {}
};
struct EpiG1 {
    static constexpr bool PERM = true, AFTER_DRAIN = false;
    bf16_t* RKV; float* L1;
    __device__ __forceinline__ void operator()(const f32x4 (&acc)[2][2][4][2], const Unit& u, int wr, int wc, int fr, int fq) const {
        const unsigned row0 = (unsigned)((u.pm % NTM) * 256 + wr * 64 + fr), cw = wc * 32 + 8 * fq;
        if (u.pn < 12) {
            bf16_t* base = RKV + (size_t)(u.pn >> 2) * MP * D;
            const unsigned off0 = row0 * D + (u.pn & 3) * 256 + cw;
#pragma unroll
            for (int ai = 0; ai < 2; ++ai)
#pragma unroll
                for (int m = 0; m < 4; ++m)
#pragma unroll
                    for (int bj = 0; bj < 2; ++bj) { const f32x4 v0 = acc[ai][bj][m][0], v1 = acc[ai][bj][m][1];
                        u32x4 w; w.x = cvt_pk(v0[0], v0[1]); w.y = cvt_pk(v0[2], v0[3]); w.z = cvt_pk(v1[0], v1[1]); w.w = cvt_pk(v1[2], v1[3]);
                        *(u32x4*)(base + (off0 + (unsigned)((ai * 128 + m * 16) * D + bj * 128))) = w; }
        } else {
            float* base = L1 + (size_t)(u.pn - 12) * MP * 256;
            const unsigned off0 = row0 * 256 + cw;
#pragma unroll
            for (int ai = 0; ai < 2; ++ai)
#pragma unroll
                for (int m = 0; m < 4; ++m)
#pragma unroll
                    for (int bj = 0; bj < 2; ++bj)
#pragma unroll
                        for (int n = 0; n < 2; ++n) *(f32x4*)(base + (off0 + (unsigned)((ai * 128 + m * 16) * 256 + bj * 128 + n * 4))) = acc[ai][bj][m][n];
        }
    }
};
struct EpiG2 {
    static constexpr bool PERM = true, AFTER_DRAIN = false;
    bf16_t* LW;
    __device__ __forceinline__ void operator()(const f32x4 (&acc)[2][2][4][2], const Unit& u, int wr, int wc, int fr, int fq) const {
        bf16_t* base = LW + (size_t)(u.pn >> 2) * MP * D;
        const unsigned off0 = (unsigned)(u.pm * 256 + wr * 64 + fr) * D + (u.pn & 3) * 256 + wc * 32 + 8 * fq;
#pragma unroll
        for (int ai = 0; ai < 2; ++ai)
#pragma unroll
            for (int m = 0; m < 4; ++m)
#pragma unroll
                for (int bj = 0; bj < 2; ++bj) { const f32x4 v0 = acc[ai][bj][m][0], v1 = acc[ai][bj][m][1];
                    u32x4 w; w.x = cvt_pk(v0[0], v0[1]); w.y = cvt_pk(v0[2], v0[3]); w.z = cvt_pk(v1[0], v1[1]); w.w = cvt_pk(v1[2], v1[3]);
                    *(u32x4*)(base + (off0 + (unsigned)((ai * 128 + m * 16) * D + bj * 128))) = w; }
    }
};
struct EpiQKV {
    static constexpr bool PERM = false, AFTER_DRAIN = false;
    bf16_t* QB; float* out; const float* qg; const float* kg; const float* rsq;
    __device__ __forceinline__ void operator()(const f32x4 (&acc)[2][2][4][2], const Unit& u, int wr, int wc, int fr, int fq) const {
        const int sec = u.pn >> 2, head = (u.pn & 3) * 4 + wc, row0 = u.pm * 256 + wr * 64 + fr;
        f32x4 gn[2][2];
#pragma unroll
        for (int bj = 0; bj < 2; ++bj)
#pragma unroll
            for (int n = 0; n < 2; ++n) { const int d = 32 * bj + 16 * n + 4 * fq;
                gn[bj][n] = sec == 0 ? *(const f32x4*)(qg + d) * 0.125f : (sec == 1 ? *(const f32x4*)(kg + d) : (f32x4){1.f, 1.f, 1.f, 1.f}); }
#pragma unroll
        for (int ai = 0; ai < 2; ++ai)
#pragma unroll
            for (int m = 0; m < 4; ++m) {
                const int row = row0 + ai * 128 + m * 16;
                const float rx = __builtin_amdgcn_rsqf(rsq[row] * (1.f / D) + RMS_EPS);
                float ss = 0.f;
#pragma unroll
                for (int bj = 0; bj < 2; ++bj)
#pragma unroll
                    for (int n = 0; n < 2; ++n) { const f32x4 x = acc[ai][bj][m][n]; ss += (x[0] * x[0] + x[1] * x[1]) + (x[2] * x[2] + x[3] * x[3]); }
                { const int ln = fq * 16 + fr; ss += shx(ss, 16, ln); ss += shx(ss, 32, ln); }
                const float rs = rx * (sec == 2 ? 1.f : __builtin_amdgcn_rsqf(ss * rx * rx * (1.f / 64.f) + RMS_EPS));
                if (row < MR) {
                    if (sec == 0) {
                        bf16_t* qp = QB + (size_t)row * D + head * 64 + 4 * fq;
#pragma unroll
                        for (int bj = 0; bj < 2; ++bj)
#pragma unroll
                            for (int n = 0; n < 2; ++n) { const f32x4 x = acc[ai][bj][m][n] * rs * gn[bj][n]; u32x2 w; w.x = cvt_pk(x[0], x[1]); w.y = cvt_pk(x[2], x[3]); *(u32x2*)(qp + 32 * bj + 16 * n) = w; }
                    } else {
                        int grp, b, t; row_bt(row, grp, b, t);
                        float* dp = grp == 0 ? out + (sec == 1 ? O_KP : O_VP) + (((size_t)b * NH + head) * TP + t) * HD
                                             : out + (sec == 1 ? O_KS : O_VS) + (((size_t)b * NH + head) * TS + t) * HD;
                        dp += 4 * fq;
#pragma unroll
                        for (int bj = 0; bj < 2; ++bj)
#pragma unroll
                            for (int n = 0; n < 2; ++n) *(f32x4*)(dp + 32 * bj + 16 * n) = acc[ai][bj][m][n] * rs * gn[bj][n];
                    }
                }
            }
    }
};
struct G1Order {
    static constexpr bool STREAM = false;
    int G, c;
    __device__ bool next(int i, Unit& u) const {
        const long L = (long)i * G + c; if (L >= 966) return false;
        int w = (int)L; { const int q = 966 / 8, r = 966 % 8, xcd = w % 8, off = w / 8; w = (xcd < r ? xcd * (q + 1) : r * (q + 1) + (xcd - r) * q) + off; }
        const int pm = w / 14, q = w % 14;
        if (q < 12) { u.pm = (q >> 2) * NTM + pm; u.pn = q; } else { u.pm = (q - 9) * NTM + pm; u.pn = q; }
        u.kb = 0; u.nt = 16; u.fl = 0; u.tl = 0;
        return true;
    }
    __device__ __forceinline__ void a_ready(const Unit&) const {}
    __device__ __forceinline__ void done(const Unit&) const {}
};

struct Job { const float* src; bf16_t* dst; const float* mu; int ld, Ksrc, koff, Kdst, rows, map, smode; };
__device__ __forceinline__ int srccol(int map, int n, int ld) {
    if (map == 0) return n < ld ? n : -1;
    if (map == 1) { const int pn = n >> 8, c = n & 255, bj = c >> 7, j = c & 127, hc = pn * 128 + j; return hc < DFF ? (bj ? DFF + hc : hc) : -1; }
    { const int t = n >> 8, c = n & 255, bj = c >> 7, wc = (c & 127) >> 5, i = c & 31; return t * 256 + 64 * wc + 32 * bj + i; }
}
__device__ __forceinline__ Job get_job(KP p, int j) {
    Job J; J.mu = nullptr; J.koff = 0; J.map = 0; J.smode = 0;
    unsigned char* ws = p->ws;
    if (j < 4) { J.src = p->in[8] + (size_t)j * D * 2 * DFF; J.dst = (bf16_t*)(ws + W_WIN + j * SZ_WIN1); J.ld = 2 * DFF; J.Ksrc = D; J.Kdst = D; J.rows = NIN; J.map = 1; J.mu = p->in[7] + (size_t)j * D; J.smode = 2; }
    else if (j < 8) { const int i = j - 4; J.src = p->in[9] + (size_t)i * DFF * D; J.dst = (bf16_t*)(ws + W_WOUT + i * SZ_WOUT1); J.ld = D; J.Ksrc = DFF; J.Kdst = DFFP; J.rows = D; }
    else if (j < 11) { const int g = j - 8; J.src = p->in[12] + (size_t)g * D * D; J.dst = (bf16_t*)(ws + W_WG1) + (size_t)g * D * D; J.ld = D; J.Ksrc = D; J.Kdst = D; J.rows = D; }
    else if (j < 17) { const int idx = j - 11, part = idx / 3, which = idx % 3;
        J.src = which == 0 ? p->in[14] : (which == 1 ? p->in[17] : p->in[19]); J.ld = which == 2 ? 128 : 64; J.rows = J.ld;
        J.mu = p->in[11] + (which == 0 ? 1 : (which == 1 ? 4 : 5)) * D; J.smode = part + 1;
        J.dst = (bf16_t*)(ws + W_WG1) + (size_t)(3072 + part * 256 + which * 64) * D; J.Ksrc = D; J.Kdst = D; }
    else if (j < 20) { const int which = j - 17; J.src = which == 0 ? p->in[15] : (which == 1 ? p->in[18] : p->in[20]); J.ld = D; J.rows = D;
        J.Ksrc = which == 2 ? 128 : 64; J.koff = which * 64; J.Kdst = 256; J.dst = (bf16_t*)(ws + W_WL2) + (size_t)which * D * 256; }
    else if (j == 20) { J.src = p->in[26]; J.dst = (bf16_t*)(ws + W_WO1); J.ld = D; J.Ksrc = D; J.Kdst = D; J.rows = D; }
    else if (j == 21) { J.src = p->in[27]; J.dst = (bf16_t*)(ws + W_WQKV); J.ld = 3 * D; J.Ksrc = D; J.Kdst = D; J.rows = 3 * D; J.map = 2; J.mu = p->in[10] + D; J.smode = 2; }
    else { J.src = p->in[30]; J.dst = (bf16_t*)(ws + W_WO2); J.ld = D; J.Ksrc = D; J.Kdst = D; J.rows = D; }
    return J;
}
__device__ __forceinline__ void convert_weights(KP p, LAS float* tl, int tid, int bid, int G) {
    int rot = 0;
    for (int j = 0; j < 23; ++j) {
        const Job J = get_job(p, j);
        const int nkt = J.Kdst >> 6, nnt = (J.rows + 255) >> 8, ntile = nnt * nkt;
        int first = bid - rot; if (first < 0) first += G;
        for (int t = first; t < ntile; t += G) {
            const int n0 = (t / nkt) << 8, k0 = (t % nkt) << 6;
            const bool inside = k0 >= J.koff && k0 < J.koff + J.Ksrc;
            if (inside) {
                const int nn = tid & 255, kh = tid >> 8;
                const int sc = (n0 + nn) < J.rows ? srccol(J.map, n0 + nn, J.ld) : -1;
                const float* sp = J.src + (size_t)(k0 - J.koff + kh) * J.ld + (sc >= 0 ? sc : 0);
                float v[32];
#pragma unroll
                for (int it = 0; it < 32; ++it) v[it] = sc >= 0 ? sp[(size_t)(2 * it) * J.ld] : 0.f;
                if (J.smode) {
#pragma unroll
                    for (int it = 0; it < 32; ++it) { const float m = J.mu[k0 - J.koff + kh + 2 * it]; v[it] *= J.smode == 1 ? 1.f - m : m; }
                }
#pragma unroll
                for (int it = 0; it < 32; ++it) tl[(kh + 2 * it) * 257 + nn] = v[it];
            }
            __syncthreads();
            {
                const int nn = tid >> 1, kh = (tid & 1) * 32;
                if (n0 + nn < J.rows) {
                    bf16_t* dp = J.dst + (size_t)(n0 + nn) * J.Kdst + k0 + kh;
#pragma unroll
                    for (int q = 0; q < 4; ++q) {
                        const unsigned z_ = (unsigned)tid >> 31;
                        u32x4 w = (u32x4){z_, z_, z_, z_};
                        if (inside) { float v[8];
#pragma unroll
                            for (int e = 0; e < 8; ++e) v[e] = tl[(kh + q * 8 + e) * 257 + nn];
                            w.x = cvt_pk(v[0], v[1]); w.y = cvt_pk(v[2], v[3]); w.z = cvt_pk(v[4], v[5]); w.w = cvt_pk(v[6], v[7]); }
                        *(u32x4*)(dp + q * 8) = w;
                    }
                }
            }
            __syncthreads();
        }
        rot = (rot + ntile) % G;
    }
}
__device__ __forceinline__ float row_rstd(const f32x4 (&v)[4], int lane) {
    float s = 0.f;
#pragma unroll
    for (int i = 0; i < 4; ++i) s += (v[i][0] * v[i][0] + v[i][1] * v[i][1]) + (v[i][2] * v[i][2] + v[i][3] * v[i][3]);
    s = wave_sum(s, lane);
    return __builtin_amdgcn_rsqf(s * (1.f / D) + RMS_EPS);
}

__device__ __forceinline__ void assemble_x(KP p, int tid, int bid, int G) {
    const int lane = tid & 63, gw = bid * 8 + (tid >> 6), nw = G * 8;
    float* X = (float*)(p->ws + W_X); bf16_t* XN = (bf16_t*)(p->ws + W_XN);
    for (int row = gw; row < MP; row += nw) {
        f32x4 v[4];
        const float* src = nullptr;
        if (row < MPR) { const int b = row / TP, t = row - b * TP; src = t < NMETA ? p->in[6] + (size_t)t * D : p->in[0] + ((size_t)b * SEQP + (t - NMETA)) * D; }
        else if (row < MR) src = p->in[1] + (size_t)(row - MPR) * D;
#pragma unroll
        for (int i = 0; i < 4; ++i) { const float zf = __uint_as_float((unsigned)tid >> 31); v[i] = src ? *(const f32x4*)(src + lane * 4 + 256 * i) : (f32x4){zf, zf, zf, zf}; }
        float ssq = 0.f;
#pragma unroll
        for (int i = 0; i < 4; ++i) ssq += (v[i][0] * v[i][0] + v[i][1] * v[i][1]) + (v[i][2] * v[i][2] + v[i][3] * v[i][3]);
        ssq = wave_sum(ssq, lane);
#pragma unroll
        for (int i = 0; i < 4; ++i) { const int c = lane * 4 + 256 * i; *(f32x4*)(X + (size_t)row * D + c) = v[i]; store_bf4(XN + (size_t)row * D + c, v[i]); }
        float* rsq = (float*)(p->ws + W_RSQ);
        if (lane < 5) rsq[(size_t)lane * MP + row] = lane == 0 ? ssq : 0.f;
    }    for (int i = gw * 64 + lane; i < 64 * 1024; i += nw * 64) ((unsigned*)(p->ws + W_SKF))[i] = 0u;
    for (int i = gw * 64 + lane; i < 65536; i += nw * 64) ((float*)(p->ws + W_SKP) + (size_t)276 * 65536)[i] = 0.f;
}
__device__ __forceinline__ void norm_phase(KP p, const float* g, int tid, int bid, int G, bool copy_y = false) {
    const int lane = tid & 63, gw = bid * 8 + (tid >> 6), nw = G * 8;
    const float* X = (const float*)(p->ws + W_X); bf16_t* XN = (bf16_t*)(p->ws + W_XN);
    for (int row = gw; row < MP; row += nw) {
        f32x4 v[4];
#pragma unroll
        for (int i = 0; i < 4; ++i) v[i] = *(const f32x4*)(X + (size_t)row * D + lane * 4 + 256 * i);
        const float rs = row_rstd(v, lane);
#pragma unroll
        for (int i = 0; i < 4; ++i) { const int c = lane * 4 + 256 * i; store_bf4(XN + (size_t)row * D + c, v[i] * rs * *(const f32x4*)(g + c)); }
        if (copy_y && row < MR) {
            float* dp = nullptr;
            if (row < MPR) { const int b = row / TP, t = row - b * TP; if (t >= NMETA) dp = p->out + O_YP + ((size_t)b * SEQP + (t - NMETA)) * D; }
            else dp = p->out + O_YS + (size_t)(row - MPR) * D;
            if (dp) {
#pragma unroll
                for (int i = 0; i < 4; ++i) *(f32x4*)(dp + lane * 4 + 256 * i) = v[i];
            }
        }
    }
}
__device__ __forceinline__ void mixprep_phase(KP p, int tid, int bid, int G) {
    const int lane = tid & 63, gw = bid * 8 + (tid >> 6), nw = G * 8;
    const float* X = (const float*)(p->ws + W_X); bf16_t* A = (bf16_t*)(p->ws + W_AALL);
    const float* g = p->in[10]; const float* mu = p->in[11];
    const int rb = (MR + nw - 1) / nw;
    f32x4 hl[4];
    for (int row = gw * rb, k = 0; k < rb && row < MR; ++row, ++k) {
        int grp, b, t; row_bt(row, grp, b, t);
        f32x4 v[4], pv[4];
#pragma unroll
        for (int i = 0; i < 4; ++i) v[i] = *(const f32x4*)(X + (size_t)row * D + lane * 4 + 256 * i);
        const float rs = row_rstd(v, lane);
        if (t > 0) {
            if (k == 0) {
#pragma unroll
                for (int i = 0; i < 4; ++i) pv[i] = *(const f32x4*)(X + (size_t)(row - 1) * D + lane * 4 + 256 * i);
                const float rp = row_rstd(pv, lane);
#pragma unroll
                for (int i = 0; i < 4; ++i) pv[i] = pv[i] * rp * *(const f32x4*)(g + lane * 4 + 256 * i);
            } else {
#pragma unroll
                for (int i = 0; i < 4; ++i) pv[i] = hl[i];
            }
        } else {
#pragma unroll
            for (int i = 0; i < 4; ++i) { const float zf = __uint_as_float((unsigned)tid >> 31); pv[i] = grp == 0 ? (f32x4){zf, zf, zf, zf} : *(const f32x4*)(p->in[3] + (size_t)b * D + lane * 4 + 256 * i); }
        }
        const bool last = t == (grp == 0 ? TP - 1 : TS - 1);
        float* sh = grp == 0 ? p->out + O_SHP + (size_t)b * D : p->out + O_SHS + (size_t)b * D;
#pragma unroll
        for (int i = 0; i < 4; ++i) {
            const int c = lane * 4 + 256 * i; const size_t o = (size_t)row * D + c;
            const f32x4 h = v[i] * rs * *(const f32x4*)(g + c), dx = pv[i] - h;
            store_bf4(A + o, h + dx * *(const f32x4*)(mu + c));
            store_bf4(A + (size_t)MP * D + o, h + dx * *(const f32x4*)(mu + 2 * D + c));
            store_bf4(A + (size_t)2 * MP * D + o, h + dx * *(const f32x4*)(mu + 3 * D + c));
            store_bf4(A + (size_t)3 * MP * D + o, h);
            store_bf4(A + (size_t)4 * MP * D + o, pv[i]);
            if (last) *(f32x4*)(sh + c) = h;
            hl[i] = h;
        }
    }
}
__device__ __forceinline__ void act_phase(KP p, int gtid, int nthr) {
    const float* L1 = (const float*)(p->ws + W_L1); bf16_t* A2 = (bf16_t*)(p->ws + W_A2);
    for (int i = gtid; i < MP * 64; i += nthr) {
        const int c = (i & 63) * 4;
        f32x4 v = *(const f32x4*)(L1 + (size_t)i * 4) + *(const f32x4*)(L1 + (size_t)MP * 256 + (size_t)i * 4);
        if (c < 64) {
#pragma unroll
            for (int j = 0; j < 4; ++j) v[j] = 1.f - 2.f * __builtin_amdgcn_rcpf(1.f + __expf(2.f * v[j]));
        } else if (c >= 128) {
#pragma unroll
            for (int j = 0; j < 4; ++j) v[j] = sigmoidf_(v[j]);
        }
        store_bf4(A2 + (size_t)i * 4, v);
    }
}

__device__ __forceinline__ float dpp_sum16(float x) {
    x += __builtin_bit_cast(float, __builtin_amdgcn_update_dpp(0, __builtin_bit_cast(int, x), 0xB1, 0xF, 0xF, true));
    x += __builtin_bit_cast(float, __builtin_amdgcn_update_dpp(0, __builtin_bit_cast(int, x), 0x4E, 0xF, 0xF, true));
    x += __builtin_bit_cast(float, __builtin_amdgcn_update_dpp(0, __builtin_bit_cast(int, x), 0x141, 0xF, 0xF, true));
    x += __builtin_bit_cast(float, __builtin_amdgcn_update_dpp(0, __builtin_bit_cast(int, x), 0x140, 0xF, 0xF, true));
    return x;
}
constexpr int SC_CH = 16, SC_STR = 400;
__device__ __forceinline__ void scan_phase(KP p, LAS float* buf, int tid, int bid, int G) {
    const int wid = tid >> 6, lane = tid & 63;
    const bf16_t* RKV = (const bf16_t*)(p->ws + W_RKV); const bf16_t* DEC = (const bf16_t*)(p->ws + W_DEC); const bf16_t* AA = (const bf16_t*)(p->ws + W_AA);
    bf16_t* SO = (bf16_t*)(p->ws + W_SO);
    const bool producer = wid >= 4;
    for (int u = bid; u < 768; u += G) {
        int bh, half, T, row0; const float* S0; float* Sout;
        if (u < 256) { bh = u >> 1; half = u & 1; T = TP; row0 = (bh >> 4) * TP; S0 = nullptr; Sout = p->out + O_SP + (size_t)bh * 4096; }
        else { const int v = u - 256; bh = v >> 1; half = v & 1; T = TS; row0 = MPR + (bh >> 4) * TS; S0 = p->in[2] + (size_t)bh * 4096; Sout = p->out + O_SS + (size_t)bh * 4096; }
        const int h = bh & 15, nchunk = T / SC_CH;
        if (producer) {
            const int t2 = tid - 256, pi = t2 >> 4, pj = t2 & 15, kc = h * 64 + 4 * pj;
            const f32x4 kkv = *(const f32x4*)(p->in[21] + kc), kav = *(const f32x4*)(p->in[22] + kc), w0v = *(const f32x4*)(p->in[13] + kc), a0v = *(const f32x4*)(p->in[16] + kc);
            u32x2 pr, pk, pvv, pa, pd;
#define SC_LOAD(c) do { const size_t o = (size_t)(row0 + (c) * SC_CH + pi) * D + kc; pr = *(const u32x2*)(RKV + o); pk = *(const u32x2*)(RKV + (size_t)MP * D + o); \
            pvv = *(const u32x2*)(RKV + (size_t)2 * MP * D + o); pa = *(const u32x2*)(AA + o); pd = *(const u32x2*)(DEC + o); } while (0)
#define SC_STORE(bi) do { LAS float* rec = buf + (bi) * (SC_CH * SC_STR) + pi * SC_STR; \
            const f32x4 r = (f32x4){bf_lo(pr.x), bf_hi(pr.x), bf_lo(pr.y), bf_hi(pr.y)}, k = (f32x4){bf_lo(pk.x), bf_hi(pk.x), bf_lo(pk.y), bf_hi(pk.y)}; \
            const f32x4 v = (f32x4){bf_lo(pvv.x), bf_hi(pvv.x), bf_lo(pvv.y), bf_hi(pvv.y)}; \
            f32x4 a = (f32x4){bf_lo(pa.x), bf_hi(pa.x), bf_lo(pa.y), bf_hi(pa.y)} + a0v; f32x4 w = (f32x4){bf_lo(pd.x), bf_hi(pd.x), bf_lo(pd.y), bf_hi(pd.y)} + w0v; \
            _Pragma("unroll") for (int j = 0; j < 4; ++j) { a[j] = sigmoidf_(a[j]); w[j] = __expf(-__expf(-softplusf_(-w[j]) - 0.5f)); } \
            const f32x4 q = k * kkv; float ss = (q[0] * q[0] + q[1] * q[1]) + (q[2] * q[2] + q[3] * q[3]); ss = dpp_sum16(ss); \
            const float inv = 1.f / fmaxf(sqrtf(ss), 1e-12f); const f32x4 nk = q * inv; \
            const f32x4 kp = k * (1.f + (a - 1.f) * kav), bb = nk * a; \
            float br = (bb[0] * r[0] + bb[1] * r[1]) + (bb[2] * r[2] + bb[3] * r[3]), kr = (kp[0] * r[0] + kp[1] * r[1]) + (kp[2] * r[2] + kp[3] * r[3]); \
            br = dpp_sum16(br); kr = dpp_sum16(kr); \
            *(LAS f32x4*)(rec + 4 * pj) = w; *(LAS f32x4*)(rec + 64 + 4 * pj) = nk; *(LAS f32x4*)(rec + 128 + 4 * pj) = bb; \
            *(LAS f32x4*)(rec + 192 + 4 * pj) = kp; *(LAS f32x4*)(rec + 256 + 4 * pj) = w * r; *(LAS f32x4*)(rec + 320 + 4 * pj) = v; \
            if (pj == 0) *(LAS f32x2*)(rec + 384) = (f32x2){br, kr}; } while (0)
            SC_LOAD(0); SC_STORE(0);
            if (nchunk > 1) SC_LOAD(1);
            __syncthreads();
            for (int c = 0; c < nchunk; ++c) {
                if (c + 1 < nchunk) { SC_STORE((c + 1) & 1); if (c + 2 < nchunk) SC_LOAD(c + 2); }
                __syncthreads();
            }
#undef SC_LOAD
#undef SC_STORE
        } else {
            const int rp = lane >> 4, kq = lane & 15, vA = half * 32 + wid * 8 + rp * 2;
            f32x4 sA = (f32x4){0.f, 0.f, 0.f, 0.f}, sB = sA;
            if (S0) { sA = *(const f32x4*)(S0 + vA * 64 + kq * 4); sB = *(const f32x4*)(S0 + (vA + 1) * 64 + kq * 4); }
            bf16_t* op = SO + (size_t)(row0 + kq) * D + h * 64 + vA;
            __syncthreads();
            for (int c = 0; c < nchunk; ++c) {
                const LAS float* cb = buf + (c & 1) * (SC_CH * SC_STR);
                float oA = 0.f, oB = 0.f;
#pragma unroll
                for (int i = 0; i < SC_CH; ++i) {
                    const LAS float* rec = cb + i * SC_STR;
                    const f32x4 wd = *(const LAS f32x4*)(rec + kq * 4), kk = *(const LAS f32x4*)(rec + 64 + kq * 4), bb = *(const LAS f32x4*)(rec + 128 + kq * 4),
                                kp = *(const LAS f32x4*)(rec + 192 + kq * 4), wr = *(const LAS f32x4*)(rec + 256 + kq * 4);
                    const f32x2 vv = *(const LAS f32x2*)(rec + 320 + vA), sc = *(const LAS f32x2*)(rec + 384);
                    const f32x2 t1A = sA.hi * kk.hi + sA.lo * kk.lo, t1B = sB.hi * kk.hi + sB.lo * kk.lo, t2A = sA.hi * wr.hi + sA.lo * wr.lo, t2B = sB.hi * wr.hi + sB.lo * wr.lo;
                    float d1A = t1A.x + t1A.y, d1B = t1B.x + t1B.y, d2A = t2A.x + t2A.y, d2B = t2B.x + t2B.y;
#define DPPR(ctl) "v_add_f32_dpp %0, %0, %0 " ctl " row_mask:0xf bank_mask:0xf bound_ctrl:1\n\tv_add_f32_dpp %1, %1, %1 " ctl " row_mask:0xf bank_mask:0xf bound_ctrl:1\n\t" \
                  "v_add_f32_dpp %2, %2, %2 " ctl " row_mask:0xf bank_mask:0xf bound_ctrl:1\n\tv_add_f32_dpp %3, %3, %3 " ctl " row_mask:0xf bank_mask:0xf bound_ctrl:1\n\t"
                    asm("s_nop 1\n\t" DPPR("quad_perm:[1,0,3,2]") DPPR("quad_perm:[2,3,0,1]") DPPR("row_half_mirror") DPPR("row_mirror") : "+v"(d1A), "+v"(d1B), "+v"(d2A), "+v"(d2B));
#undef DPPR
                    const float saA = -d1A, saB = -d1B;
                    const float tA = d2A + saA * sc.x + vv.x * sc.y, tB = d2B + saB * sc.x + vv.y * sc.y;
                    sA = sA * wd + bb * saA + kp * vv.x;
                    sB = sB * wd + bb * saB + kp * vv.y;
                    oA = kq == i ? tA : oA; oB = kq == i ? tB : oB;
                }
                *(unsigned*)(op + (size_t)c * SC_CH * D) = cvt_pk(oA, oB);
                __syncthreads();
            }
            *(f32x4*)(Sout + vA * 64 + kq * 4) = sA; *(f32x4*)(Sout + (vA + 1) * 64 + kq * 4) = sB;
        }
    }
}
__device__ __forceinline__ void post_phase(KP p, int tid, int bid, int G) {
    const int lane = tid & 63, gw = bid * 8 + (tid >> 6), nw = G * 8;
    const bf16_t* RKV = (const bf16_t*)(p->ws + W_RKV); const bf16_t* AA = (const bf16_t*)(p->ws + W_AA); const bf16_t* GG = (const bf16_t*)(p->ws + W_GG);
    const bf16_t* SO = (const bf16_t*)(p->ws + W_SO); bf16_t* OG = (bf16_t*)(p->ws + W_OG);
    const float* k_a = p->in[22]; const float* a0p = p->in[16]; const float* r_k = p->in[23]; const float* gnw = p->in[24]; const float* gnb = p->in[25];
    const int c0 = lane * 16;
    for (int row = gw; row < MR; row += nw) {
        const size_t o = (size_t)row * D + c0;
        float ov[16], rv[16], kv[16], vv[16], av[16], gv[16];
#pragma unroll
#define LD16(dst, ptr) do { const u32x4 a_ = *(const u32x4*)(ptr), b_ = *(const u32x4*)((ptr) + 8); \
        dst[0] = bf_lo(a_.x); dst[1] = bf_hi(a_.x); dst[2] = bf_lo(a_.y); dst[3] = bf_hi(a_.y); dst[4] = bf_lo(a_.z); dst[5] = bf_hi(a_.z); dst[6] = bf_lo(a_.w); dst[7] = bf_hi(a_.w); \
        dst[8] = bf_lo(b_.x); dst[9] = bf_hi(b_.x); dst[10] = bf_lo(b_.y); dst[11] = bf_hi(b_.y); dst[12] = bf_lo(b_.z); dst[13] = bf_hi(b_.z); dst[14] = bf_lo(b_.w); dst[15] = bf_hi(b_.w); } while (0)
        LD16(ov, SO + o); LD16(rv, RKV + o); LD16(kv, RKV + (size_t)MP * D + o); LD16(vv, RKV + (size_t)2 * MP * D + o); LD16(av, AA + o); LD16(gv, GG + o);
#undef LD16
        float sm = 0.f, rk = 0.f;
#pragma unroll
        for (int e = 0; e < 16; ++e) { sm += ov[e]; const float kp = kv[e] * (1.f + (sigmoidf_(a0p[c0 + e] + av[e]) - 1.f) * k_a[c0 + e]); rk += rv[e] * kp * r_k[c0 + e]; }
        sm += shx(sm, 1, lane); sm += shx(sm, 2, lane); rk += shx(rk, 1, lane); rk += shx(rk, 2, lane);
        const float mean = sm * (1.f / 64.f);
        float vs = 0.f;
#pragma unroll
        for (int e = 0; e < 16; ++e) { const float d = ov[e] - mean; vs += d * d; }
        vs += shx(vs, 1, lane); vs += shx(vs, 2, lane);
        const float rstd = __builtin_amdgcn_rsqf(vs * (1.f / 64.f) + GN_EPS);
        unsigned w[8];
#pragma unroll
        for (int e = 0; e < 16; e += 2) {
            const float y0 = ((ov[e] - mean) * rstd * gnw[c0 + e] + gnb[c0 + e] + rk * vv[e]) * gv[e];
            const float y1 = ((ov[e + 1] - mean) * rstd * gnw[c0 + e + 1] + gnb[c0 + e + 1] + rk * vv[e + 1]) * gv[e + 1];
            w[e >> 1] = cvt_pk(y0, y1);
        }
        *(u32x4*)(OG + o) = (u32x4){w[0], w[1], w[2], w[3]}; *(u32x4*)(OG + o + 8) = (u32x4){w[4], w[5], w[6], w[7]};
    }
}

__device__ __forceinline__ int crow(int r, int hi) { return (r & 3) + 8 * (r >> 2) + 4 * hi; }
__device__ __forceinline__ bf16x8 pack8(f32x4 a, f32x4 b) {
    u32x4 w; w.x = cvt_pk(a[0], a[1]); w.y = cvt_pk(a[2], a[3]); w.z = cvt_pk(b[0], b[1]); w.w = cvt_pk(b[2], b[3]);
    return __builtin_bit_cast(bf16x8, w);
}
__device__ __forceinline__ void attn_phase(KP p, int tid, int bid, int G) {
    const int lane = tid & 63, gw = bid * 8 + (tid >> 6), nw = G * 8;
    const bf16_t* QB = (const bf16_t*)(p->ws + W_QB); bf16_t* AO = (bf16_t*)(p->ws + W_OG);
    const int ql = lane & 31, hi = lane >> 5;
    constexpr int NU_P = BP * NH * 65;
    for (int u = gw; u < NU_P + BS * NH * 2; u += nw) {
        int bh, Q0, nq, npast, row_base, Tn; const float *kc, *vc, *kn, *vn;
        const int us = u < BS * NH * 2 ? NU_P + u : (u - BS * NH * 2);
        if (us < NU_P) { const int qbr = us / (BP * NH); bh = us - qbr * (BP * NH); Q0 = (64 - qbr) * 32; nq = min(32, TP - Q0); npast = 0; row_base = (bh >> 4) * TP; Tn = TP;
            kc = nullptr; vc = nullptr; kn = p->out + O_KP + (size_t)bh * TP * HD; vn = p->out + O_VP + (size_t)bh * TP * HD; }
        else { const int v = us - NU_P; bh = v >> 1; Q0 = (v & 1) * 32; nq = 32; npast = PAST; row_base = MPR + (bh >> 4) * TS; Tn = TS;
            kc = p->in[4] + (size_t)bh * PAST * HD; vc = p->in[5] + (size_t)bh * PAST * HD; kn = p->out + O_KS + (size_t)bh * TS * HD; vn = p->out + O_VS + (size_t)bh * TS * HD; }
        const int h = bh & 15, qpos0 = npast + Q0;
        bf16x8 qf[4];
        { const bf16_t* qp = QB + (size_t)(row_base + Q0 + min(ql, nq - 1)) * D + h * 64 + hi * 8;
#pragma unroll
          for (int s = 0; s < 4; ++s) qf[s] = *(const bf16x8*)(qp + 16 * s); }
        f32x16 o0, o1;
#pragma unroll
        for (int r = 0; r < 16; ++r) { o0[r] = 0.f; o1[r] = 0.f; }
        float carry = ql < nq ? 0.f : -1e30f;
        const int qpos = qpos0 + ql;
        f32x4 kc4[8];
#define ATT_TILE_PTRS(P0_, kb_, vb_, lim_) const bool inpast_ = (P0_) < npast; \
            const float* kb_ = inpast_ ? kc + (size_t)(P0_) * HD : kn + (size_t)((P0_) - npast) * HD; \
            const float* vb_ = inpast_ ? vc + (size_t)(P0_) * HD : vn + (size_t)((P0_) - npast) * HD; \
            const int lim_ = inpast_ ? 31 : min(31, Tn - 1 - ((P0_) - npast));
        { ATT_TILE_PTRS((qpos0 >> 5) * 32, kb0, vb0, lim0); (void)vb0;
          const float* kp = kb0 + (size_t)min(ql, lim0) * HD + hi * 8;
#pragma unroll
          for (int s = 0; s < 4; ++s) { kc4[2 * s] = *(const f32x4*)(kp + 16 * s); kc4[2 * s + 1] = *(const f32x4*)(kp + 16 * s + 4); } }
        for (int kt = qpos0 >> 5; kt >= 0; --kt) {
            const int P0 = kt * 32;
            ATT_TILE_PTRS(P0, kb, vb, lim); (void)kb;
            float x0[16], x1[16];
#pragma unroll
            for (int r = 0; r < 16; ++r) { const float* vp = vb + (size_t)min(crow(r, hi), lim) * HD + ql; x0[r] = vp[0]; x1[r] = vp[32]; }
            f32x4 kn4[8];
            { const int Pn = kt > 0 ? P0 - 32 : P0; ATT_TILE_PTRS(Pn, kbn, vbn, limn); (void)vbn;
              const float* kp = kbn + (size_t)min(ql, limn) * HD + hi * 8;
#pragma unroll
              for (int s = 0; s < 4; ++s) { kn4[2 * s] = *(const f32x4*)(kp + 16 * s); kn4[2 * s + 1] = *(const f32x4*)(kp + 16 * s + 4); } }
            f32x16 st;
#pragma unroll
            for (int r = 0; r < 16; ++r) st[r] = 0.f;
#pragma unroll
            for (int s = 0; s < 4; ++s) st = __builtin_amdgcn_mfma_f32_32x32x16_bf16(pack8(kc4[2 * s], kc4[2 * s + 1]), qf[s], st, 0, 0, 0);
            float L[16];
            float own[4];
#pragma unroll
            for (int g = 0; g < 4; ++g) { float sg = 0.f;
#pragma unroll
                for (int i = 0; i < 4; ++i) { const int r = 4 * g + i; const bool vis = (P0 + crow(r, hi)) < qpos; L[r] = vis ? -softplusf_(st[r]) : 0.f; sg += L[r]; }
                own[g] = sg; }
            float oth[4];
#pragma unroll
            for (int g = 0; g < 4; ++g) oth[g] = shx(own[g], 32, lane);
            float suf = carry;
            float A[16];
#pragma unroll
            for (int g = 3; g >= 0; --g) {
                float c = suf + (hi == 0 ? oth[g] : 0.f);
#pragma unroll
                for (int i = 3; i >= 0; --i) { const int r = 4 * g + i; c += L[r]; const bool vis = (P0 + crow(r, hi)) < qpos; A[r] = vis ? __expf(st[r] + c) : 0.f; }
                suf += own[g] + oth[g];
            }
            carry = suf;
            const bf16x8 pa0 = pack8((f32x4){A[0], A[1], A[2], A[3]}, (f32x4){A[4], A[5], A[6], A[7]});
            const bf16x8 pa1 = pack8((f32x4){A[8], A[9], A[10], A[11]}, (f32x4){A[12], A[13], A[14], A[15]});
            o0 = __builtin_amdgcn_mfma_f32_32x32x16_bf16(pa0, pack8((f32x4){x0[0], x0[1], x0[2], x0[3]}, (f32x4){x0[4], x0[5], x0[6], x0[7]}), o0, 0, 0, 0);
            o1 = __builtin_amdgcn_mfma_f32_32x32x16_bf16(pa0, pack8((f32x4){x1[0], x1[1], x1[2], x1[3]}, (f32x4){x1[4], x1[5], x1[6], x1[7]}), o1, 0, 0, 0);
            o0 = __builtin_amdgcn_mfma_f32_32x32x16_bf16(pa1, pack8((f32x4){x0[8], x0[9], x0[10], x0[11]}, (f32x4){x0[12], x0[13], x0[14], x0[15]}), o0, 0, 0, 0);
            o1 = __builtin_amdgcn_mfma_f32_32x32x16_bf16(pa1, pack8((f32x4){x1[8], x1[9], x1[10], x1[11]}, (f32x4){x1[12], x1[13], x1[14], x1[15]}), o1, 0, 0, 0);
#pragma unroll
            for (int e = 0; e < 8; ++e) kc4[e] = kn4[e];
            if (!__any(carry >= -104.f)) break;
        }
#undef ATT_TILE_PTRS
        bf16_t* op = AO + (size_t)(row_base + Q0) * D + h * 64 + ql;
#pragma unroll
        for (int r = 0; r < 16; ++r) { const int qr = crow(r, hi); if (qr < nq) { op[(size_t)qr * D] = (bf16_t)(cvt_pk(o0[r], 0.f) & 0xffffu); op[(size_t)qr * D + 32] = (bf16_t)(cvt_pk(o1[r], 0.f) & 0xffffu); } }
    }
}

template <int NS> __device__ __forceinline__ void fixup_phase(KP p, int ffn, int tid, int bid, int G) {
    float* X = (float*)(p->ws + W_X); bf16_t* XB = (bf16_t*)(p->ws + W_XN); const float* spl = (const float*)(p->ws + W_SKP);
    float* rsq = (float*)(p->ws + W_RSQ) + (size_t)(ffn == 1 ? 2 : (ffn == 2 ? 3 : (ffn == 4 ? 1 : 4))) * MP;
    const bool fold = ffn == 1 || ffn == 2 || ffn >= 4, fin = ffn == 3; const float scl = ffn >= 4 ? 1.0f : 0.5f;
    pg8::StaticOrder so; so.init(MP, D, 1, 0); so.nt0 = 0;
    const int ntail = so.nwg - G; if (ntail <= 0) return;
    const int wid = tid >> 6, lane = tid & 63, wr = wid >> 2, wc = wid & 3, fr = lane & 15, fq = lane >> 4;
    for (int B = bid; B < ntail * 32; B += G) {
        const int j = B >> 5, q = B & 31, n = q & 1, m = (q >> 1) & 3, bj = (q >> 3) & 1, ai = q >> 4;
        Unit u; so.next(G + j, u);
        f32x4 pv_[NS];
#pragma unroll
        for (int ch = 0; ch < NS; ++ch) pv_[ch] = *((const f32x4*)(spl + (size_t)(j * NS + ch) * 65536) + q * 512 + tid);
        f32x4 sum = pv_[0];
#pragma unroll
        for (int ch = 1; ch < NS; ++ch) sum += pv_[ch];
        const int row = u.pm * 256 + ai * 128 + wr * 64 + m * 16 + fr, col = u.pn * 256 + bj * 128 + wc * 32 + n * 16 + fq * 4;
        const size_t off = (size_t)row * D + col;
        const f32x4 x = *(const f32x4*)(X + off) + sum * scl;
        if (!fin) {
            *(f32x4*)(X + off) = x;
            if (fold) { store_bf4(XB + off, x); float ss = (x[0] * x[0] + x[1] * x[1]) + (x[2] * x[2] + x[3] * x[3]); ss += shx(ss, 16, lane); ss += shx(ss, 32, lane); if (fq == 0) unsafeAtomicAdd(rsq + row, ss); }
        } else if (row < MR) {
            float* dp = nullptr;
            if (row < MPR) { const int b = row / TP, t = row - b * TP; if (t >= NMETA) dp = p->out + O_YP + ((size_t)b * SEQP + (t - NMETA)) * D + col; }
            else dp = p->out + O_YS + (size_t)(row - MPR) * D + col;
            if (dp) *(f32x4*)dp = x;
        }
    }
}
#define XB_TMO      128
#define XB_XCNT(j)  (256  + 64 * (j))
#define XB_XSUB(j)  (1280 + 64 * (j))
#define XB_XGEN(j)  (2304 + 64 * (j))
#define XB_TOP      3328
#define XB_TOPGEN   3392
#define XCD_BAR_WORDS 3456
#define XB_SPIN_CAP (1u << 18)

__device__ __forceinline__ unsigned xb_ld(unsigned* p)              { return __hip_atomic_load(p, __ATOMIC_RELAXED, __HIP_MEMORY_SCOPE_AGENT); }
__device__ __forceinline__ unsigned xb_add(unsigned* p, unsigned v) { return __hip_atomic_fetch_add(p, v, __ATOMIC_RELAXED, __HIP_MEMORY_SCOPE_AGENT); }
__device__ __forceinline__ unsigned xb_xcc_id() { return (unsigned)__builtin_amdgcn_s_getreg((3 << 11) | 20) & 0xFu; }
#define XB_SPIN(cond, bar) do { unsigned _sp = 0; while (cond) { __builtin_amdgcn_s_sleep(1); \
    if ((++_sp & 255u) == 0u) { if (xb_ld(&(bar)[XB_TMO])) break; if (_sp > XB_SPIN_CAP) { atomicAdd(&(bar)[XB_TMO], 1u); break; } } } } while (0)

struct XcdBarrier {
    unsigned* bar; unsigned x;
    volatile LAS unsigned* st;
};

__device__ __forceinline__ XcdBarrier xcd_barrier_post(unsigned* bar, volatile LAS unsigned* st, bool xb_tid0) {
    XcdBarrier b; b.bar = bar; b.x = xb_xcc_id(); b.st = st;
    if (xb_tid0) (void)xb_add(&bar[XB_XCNT(b.x)], 1u);
    return b;
}
__device__ __forceinline__ void xcd_barrier_complete(unsigned* bar, unsigned x, unsigned& nloc, unsigned& nx) {
    const unsigned G = gridDim.x * gridDim.y * gridDim.z;
    unsigned sum, cnt, mine, sp = 0u;
    for (;;) {
        sum = 0u; cnt = 0u; mine = 0u;
#pragma unroll
        for (unsigned j = 0; j < 16; ++j) { const unsigned c = xb_ld(&bar[XB_XCNT(j)]); sum += c; cnt += (c > 0u) ? 1u : 0u; mine = (j == x) ? c : mine; }
        if (sum == G) break;
        __builtin_amdgcn_s_sleep(1);
        if ((++sp & 255u) == 0u) { if (xb_ld(&bar[XB_TMO])) break; if (sp > XB_SPIN_CAP) { atomicAdd(&bar[XB_TMO], 1u); break; } }
    }
    nloc = mine > 0u ? mine : 1u; nx = cnt > 0u ? cnt : 1u;
}

__device__ __forceinline__ void xcd_barrier(const XcdBarrier& b, bool xb_tid0) {
    asm volatile("s_waitcnt vmcnt(0)" ::: "memory");
    __syncthreads();
    if (xb_tid0) {
        unsigned* bar = b.bar;
        __builtin_amdgcn_s_waitcnt(0);
        unsigned nloc = b.st[0], nx = b.st[1];
        if (nloc == 0u) { xcd_barrier_complete(bar, b.x, nloc, nx); b.st[0] = nloc; b.st[1] = nx; }
        const unsigned old = xb_add(&bar[XB_XSUB(b.x)], 1u);
        const unsigned gen = old / nloc;
        if (old + 1u == (gen + 1u) * nloc) {
            __builtin_amdgcn_fence(__ATOMIC_RELEASE, "agent");
            asm volatile("s_waitcnt vmcnt(0)" ::: "memory");
            const unsigned og = xb_add(&bar[XB_TOP], 1u);
            const unsigned tg = og / nx;
            if (og + 1u == (tg + 1u) * nx) xb_add(&bar[XB_TOPGEN], 1u);
            else XB_SPIN(xb_ld(&bar[XB_TOPGEN]) == tg, bar);
            __builtin_amdgcn_fence(__ATOMIC_ACQUIRE, "agent");
            xb_add(&bar[XB_XGEN(b.x)], 1u);
            asm volatile("s_waitcnt vmcnt(0)" ::: "memory");
        } else {
            XB_SPIN(xb_ld(&bar[XB_XGEN(b.x)]) == gen, bar);
            __builtin_amdgcn_fence(__ATOMIC_ACQUIRE, "agent");
            asm volatile("s_waitcnt vmcnt(0)" ::: "memory");
        }
    }
    __syncthreads();
}
constexpr int NPHASE = 23;
#ifndef PHM
#define PHM 0xffff
#endif
#define EN(k) (((PHM) >> (k)) & 1)
constexpr int LDS_BYTES = 131072 + 8 * 576 * 4;
template <class Epi, class Sched>
__device__ __forceinline__ void run_gemm(LAS unsigned char* lds, int wb, const bf16_t* A, const bf16_t* Bt, int M, int N, int K, const Sched& S, const Epi& E, float* skp = nullptr, unsigned* skf = nullptr) {
    pg8::Gemm g{A, Bt, M, N, K, wb, skp, skf};
    pg8::gemm_phase<Epi, Sched, GP_ALIGN, GP_SP2>(lds, g, S, E);
}
__global__ void __launch_bounds__(512, 2) mega(Params p_unused) {
    LAS unsigned char* lds = (LAS unsigned char*)lds_raw;
    cg::grid_group grid = cg::this_grid();
    KP p = (KP)__builtin_amdgcn_kernarg_segment_ptr();
    const int ph_lo = p->ph_lo, ph_hi = p->ph_hi;
    const int wb = __builtin_amdgcn_readfirstlane((int)threadIdx.x) & ~63;
    { LAS unsigned* stw = (LAS unsigned*)(lds + 131072); if ((int)threadIdx.x < 2) stw[threadIdx.x] = 0u; __syncthreads(); }
    const XcdBarrier xbar = xcd_barrier_post((unsigned*)(p->ws + W_BAR), (volatile LAS unsigned*)(lds + 131072), threadIdx.x == 0);
    for (int pi_ = ph_lo; pi_ < ph_hi; ++pi_) {
        asm volatile("" ::: "v1","v2","v3","v4","v5","v6","v7","v8","v9","v10","v11","v12","v13","v14","v15","v16","v17","v18","v19","v20","v21","v22","v23","v24","v25","v26","v27","v28","v29","v30","v31","v32","v33","v34","v35","v36","v37","v38","v39","v40","v41","v42","v43","v44","v45","v46","v47","v48","v49","v50","v51","v52","v53","v54","v55","v56","v57","v58","v59","v60","v61","v62","v63","v64","v65","v66","v67","v68","v69","v70","v71","v72","v73","v74","v75","v76","v77","v78","v79","v80","v81","v82","v83","v84","v85","v86","v87","v88","v89","v90","v91","v92","v93","v94","v95","v96","v97","v98","v99","v100","v101","v102","v103","v104","v105","v106","v107","v108","v109","v110","v111","v112","v113","v114","v115","v116","v117","v118","v119","v120","v121","v122","v123","v124","v125","v126","v127","v128","v129","v130","v131","v132","v133","v134","v135","v136","v137","v138","v139","v140","v141","v142","v143","v144","v145","v146","v147","v148","v149","v150","v151","v152","v153","v154","v155","v156","v157","v158","v159","v160","v161","v162","v163","v164","v165","v166","v167","v168","v169","v170","v171","v172","v173","v174","v175","v176","v177","v178","v179","v180","v181","v182","v183","v184","v185","v186","v187","v188","v189","v190","v191","v192","v193","v194","v195","v196","v197","v198","v199","v200","v201","v202","v203","v204","v205","v206","v207","v208","v209","v210","v211","v212","v213","v214","v215","v216","v217","v218","v219","v220","v221","v222","v223","v224","v225","v226","v227","v228","v229","v230","v231","v232","v233","v234","v235","v236","v237","v238","v239","v240","v241","v242","v243","v244","v245","v246","v247","v248","v249");
        asm volatile("" : "+s"(p));
        const int phc = p->seq[pi_], ph = phc & 63; const bool dry = (phc & 64) != 0;
        int bid = blockIdx.x, G = gridDim.x;
        asm volatile("" : "+s"(bid), "+s"(G));
#define TID_HERE (wb + lane_now())
        int ffn = -1; bool ffn_in = false;
        if (ph == 1 || ph == 2) { ffn = 0; ffn_in = ph == 1; } else if (ph == 11 || ph == 12) { ffn = 1; ffn_in = ph == 11; }
        else if (ph == 14 || ph == 15) { ffn = 2; ffn_in = ph == 14; } else if (ph == 21 || ph == 22) { ffn = 3; ffn_in = ph == 21; }
        if (EN(0) && ph == 0) { { const int tid = TID_HERE; convert_weights(p, (LAS float*)lds, tid, bid, G); assemble_x(p, tid, bid, G); } }
        else if (EN(1) && ffn >= 0 && ffn_in) {
            pg8::StaticOrder S; S.init(MP, NIN, G, bid); S.nt0 = D / 64;
            unsigned char* ws = p->ws; EpiSwiGLU E{(bf16_t*)(ws + W_HB), (const float*)(ws + W_RSQ) + (size_t)(ffn == 0 ? 0 : (ffn == 1 ? 1 : (ffn == 2 ? 2 : 4))) * MP};
            run_gemm(lds, wb, (const bf16_t*)(ws + W_XN), (const bf16_t*)(ws + W_WIN + ffn * SZ_WIN1), MP, NIN, D, S, E);
        } else if (EN(2) && ffn >= 0) {
            TailSplitOrder S; S.init(MP, D, DFFP, G, bid, 11);
            unsigned char* ws = p->ws; const bool fold = (ffn == 1 || ffn == 2) && !dry;
            EpiRes E{(float*)(ws + W_X), dry ? 0.f : 0.5f, (ffn == 3 && !dry) ? p->out : nullptr, fold ? (bf16_t*)(ws + W_XN) : nullptr, (float*)(ws + W_RSQ) + (size_t)(ffn == 1 ? 2 : 3) * MP, (float*)(ws + W_SKP)};
            run_gemm(lds, wb, (const bf16_t*)(ws + W_HB), (const bf16_t*)(ws + W_WOUT + ffn * SZ_WOUT1), MP, D, DFFP, S, E, (float*)(ws + W_SKP), (unsigned*)(ws + W_SKF) + pi_ * 1024);
        }
        else if (ph >= 24 && ph < 28) { if (!dry) fixup_phase<11>(p, ph - 24, TID_HERE, bid, G); }
        else if (ph >= 28 && ph < 30) { if (!dry) fixup_phase<WO_NS>(p, ph - 24, TID_HERE, bid, G); }
        else if (EN(3) && ph == 3) mixprep_phase(p, TID_HERE, bid, G);
        else if (EN(4) && ph == 4) {
            G1Order S{G, bid};
            unsigned char* ws = p->ws; EpiG1 E{(bf16_t*)(ws + W_RKV), (float*)(ws + W_L1)};
            run_gemm(lds, wb, (const bf16_t*)(ws + W_AALL), (const bf16_t*)(ws + W_WG1), 5 * MP, 3584, D, S, E);
        }
        else if (EN(5) && ph == 5) act_phase(p, bid * 512 + TID_HERE, G * 512);
        else if (EN(6) && ph == 6) {
            G2Order S; S.init(G, bid);
            unsigned char* ws = p->ws; EpiG2 E{(bf16_t*)(ws + W_DEC)};
            run_gemm(lds, wb, (const bf16_t*)(ws + W_A2), (const bf16_t*)(ws + W_WL2), MP, 3072, 256, S, E);
        }
        else if (EN(7) && ph == 7) scan_phase(p, (LAS float*)lds, TID_HERE, bid, G);
        else if (EN(8) && ph == 8) post_phase(p, TID_HERE, bid, G);
        else if (EN(9) && (ph == 9 || ph == 19)) {
            TailSplitOrder S; S.init(MP, D, D, G, bid, WO_NS);
            unsigned char* ws = p->ws; EpiRes E{(float*)(ws + W_X), dry ? 0.f : 1.0f, nullptr, dry ? nullptr : (bf16_t*)(ws + W_XN), (float*)(ws + W_RSQ) + (size_t)(ph == 9 ? 1 : 4) * MP, (float*)(ws + W_SKP)};
            run_gemm(lds, wb, (const bf16_t*)(ws + W_OG), (const bf16_t*)(ws + (ph == 9 ? W_WO1 : W_WO2)), MP, D, D, S, E, (float*)(ws + W_SKP), (unsigned*)(ws + W_SKF) + pi_ * 1024);
        }
        else if (EN(11) && ph == 17) {
            pg8::StaticOrder S; S.init(MP, 3 * D, G, bid); S.nt0 = D / 64;
            unsigned char* ws = p->ws; EpiQKV E{(bf16_t*)(ws + W_QB), p->out, p->in[28], p->in[29], (const float*)(ws + W_RSQ) + (size_t)3 * MP};
            run_gemm(lds, wb, (const bf16_t*)(ws + W_XN), (const bf16_t*)(ws + W_WQKV), MP, 3 * D, D, S, E);
        }
        else if (EN(12) && ph == 18) attn_phase(p, TID_HERE, bid, G);
        if (pi_ + 1 < ph_hi) { if (pi_ < 0) grid.sync(); else xcd_barrier(xbar, (wb + lane_now()) == 0); }
    }
}

#ifndef ONE_LAUNCH
#define ONE_LAUNCH 1
#endif
extern "C" void kernel_launch(void* const* d_in, const int* in_sizes, int n_in, void* d_out, int out_size, void* d_ws, size_t ws_size, hipStream_t stream) {
    static int grid = 0;
    if (grid == 0) {
        if (n_in != 31 || (size_t)out_size != O_END || ws_size < W_END) { fprintf(stderr, "kernel_launch: unexpected sizes (n_in %d out %d ws %zu need %zu)\n", n_in, out_size, ws_size, (size_t)W_END); grid = -1; return; }
        int dev = 0, cus = 0, per_cu = 0;
        hipGetDevice(&dev); hipDeviceGetAttribute(&cus, hipDeviceAttributeMultiprocessorCount, dev);
        if (hipFuncSetAttribute((const void*)mega, hipFuncAttributeMaxDynamicSharedMemorySize, LDS_BYTES) != hipSuccess) { fprintf(stderr, "kernel_launch: hipFuncSetAttribute failed\n"); grid = -1; return; }
        hipOccupancyMaxActiveBlocksPerMultiprocessor(&per_cu, (const void*)mega, 512, LDS_BYTES);
        (void)hipGetLastError();
        if (per_cu < 1) per_cu = 1;
        grid = cus * per_cu;
    }
    if (grid < 0) return;
    Params p{};
    for (int i = 0; i < 31; ++i) p.in[i] = (const float*)d_in[i];
    p.out = (float*)d_out; p.ws = (unsigned char*)d_ws;
    int nseq = 0;
    for (int ph = 0; ph < NPHASE; ++ph) {
        if (ph == 10 || ph == 13 || ph == 16 || ph == 20) continue;
        p.seq[nseq++] = ph;
        if (ph == 2 || ph == 12 || ph == 15 || ph == 22) p.seq[nseq++] = 24 + (ph == 2 ? 0 : (ph == 12 ? 1 : (ph == 15 ? 2 : 3)));
        if (ph == 9 || ph == 19) p.seq[nseq++] = ph == 9 ? 28 : 29;
#ifdef REP_OF
        for (int r = 0; r < (REP_OF(ph)); ++r) p.seq[nseq++] = (ph | ((ph == 2 || ph == 9) ? 64 : 0));
#endif
    }
#if ONE_LAUNCH
    (void)hipMemsetAsync((unsigned char*)d_ws + W_BAR, 0, 16384, stream);
    p.ph_lo = 0; p.ph_hi = nseq;
    void* args[] = {&p};
    hipError_t e = hipLaunchCooperativeKernel((const void*)mega, dim3(grid), dim3(512), args, LDS_BYTES, stream);
    if (e != hipSuccess) fprintf(stderr, "cooperative launch failed: %s (grid %d)\n", hipGetErrorString(e), grid);
#else
    for (int ph = 0; ph < nseq; ++ph) { p.ph_lo = ph; p.ph_hi = ph + 1; hipLaunchKernelGGL(mega, dim3(grid), dim3(512), LDS_BYTES, stream, p); }
#endif
}
```

```cpp
#include <hip/hip_runtime.h>
#include <hip/hip_cooperative_groups.h>
#include <cstdio>
#include <cstdint>
namespace cg = cooperative_groups;
#ifndef GP_SP2
#define GP_SP2 true
#endif
#ifndef GP_ALIGN
#define GP_ALIGN true
#endif
#ifndef WO_NS
#define WO_NS 4
#endif
#ifndef WGM_SET
#define WGM_SET 8
#endif
__device__ __forceinline__ int lane_now() { int l; asm volatile("v_mbcnt_lo_u32_b32 %0, -1, 0\n\tv_mbcnt_hi_u32_b32 %0, -1, %0" : "=v"(l)); return l; }
namespace pg8 {
#define PG8_LAS __attribute__((address_space(3)))
typedef unsigned short bf16_t;
typedef short bf16x8 __attribute__((ext_vector_type(8)));
typedef float f32x4 __attribute__((ext_vector_type(4)));
typedef unsigned u32x4 __attribute__((ext_vector_type(4)));
constexpr int BM = 256, BK = 64, HALF = 128, HTB = HALF * BK * 2  , STAGE_BYTES = 8 * HTB, NXCD = 8, WGM = WGM_SET;

__host__ __device__ __forceinline__ int lds_byte(int r, int c) { const int st = (r >> 4) * 2 + (c >> 5), rr = r & 15, cc = c & 31, ob = rr * 64 + cc * 2; return st * 1024 + (ob ^ (((ob >> 9) & 1) << 5)); }
__host__ __device__ __forceinline__ void stage_rc(int b, int& R, int& C) { const int st = b / 1024, sb = b % 1024, swz = sb ^ (((sb >> 9) & 1) << 5); R = (st >> 1) * 16 + swz / 64; C = (st & 1) * 32 + (swz % 64) / 2; }
__host__ __device__ __forceinline__ int perm32(int rho) { const int n = rho >> 4, i = rho & 15; return 8 * (i >> 2) + 4 * n + (i & 3); }

struct Unit { int pm, pn, kb, nt, fl, tl; };
struct Gemm { const bf16_t* A; const bf16_t* Bt; int M, N, K, wb; float* skp; unsigned* skf; };

struct StaticOrder {
    static constexpr bool STREAM = false; int nM, nN, nwg, G, c, nt0;
    __host__ __device__ void init(int M, int N, int G_, int c_) { nM = M / BM; nN = N / BM; nwg = nM * nN; G = G_; c = c_; }
    __host__ __device__ bool next(int i, Unit& u) const {
        const long L = (long)i * G + c; if (L >= nwg) return false;
        int wgid = (int)L; { const int q = nwg / NXCD, r = nwg % NXCD, xcd = wgid % NXCD, off = wgid / NXCD; wgid = (xcd < r ? xcd * (q + 1) : r * (q + 1) + (xcd - r) * q) + off; }
        const int nig = WGM * nN, gid = wgid / nig, fm = gid * WGM, gsz = (nM - fm) < WGM ? (nM - fm) : WGM;
        u.pm = fm + ((wgid % nig) % gsz); u.pn = (wgid % nig) / gsz; u.kb = 0; u.nt = nt0; u.fl = 0; u.tl = 0; return true;
    }
    __device__ __forceinline__ void a_ready(const Unit&) const {}
    __device__ __forceinline__ void done(const Unit&) const {}
};
typedef __attribute__((address_space(1))) f32x4 gf32x4;
typedef unsigned long long u64_t;
__device__ __forceinline__ void streamk_store(const f32x4 (&acc)[2][2][4][2], const Unit& u, float* skp, unsigned* skf, int tid) {
    u64_t* q = (u64_t*)(skp + (size_t)u.tl * 65536) + 2 * tid;
#pragma unroll
    for (int a = 0; a < 2; ++a)
#pragma unroll
        for (int b = 0; b < 2; ++b)
#pragma unroll
            for (int m = 0; m < 4; ++m)
#pragma unroll
                for (int n = 0; n < 2; ++n) { const f32x4 v = acc[a][b][m][n];
                    __hip_atomic_store(q, ((u64_t)__float_as_uint(v[1]) << 32) | __float_as_uint(v[0]), __ATOMIC_RELAXED, __HIP_MEMORY_SCOPE_AGENT);
                    __hip_atomic_store(q + 1, ((u64_t)__float_as_uint(v[3]) << 32) | __float_as_uint(v[2]), __ATOMIC_RELAXED, __HIP_MEMORY_SCOPE_AGENT);
                    q += 1024; asm volatile("" : "+v"(q) :: "memory"); }
    asm volatile("s_waitcnt vmcnt(0)" ::: "memory");
    __builtin_amdgcn_s_barrier();
    if (tid == 0) __hip_atomic_store(skf + u.tl, 1u, __ATOMIC_RELAXED, __HIP_MEMORY_SCOPE_AGENT);
}
__device__ __forceinline__ const float* streamk_wait(const Unit& u, float* skp, unsigned* skf, int tid) {
    if (u.fl == 2) {
        if (tid == 0) { while (__hip_atomic_load(skf + u.tl, __ATOMIC_RELAXED, __HIP_MEMORY_SCOPE_AGENT) == 0u) __builtin_amdgcn_s_sleep(2); }
        __builtin_amdgcn_s_barrier();
        __builtin_amdgcn_fence(__ATOMIC_ACQUIRE, "agent");
    } else __builtin_amdgcn_s_barrier();
    return skp + (size_t)u.tl * 65536;
}
__device__ __forceinline__ f32x4 streamk_part(const float* part, int idx, int tid) {
    const u64_t* q = (const u64_t*)part + (size_t)idx * 1024 + 2 * tid;
    const u64_t a = __hip_atomic_load(q, __ATOMIC_RELAXED, __HIP_MEMORY_SCOPE_AGENT), b = __hip_atomic_load(q + 1, __ATOMIC_RELAXED, __HIP_MEMORY_SCOPE_AGENT);
    return (f32x4){__uint_as_float((unsigned)a), __uint_as_float((unsigned)(a >> 32)), __uint_as_float((unsigned)b), __uint_as_float((unsigned)(b >> 32))};
}
template <class Epi, class Sched, bool ALIGN_EPI = false, bool SP2 = false>
__device__ __forceinline__ void gemm_phase(PG8_LAS unsigned char* lds, const Gemm g, const Sched& S, const Epi& E) {
    int tid = g.wb + lane_now(); asm volatile("" : "+v"(tid)); const int wid = __builtin_amdgcn_readfirstlane(tid >> 6), lane = tid & 63, wr = wid >> 2, wc = wid & 3, fr = lane & 15, fq = lane >> 4;
    const int K = g.K, nt = K / BK;
    unsigned voffA[2], voffB[2];
#pragma unroll
    for (int i = 0; i < 2; ++i) { int R, C; stage_rc(tid * 16 + i * 8192, R, C); const int Rb = Epi::PERM ? ((R & ~31) + perm32(R & 31)) : R;
        voffA[i] = (unsigned)(R * K + C) * 2u; voffB[i] = (unsigned)(Rb * K + C) * 2u; }
    const size_t kstep = (size_t)(BK * 2);
    const size_t hstep = (size_t)HALF * K * 2;
    const size_t tstep = 2 * hstep;
    const unsigned ldsw = (unsigned)wid * 1024u;
    const int aoff = lds_byte(wr * 64 + fr, fq * 8), boff = lds_byte(wc * 32 + fr, fq * 8);
#define PG8_SA(b, h) (((b) * 2 + (h)) * HTB)
#define PG8_SB(b, h) ((4 + (b) * 2 + (h)) * HTB)
#define PG8_STAGE(bufoff, gbase, voff) do { _Pragma("unroll") for (int _i = 0; _i < 2; ++_i) \
        __builtin_amdgcn_global_load_lds((const unsigned*)((const char*)(gbase) + (voff)[_i]), (PG8_LAS unsigned*)(lds + (bufoff) + ldsw + _i * 8192), 16, 0, 0); } while (0)
#define PG8_LDA(dst, b, h) do { _Pragma("unroll") for (int m = 0; m < 4; ++m) _Pragma("unroll") for (int k = 0; k < 2; ++k) dst[m][k] = *(const PG8_LAS bf16x8*)(lds + PG8_SA(b, h) + aoff + m * 2048 + k * 1024); } while (0)
#define PG8_LDB(dst, b, h) do { _Pragma("unroll") for (int n = 0; n < 2; ++n) _Pragma("unroll") for (int k = 0; k < 2; ++k) dst[n][k] = *(const PG8_LAS bf16x8*)(lds + PG8_SB(b, h) + boff + n * 2048 + k * 1024); } while (0)
#define PG8_MMA(ai, bj, At, Bt) do { __builtin_amdgcn_s_setprio(1); _Pragma("unroll") for (int m = 0; m < 4; ++m) _Pragma("unroll") for (int n = 0; n < 2; ++n) _Pragma("unroll") for (int k = 0; k < 2; ++k) \
        acc[ai][bj][m][n] = __builtin_amdgcn_mfma_f32_16x16x32_bf16(Bt[n][k], At[m][k], acc[ai][bj][m][n], 0, 0, 0); __builtin_amdgcn_s_setprio(0); } while (0)
#define PG8_WAIT_V(n) asm volatile("s_waitcnt vmcnt(" #n ")" ::: "memory")
#define PG8_WAIT_L(n) asm volatile("s_waitcnt lgkmcnt(" #n ")" ::: "memory")
#define PG8_BAR __builtin_amdgcn_s_barrier()
#define PG8_SCHED __builtin_amdgcn_sched_barrier(0)
    Unit cur, nxt; int ui = 0;
    if (!S.next(0, cur)) return;
    f32x4 acc[2][2][4][2];
#pragma unroll
    for (int a = 0; a < 2; ++a)
#pragma unroll
        for (int b = 0; b < 2; ++b)
#pragma unroll
            for (int m = 0; m < 4; ++m)
#pragma unroll
                for (int n = 0; n < 2; ++n) acc[a][b][m][n] = (f32x4){0.f, 0.f, 0.f, 0.f};
    bf16x8 At[4][2], B0[2][2], B1[2][2];
    const char* cA = (const char*)g.A + (size_t)cur.pm * tstep + cur.kb; const char* cB = (const char*)g.Bt + (size_t)cur.pn * tstep + cur.kb;
    S.a_ready(cur);
    if constexpr (SP2) {
        PG8_STAGE(PG8_SB(0, 0), cB, voffB); PG8_STAGE(PG8_SB(0, 1), cB + hstep, voffB); PG8_STAGE(PG8_SA(0, 0), cA, voffA); PG8_STAGE(PG8_SA(0, 1), cA + hstep, voffA);
        if (wr == 1) PG8_BAR;
        PG8_WAIT_V(2); PG8_BAR;
        PG8_STAGE(PG8_SB(1, 0), cB + kstep, voffB); PG8_STAGE(PG8_SA(1, 0), cA + kstep, voffA); PG8_STAGE(PG8_SB(1, 1), cB + hstep + kstep, voffB);
        PG8_WAIT_V(6); PG8_BAR;
    } else {
        PG8_STAGE(PG8_SB(0, 0), cB, voffB); PG8_STAGE(PG8_SA(0, 0), cA, voffA); PG8_STAGE(PG8_SB(0, 1), cB + hstep, voffB); PG8_STAGE(PG8_SA(0, 1), cA + hstep, voffA);
        if (wr == 1) PG8_BAR;
        PG8_WAIT_V(4); PG8_BAR;
        PG8_STAGE(PG8_SB(1, 0), cB + kstep, voffB); PG8_STAGE(PG8_SA(1, 0), cA + kstep, voffA); PG8_STAGE(PG8_SB(1, 1), cB + hstep + kstep, voffB);
        PG8_WAIT_V(6); PG8_BAR;
    }
    for (;;) {
        const bool has_next = S.next(ui + 1, nxt);
        const char* nA = has_next ? (const char*)g.A + (size_t)nxt.pm * tstep + nxt.kb : cA; const char* nB = has_next ? (const char*)g.Bt + (size_t)nxt.pn * tstep + nxt.kb : cB;
        const int ntu = cur.nt;
        for (int t = 0; t < ntu; t += 2) {
            const bool last = (t == ntu - 2);
            const char* a1 = cA + (size_t)(t + 1) * kstep;
            const char* a2 = last ? nA : cA + (size_t)(t + 2) * kstep; const char* b2 = last ? nB : cB + (size_t)(t + 2) * kstep;
            const char* a3 = a2 + kstep; const char* b3 = b2 + kstep;
            if (last && has_next) S.a_ready(nxt);
            if constexpr (SP2) {
            PG8_LDB(B0, 0, 0); PG8_LDB(B1, 0, 1); PG8_SCHED; PG8_LDA(At, 0, 0); PG8_STAGE(PG8_SA(1, 1), a1 + hstep, voffA);
            PG8_WAIT_V(8); PG8_WAIT_L(0); PG8_BAR; PG8_MMA(0, 0, At, B0); PG8_MMA(0, 1, At, B1); PG8_BAR; PG8_SCHED;
            PG8_LDA(At, 0, 1); PG8_STAGE(PG8_SB(0, 0), b2, voffB); PG8_STAGE(PG8_SB(0, 1), b2 + hstep, voffB); PG8_STAGE(PG8_SA(0, 0), a2, voffA);
            PG8_WAIT_V(8); PG8_WAIT_L(0); PG8_BAR; PG8_MMA(1, 0, At, B0); PG8_MMA(1, 1, At, B1); PG8_BAR; PG8_SCHED;
            PG8_LDB(B0, 1, 0); PG8_LDB(B1, 1, 1); PG8_SCHED; PG8_LDA(At, 1, 0); PG8_STAGE(PG8_SA(0, 1), a2 + hstep, voffA);
            PG8_WAIT_V(8); PG8_WAIT_L(0); PG8_BAR; PG8_MMA(0, 0, At, B0); PG8_MMA(0, 1, At, B1); PG8_BAR; PG8_SCHED;
            PG8_LDA(At, 1, 1); PG8_STAGE(PG8_SB(1, 0), b3, voffB); PG8_STAGE(PG8_SB(1, 1), b3 + hstep, voffB); PG8_STAGE(PG8_SA(1, 0), a3, voffA);
            PG8_WAIT_V(8); PG8_WAIT_L(0); PG8_BAR; PG8_MMA(1, 0, At, B0); PG8_MMA(1, 1, At, B1); PG8_BAR; PG8_SCHED;
            } else {
            PG8_LDB(B0, 0, 0); PG8_SCHED; PG8_LDA(At, 0, 0); PG8_STAGE(PG8_SA(1, 1), a1 + hstep, voffA);
            PG8_WAIT_L(8); PG8_BAR; PG8_WAIT_L(0); PG8_MMA(0, 0, At, B0); PG8_BAR; PG8_SCHED;
            PG8_LDB(B1, 0, 1); PG8_STAGE(PG8_SB(0, 0), b2, voffB);
            PG8_BAR; PG8_WAIT_L(0); PG8_MMA(0, 1, At, B1); PG8_BAR;
            PG8_LDA(At, 0, 1); PG8_STAGE(PG8_SA(0, 0), a2, voffA);
            PG8_BAR; PG8_WAIT_L(0); PG8_MMA(1, 0, At, B0); PG8_BAR; PG8_SCHED;
            PG8_STAGE(PG8_SB(0, 1), b2 + hstep, voffB);
            PG8_WAIT_V(6); PG8_BAR; PG8_MMA(1, 1, At, B1); PG8_BAR;
            PG8_LDB(B0, 1, 0); PG8_SCHED; PG8_LDA(At, 1, 0); PG8_STAGE(PG8_SA(0, 1), a2 + hstep, voffA);
            PG8_WAIT_L(8); PG8_BAR; PG8_WAIT_L(0); PG8_MMA(0, 0, At, B0); PG8_BAR; PG8_SCHED;
            PG8_LDB(B1, 1, 1); PG8_STAGE(PG8_SB(1, 0), b3, voffB);
            PG8_BAR; PG8_WAIT_L(0); PG8_MMA(0, 1, At, B1); PG8_BAR;
            PG8_LDA(At, 1, 1); PG8_STAGE(PG8_SA(1, 0), a3, voffA);
            PG8_BAR; PG8_WAIT_L(0); PG8_MMA(1, 0, At, B0); PG8_BAR; PG8_SCHED;
            PG8_STAGE(PG8_SB(1, 1), b3 + hstep, voffB);
            PG8_WAIT_V(6); PG8_BAR; PG8_MMA(1, 1, At, B1); PG8_BAR;
            }
        }
        if constexpr (ALIGN_EPI) { if (wr == 0) PG8_BAR; }
        if constexpr (!Epi::AFTER_DRAIN) { int t_ = g.wb + lane_now(); asm volatile("" : "+v"(t_)); const int fr_ = t_ & 15, fq_ = (t_ >> 4) & 3; if constexpr (!Sched::STREAM) E(acc, cur, wr, wc, fr_, fq_); else { if (cur.fl == 1) streamk_store(acc, cur, g.skp, g.skf, t_); else { const float* part_ = streamk_wait(cur, g.skp, g.skf, t_); int t2_ = g.wb + lane_now(); asm volatile("" : "+v"(t2_)); E(acc, cur, wr, wc, t2_ & 15, (t2_ >> 4) & 3, part_, t2_); } } S.done(cur); }
        if (!has_next) break;
#pragma unroll
        for (int a = 0; a < 2; ++a)
#pragma unroll
            for (int b = 0; b < 2; ++b)
#pragma unroll
                for (int m = 0; m < 4; ++m)
#pragma unroll
                    for (int n = 0; n < 2; ++n) acc[a][b][m][n] = (f32x4){0.f, 0.f, 0.f, 0.f};
        cur = nxt; cA = nA; cB = nB; ++ui;
        if constexpr (ALIGN_EPI) { if (wr == 1) PG8_BAR; }
    }
    PG8_WAIT_V(0);
    if constexpr (!ALIGN_EPI) { if (wr == 0) PG8_BAR; }
    PG8_BAR;
    if constexpr (Epi::AFTER_DRAIN) { E.fused(acc, cur, wr, wc, fr, fq, lds, wid, lane); S.done(cur); }
#undef PG8_SA
#undef PG8_SB
#undef PG8_STAGE
#undef PG8_LDA
#undef PG8_LDB
#undef PG8_MMA
#undef PG8_WAIT_V
#undef PG8_WAIT_L
#undef PG8_BAR
#undef PG8_SCHED
}
}

#define LAS __attribute__((address_space(3)))
typedef unsigned short bf16_t;
typedef short bf16x8 __attribute__((ext_vector_type(8)));
typedef float f32x4 __attribute__((ext_vector_type(4)));
typedef float f32x2 __attribute__((ext_vector_type(2)));
typedef float f32x16 __attribute__((ext_vector_type(16)));
typedef unsigned u32x4 __attribute__((ext_vector_type(4)));
typedef unsigned u32x2 __attribute__((ext_vector_type(2)));

constexpr int D = 1024, NH = 16, HD = 64;
constexpr int BP = 8, TP = 2064, SEQP = 2048, NMETA = 16, BS = 16, TS = 64, PAST = 4096;
constexpr int MPR = BP * TP;
constexpr int MR = MPR + BS * TS;
constexpr int MP = 17664;
constexpr int NTM = 69;
constexpr int DFF = 2752, DFFP = 2816, NIN = 5632;
constexpr float RMS_EPS = 1e-6f, GN_EPS = 64e-5f;
constexpr float LOG2E = 1.4426950408889634f;

constexpr size_t O_YP = 0, O_YS = 16777216, O_SP = 17825792, O_SHP = 18350080, O_KP = 18358272, O_VP = 35266560,
                 O_SS = 52174848, O_SHS = 53223424, O_KS = 53239808, O_VS = 54288384, O_END = 55336960;

constexpr size_t SZ_ROWBF = (size_t)MP * D * 2, SZ_ROWF = (size_t)MP * D * 4;
constexpr size_t W_X = 0;
constexpr size_t W_XN = W_X + SZ_ROWF;
constexpr size_t W_HB = W_XN + SZ_ROWBF;
constexpr size_t W_WIN = W_HB + (size_t)MP * DFFP * 2;
constexpr size_t SZ_WIN1 = (size_t)NIN * D * 2, SZ_WOUT1 = (size_t)D * DFFP * 2;
constexpr size_t W_WOUT = W_WIN + 4 * SZ_WIN1;
constexpr size_t W_WG1 = W_WOUT + 4 * SZ_WOUT1;
constexpr size_t W_WL2 = W_WG1 + (size_t)3584 * D * 2;
constexpr size_t W_WO1 = W_WL2 + (size_t)3072 * 256 * 2;
constexpr size_t W_WQKV = W_WO1 + (size_t)D * D * 2;
constexpr size_t W_WO2 = W_WQKV + (size_t)3 * D * D * 2;
constexpr size_t W_AALL = W_WO2 + (size_t)D * D * 2;
constexpr size_t W_RKV = W_AALL + 5 * SZ_ROWBF;
constexpr size_t W_L1 = W_RKV + 3 * SZ_ROWBF;
constexpr size_t W_A2 = W_L1 + (size_t)2 * MP * 256 * 4;
constexpr size_t W_DEC = W_A2 + (size_t)MP * 256 * 2;
constexpr size_t W_AA = W_DEC + SZ_ROWBF;
constexpr size_t W_GG = W_AA + SZ_ROWBF;
constexpr size_t W_SO = W_GG + SZ_ROWBF;
constexpr size_t W_OG = W_SO + SZ_ROWF;
constexpr size_t W_QB = W_OG + SZ_ROWBF;
constexpr size_t W_RSQ = W_QB + SZ_ROWBF;
constexpr size_t W_SKF = W_RSQ + (size_t)5 * MP * 4;
constexpr size_t W_SKP = W_SKF + 64 * 1024 * 4;
constexpr size_t W_BAR = W_SKP + (size_t)277 * 262144;
constexpr size_t W_END = W_BAR + 16384;

struct Params { const float* in[31]; float* out; unsigned char* ws; int ph_lo, ph_hi; int seq[64]; };
typedef const Params __attribute__((address_space(4)))* KP;

__device__ __forceinline__ unsigned cvt_pk(float lo, float hi) { unsigned r; asm("v_cvt_pk_bf16_f32 %0, %1, %2" : "=v"(r) : "v"(lo), "v"(hi)); return r; }
__device__ __forceinline__ void store_bf4(bf16_t* p, f32x4 v) { u32x2 w; w.x = cvt_pk(v[0], v[1]); w.y = cvt_pk(v[2], v[3]); *(u32x2*)p = w; }
__device__ __forceinline__ float bf_lo(unsigned w) { return __uint_as_float(w << 16); }
__device__ __forceinline__ float bf_hi(unsigned w) { return __uint_as_float(w & 0xffff0000u); }
__device__ __forceinline__ float sigmoidf_(float x) { return __builtin_amdgcn_rcpf(1.f + __expf(-x)); }
__device__ __forceinline__ float softplusf_(float x) { return fmaxf(x, 0.f) + __logf(1.f + __expf(-fabsf(x))); }
__device__ __forceinline__ float shx(float v, int o, int lane) { return __builtin_bit_cast(float, __builtin_amdgcn_ds_bpermute((lane ^ o) << 2, __builtin_bit_cast(int, v))); }
__device__ __forceinline__ float wave_sum(float v, int lane) {
#pragma unroll
    for (int o = 1; o < 64; o <<= 1) v += shx(v, o, lane);
    return v;
}
__device__ __forceinline__ void row_bt(int row, int& grp, int& b, int& t) { if (row < MPR) { grp = 0; b = row / TP; t = row - b * TP; } else { grp = 1; const int r = row - MPR; b = r >> 6; t = r & 63; } }

using pg8::Unit;
extern __shared__ __attribute__((aligned(16))) unsigned char lds_raw[];
struct EpiSwiGLU {
    static constexpr bool PERM = true, AFTER_DRAIN = false;
    bf16_t* HB; const float* rsq;
    __device__ __forceinline__ void operator()(const f32x4 (&acc)[2][2][4][2], const Unit& u, int wr, int wc, int fr, int fq) const {
        const int row0 = u.pm * 256 + wr * 64 + fr, col0 = u.pn * 128 + wc * 32 + 8 * fq;
#pragma unroll
        for (int ai = 0; ai < 2; ++ai)
#pragma unroll
            for (int m = 0; m < 4; ++m) {
                bf16_t* rowp = HB + (size_t)(row0 + ai * 128 + m * 16) * DFFP + col0;
                const float rs = __builtin_amdgcn_rsqf(rsq[row0 + ai * 128 + m * 16] * (1.f / D) + RMS_EPS), rs2 = rs * rs, c1 = -rs * LOG2E;
                float hv[8];
#pragma unroll
                for (int n = 0; n < 2; ++n)
#pragma unroll
                    for (int j = 0; j < 4; ++j) { const float ag = acc[ai][0][m][n][j], au = acc[ai][1][m][n][j]; hv[n * 4 + j] = (ag * au) * rs2 * __builtin_amdgcn_rcpf(1.f + __builtin_amdgcn_exp2f(ag * c1)); }
                u32x4 w; w.x = cvt_pk(hv[0], hv[1]); w.y = cvt_pk(hv[2], hv[3]); w.z = cvt_pk(hv[4], hv[5]); w.w = cvt_pk(hv[6], hv[7]);
                *(u32x4*)rowp = w;
            }
    }
};
struct EpiRes {
    static constexpr bool PERM = false, AFTER_DRAIN = false;
    float* X; float scale; float* out; bf16_t* XB; float* rsq; float* spl;
    __device__ __forceinline__ void operator()(const f32x4 (&acc)[2][2][4][2], const Unit& u, int wr, int wc, int fr, int fq, const float* part = nullptr, int tid = 0) const {
        const bool hasp = u.fl == 2;
        if (u.fl == 1 && spl != nullptr) {
            const int t_ = (wr * 4 + wc) * 64 + fq * 16 + fr;
            f32x4* q = (f32x4*)(spl + (size_t)u.tl * 65536) + t_;
#pragma unroll
            for (int ai = 0; ai < 2; ++ai)
#pragma unroll
                for (int bj = 0; bj < 2; ++bj)
#pragma unroll
                    for (int m = 0; m < 4; ++m)
#pragma unroll
                        for (int n = 0; n < 2; ++n) q[(((ai * 2 + bj) * 4 + m) * 2 + n) * 512] = acc[ai][bj][m][n];
            return;
        }
        float* const X_ = X; float* const out_ = out; bf16_t* const XB_ = XB; float* const rsq_ = rsq; const float sc_ = scale;
        const int row0 = u.pm * 256 + wr * 64 + fr, col0 = u.pn * 256 + wc * 32 + 4 * fq, ln = fq * 16 + fr;
#pragma unroll
        for (int ai = 0; ai < 2; ++ai)
#pragma unroll
            for (int m = 0; m < 4; ++m) {
                const int row = row0 + ai * 128 + m * 16;
                const unsigned off = (unsigned)row * D + col0;
                if (out_ == nullptr) {
                    float ss = 0.f;
#pragma unroll
                    for (int bj = 0; bj < 2; ++bj)
#pragma unroll
                        for (int n = 0; n < 2; ++n) { f32x4* q = (f32x4*)(X_ + off + bj * 128 + n * 16); f32x4 av = acc[ai][bj][m][n]; if (hasp) av += pg8::streamk_part(part, ((ai * 2 + bj) * 4 + m) * 2 + n, tid); const f32x4 x = *q + av * sc_; *q = x;
                            if (XB_) { store_bf4(XB_ + off + bj * 128 + n * 16, x); ss += (x[0] * x[0] + x[1] * x[1]) + (x[2] * x[2] + x[3] * x[3]); } }
                    if (XB_) { ss += shx(ss, 16, ln); ss += shx(ss, 32, ln); if (fq == 0) unsafeAtomicAdd(rsq_ + row, ss); }
                } else if (row < MR) {
                    float* dp = nullptr;
                    if (row < MPR) { const int b = row / TP, t = row - b * TP; if (t >= NMETA) dp = out_ + O_YP + ((size_t)b * SEQP + (t - NMETA)) * D + col0; }
                    else dp = out_ + O_YS + (size_t)(row - MPR) * D + col0;
                    if (dp) {
#pragma unroll
                        for (int bj = 0; bj < 2; ++bj)
#pragma unroll
                            for (int n = 0; n < 2; ++n) { f32x4 av = acc[ai][bj][m][n]; if (hasp) av += pg8::streamk_part(part, ((ai * 2 + bj) * 4 + m) * 2 + n, tid); *(f32x4*)(dp + bj * 128 + n * 16) = *(const f32x4*)(X_ + off + bj * 128 + n * 16) + av * sc_; }
                    }
                }
                asm volatile("" ::: "memory");
            }
    }
};
struct G2Order {
    static constexpr bool STREAM = false;
    pg8::StaticOrder so;
    __device__ void init(int G, int c) { so.init(MP, 3072, G, c); so.nt0 = 2; }
    __device__ bool next(int i, Unit& u) const { if (!so.next(i, u)) return false; u.kb = (u.pn >> 2) * 128; return true; }
    __device__ __forceinline__ void a_ready(const Unit&) const {}
    __device__ __forceinline__ void done(const Unit&) const {}
};
struct TailSplitOrder {
    static constexpr bool STREAM = false;
    pg8::StaticOrder so; int G, c, ns, ntsplit;
    __device__ void init(int M, int N, int K, int G_, int c_, int ns_) { so.init(M, N, 1, 0); so.nt0 = K / 64; G = G_; c = c_; ns = ns_; ntsplit = so.nt0 / ns_; }
    __device__ bool next(int i, Unit& u) const {
        const int L = i * G + c;
        if (L < G && L < so.nwg) return so.next(L, u);
        const int L2 = L - G; if (so.nwg <= G || L2 < 0 || L2 >= (so.nwg - G) * ns) return false;
        const int j = L2 / ns, ch = L2 - j * ns;
        so.next(G + j, u); u.kb = ch * ntsplit * 128; u.nt = ntsplit; u.fl = 1; u.tl = L2; return true;
    }
    __device__ __forceinline__ void a_ready(const Unit&) const {}
    __device__ __forceinline__ void done(const Unit&) const {}
};
struct StreamOrder {
    static constexpr bool STREAM = true;
    int nN, ppt, c; long s, e;
    __device__ void init(int M, int N, int K, int G, int c_) {
        nN = N / 256; ppt = K / 128;
        c = (G % 8 == 0) ? (c_ % 8) * (G / 8) + c_ / 8 : c_;
        const long P = (long)(M / 256) * nN * ppt;
        s = (long)c * P / G; e = (long)(c + 1) * P / G;
    }
    __device__ bool next(int i, Unit& u) const {
        const int t = (int)(s / ppt) + i; const long t0 = (long)t * ppt;
        if (t0 >= e) return false;
        const long lo = s > t0 ? s : t0, hi = e < t0 + ppt ? e : t0 + ppt;
        u.pm = t / nN; u.pn = t - u.pm * nN; u.tl = t;
        u.kb = (int)(lo - t0) * 256; u.nt = (int)(hi - lo) * 2;
        u.fl = lo > t0 ? 1 : (hi < t0 + ppt ? 2 : 0);
        return true;
    }
    __device__ __forceinline__ void a_ready(const Unit&) const {}
    __device__ __forceinline__ void done(const Unit&) const {}
};
struct EpiG1 {
    static constexpr bool PERM = true, AFTER_DRAIN = false;
    bf16_t* RKV; float* L1;
    __device__ __forceinline__ void operator()(const f32x4 (&acc)[2][2][4][2], const Unit& u, int wr, int wc, int fr, int fq) const {
        const unsigned row0 = (unsigned)((u.pm % NTM) * 256 + wr * 64 + fr), cw = wc * 32 + 8 * fq;
        if (u.pn < 12) {
            bf16_t* base = RKV + (size_t)(u.pn >> 2) * MP * D;
            const unsigned off0 = row0 * D + (u.pn & 3) * 256 + cw;
#pragma unroll
            for (int ai = 0; ai < 2; ++ai)
#pragma unroll
                for (int m = 0; m < 4; ++m)
#pragma unroll
                    for (int bj = 0; bj < 2; ++bj) { const f32x4 v0 = acc[ai][bj][m][0], v1 = acc[ai][bj][m][1];
                        u32x4 w; w.x = cvt_pk(v0[0], v0[1]); w.y = cvt_pk(v0[2], v0[3]); w.z = cvt_pk(v1[0], v1[1]); w.w = cvt_pk(v1[2], v1[3]);
                        *(u32x4*)(base + (off0 + (unsigned)((ai * 128 + m * 16) * D + bj * 128))) = w; }
        } else {
            float* base = L1 + (size_t)(u.pn - 12) * MP * 256;
            const unsigned off0 = row0 * 256 + cw;
#pragma unroll
            for (int ai = 0; ai < 2; ++ai)
#pragma unroll
                for (int m = 0; m < 4; ++m)
#pragma unroll
                    for (int bj = 0; bj < 2; ++bj)
#pragma unroll
                        for (int n = 0; n < 2; ++n) *(f32x4*)(base + (off0 + (unsigned)((ai * 128 + m * 16) * 256 + bj * 128 + n * 4))) = acc[ai][bj][m][n];
        }
    }
};
struct EpiG2 {
    static constexpr bool PERM = true, AFTER_DRAIN = false;
    bf16_t* LW;
    __device__ __forceinline__ void operator()(const f32x4 (&acc)[2][2][4][2], const Unit& u, int wr, int wc, int fr, int fq) const {
        bf16_t* base = LW + (size_t)(u.pn >> 2) * MP * D;
        const unsigned off0 = (unsigned)(u.pm * 256 + wr * 64 + fr) * D + (u.pn & 3) * 256 + wc * 32 + 8 * fq;
#pragma unroll
        for (int ai = 0; ai < 2; ++ai)
#pragma unroll
            for (int m = 0; m < 4; ++m)
#pragma unroll
                for (int bj = 0; bj < 2; ++bj) { const f32x4 v0 = acc[ai][bj][m][0], v1 = acc[ai][bj][m][1];
                    u32x4 w; w.x = cvt_pk(v0[0], v0[1]); w.y = cvt_pk(v0[2], v0[3]); w.z = cvt_pk(v1[0], v1[1]); w.w = cvt_pk(v1[2], v1[3]);
                    *(u32x4*)(base + (off0 + (unsigned)((ai * 128 + m * 16) * D + bj * 128))) = w; }
    }
};
struct EpiQKV {
    static constexpr bool PERM = false, AFTER_DRAIN = false;
    bf16_t* QB; float* out; const float* qg; const float* kg; const float* rsq;
    __device__ __forceinline__ void operator()(const f32x4 (&acc)[2][2][4][2], const Unit& u, int wr, int wc, int fr, int fq) const {
        const int sec = u.pn >> 2, head = (u.pn & 3) * 4 + wc, row0 = u.pm * 256 + wr * 64 + fr;
        f32x4 gn[2][2];
#pragma unroll
        for (int bj = 0; bj < 2; ++bj)
#pragma unroll
            for (int n = 0; n < 2; ++n) { const int d = 32 * bj + 16 * n + 4 * fq;
                gn[bj][n] = sec == 0 ? *(const f32x4*)(qg + d) * 0.125f : (sec == 1 ? *(const f32x4*)(kg + d) : (f32x4){1.f, 1.f, 1.f, 1.f}); }
#pragma unroll
        for (int ai = 0; ai < 2; ++ai)
#pragma unroll
            for (int m = 0; m < 4; ++m) {
                const int row = row0 + ai * 128 + m * 16;
                const float rx = __builtin_amdgcn_rsqf(rsq[row] * (1.f / D) + RMS_EPS);
                float ss = 0.f;
#pragma unroll
                for (int bj = 0; bj < 2; ++bj)
#pragma unroll
                    for (int n = 0; n < 2; ++n) { const f32x4 x = acc[ai][bj][m][n]; ss += (x[0] * x[0] + x[1] * x[1]) + (x[2] * x[2] + x[3] * x[3]); }
                { const int ln = fq * 16 + fr; ss += shx(ss, 16, ln); ss += shx(ss, 32, ln); }
                const float rs = rx * (sec == 2 ? 1.f : __builtin_amdgcn_rsqf(ss * rx * rx * (1.f / 64.f) + RMS_EPS));
                if (row < MR) {
                    if (sec == 0) {
                        bf16_t* qp = QB + (size_t)row * D + head * 64 + 4 * fq;
#pragma unroll
                        for (int bj = 0; bj < 2; ++bj)
#pragma unroll
                            for (int n = 0; n < 2; ++n) { const f32x4 x = acc[ai][bj][m][n] * rs * gn[bj][n]; u32x2 w; w.x = cvt_pk(x[0], x[1]); w.y = cvt_pk(x[2], x[3]); *(u32x2*)(qp + 32 * bj + 16 * n) = w; }
                    } else {
                        int grp, b, t; row_bt(row, grp, b, t);
                        float* dp = grp == 0 ? out + (sec == 1 ? O_KP : O_VP) + (((size_t)b * NH + head) * TP + t) * HD
                                             : out + (sec == 1 ? O_KS : O_VS) + (((size_t)b * NH + head) * TS + t) * HD;
                        dp += 4 * fq;
#pragma unroll
                        for (int bj = 0; bj < 2; ++bj)
#pragma unroll
                            for (int n = 0; n < 2; ++n) *(f32x4*)(dp + 32 * bj + 16 * n) = acc[ai][bj][m][n] * rs * gn[bj][n];
                    }
                }
            }
    }
};
struct G1Order {
    static constexpr bool STREAM = false;
    int G, c;
    __device__ bool next(int i, Unit& u) const {
        const long L = (long)i * G + c; if (L >= 966) return false;
        int w = (int)L; { const int q = 966 / 8, r = 966 % 8, xcd = w % 8, off = w / 8; w = (xcd < r ? xcd * (q + 1) : r * (q + 1) + (xcd - r) * q) + off; }
        const int pm = w / 14, q = w % 14;
        if (q < 12) { u.pm = (q >> 2) * NTM + pm; u.pn = q; } else { u.pm = (q - 9) * NTM + pm; u.pn = q; }
        u.kb = 0; u.nt = 16; u.fl = 0; u.tl = 0;
        return true;
    }
    __device__ __forceinline__ void a_ready(const Unit&) const {}
    __device__ __forceinline__ void done(const Unit&) const {}
};

struct Job { const float* src; bf16_t* dst; const float* mu; int ld, Ksrc, koff, Kdst, rows, map, smode; };
__device__ __forceinline__ int srccol(int map, int n, int ld) {
    if (map == 0) return n < ld ? n : -1;
    if (map == 1) { const int pn = n >> 8, c = n & 255, bj = c >> 7, j = c & 127, hc = pn * 128 + j; return hc < DFF ? (bj ? DFF + hc : hc) : -1; }
    { const int t = n >> 8, c = n & 255, bj = c >> 7, wc = (c & 127) >> 5, i = c & 31; return t * 256 + 64 * wc + 32 * bj + i; }
}
__device__ __forceinline__ Job get_job(KP p, int j) {
    Job J; J.mu = nullptr; J.koff = 0; J.map = 0; J.smode = 0;
    unsigned char* ws = p->ws;
    if (j < 4) { J.src = p->in[8] + (size_t)j * D * 2 * DFF; J.dst = (bf16_t*)(ws + W_WIN + j * SZ_WIN1); J.ld = 2 * DFF; J.Ksrc = D; J.Kdst = D; J.rows = NIN; J.map = 1; J.mu = p->in[7] + (size_t)j * D; J.smode = 2; }
    else if (j < 8) { const int i = j - 4; J.src = p->in[9] + (size_t)i * DFF * D; J.dst = (bf16_t*)(ws + W_WOUT + i * SZ_WOUT1); J.ld = D; J.Ksrc = DFF; J.Kdst = DFFP; J.rows = D; }
    else if (j < 11) { const int g = j - 8; J.src = p->in[12] + (size_t)g * D * D; J.dst = (bf16_t*)(ws + W_WG1) + (size_t)g * D * D; J.ld = D; J.Ksrc = D; J.Kdst = D; J.rows = D; }
    else if (j < 17) { const int idx = j - 11, part = idx / 3, which = idx % 3;
        J.src = which == 0 ? p->in[14] : (which == 1 ? p->in[17] : p->in[19]); J.ld = which == 2 ? 128 : 64; J.rows = J.ld;
        J.mu = p->in[11] + (which == 0 ? 1 : (which == 1 ? 4 : 5)) * D; J.smode = part + 1;
        J.dst = (bf16_t*)(ws + W_WG1) + (size_t)(3072 + part * 256 + which * 64) * D; J.Ksrc = D; J.Kdst = D; }
    else if (j < 20) { const int which = j - 17; J.src = which == 0 ? p->in[15] : (which == 1 ? p->in[18] : p->in[20]); J.ld = D; J.rows = D;
        J.Ksrc = which == 2 ? 128 : 64; J.koff = which * 64; J.Kdst = 256; J.dst = (bf16_t*)(ws + W_WL2) + (size_t)which * D * 256; }
    else if (j == 20) { J.src = p->in[26]; J.dst = (bf16_t*)(ws + W_WO1); J.ld = D; J.Ksrc = D; J.Kdst = D; J.rows = D; }
    else if (j == 21) { J.src = p->in[27]; J.dst = (bf16_t*)(ws + W_WQKV); J.ld = 3 * D; J.Ksrc = D; J.Kdst = D; J.rows = 3 * D; J.map = 2; J.mu = p->in[10] + D; J.smode = 2; }
    else { J.src = p->in[30]; J.dst = (bf16_t*)(ws + W_WO2); J.ld = D; J.Ksrc = D; J.Kdst = D; J.rows = D; }
    return J;
}
__device__ __forceinline__ void convert_weights(KP p, LAS float* tl, int tid, int bid, int G) {
    int rot = 0;
    for (int j = 0; j < 23; ++j) {
        const Job J = get_job(p, j);
        const int nkt = J.Kdst >> 6, nnt = (J.rows + 255) >> 8, ntile = nnt * nkt;
        int first = bid - rot; if (first < 0) first += G;
        for (int t = first; t < ntile; t += G) {
            const int n0 = (t / nkt) << 8, k0 = (t % nkt) << 6;
            const bool inside = k0 >= J.koff && k0 < J.koff + J.Ksrc;
            if (inside) {
                const int nn = tid & 255, kh = tid >> 8;
                const int sc = (n0 + nn) < J.rows ? srccol(J.map, n0 + nn, J.ld) : -1;
                const float* sp = J.src + (size_t)(k0 - J.koff + kh) * J.ld + (sc >= 0 ? sc : 0);
                float v[32];
#pragma unroll
                for (int it = 0; it < 32; ++it) v[it] = sc >= 0 ? sp[(size_t)(2 * it) * J.ld] : 0.f;
                if (J.smode) {
#pragma unroll
                    for (int it = 0; it < 32; ++it) { const float m = J.mu[k0 - J.koff + kh + 2 * it]; v[it] *= J.smode == 1 ? 1.f - m : m; }
                }
#pragma unroll
                for (int it = 0; it < 32; ++it) tl[(kh + 2 * it) * 257 + nn] = v[it];
            }
            __syncthreads();
            {
                const int nn = tid >> 1, kh = (tid & 1) * 32;
                if (n0 + nn < J.rows) {
                    bf16_t* dp = J.dst + (size_t)(n0 + nn) * J.Kdst + k0 + kh;
#pragma unroll
                    for (int q = 0; q < 4; ++q) {
                        const unsigned z_ = (unsigned)tid >> 31;
                        u32x4 w = (u32x4){z_, z_, z_, z_};
                        if (inside) { float v[8];
#pragma unroll
                            for (int e = 0; e < 8; ++e) v[e] = tl[(kh + q * 8 + e) * 257 + nn];
                            w.x = cvt_pk(v[0], v[1]); w.y = cvt_pk(v[2], v[3]); w.z = cvt_pk(v[4], v[5]); w.w = cvt_pk(v[6], v[7]); }
                        *(u32x4*)(dp + q * 8) = w;
                    }
                }
            }
            __syncthreads();
        }
        rot = (rot + ntile) % G;
    }
}
__device__ __forceinline__ float row_rstd(const f32x4 (&v)[4], int lane) {
    float s = 0.f;
#pragma unroll
    for (int i = 0; i < 4; ++i) s += (v[i][0] * v[i][0] + v[i][1] * v[i][1]) + (v[i][2] * v[i][2] + v[i][3] * v[i][3]);
    s = wave_sum(s, lane);
    return __builtin_amdgcn_rsqf(s * (1.f / D) + RMS_EPS);
}

__device__ __forceinline__ void assemble_x(KP p, int tid, int bid, int G) {
    const int lane = tid & 63, gw = bid * 8 + (tid >> 6), nw = G * 8;
    float* X = (float*)(p->ws + W_X); bf16_t* XN = (bf16_t*)(p->ws + W_XN);
    for (int row = gw; row < MP; row += nw) {
        f32x4 v[4];
        const float* src = nullptr;
        if (row < MPR) { const int b = row / TP, t = row - b * TP; src = t < NMETA ? p->in[6] + (size_t)t * D : p->in[0] + ((size_t)b * SEQP + (t - NMETA)) * D; }
        else if (row < MR) src = p->in[1] + (size_t)(row - MPR) * D;
#pragma unroll
        for (int i = 0; i < 4; ++i) { const float zf = __uint_as_float((unsigned)tid >> 31); v[i] = src ? *(const f32x4*)(src + lane * 4 + 256 * i) : (f32x4){zf, zf, zf, zf}; }
        float ssq = 0.f;
#pragma unroll
        for (int i = 0; i < 4; ++i) ssq += (v[i][0] * v[i][0] + v[i][1] * v[i][1]) + (v[i][2] * v[i][2] + v[i][3] * v[i][3]);
        ssq = wave_sum(ssq, lane);
#pragma unroll
        for (int i = 0; i < 4; ++i) { const int c = lane * 4 + 256 * i; *(f32x4*)(X + (size_t)row * D + c) = v[i]; store_bf4(XN + (size_t)row * D + c, v[i]); }
        float* rsq = (float*)(p->ws + W_RSQ);
        if (lane < 5) rsq[(size_t)lane * MP + row] = lane == 0 ? ssq : 0.f;
    }    for (int i = gw * 64 + lane; i < 64 * 1024; i += nw * 64) ((unsigned*)(p->ws + W_SKF))[i] = 0u;
    for (int i = gw * 64 + lane; i < 65536; i += nw * 64) ((float*)(p->ws + W_SKP) + (size_t)276 * 65536)[i] = 0.f;
}
__device__ __forceinline__ void norm_phase(KP p, const float* g, int tid, int bid, int G, bool copy_y = false) {
    const int lane = tid & 63, gw = bid * 8 + (tid >> 6), nw = G * 8;
    const float* X = (const float*)(p->ws + W_X); bf16_t* XN = (bf16_t*)(p->ws + W_XN);
    for (int row = gw; row < MP; row += nw) {
        f32x4 v[4];
#pragma unroll
        for (int i = 0; i < 4; ++i) v[i] = *(const f32x4*)(X + (size_t)row * D + lane * 4 + 256 * i);
        const float rs = row_rstd(v, lane);
#pragma unroll
        for (int i = 0; i < 4; ++i) { const int c = lane * 4 + 256 * i; store_bf4(XN + (size_t)row * D + c, v[i] * rs * *(const f32x4*)(g + c)); }
        if (copy_y && row < MR) {
            float* dp = nullptr;
            if (row < MPR) { const int b = row / TP, t = row - b * TP; if (t >= NMETA) dp = p->out + O_YP + ((size_t)b * SEQP + (t - NMETA)) * D; }
            else dp = p->out + O_YS + (size_t)(row - MPR) * D;
            if (dp) {
#pragma unroll
                for (int i = 0; i < 4; ++i) *(f32x4*)(dp + lane * 4 + 256 * i) = v[i];
            }
        }
    }
}
__device__ __forceinline__ void mixprep_phase(KP p, int tid, int bid, int G) {
    const int lane = tid & 63, gw = bid * 8 + (tid >> 6), nw = G * 8;
    const float* X = (const float*)(p->ws + W_X); bf16_t* A = (bf16_t*)(p->ws + W_AALL);
    const float* g = p->in[10]; const float* mu = p->in[11];
    const int rb = (MR + nw - 1) / nw;
    f32x4 hl[4];
    for (int row = gw * rb, k = 0; k < rb && row < MR; ++row, ++k) {
        int grp, b, t; row_bt(row, grp, b, t);
        f32x4 v[4], pv[4];
#pragma unroll
        for (int i = 0; i < 4; ++i) v[i] = *(const f32x4*)(X + (size_t)row * D + lane * 4 + 256 * i);
        const float rs = row_rstd(v, lane);
        if (t > 0) {
            if (k == 0) {
#pragma unroll
                for (int i = 0; i < 4; ++i) pv[i] = *(const f32x4*)(X + (size_t)(row - 1) * D + lane * 4 + 256 * i);
                const float rp = row_rstd(pv, lane);
#pragma unroll
                for (int i = 0; i < 4; ++i) pv[i] = pv[i] * rp * *(const f32x4*)(g + lane * 4 + 256 * i);
            } else {
#pragma unroll
                for (int i = 0; i < 4; ++i) pv[i] = hl[i];
            }
        } else {
#pragma unroll
            for (int i = 0; i < 4; ++i) { const float zf = __uint_as_float((unsigned)tid >> 31); pv[i] = grp == 0 ? (f32x4){zf, zf, zf, zf} : *(const f32x4*)(p->in[3] + (size_t)b * D + lane * 4 + 256 * i); }
        }
        const bool last = t == (grp == 0 ? TP - 1 : TS - 1);
        float* sh = grp == 0 ? p->out + O_SHP + (size_t)b * D : p->out + O_SHS + (size_t)b * D;
#pragma unroll
        for (int i = 0; i < 4; ++i) {
            const int c = lane * 4 + 256 * i; const size_t o = (size_t)row * D + c;
            const f32x4 h = v[i] * rs * *(const f32x4*)(g + c), dx = pv[i] - h;
            store_bf4(A + o, h + dx * *(const f32x4*)(mu + c));
            store_bf4(A + (size_t)MP * D + o, h + dx * *(const f32x4*)(mu + 2 * D + c));
            store_bf4(A + (size_t)2 * MP * D + o, h + dx * *(const f32x4*)(mu + 3 * D + c));
            store_bf4(A + (size_t)3 * MP * D + o, h);
            store_bf4(A + (size_t)4 * MP * D + o, pv[i]);
            if (last) *(f32x4*)(sh + c) = h;
            hl[i] = h;
        }
    }
}
__device__ __forceinline__ void act_phase(KP p, int gtid, int nthr) {
    const float* L1 = (const float*)(p->ws + W_L1); bf16_t* A2 = (bf16_t*)(p->ws + W_A2);
    for (int i = gtid; i < MP * 64; i += nthr) {
        const int c = (i & 63) * 4;
        f32x4 v = *(const f32x4*)(L1 + (size_t)i * 4) + *(const f32x4*)(L1 + (size_t)MP * 256 + (size_t)i * 4);
        if (c < 64) {
#pragma unroll
            for (int j = 0; j < 4; ++j) v[j] = 1.f - 2.f * __builtin_amdgcn_rcpf(1.f + __expf(2.f * v[j]));
        } else if (c >= 128) {
#pragma unroll
            for (int j = 0; j < 4; ++j) v[j] = sigmoidf_(v[j]);
        }
        store_bf4(A2 + (size_t)i * 4, v);
    }
}

__device__ __forceinline__ float dpp_sum16(float x) {
    x += __builtin_bit_cast(float, __builtin_amdgcn_update_dpp(0, __builtin_bit_cast(int, x), 0xB1, 0xF, 0xF, true));
    x += __builtin_bit_cast(float, __builtin_amdgcn_update_dpp(0, __builtin_bit_cast(int, x), 0x4E, 0xF, 0xF, true));
    x += __builtin_bit_cast(float, __builtin_amdgcn_update_dpp(0, __builtin_bit_cast(int, x), 0x141, 0xF, 0xF, true));
    x += __builtin_bit_cast(float, __builtin_amdgcn_update_dpp(0, __builtin_bit_cast(int, x), 0x140, 0xF, 0xF, true));
    return x;
}
constexpr int SC_CH = 16, SC_STR = 400;
__device__ __forceinline__ void scan_phase(KP p, LAS float* buf, int tid, int bid, int G) {
    const int wid = tid >> 6, lane = tid & 63;
    const bf16_t* RKV = (const bf16_t*)(p->ws + W_RKV); const bf16_t* DEC = (const bf16_t*)(p->ws + W_DEC); const bf16_t* AA = (const bf16_t*)(p->ws + W_AA);
    bf16_t* SO = (bf16_t*)(p->ws + W_SO);
    const bool producer = wid >= 4;
    for (int u = bid; u < 768; u += G) {
        int bh, half, T, row0; const float* S0; float* Sout;
        if (u < 256) { bh = u >> 1; half = u & 1; T = TP; row0 = (bh >> 4) * TP; S0 = nullptr; Sout = p->out + O_SP + (size_t)bh * 4096; }
        else { const int v = u - 256; bh = v >> 1; half = v & 1; T = TS; row0 = MPR + (bh >> 4) * TS; S0 = p->in[2] + (size_t)bh * 4096; Sout = p->out + O_SS + (size_t)bh * 4096; }
        const int h = bh & 15, nchunk = T / SC_CH;
        if (producer) {
            const int t2 = tid - 256, pi = t2 >> 4, pj = t2 & 15, kc = h * 64 + 4 * pj;
            const f32x4 kkv = *(const f32x4*)(p->in[21] + kc), kav = *(const f32x4*)(p->in[22] + kc), w0v = *(const f32x4*)(p->in[13] + kc), a0v = *(const f32x4*)(p->in[16] + kc);
            u32x2 pr, pk, pvv, pa, pd;
#define SC_LOAD(c) do { const size_t o = (size_t)(row0 + (c) * SC_CH + pi) * D + kc; pr = *(const u32x2*)(RKV + o); pk = *(const u32x2*)(RKV + (size_t)MP * D + o); \
            pvv = *(const u32x2*)(RKV + (size_t)2 * MP * D + o); pa = *(const u32x2*)(AA + o); pd = *(const u32x2*)(DEC + o); } while (0)
#define SC_STORE(bi) do { LAS float* rec = buf + (bi) * (SC_CH * SC_STR) + pi * SC_STR; \
            const f32x4 r = (f32x4){bf_lo(pr.x), bf_hi(pr.x), bf_lo(pr.y), bf_hi(pr.y)}, k = (f32x4){bf_lo(pk.x), bf_hi(pk.x), bf_lo(pk.y), bf_hi(pk.y)}; \
            const f32x4 v = (f32x4){bf_lo(pvv.x), bf_hi(pvv.x), bf_lo(pvv.y), bf_hi(pvv.y)}; \
            f32x4 a = (f32x4){bf_lo(pa.x), bf_hi(pa.x), bf_lo(pa.y), bf_hi(pa.y)} + a0v; f32x4 w = (f32x4){bf_lo(pd.x), bf_hi(pd.x), bf_lo(pd.y), bf_hi(pd.y)} + w0v; \
            _Pragma("unroll") for (int j = 0; j < 4; ++j) { a[j] = sigmoidf_(a[j]); w[j] = __expf(-__expf(-softplusf_(-w[j]) - 0.5f)); } \
            const f32x4 q = k * kkv; float ss = (q[0] * q[0] + q[1] * q[1]) + (q[2] * q[2] + q[3] * q[3]); ss = dpp_sum16(ss); \
            const float inv = 1.f / fmaxf(sqrtf(ss), 1e-12f); const f32x4 nk = q * inv; \
            const f32x4 kp = k * (1.f + (a - 1.f) * kav), bb = nk * a; \
            float br = (bb[0] * r[0] + bb[1] * r[1]) + (bb[2] * r[2] + bb[3] * r[3]), kr = (kp[0] * r[0] + kp[1] * r[1]) + (kp[2] * r[2] + kp[3] * r[3]); \
            br = dpp_sum16(br); kr = dpp_sum16(kr); \
            *(LAS f32x4*)(rec + 4 * pj) = w; *(LAS f32x4*)(rec + 64 + 4 * pj) = nk; *(LAS f32x4*)(rec + 128 + 4 * pj) = bb; \
            *(LAS f32x4*)(rec + 192 + 4 * pj) = kp; *(LAS f32x4*)(rec + 256 + 4 * pj) = w * r; *(LAS f32x4*)(rec + 320 + 4 * pj) = v; \
            if (pj == 0) *(LAS f32x2*)(rec + 384) = (f32x2){br, kr}; } while (0)
            SC_LOAD(0); SC_STORE(0);
            if (nchunk > 1) SC_LOAD(1);
            __syncthreads();
            for (int c = 0; c < nchunk; ++c) {
                if (c + 1 < nchunk) { SC_STORE((c + 1) & 1); if (c + 2 < nchunk) SC_LOAD(c + 2); }
                __syncthreads();
            }
#undef SC_LOAD
#undef SC_STORE
        } else {
            const int rp = lane >> 4, kq = lane & 15, vA = half * 32 + wid * 8 + rp * 2;
            f32x4 sA = (f32x4){0.f, 0.f, 0.f, 0.f}, sB = sA;
            if (S0) { sA = *(const f32x4*)(S0 + vA * 64 + kq * 4); sB = *(const f32x4*)(S0 + (vA + 1) * 64 + kq * 4); }
            bf16_t* op = SO + (size_t)(row0 + kq) * D + h * 64 + vA;
            __syncthreads();
            for (int c = 0; c < nchunk; ++c) {
                const LAS float* cb = buf + (c & 1) * (SC_CH * SC_STR);
                float oA = 0.f, oB = 0.f;
#pragma unroll
                for (int i = 0; i < SC_CH; ++i) {
                    const LAS float* rec = cb + i * SC_STR;
                    const f32x4 wd = *(const LAS f32x4*)(rec + kq * 4), kk = *(const LAS f32x4*)(rec + 64 + kq * 4), bb = *(const LAS f32x4*)(rec + 128 + kq * 4),
                                kp = *(const LAS f32x4*)(rec + 192 + kq * 4), wr = *(const LAS f32x4*)(rec + 256 + kq * 4);
                    const f32x2 vv = *(const LAS f32x2*)(rec + 320 + vA), sc = *(const LAS f32x2*)(rec + 384);
                    const f32x2 t1A = sA.hi * kk.hi + sA.lo * kk.lo, t1B = sB.hi * kk.hi + sB.lo * kk.lo, t2A = sA.hi * wr.hi + sA.lo * wr.lo, t2B = sB.hi * wr.hi + sB.lo * wr.lo;
                    float d1A = t1A.x + t1A.y, d1B = t1B.x + t1B.y, d2A = t2A.x + t2A.y, d2B = t2B.x + t2B.y;
#define DPPR(ctl) "v_add_f32_dpp %0, %0, %0 " ctl " row_mask:0xf bank_mask:0xf bound_ctrl:1\n\tv_add_f32_dpp %1, %1, %1 " ctl " row_mask:0xf bank_mask:0xf bound_ctrl:1\n\t" \
                  "v_add_f32_dpp %2, %2, %2 " ctl " row_mask:0xf bank_mask:0xf bound_ctrl:1\n\tv_add_f32_dpp %3, %3, %3 " ctl " row_mask:0xf bank_mask:0xf bound_ctrl:1\n\t"
                    asm("s_nop 1\n\t" DPPR("quad_perm:[1,0,3,2]") DPPR("quad_perm:[2,3,0,1]") DPPR("row_half_mirror") DPPR("row_mirror") : "+v"(d1A), "+v"(d1B), "+v"(d2A), "+v"(d2B));
#undef DPPR
                    const float saA = -d1A, saB = -d1B;
                    const float tA = d2A + saA * sc.x + vv.x * sc.y, tB = d2B + saB * sc.x + vv.y * sc.y;
                    sA = sA * wd + bb * saA + kp * vv.x;
                    sB = sB * wd + bb * saB + kp * vv.y;
                    oA = kq == i ? tA : oA; oB = kq == i ? tB : oB;
                }
                *(unsigned*)(op + (size_t)c * SC_CH * D) = cvt_pk(oA, oB);
                __syncthreads();
            }
            *(f32x4*)(Sout + vA * 64 + kq * 4) = sA; *(f32x4*)(Sout + (vA + 1) * 64 + kq * 4) = sB;
        }
    }
}
__device__ __forceinline__ void post_phase(KP p, int tid, int bid, int G) {
    const int lane = tid & 63, gw = bid * 8 + (tid >> 6), nw = G * 8;
    const bf16_t* RKV = (const bf16_t*)(p->ws + W_RKV); const bf16_t* AA = (const bf16_t*)(p->ws + W_AA); const bf16_t* GG = (const bf16_t*)(p->ws + W_GG);
    const bf16_t* SO = (const bf16_t*)(p->ws + W_SO); bf16_t* OG = (bf16_t*)(p->ws + W_OG);
    const float* k_a = p->in[22]; const float* a0p = p->in[16]; const float* r_k = p->in[23]; const float* gnw = p->in[24]; const float* gnb = p->in[25];
    const int c0 = lane * 16;
    for (int row = gw; row < MR; row += nw) {
        const size_t o = (size_t)row * D + c0;
        float ov[16], rv[16], kv[16], vv[16], av[16], gv[16];
#pragma unroll
#define LD16(dst, ptr) do { const u32x4 a_ = *(const u32x4*)(ptr), b_ = *(const u32x4*)((ptr) + 8); \
        dst[0] = bf_lo(a_.x); dst[1] = bf_hi(a_.x); dst[2] = bf_lo(a_.y); dst[3] = bf_hi(a_.y); dst[4] = bf_lo(a_.z); dst[5] = bf_hi(a_.z); dst[6] = bf_lo(a_.w); dst[7] = bf_hi(a_.w); \
        dst[8] = bf_lo(b_.x); dst[9] = bf_hi(b_.x); dst[10] = bf_lo(b_.y); dst[11] = bf_hi(b_.y); dst[12] = bf_lo(b_.z); dst[13] = bf_hi(b_.z); dst[14] = bf_lo(b_.w); dst[15] = bf_hi(b_.w); } while (0)
        LD16(ov, SO + o); LD16(rv, RKV + o); LD16(kv, RKV + (size_t)MP * D + o); LD16(vv, RKV + (size_t)2 * MP * D + o); LD16(av, AA + o); LD16(gv, GG + o);
#undef LD16
        float sm = 0.f, rk = 0.f;
#pragma unroll
        for (int e = 0; e < 16; ++e) { sm += ov[e]; const float kp = kv[e] * (1.f + (sigmoidf_(a0p[c0 + e] + av[e]) - 1.f) * k_a[c0 + e]); rk += rv[e] * kp * r_k[c0 + e]; }
        sm += shx(sm, 1, lane); sm += shx(sm, 2, lane); rk += shx(rk, 1, lane); rk += shx(rk, 2, lane);
        const float mean = sm * (1.f / 64.f);
        float vs = 0.f;
#pragma unroll
        for (int e = 0; e < 16; ++e) { const float d = ov[e] - mean; vs += d * d; }
        vs += shx(vs, 1, lane); vs += shx(vs, 2, lane);
        const float rstd = __builtin_amdgcn_rsqf(vs * (1.f / 64.f) + GN_EPS);
        unsigned w[8];
#pragma unroll
        for (int e = 0; e < 16; e += 2) {
            const float y0 = ((ov[e] - mean) * rstd * gnw[c0 + e] + gnb[c0 + e] + rk * vv[e]) * gv[e];
            const float y1 = ((ov[e + 1] - mean) * rstd * gnw[c0 + e + 1] + gnb[c0 + e + 1] + rk * vv[e + 1]) * gv[e + 1];
            w[e >> 1] = cvt_pk(y0, y1);
        }
        *(u32x4*)(OG + o) = (u32x4){w[0], w[1], w[2], w[3]}; *(u32x4*)(OG + o + 8) = (u32x4){w[4], w[5], w[6], w[7]};
    }
}

__device__ __forceinline__ int crow(int r, int hi) { return (r & 3) + 8 * (r >> 2) + 4 * hi; }
__device__ __forceinline__ bf16x8 pack8(f32x4 a, f32x4 b) {
    u32x4 w; w.x = cvt_pk(a[0], a[1]); w.y = cvt_pk(a[2], a[3]); w.z = cvt_pk(b[0], b[1]); w.w = cvt_pk(b[2], b[3]);
    return __builtin_bit_cast(bf16x8, w);
}
__device__ __forceinline__ void attn_phase(KP p, int tid, int bid, int G) {
    const int lane = tid & 63, gw = bid * 8 + (tid >> 6), nw = G * 8;
    const bf16_t* QB = (const bf16_t*)(p->ws + W_QB); bf16_t* AO = (bf16_t*)(p->ws + W_OG);
    const int ql = lane & 31, hi = lane >> 5;
    constexpr int NU_P = BP * NH * 65;
    for (int u = gw; u < NU_P + BS * NH * 2; u += nw) {
        int bh, Q0, nq, npast, row_base, Tn; const float *kc, *vc, *kn, *vn;
        const int us = u < BS * NH * 2 ? NU_P + u : (u - BS * NH * 2);
        if (us < NU_P) { const int qbr = us / (BP * NH); bh = us - qbr * (BP * NH); Q0 = (64 - qbr) * 32; nq = min(32, TP - Q0); npast = 0; row_base = (bh >> 4) * TP; Tn = TP;
            kc = nullptr; vc = nullptr; kn = p->out + O_KP + (size_t)bh * TP * HD; vn = p->out + O_VP + (size_t)bh * TP * HD; }
        else { const int v = us - NU_P; bh = v >> 1; Q0 = (v & 1) * 32; nq = 32; npast = PAST; row_base = MPR + (bh >> 4) * TS; Tn = TS;
            kc = p->in[4] + (size_t)bh * PAST * HD; vc = p->in[5] + (size_t)bh * PAST * HD; kn = p->out + O_KS + (size_t)bh * TS * HD; vn = p->out + O_VS + (size_t)bh * TS * HD; }
        const int h = bh & 15, qpos0 = npast + Q0;
        bf16x8 qf[4];
        { const bf16_t* qp = QB + (size_t)(row_base + Q0 + min(ql, nq - 1)) * D + h * 64 + hi * 8;
#pragma unroll
          for (int s = 0; s < 4; ++s) qf[s] = *(const bf16x8*)(qp + 16 * s); }
        f32x16 o0, o1;
#pragma unroll
        for (int r = 0; r < 16; ++r) { o0[r] = 0.f; o1[r] = 0.f; }
        float carry = ql < nq ? 0.f : -1e30f;
        const int qpos = qpos0 + ql;
        f32x4 kc4[8];
#define ATT_TILE_PTRS(P0_, kb_, vb_, lim_) const bool inpast_ = (P0_) < npast; \
            const float* kb_ = inpast_ ? kc + (size_t)(P0_) * HD : kn + (size_t)((P0_) - npast) * HD; \
            const float* vb_ = inpast_ ? vc + (size_t)(P0_) * HD : vn + (size_t)((P0_) - npast) * HD; \
            const int lim_ = inpast_ ? 31 : min(31, Tn - 1 - ((P0_) - npast));
        { ATT_TILE_PTRS((qpos0 >> 5) * 32, kb0, vb0, lim0); (void)vb0;
          const float* kp = kb0 + (size_t)min(ql, lim0) * HD + hi * 8;
#pragma unroll
          for (int s = 0; s < 4; ++s) { kc4[2 * s] = *(const f32x4*)(kp + 16 * s); kc4[2 * s + 1] = *(const f32x4*)(kp + 16 * s + 4); } }
        for (int kt = qpos0 >> 5; kt >= 0; --kt) {
            const int P0 = kt * 32;
            ATT_TILE_PTRS(P0, kb, vb, lim); (void)kb;
            float x0[16], x1[16];
#pragma unroll
            for (int r = 0; r < 16; ++r) { const float* vp = vb + (size_t)min(crow(r, hi), lim) * HD + ql; x0[r] = vp[0]; x1[r] = vp[32]; }
            f32x4 kn4[8];
            { const int Pn = kt > 0 ? P0 - 32 : P0; ATT_TILE_PTRS(Pn, kbn, vbn, limn); (void)vbn;
              const float* kp = kbn + (size_t)min(ql, limn) * HD + hi * 8;
#pragma unroll
              for (int s = 0; s < 4; ++s) { kn4[2 * s] = *(const f32x4*)(kp + 16 * s); kn4[2 * s + 1] = *(const f32x4*)(kp + 16 * s + 4); } }
            f32x16 st;
#pragma unroll
            for (int r = 0; r < 16; ++r) st[r] = 0.f;
#pragma unroll
            for (int s = 0; s < 4; ++s) st = __builtin_amdgcn_mfma_f32_32x32x16_bf16(pack8(kc4[2 * s], kc4[2 * s + 1]), qf[s], st, 0, 0, 0);
            float L[16];
            float own[4];
#pragma unroll
            for (int g = 0; g < 4; ++g) { float sg = 0.f;
#pragma unroll
                for (int i = 0; i < 4; ++i) { const int r = 4 * g + i; const bool vis = (P0 + crow(r, hi)) < qpos; L[r] = vis ? -softplusf_(st[r]) : 0.f; sg += L[r]; }
                own[g] = sg; }
            float oth[4];
#pragma unroll
            for (int g = 0; g < 4; ++g) oth[g] = shx(own[g], 32, lane);
            float suf = carry;
            float A[16];
#pragma unroll
            for (int g = 3; g >= 0; --g) {
                float c = suf + (hi == 0 ? oth[g] : 0.f);
#pragma unroll
                for (int i = 3; i >= 0; --i) { const int r = 4 * g + i; c += L[r]; const bool vis = (P0 + crow(r, hi)) < qpos; A[r] = vis ? __expf(st[r] + c) : 0.f; }
                suf += own[g] + oth[g];
            }
            carry = suf;
            const bf16x8 pa0 = pack8((f32x4){A[0], A[1], A[2], A[3]}, (f32x4){A[4], A[5], A[6], A[7]});
            const bf16x8 pa1 = pack8((f32x4){A[8], A[9], A[10], A[11]}, (f32x4){A[12], A[13], A[14], A[15]});
            o0 = __builtin_amdgcn_mfma_f32_32x32x16_bf16(pa0, pack8((f32x4){x0[0], x0[1], x0[2], x0[3]}, (f32x4){x0[4], x0[5], x0[6], x0[7]}), o0, 0, 0, 0);
            o1 = __builtin_amdgcn_mfma_f32_32x32x16_bf16(pa0, pack8((f32x4){x1[0], x1[1], x1[2], x1[3]}, (f32x4){x1[4], x1[5], x1[6], x1[7]}), o1, 0, 0, 0);
            o0 = __builtin_amdgcn_mfma_f32_32x32x16_bf16(pa1, pack8((f32x4){x0[8], x0[9], x0[10], x0[11]}, (f32x4){x0[12], x0[13], x0[14], x0[15]}), o0, 0, 0, 0);
            o1 = __builtin_amdgcn_mfma_f32_32x32x16_bf16(pa1, pack8((f32x4){x1[8], x1[9], x1[10], x1[11]}, (f32x4){x1[12], x1[13], x1[14], x1[15]}), o1, 0, 0, 0);
#pragma unroll
            for (int e = 0; e < 8; ++e) kc4[e] = kn4[e];
            if (!__any(carry >= -104.f)) break;
        }
#undef ATT_TILE_PTRS
        bf16_t* op = AO + (size_t)(row_base + Q0) * D + h * 64 + ql;
#pragma unroll
        for (int r = 0; r < 16; ++r) { const int qr = crow(r, hi); if (qr < nq) { op[(size_t)qr * D] = (bf16_t)(cvt_pk(o0[r], 0.f) & 0xffffu); op[(size_t)qr * D + 32] = (bf16_t)(cvt_pk(o1[r], 0.f) & 0xffffu); } }
    }
}

template <int NS> __device__ __forceinline__ void fixup_phase(KP p, int ffn, int tid, int bid, int G) {
    float* X = (float*)(p->ws + W_X); bf16_t* XB = (bf16_t*)(p->ws + W_XN); const float* spl = (const float*)(p->ws + W_SKP);
    float* rsq = (float*)(p->ws + W_RSQ) + (size_t)(ffn == 1 ? 2 : (ffn == 2 ? 3 : (ffn == 4 ? 1 : 4))) * MP;
    const bool fold = ffn == 1 || ffn == 2 || ffn >= 4, fin = ffn == 3; const float scl = ffn >= 4 ? 1.0f : 0.5f;
    pg8::StaticOrder so; so.init(MP, D, 1, 0); so.nt0 = 0;
    const int ntail = so.nwg - G; if (ntail <= 0) return;
    const int wid = tid >> 6, lane = tid & 63, wr = wid >> 2, wc = wid & 3, fr = lane & 15, fq = lane >> 4;
    for (int B = bid; B < ntail * 32; B += G) {
        const int j = B >> 5, q = B & 31, n = q & 1, m = (q >> 1) & 3, bj = (q >> 3) & 1, ai = q >> 4;
        Unit u; so.next(G + j, u);
        f32x4 pv_[NS];
#pragma unroll
        for (int ch = 0; ch < NS; ++ch) pv_[ch] = *((const f32x4*)(spl + (size_t)(j * NS + ch) * 65536) + q * 512 + tid);
        f32x4 sum = pv_[0];
#pragma unroll
        for (int ch = 1; ch < NS; ++ch) sum += pv_[ch];
        const int row = u.pm * 256 + ai * 128 + wr * 64 + m * 16 + fr, col = u.pn * 256 + bj * 128 + wc * 32 + n * 16 + fq * 4;
        const size_t off = (size_t)row * D + col;
        const f32x4 x = *(const f32x4*)(X + off) + sum * scl;
        if (!fin) {
            *(f32x4*)(X + off) = x;
            if (fold) { store_bf4(XB + off, x); float ss = (x[0] * x[0] + x[1] * x[1]) + (x[2] * x[2] + x[3] * x[3]); ss += shx(ss, 16, lane); ss += shx(ss, 32, lane); if (fq == 0) unsafeAtomicAdd(rsq + row, ss); }
        } else if (row < MR) {
            float* dp = nullptr;
            if (row < MPR) { const int b = row / TP, t = row - b * TP; if (t >= NMETA) dp = p->out + O_YP + ((size_t)b * SEQP + (t - NMETA)) * D + col; }
            else dp = p->out + O_YS + (size_t)(row - MPR) * D + col;
            if (dp) *(f32x4*)dp = x;
        }
    }
}
#define XB_TMO      128
#define XB_XCNT(j)  (256  + 64 * (j))
#define XB_XSUB(j)  (1280 + 64 * (j))
#define XB_XGEN(j)  (2304 + 64 * (j))
#define XB_TOP      3328
#define XB_TOPGEN   3392
#define XCD_BAR_WORDS 3456
#define XB_SPIN_CAP (1u << 18)

__device__ __forceinline__ unsigned xb_ld(unsigned* p)              { return __hip_atomic_load(p, __ATOMIC_RELAXED, __HIP_MEMORY_SCOPE_AGENT); }
__device__ __forceinline__ unsigned xb_add(unsigned* p, unsigned v) { return __hip_atomic_fetch_add(p, v, __ATOMIC_RELAXED, __HIP_MEMORY_SCOPE_AGENT); }
__device__ __forceinline__ unsigned xb_xcc_id() { return (unsigned)__builtin_amdgcn_s_getreg((3 << 11) | 20) & 0xFu; }
#define XB_SPIN(cond, bar) do { unsigned _sp = 0; while (cond) { __builtin_amdgcn_s_sleep(1); \
    if ((++_sp & 255u) == 0u) { if (xb_ld(&(bar)[XB_TMO])) break; if (_sp > XB_SPIN_CAP) { atomicAdd(&(bar)[XB_TMO], 1u); break; } } } } while (0)

struct XcdBarrier {
    unsigned* bar; unsigned x;
    volatile LAS unsigned* st;
};

__device__ __forceinline__ XcdBarrier xcd_barrier_post(unsigned* bar, volatile LAS unsigned* st, bool xb_tid0) {
    XcdBarrier b; b.bar = bar; b.x = xb_xcc_id(); b.st = st;
    if (xb_tid0) (void)xb_add(&bar[XB_XCNT(b.x)], 1u);
    return b;
}
__device__ __forceinline__ void xcd_barrier_complete(unsigned* bar, unsigned x, unsigned& nloc, unsigned& nx) {
    const unsigned G = gridDim.x * gridDim.y * gridDim.z;
    unsigned sum, cnt, mine, sp = 0u;
    for (;;) {
        sum = 0u; cnt = 0u; mine = 0u;
#pragma unroll
        for (unsigned j = 0; j < 16; ++j) { const unsigned c = xb_ld(&bar[XB_XCNT(j)]); sum += c; cnt += (c > 0u) ? 1u : 0u; mine = (j == x) ? c : mine; }
        if (sum == G) break;
        __builtin_amdgcn_s_sleep(1);
        if ((++sp & 255u) == 0u) { if (xb_ld(&bar[XB_TMO])) break; if (sp > XB_SPIN_CAP) { atomicAdd(&bar[XB_TMO], 1u); break; } }
    }
    nloc = mine > 0u ? mine : 1u; nx = cnt > 0u ? cnt : 1u;
}

__device__ __forceinline__ void xcd_barrier(const XcdBarrier& b, bool xb_tid0) {
    asm volatile("s_waitcnt vmcnt(0)" ::: "memory");
    __syncthreads();
    if (xb_tid0) {
        unsigned* bar = b.bar;
        __builtin_amdgcn_s_waitcnt(0);
        unsigned nloc = b.st[0], nx = b.st[1];
        if (nloc == 0u) { xcd_barrier_complete(bar, b.x, nloc, nx); b.st[0] = nloc; b.st[1] = nx; }
        const unsigned old = xb_add(&bar[XB_XSUB(b.x)], 1u);
        const unsigned gen = old / nloc;
        if (old + 1u == (gen + 1u) * nloc) {
            __builtin_amdgcn_fence(__ATOMIC_RELEASE, "agent");
            asm volatile("s_waitcnt vmcnt(0)" ::: "memory");
            const unsigned og = xb_add(&bar[XB_TOP], 1u);
            const unsigned tg = og / nx;
            if (og + 1u == (tg + 1u) * nx) xb_add(&bar[XB_TOPGEN], 1u);
            else XB_SPIN(xb_ld(&bar[XB_TOPGEN]) == tg, bar);
            __builtin_amdgcn_fence(__ATOMIC_ACQUIRE, "agent");
            xb_add(&bar[XB_XGEN(b.x)], 1u);
            asm volatile("s_waitcnt vmcnt(0)" ::: "memory");
        } else {
            XB_SPIN(xb_ld(&bar[XB_XGEN(b.x)]) == gen, bar);
            __builtin_amdgcn_fence(__ATOMIC_ACQUIRE, "agent");
            asm volatile("s_waitcnt vmcnt(0)" ::: "memory");
        }
    }
    __syncthreads();
}
constexpr int NPHASE = 23;
#ifndef PHM
#define PHM 0xffff
#endif
#define EN(k) (((PHM) >> (k)) & 1)
constexpr int LDS_BYTES = 131072 + 8 * 576 * 4;
template <class Epi, class Sched>
__device__ __forceinline__ void run_gemm(LAS unsigned char* lds, int wb, const bf16_t* A, const bf16_t* Bt, int M, int N, int K, const Sched& S, const Epi& E, float* skp = nullptr, unsigned* skf = nullptr) {
    pg8::Gemm g{A, Bt, M, N, K, wb, skp, skf};
    pg8::gemm_phase<Epi, Sched, GP_ALIGN, GP_SP2>(lds, g, S, E);
}
__global__ void __launch_bounds__(512, 2) mega(Params p_unused) {
    LAS unsigned char* lds = (LAS unsigned char*)lds_raw;
    cg::grid_group grid = cg::this_grid();
    KP p = (KP)__builtin_amdgcn_kernarg_segment_ptr();
    const int ph_lo = p->ph_lo, ph_hi = p->ph_hi;
    const int wb = __builtin_amdgcn_readfirstlane((int)threadIdx.x) & ~63;
    { LAS unsigned* stw = (LAS unsigned*)(lds + 131072); if ((int)threadIdx.x < 2) stw[threadIdx.x] = 0u; __syncthreads(); }
    const XcdBarrier xbar = xcd_barrier_post((unsigned*)(p->ws + W_BAR), (volatile LAS unsigned*)(lds + 131072), threadIdx.x == 0);
    for (int pi_ = ph_lo; pi_ < ph_hi; ++pi_) {
        asm volatile("" ::: "v1","v2","v3","v4","v5","v6","v7","v8","v9","v10","v11","v12","v13","v14","v15","v16","v17","v18","v19","v20","v21","v22","v23","v24","v25","v26","v27","v28","v29","v30","v31","v32","v33","v34","v35","v36","v37","v38","v39","v40","v41","v42","v43","v44","v45","v46","v47","v48","v49","v50","v51","v52","v53","v54","v55","v56","v57","v58","v59","v60","v61","v62","v63","v64","v65","v66","v67","v68","v69","v70","v71","v72","v73","v74","v75","v76","v77","v78","v79","v80","v81","v82","v83","v84","v85","v86","v87","v88","v89","v90","v91","v92","v93","v94","v95","v96","v97","v98","v99","v100","v101","v102","v103","v104","v105","v106","v107","v108","v109","v110","v111","v112","v113","v114","v115","v116","v117","v118","v119","v120","v121","v122","v123","v124","v125","v126","v127","v128","v129","v130","v131","v132","v133","v134","v135","v136","v137","v138","v139","v140","v141","v142","v143","v144","v145","v146","v147","v148","v149","v150","v151","v152","v153","v154","v155","v156","v157","v158","v159","v160","v161","v162","v163","v164","v165","v166","v167","v168","v169","v170","v171","v172","v173","v174","v175","v176","v177","v178","v179","v180","v181","v182","v183","v184","v185","v186","v187","v188","v189","v190","v191","v192","v193","v194","v195","v196","v197","v198","v199","v200","v201","v202","v203","v204","v205","v206","v207","v208","v209","v210","v211","v212","v213","v214","v215","v216","v217","v218","v219","v220","v221","v222","v223","v224","v225","v226","v227","v228","v229","v230","v231","v232","v233","v234","v235","v236","v237","v238","v239","v240","v241","v242","v243","v244","v245","v246","v247","v248","v249");
        asm volatile("" : "+s"(p));
        const int phc = p->seq[pi_], ph = phc & 63; const bool dry = (phc & 64) != 0;
        int bid = blockIdx.x, G = gridDim.x;
        asm volatile("" : "+s"(bid), "+s"(G));
#define TID_HERE (wb + lane_now())
        int ffn = -1; bool ffn_in = false;
        if (ph == 1 || ph == 2) { ffn = 0; ffn_in = ph == 1; } else if (ph == 11 || ph == 12) { ffn = 1; ffn_in = ph == 11; }
        else if (ph == 14 || ph == 15) { ffn = 2; ffn_in = ph == 14; } else if (ph == 21 || ph == 22) { ffn = 3; ffn_in = ph == 21; }
        if (EN(0) && ph == 0) { { const int tid = TID_HERE; convert_weights(p, (LAS float*)lds, tid, bid, G); assemble_x(p, tid, bid, G); } }
        else if (EN(1) && ffn >= 0 && ffn_in) {
            pg8::StaticOrder S; S.init(MP, NIN, G, bid); S.nt0 = D / 64;
            unsigned char* ws = p->ws; EpiSwiGLU E{(bf16_t*)(ws + W_HB), (const float*)(ws + W_RSQ) + (size_t)(ffn == 0 ? 0 : (ffn == 1 ? 1 : (ffn == 2 ? 2 : 4))) * MP};
            run_gemm(lds, wb, (const bf16_t*)(ws + W_XN), (const bf16_t*)(ws + W_WIN + ffn * SZ_WIN1), MP, NIN, D, S, E);
        } else if (EN(2) && ffn >= 0) {
            TailSplitOrder S; S.init(MP, D, DFFP, G, bid, 11);
            unsigned char* ws = p->ws; const bool fold = (ffn == 1 || ffn == 2) && !dry;
            EpiRes E{(float*)(ws + W_X), dry ? 0.f : 0.5f, (ffn == 3 && !dry) ? p->out : nullptr, fold ? (bf16_t*)(ws + W_XN) : nullptr, (float*)(ws + W_RSQ) + (size_t)(ffn == 1 ? 2 : 3) * MP, (float*)(ws + W_SKP)};
            run_gemm(lds, wb, (const bf16_t*)(ws + W_HB), (const bf16_t*)(ws + W_WOUT + ffn * SZ_WOUT1), MP, D, DFFP, S, E, (float*)(ws + W_SKP), (unsigned*)(ws + W_SKF) + pi_ * 1024);
        }
        else if (ph >= 24 && ph < 28) { if (!dry) fixup_phase<11>(p, ph - 24, TID_HERE, bid, G); }
        else if (ph >= 28 && ph < 30) { if (!dry) fixup_phase<WO_NS>(p, ph - 24, TID_HERE, bid, G); }
        else if (EN(3) && ph == 3) mixprep_phase(p, TID_HERE, bid, G);
        else if (EN(4) && ph == 4) {
            G1Order S{G, bid};
            unsigned char* ws = p->ws; EpiG1 E{(bf16_t*)(ws + W_RKV), (float*)(ws + W_L1)};
            run_gemm(lds, wb, (const bf16_t*)(ws + W_AALL), (const bf16_t*)(ws + W_WG1), 5 * MP, 3584, D, S, E);
        }
        else if (EN(5) && ph == 5) act_phase(p, bid * 512 + TID_HERE, G * 512);
        else if (EN(6) && ph == 6) {
            G2Order S; S.init(G, bid);
            unsigned char* ws = p->ws; EpiG2 E{(bf16_t*)(ws + W_DEC)};
            run_gemm(lds, wb, (const bf16_t*)(ws + W_A2), (const bf16_t*)(ws + W_WL2), MP, 3072, 256, S, E);
        }
        else if (EN(7) && ph == 7) scan_phase(p, (LAS float*)lds, TID_HERE, bid, G);
        else if (EN(8) && ph == 8) post_phase(p, TID_HERE, bid, G);
        else if (EN(9) && (ph == 9 || ph == 19)) {
            TailSplitOrder S; S.init(MP, D, D, G, bid, WO_NS);
            unsigned char* ws = p->ws; EpiRes E{(float*)(ws + W_X), dry ? 0.f : 1.0f, nullptr, dry ? nullptr : (bf16_t*)(ws + W_XN), (float*)(ws + W_RSQ) + (size_t)(ph == 9 ? 1 : 4) * MP, (float*)(ws + W_SKP)};
            run_gemm(lds, wb, (const bf16_t*)(ws + W_OG), (const bf16_t*)(ws + (ph == 9 ? W_WO1 : W_WO2)), MP, D, D, S, E, (float*)(ws + W_SKP), (unsigned*)(ws + W_SKF) + pi_ * 1024);
        }
        else if (EN(11) && ph == 17) {
            pg8::StaticOrder S; S.init(MP, 3 * D, G, bid); S.nt0 = D / 64;
            unsigned char* ws = p->ws; EpiQKV E{(bf16_t*)(ws + W_QB), p->out, p->in[28], p->in[29], (const float*)(ws + W_RSQ) + (size_t)3 * MP};
            run_gemm(lds, wb, (const bf16_t*)(ws + W_XN), (const bf16_t*)(ws + W_WQKV), MP, 3 * D, D, S, E);
        }
        else if (EN(12) && ph == 18) attn_phase(p, TID_HERE, bid, G);
        if (pi_ + 1 < ph_hi) { if (pi_ < 0) grid.sync(); else xcd_barrier(xbar, (wb + lane_now()) == 0); }
    }
}

#ifndef ONE_LAUNCH
#define ONE_LAUNCH 1
#endif
extern "C" void kernel_launch(void* const* d_in, const int* in_sizes, int n_in, void* d_out, int out_size, void* d_ws, size_t ws_size, hipStream_t stream) {
    static int grid = 0;
    if (grid == 0) {
        if (n_in != 31 || (size_t)out_size != O_END || ws_size < W_END) { fprintf(stderr, "kernel_launch: unexpected sizes (n_in %d out %d ws %zu need %zu)\n", n_in, out_size, ws_size, (size_t)W_END); grid = -1; return; }
        int dev = 0, cus = 0, per_cu = 0;
        hipGetDevice(&dev); hipDeviceGetAttribute(&cus, hipDeviceAttributeMultiprocessorCount, dev);
        if (hipFuncSetAttribute((const void*)mega, hipFuncAttributeMaxDynamicSharedMemorySize, LDS_BYTES) != hipSuccess) { fprintf(stderr, "kernel_launch: hipFuncSetAttribute failed\n"); grid = -1; return; }
        hipOccupancyMaxActiveBlocksPerMultiprocessor(&per_cu, (const void*)mega, 512, LDS_BYTES);
        (void)hipGetLastError();
        if (per_cu < 1) per_cu = 1;
        grid = cus * per_cu;
    }
    if (grid < 0) return;
    Params p{};
    for (int i = 0; i < 31; ++i) p.in[i] = (const float*)d_in[i];
    p.out = (float*)d_out; p.ws = (unsigned char*)d_ws;
    int nseq = 0;
    for (int ph = 0; ph < NPHASE; ++ph) {
        if (ph == 10 || ph == 13 || ph == 16 || ph == 20) continue;
        p.seq[nseq++] = ph;
        if (ph == 2 || ph == 12 || ph == 15 || ph == 22) p.seq[nseq++] = 24 + (ph == 2 ? 0 : (ph == 12 ? 1 : (ph == 15 ? 2 : 3)));
        if (ph == 9 || ph == 19) p.seq[nseq++] = ph == 9 ? 28 : 29;
#ifdef REP_OF
        for (int r = 0; r < (REP_OF(ph)); ++r) p.seq[nseq++] = (ph | ((ph == 2 || ph == 9) ? 64 : 0));
#endif
    }
#if ONE_LAUNCH
    (void)hipMemsetAsync((unsigned char*)d_ws + W_BAR, 0, 16384, stream);
    p.ph_lo = 0; p.ph_hi = nseq;
    void* args[] = {&p};
    hipError_t e = hipLaunchCooperativeKernel((const void*)mega, dim3(grid), dim3(512), args, LDS_BYTES, stream);
    if (e != hipSuccess) fprintf(stderr, "cooperative launch failed: %s (grid %d)\n", hipGetErrorString(e), grid);
#else
    for (int ph = 0; ph < nseq; ++ph) { p.ph_lo = ph; p.ph_hi = ph + 1; hipLaunchKernelGGL(mega, dim3(grid), dim3(512), LDS_BYTES, stream, p); }
#endif
}
```

```cpp
#define WGM_SET 4
#include <hip/hip_runtime.h>
#include <hip/hip_cooperative_groups.h>
#include <cstdio>
#include <cstdint>
namespace cg = cooperative_groups;
#ifndef GP_SP2
#define GP_SP2 true
#endif
#ifndef GP_ALIGN
#define GP_ALIGN true
#endif
#ifndef WO_NS
#define WO_NS 4
#endif
#ifndef WGM_SET
#define WGM_SET 8
#endif
__device__ __forceinline__ int lane_now() { int l; asm volatile("v_mbcnt_lo_u32_b32 %0, -1, 0\n\tv_mbcnt_hi_u32_b32 %0, -1, %0" : "=v"(l)); return l; }
namespace pg8 {
#define PG8_LAS __attribute__((address_space(3)))
typedef unsigned short bf16_t;
typedef short bf16x8 __attribute__((ext_vector_type(8)));
typedef float f32x4 __attribute__((ext_vector_type(4)));
typedef unsigned u32x4 __attribute__((ext_vector_type(4)));
constexpr int BM = 256, BK = 64, HALF = 128, HTB = HALF * BK * 2  , STAGE_BYTES = 8 * HTB, NXCD = 8, WGM = WGM_SET;

__host__ __device__ __forceinline__ int lds_byte(int r, int c) { const int st = (r >> 4) * 2 + (c >> 5), rr = r & 15, cc = c & 31, ob = rr * 64 + cc * 2; return st * 1024 + (ob ^ (((ob >> 9) & 1) << 5)); }
__host__ __device__ __forceinline__ void stage_rc(int b, int& R, int& C) { const int st = b / 1024, sb = b % 1024, swz = sb ^ (((sb >> 9) & 1) << 5); R = (st >> 1) * 16 + swz / 64; C = (st & 1) * 32 + (swz % 64) / 2; }
__host__ __device__ __forceinline__ int perm32(int rho) { const int n = rho >> 4, i = rho & 15; return 8 * (i >> 2) + 4 * n + (i & 3); }

struct Unit { int pm, pn, kb, nt, fl, tl; };
struct Gemm { const bf16_t* A; const bf16_t* Bt; int M, N, K, wb; float* skp; unsigned* skf; };

struct StaticOrder {
    static constexpr bool STREAM = false; int nM, nN, nwg, G, c, nt0;
    __host__ __device__ void init(int M, int N, int G_, int c_) { nM = M / BM; nN = N / BM; nwg = nM * nN; G = G_; c = c_; }
    __host__ __device__ bool next(int i, Unit& u) const {
        const long L = (long)i * G + c; if (L >= nwg) return false;
        int wgid = (int)L; { const int q = nwg / NXCD, r = nwg % NXCD, xcd = wgid % NXCD, off = wgid / NXCD; wgid = (xcd < r ? xcd * (q + 1) : r * (q + 1) + (xcd - r) * q) + off; }
        const int nig = WGM * nN, gid = wgid / nig, fm = gid * WGM, gsz = (nM - fm) < WGM ? (nM - fm) : WGM;
        u.pm = fm + ((wgid % nig) % gsz); u.pn = (wgid % nig) / gsz; u.kb = 0; u.nt = nt0; u.fl = 0; u.tl = 0; return true;
    }
    __device__ __forceinline__ void a_ready(const Unit&) const {}
    __device__ __forceinline__ void done(const Unit&) const {}
};
typedef __attribute__((address_space(1))) f32x4 gf32x4;
typedef unsigned long long u64_t;
__device__ __forceinline__ void streamk_store(const f32x4 (&acc)[2][2][4][2], const Unit& u, float* skp, unsigned* skf, int tid) {
    u64_t* q = (u64_t*)(skp + (size_t)u.tl * 65536) + 2 * tid;
#pragma unroll
    for (int a = 0; a < 2; ++a)
#pragma unroll
        for (int b = 0; b < 2; ++b)
#pragma unroll
            for (int m = 0; m < 4; ++m)
#pragma unroll
                for (int n = 0; n < 2; ++n) { const f32x4 v = acc[a][b][m][n];
                    __hip_atomic_store(q, ((u64_t)__float_as_uint(v[1]) << 32) | __float_as_uint(v[0]), __ATOMIC_RELAXED, __HIP_MEMORY_SCOPE_AGENT);
                    __hip_atomic_store(q + 1, ((u64_t)__float_as_uint(v[3]) << 32) | __float_as_uint(v[2]), __ATOMIC_RELAXED, __HIP_MEMORY_SCOPE_AGENT);
                    q += 1024; asm volatile("" : "+v"(q) :: "memory"); }
    asm volatile("s_waitcnt vmcnt(0)" ::: "memory");
    __builtin_amdgcn_s_barrier();
    if (tid == 0) __hip_atomic_store(skf + u.tl, 1u, __ATOMIC_RELAXED, __HIP_MEMORY_SCOPE_AGENT);
}
__device__ __forceinline__ const float* streamk_wait(const Unit& u, float* skp, unsigned* skf, int tid) {
    if (u.fl == 2) {
        if (tid == 0) { while (__hip_atomic_load(skf + u.tl, __ATOMIC_RELAXED, __HIP_MEMORY_SCOPE_AGENT) == 0u) __builtin_amdgcn_s_sleep(2); }
        __builtin_amdgcn_s_barrier();
        __builtin_amdgcn_fence(__ATOMIC_ACQUIRE, "agent");
    } else __builtin_amdgcn_s_barrier();
    return skp + (size_t)u.tl * 65536;
}
__device__ __forceinline__ f32x4 streamk_part(const float* part, int idx, int tid) {
    const u64_t* q = (const u64_t*)part + (size_t)idx * 1024 + 2 * tid;
    const u64_t a = __hip_atomic_load(q, __ATOMIC_RELAXED, __HIP_MEMORY_SCOPE_AGENT), b = __hip_atomic_load(q + 1, __ATOMIC_RELAXED, __HIP_MEMORY_SCOPE_AGENT);
    return (f32x4){__uint_as_float((unsigned)a), __uint_as_float((unsigned)(a >> 32)), __uint_as_float((unsigned)b), __uint_as_float((unsigned)(b >> 32))};
}
template <class Epi, class Sched, bool ALIGN_EPI = false, bool SP2 = false>
__device__ __forceinline__ void gemm_phase(PG8_LAS unsigned char* lds, const Gemm g, const Sched& S, const Epi& E) {
    int tid = g.wb + lane_now(); asm volatile("" : "+v"(tid)); const int wid = __builtin_amdgcn_readfirstlane(tid >> 6), lane = tid & 63, wr = wid >> 2, wc = wid & 3, fr = lane & 15, fq = lane >> 4;
    const int K = g.K, nt = K / BK;
    unsigned voffA[2], voffB[2];
#pragma unroll
    for (int i = 0; i < 2; ++i) { int R, C; stage_rc(tid * 16 + i * 8192, R, C); const int Rb = Epi::PERM ? ((R & ~31) + perm32(R & 31)) : R;
        voffA[i] = (unsigned)(R * K + C) * 2u; voffB[i] = (unsigned)(Rb * K + C) * 2u; }
    const size_t kstep = (size_t)(BK * 2);
    const size_t hstep = (size_t)HALF * K * 2;
    const size_t tstep = 2 * hstep;
    const unsigned ldsw = (unsigned)wid * 1024u;
    const int aoff = lds_byte(wr * 64 + fr, fq * 8), boff = lds_byte(wc * 32 + fr, fq * 8);
#define PG8_SA(b, h) (((b) * 2 + (h)) * HTB)
#define PG8_SB(b, h) ((4 + (b) * 2 + (h)) * HTB)
#define PG8_STAGE(bufoff, gbase, voff) do { _Pragma("unroll") for (int _i = 0; _i < 2; ++_i) \
        __builtin_amdgcn_global_load_lds((const unsigned*)((const char*)(gbase) + (voff)[_i]), (PG8_LAS unsigned*)(lds + (bufoff) + ldsw + _i * 8192), 16, 0, 0); } while (0)
#define PG8_LDA(dst, b, h) do { _Pragma("unroll") for (int m = 0; m < 4; ++m) _Pragma("unroll") for (int k = 0; k < 2; ++k) dst[m][k] = *(const PG8_LAS bf16x8*)(lds + PG8_SA(b, h) + aoff + m * 2048 + k * 1024); } while (0)
#define PG8_LDB(dst, b, h) do { _Pragma("unroll") for (int n = 0; n < 2; ++n) _Pragma("unroll") for (int k = 0; k < 2; ++k) dst[n][k] = *(const PG8_LAS bf16x8*)(lds + PG8_SB(b, h) + boff + n * 2048 + k * 1024); } while (0)
#define PG8_MMA(ai, bj, At, Bt) do { __builtin_amdgcn_s_setprio(1); _Pragma("unroll") for (int m = 0; m < 4; ++m) _Pragma("unroll") for (int n = 0; n < 2; ++n) _Pragma("unroll") for (int k = 0; k < 2; ++k) \
        acc[ai][bj][m][n] = __builtin_amdgcn_mfma_f32_16x16x32_bf16(Bt[n][k], At[m][k], acc[ai][bj][m][n], 0, 0, 0); __builtin_amdgcn_s_setprio(0); } while (0)
#define PG8_WAIT_V(n) asm volatile("s_waitcnt vmcnt(" #n ")" ::: "memory")
#define PG8_WAIT_L(n) asm volatile("s_waitcnt lgkmcnt(" #n ")" ::: "memory")
#define PG8_BAR __builtin_amdgcn_s_barrier()
#define PG8_SCHED __builtin_amdgcn_sched_barrier(0)
    Unit cur, nxt; int ui = 0;
    if (!S.next(0, cur)) return;
    f32x4 acc[2][2][4][2];
#pragma unroll
    for (int a = 0; a < 2; ++a)
#pragma unroll
        for (int b = 0; b < 2; ++b)
#pragma unroll
            for (int m = 0; m < 4; ++m)
#pragma unroll
                for (int n = 0; n < 2; ++n) acc[a][b][m][n] = (f32x4){0.f, 0.f, 0.f, 0.f};
    bf16x8 At[4][2], B0[2][2], B1[2][2];
    const char* cA = (const char*)g.A + (size_t)cur.pm * tstep + cur.kb; const char* cB = (const char*)g.Bt + (size_t)cur.pn * tstep + cur.kb;
    S.a_ready(cur);
    if constexpr (SP2) {
        PG8_STAGE(PG8_SB(0, 0), cB, voffB); PG8_STAGE(PG8_SB(0, 1), cB + hstep, voffB); PG8_STAGE(PG8_SA(0, 0), cA, voffA); PG8_STAGE(PG8_SA(0, 1), cA + hstep, voffA);
        if (wr == 1) PG8_BAR;
        PG8_WAIT_V(2); PG8_BAR;
        PG8_STAGE(PG8_SB(1, 0), cB + kstep, voffB); PG8_STAGE(PG8_SA(1, 0), cA + kstep, voffA); PG8_STAGE(PG8_SB(1, 1), cB + hstep + kstep, voffB);
        PG8_WAIT_V(6); PG8_BAR;
    } else {
        PG8_STAGE(PG8_SB(0, 0), cB, voffB); PG8_STAGE(PG8_SA(0, 0), cA, voffA); PG8_STAGE(PG8_SB(0, 1), cB + hstep, voffB); PG8_STAGE(PG8_SA(0, 1), cA + hstep, voffA);
        if (wr == 1) PG8_BAR;
        PG8_WAIT_V(4); PG8_BAR;
        PG8_STAGE(PG8_SB(1, 0), cB + kstep, voffB); PG8_STAGE(PG8_SA(1, 0), cA + kstep, voffA); PG8_STAGE(PG8_SB(1, 1), cB + hstep + kstep, voffB);
        PG8_WAIT_V(6); PG8_BAR;
    }
    for (;;) {
        const bool has_next = S.next(ui + 1, nxt);
        const char* nA = has_next ? (const char*)g.A + (size_t)nxt.pm * tstep + nxt.kb : cA; const char* nB = has_next ? (const char*)g.Bt + (size_t)nxt.pn * tstep + nxt.kb : cB;
        const int ntu = cur.nt;
        for (int t = 0; t < ntu; t += 2) {
            const bool last = (t == ntu - 2);
            const char* a1 = cA + (size_t)(t + 1) * kstep;
            const char* a2 = last ? nA : cA + (size_t)(t + 2) * kstep; const char* b2 = last ? nB : cB + (size_t)(t + 2) * kstep;
            const char* a3 = a2 + kstep; const char* b3 = b2 + kstep;
            if (last && has_next) S.a_ready(nxt);
            if constexpr (SP2) {
            PG8_LDB(B0, 0, 0); PG8_LDB(B1, 0, 1); PG8_SCHED; PG8_LDA(At, 0, 0); PG8_STAGE(PG8_SA(1, 1), a1 + hstep, voffA);
            PG8_WAIT_V(8); PG8_WAIT_L(0); PG8_BAR; PG8_MMA(0, 0, At, B0); PG8_MMA(0, 1, At, B1); PG8_BAR; PG8_SCHED;
            PG8_LDA(At, 0, 1); PG8_STAGE(PG8_SB(0, 0), b2, voffB); PG8_STAGE(PG8_SB(0, 1), b2 + hstep, voffB); PG8_STAGE(PG8_SA(0, 0), a2, voffA);
            PG8_WAIT_V(8); PG8_WAIT_L(0); PG8_BAR; PG8_MMA(1, 0, At, B0); PG8_MMA(1, 1, At, B1); PG8_BAR; PG8_SCHED;
            PG8_LDB(B0, 1, 0); PG8_LDB(B1, 1, 1); PG8_SCHED; PG8_LDA(At, 1, 0); PG8_STAGE(PG8_SA(0, 1), a2 + hstep, voffA);
            PG8_WAIT_V(8); PG8_WAIT_L(0); PG8_BAR; PG8_MMA(0, 0, At, B0); PG8_MMA(0, 1, At, B1); PG8_BAR; PG8_SCHED;
            PG8_LDA(At, 1, 1); PG8_STAGE(PG8_SB(1, 0), b3, voffB); PG8_STAGE(PG8_SB(1, 1), b3 + hstep, voffB); PG8_STAGE(PG8_SA(1, 0), a3, voffA);
            PG8_WAIT_V(8); PG8_WAIT_L(0); PG8_BAR; PG8_MMA(1, 0, At, B0); PG8_MMA(1, 1, At, B1); PG8_BAR; PG8_SCHED;
            } else {
            PG8_LDB(B0, 0, 0); PG8_SCHED; PG8_LDA(At, 0, 0); PG8_STAGE(PG8_SA(1, 1), a1 + hstep, voffA);
            PG8_WAIT_L(8); PG8_BAR; PG8_WAIT_L(0); PG8_MMA(0, 0, At, B0); PG8_BAR; PG8_SCHED;
            PG8_LDB(B1, 0, 1); PG8_STAGE(PG8_SB(0, 0), b2, voffB);
            PG8_BAR; PG8_WAIT_L(0); PG8_MMA(0, 1, At, B1); PG8_BAR;
            PG8_LDA(At, 0, 1); PG8_STAGE(PG8_SA(0, 0), a2, voffA);
            PG8_BAR; PG8_WAIT_L(0); PG8_MMA(1, 0, At, B0); PG8_BAR; PG8_SCHED;
            PG8_STAGE(PG8_SB(0, 1), b2 + hstep, voffB);
            PG8_WAIT_V(6); PG8_BAR; PG8_MMA(1, 1, At, B1); PG8_BAR;
            PG8_LDB(B0, 1, 0); PG8_SCHED; PG8_LDA(At, 1, 0); PG8_STAGE(PG8_SA(0, 1), a2 + hstep, voffA);
            PG8_WAIT_L(8); PG8_BAR; PG8_WAIT_L(0); PG8_MMA(0, 0, At, B0); PG8_BAR; PG8_SCHED;
            PG8_LDB(B1, 1, 1); PG8_STAGE(PG8_SB(1, 0), b3, voffB);
            PG8_BAR; PG8_WAIT_L(0); PG8_MMA(0, 1, At, B1); PG8_BAR;
            PG8_LDA(At, 1, 1); PG8_STAGE(PG8_SA(1, 0), a3, voffA);
            PG8_BAR; PG8_WAIT_L(0); PG8_MMA(1, 0, At, B0); PG8_BAR; PG8_SCHED;
            PG8_STAGE(PG8_SB(1, 1), b3 + hstep, voffB);
            PG8_WAIT_V(6); PG8_BAR; PG8_MMA(1, 1, At, B1); PG8_BAR;
            }
        }
        if constexpr (ALIGN_EPI) { if (wr == 0) PG8_BAR; }
        if constexpr (!Epi::AFTER_DRAIN) { int t_ = g.wb + lane_now(); asm volatile("" : "+v"(t_)); const int fr_ = t_ & 15, fq_ = (t_ >> 4) & 3; if constexpr (!Sched::STREAM) E(acc, cur, wr, wc, fr_, fq_); else { if (cur.fl == 1) streamk_store(acc, cur, g.skp, g.skf, t_); else { const float* part_ = streamk_wait(cur, g.skp, g.skf, t_); int t2_ = g.wb + lane_now(); asm volatile("" : "+v"(t2_)); E(acc, cur, wr, wc, t2_ & 15, (t2_ >> 4) & 3, part_, t2_); } } S.done(cur); }
        if (!has_next) break;
#pragma unroll
        for (int a = 0; a < 2; ++a)
#pragma unroll
            for (int b = 0; b < 2; ++b)
#pragma unroll
                for (int m = 0; m < 4; ++m)
#pragma unroll
                    for (int n = 0; n < 2; ++n) acc[a][b][m][n] = (f32x4){0.f, 0.f, 0.f, 0.f};
        cur = nxt; cA = nA; cB = nB; ++ui;
        if constexpr (ALIGN_EPI) { if (wr == 1) PG8_BAR; }
    }
    PG8_WAIT_V(0);
    if constexpr (!ALIGN_EPI) { if (wr == 0) PG8_BAR; }
    PG8_BAR;
    if constexpr (Epi::AFTER_DRAIN) { E.fused(acc, cur, wr, wc, fr, fq, lds, wid, lane); S.done(cur); }
#undef PG8_SA
#undef PG8_SB
#undef PG8_STAGE
#undef PG8_LDA
#undef PG8_LDB
#undef PG8_MMA
#undef PG8_WAIT_V
#undef PG8_WAIT_L
#undef PG8_BAR
#undef PG8_SCHED
}
}

#define LAS __attribute__((address_space(3)))
typedef unsigned short bf16_t;
typedef short bf16x8 __attribute__((ext_vector_type(8)));
typedef float f32x4 __attribute__((ext_vector_type(4)));
typedef float f32x2 __attribute__((ext_vector_type(2)));
typedef float f32x16 __attribute__((ext_vector_type(16)));
typedef unsigned u32x4 __attribute__((ext_vector_type(4)));
typedef unsigned u32x2 __attribute__((ext_vector_type(2)));

constexpr int D = 1024, NH = 16, HD = 64;
constexpr int BP = 8, TP = 2064, SEQP = 2048, NMETA = 16, BS = 16, TS = 64, PAST = 4096;
constexpr int MPR = BP * TP;
constexpr int MR = MPR + BS * TS;
constexpr int MP = 17664;
constexpr int NTM = 69;
constexpr int DFF = 2752, DFFP = 2816, NIN = 5632;
constexpr float RMS_EPS = 1e-6f, GN_EPS = 64e-5f;
constexpr float LOG2E = 1.4426950408889634f;

constexpr size_t O_YP = 0, O_YS = 16777216, O_SP = 17825792, O_SHP = 18350080, O_KP = 18358272, O_VP = 35266560,
                 O_SS = 52174848, O_SHS = 53223424, O_KS = 53239808, O_VS = 54288384, O_END = 55336960;

constexpr size_t SZ_ROWBF = (size_t)MP * D * 2, SZ_ROWF = (size_t)MP * D * 4;
constexpr size_t W_X = 0;
constexpr size_t W_XN = W_X + SZ_ROWF;
constexpr size_t W_HB = W_XN + SZ_ROWBF;
constexpr size_t W_WIN = W_HB + (size_t)MP * DFFP * 2;
constexpr size_t SZ_WIN1 = (size_t)NIN * D * 2, SZ_WOUT1 = (size_t)D * DFFP * 2;
constexpr size_t W_WOUT = W_WIN + 4 * SZ_WIN1;
constexpr size_t W_WG1 = W_WOUT + 4 * SZ_WOUT1;
constexpr size_t W_WL2 = W_WG1 + (size_t)3584 * D * 2;
constexpr size_t W_WO1 = W_WL2 + (size_t)3072 * 256 * 2;
constexpr size_t W_WQKV = W_WO1 + (size_t)D * D * 2;
constexpr size_t W_WO2 = W_WQKV + (size_t)3 * D * D * 2;
constexpr size_t W_AALL = W_WO2 + (size_t)D * D * 2;
constexpr size_t W_RKV = W_AALL + 5 * SZ_ROWBF;
constexpr size_t W_L1 = W_RKV + 3 * SZ_ROWBF;
constexpr size_t W_A2 = W_L1 + (size_t)2 * MP * 256 * 4;
constexpr size_t W_DEC = W_A2 + (size_t)MP * 256 * 2;
constexpr size_t W_AA = W_DEC + SZ_ROWBF;
constexpr size_t W_GG = W_AA + SZ_ROWBF;
constexpr size_t W_SO = W_GG + SZ_ROWBF;
constexpr size_t W_OG = W_SO + SZ_ROWF;
constexpr size_t W_QB = W_OG + SZ_ROWBF;
constexpr size_t W_RSQ = W_QB + SZ_ROWBF;
constexpr size_t W_SKF = W_RSQ + (size_t)5 * MP * 4;
constexpr size_t W_SKP = W_SKF + 64 * 1024 * 4;
constexpr size_t W_BAR = W_SKP + (size_t)277 * 262144;
constexpr size_t W_END = W_BAR + 16384;

struct Params { const float* in[31]; float* out; unsigned char* ws; int ph_lo, ph_hi; int seq[64]; };
typedef const Params __attribute__((address_space(4)))* KP;

__device__ __forceinline__ unsigned cvt_pk(float lo, float hi) { unsigned r; asm("v_cvt_pk_bf16_f32 %0, %1, %2" : "=v"(r) : "v"(lo), "v"(hi)); return r; }
__device__ __forceinline__ void store_bf4(bf16_t* p, f32x4 v) { u32x2 w; w.x = cvt_pk(v[0], v[1]); w.y = cvt_pk(v[2], v[3]); *(u32x2*)p = w; }
__device__ __forceinline__ float bf_lo(unsigned w) { return __uint_as_float(w << 16); }
__device__ __forceinline__ float bf_hi(unsigned w) { return __uint_as_float(w & 0xffff0000u); }
__device__ __forceinline__ float sigmoidf_(float x) { return __builtin_amdgcn_rcpf(1.f + __expf(-x)); }
__device__ __forceinline__ float softplusf_(float x) { return fmaxf(x, 0.f) + __logf(1.f + __expf(-fabsf(x))); }
__device__ __forceinline__ float shx(float v, int o, int lane) { return __builtin_bit_cast(float, __builtin_amdgcn_ds_bpermute((lane ^ o) << 2, __builtin_bit_cast(int, v))); }
__device__ __forceinline__ float wave_sum(float v, int lane) {
#pragma unroll
    for (int o = 1; o < 64; o <<= 1) v += shx(v, o, lane);
    return v;
}
__device__ __forceinline__ void row_bt(int row, int& grp, int& b, int& t) { if (row < MPR) { grp = 0; b = row / TP; t = row - b * TP; } else { grp = 1; const int r = row - MPR; b = r >> 6; t = r & 63; } }

using pg8::Unit;
extern __shared__ __attribute__((aligned(16))) unsigned char lds_raw[];
struct EpiSwiGLU {
    static constexpr bool PERM = true, AFTER_DRAIN = false;
    bf16_t* HB; const float* rsq;
    __device__ __forceinline__ void operator()(const f32x4 (&acc)[2][2][4][2], const Unit& u, int wr, int wc, int fr, int fq) const {
        const int row0 = u.pm * 256 + wr * 64 + fr, col0 = u.pn * 128 + wc * 32 + 8 * fq;
#pragma unroll
        for (int ai = 0; ai < 2; ++ai)
#pragma unroll
            for (int m = 0; m < 4; ++m) {
                bf16_t* rowp = HB + (size_t)(row0 + ai * 128 + m * 16) * DFFP + col0;
                const float rs = __builtin_amdgcn_rsqf(rsq[row0 + ai * 128 + m * 16] * (1.f / D) + RMS_EPS), rs2 = rs * rs, c1 = -rs * LOG2E;
                float hv[8];
#pragma unroll
                for (int n = 0; n < 2; ++n)
#pragma unroll
                    for (int j = 0; j < 4; ++j) { const float ag = acc[ai][0][m][n][j], au = acc[ai][1][m][n][j]; hv[n * 4 + j] = (ag * au) * rs2 * __builtin_amdgcn_rcpf(1.f + __builtin_amdgcn_exp2f(ag * c1)); }
                u32x4 w; w.x = cvt_pk(hv[0], hv[1]); w.y = cvt_pk(hv[2], hv[3]); w.z = cvt_pk(hv[4], hv[5]); w.w = cvt_pk(hv[6], hv[7]);
                *(u32x4*)rowp = w;
            }
    }
};
struct EpiRes {
    static constexpr bool PERM = false, AFTER_DRAIN = false;
    float* X; float scale; float* out; bf16_t* XB; float* rsq; float* spl;
    __device__ __forceinline__ void operator()(const f32x4 (&acc)[2][2][4][2], const Unit& u, int wr, int wc, int fr, int fq, const float* part = nullptr, int tid = 0) const {
        const bool hasp = u.fl == 2;
        if (u.fl == 1 && spl != nullptr) {
            const int t_ = (wr * 4 + wc) * 64 + fq * 16 + fr;
            f32x4* q = (f32x4*)(spl + (size_t)u.tl * 65536) + t_;
#pragma unroll
            for (int ai = 0; ai < 2; ++ai)
#pragma unroll
                for (int bj = 0; bj < 2; ++bj)
#pragma unroll
                    for (int m = 0; m < 4; ++m)
#pragma unroll
                        for (int n = 0; n < 2; ++n) q[(((ai * 2 + bj) * 4 + m) * 2 + n) * 512] = acc[ai][bj][m][n];
            return;
        }
        float* const X_ = X; float* const out_ = out; bf16_t* const XB_ = XB; float* const rsq_ = rsq; const float sc_ = scale;
        const int row0 = u.pm * 256 + wr * 64 + fr, col0 = u.pn * 256 + wc * 32 + 4 * fq, ln = fq * 16 + fr;
#pragma unroll
        for (int ai = 0; ai < 2; ++ai)
#pragma unroll
            for (int m = 0; m < 4; ++m) {
                const int row = row0 + ai * 128 + m * 16;
                const unsigned off = (unsigned)row * D + col0;
                if (out_ == nullptr) {
                    float ss = 0.f;
#pragma unroll
                    for (int bj = 0; bj < 2; ++bj)
#pragma unroll
                        for (int n = 0; n < 2; ++n) { f32x4* q = (f32x4*)(X_ + off + bj * 128 + n * 16); f32x4 av = acc[ai][bj][m][n]; if (hasp) av += pg8::streamk_part(part, ((ai * 2 + bj) * 4 + m) * 2 + n, tid); const f32x4 x = *q + av * sc_; *q = x;
                            if (XB_) { store_bf4(XB_ + off + bj * 128 + n * 16, x); ss += (x[0] * x[0] + x[1] * x[1]) + (x[2] * x[2] + x[3] * x[3]); } }
                    if (XB_) { ss += shx(ss, 16, ln); ss += shx(ss, 32, ln); if (fq == 0) unsafeAtomicAdd(rsq_ + row, ss); }
                } else if (row < MR) {
                    float* dp = nullptr;
                    if (row < MPR) { const int b = row / TP, t = row - b * TP; if (t >= NMETA) dp = out_ + O_YP + ((size_t)b * SEQP + (t - NMETA)) * D + col0; }
                    else dp = out_ + O_YS + (size_t)(row - MPR) * D + col0;
                    if (dp) {
#pragma unroll
                        for (int bj = 0; bj < 2; ++bj)
#pragma unroll
                            for (int n = 0; n < 2; ++n) { f32x4 av = acc[ai][bj][m][n]; if (hasp) av += pg8::streamk_part(part, ((ai * 2 + bj) * 4 + m) * 2 + n, tid); *(f32x4*)(dp + bj * 128 + n * 16) = *(const f32x4*)(X_ + off + bj * 128 + n * 16) + av * sc_; }
                    }
                }
                asm volatile("" ::: "memory");
            }
    }
};
struct G2Order {
    static constexpr bool STREAM = false;
    pg8::StaticOrder so;
    __device__ void init(int G, int c) { so.init(MP, 3072, G, c); so.nt0 = 2; }
    __device__ bool next(int i, Unit& u) const { if (!so.next(i, u)) return false; u.kb = (u.pn >> 2) * 128; return true; }
    __device__ __forceinline__ void a_ready(const Unit&) const {}
    __device__ __forceinline__ void done(const Unit&) const {}
};
struct TailSplitOrder {
    static constexpr bool STREAM = false;
    pg8::StaticOrder so; int G, c, ns, ntsplit;
    __device__ void init(int M, int N, int K, int G_, int c_, int ns_) { so.init(M, N, 1, 0); so.nt0 = K / 64; G = G_; c = c_; ns = ns_; ntsplit = so.nt0 / ns_; }
    __device__ bool next(int i, Unit& u) const {
        const int L = i * G + c;
        if (L < G && L < so.nwg) return so.next(L, u);
        const int L2 = L - G; if (so.nwg <= G || L2 < 0 || L2 >= (so.nwg - G) * ns) return false;
        const int j = L2 / ns, ch = L2 - j * ns;
        so.next(G + j, u); u.kb = ch * ntsplit * 128; u.nt = ntsplit; u.fl = 1; u.tl = L2; return true;
    }
    __device__ __forceinline__ void a_ready(const Unit&) const {}
    __device__ __forceinline__ void done(const Unit&) const {}
};
struct StreamOrder {
    static constexpr bool STREAM = true;
    int nN, ppt, c; long s, e;
    __device__ void init(int M, int N, int K, int G, int c_) {
        nN = N / 256; ppt = K / 128;
        c = (G % 8 == 0) ? (c_ % 8) * (G / 8) + c_ / 8 : c_;
        const long P = (long)(M / 256) * nN * ppt;
        s = (long)c * P / G; e = (long)(c + 1) * P / G;
    }
    __device__ bool next(int i, Unit& u) const {
        const int t = (int)(s / ppt) + i; const long t0 = (long)t * ppt;
        if (t0 >= e) return false;
        const long lo = s > t0 ? s : t0, hi = e < t0 + ppt ? e : t0 + ppt;
        u.pm = t / nN; u.pn = t - u.pm * nN; u.tl = t;
        u.kb = (int)(lo - t0) * 256; u.nt = (int)(hi - lo) * 2;
        u.fl = lo > t0 ? 1 : (hi < t0 + ppt ? 2 : 0);
        return true;
    }
    __device__ __forceinline__ void a_ready(const Unit&) const {}
    __device__ __forceinline__ void done(const Unit&) const {}
};
struct EpiG1 {
    static constexpr bool PERM = true, AFTER_DRAIN = false;
    bf16_t* RKV; float* L1;
    __device__ __forceinline__ void operator()(const f32x4 (&acc)[2][2][4][2], const Unit& u, int wr, int wc, int fr, int fq) const {
        const unsigned row0 = (unsigned)((u.pm % NTM) * 256 + wr * 64 + fr), cw = wc * 32 + 8 * fq;
        if (u.pn < 12) {
            bf16_t* base = RKV + (size_t)(u.pn >> 2) * MP * D;
            const unsigned off0 = row0 * D + (u.pn & 3) * 256 + cw;
#pragma unroll
            for (int ai = 0; ai < 2; ++ai)
#pragma unroll
                for (int m = 0; m < 4; ++m)
#pragma unroll
                    for (int bj = 0; bj < 2; ++bj) { const f32x4 v0 = acc[ai][bj][m][0], v1 = acc[ai][bj][m][1];
                        u32x4 w; w.x = cvt_pk(v0[0], v0[1]); w.y = cvt_pk(v0[2], v0[3]); w.z = cvt_pk(v1[0], v1[1]); w.w = cvt_pk(v1[2], v1[3]);
                        *(u32x4*)(base + (off0 + (unsigned)((ai * 128 + m * 16) * D + bj * 128))) = w; }
        } else {
            float* base = L1 + (size_t)(u.pn - 12) * MP * 256;
            const unsigned off0 = row0 * 256 + cw;
#pragma unroll
            for (int ai = 0; ai < 2; ++ai)
#pragma unroll
                for (int m = 0; m < 4; ++m)
#pragma unroll
                    for (int bj = 0; bj < 2; ++bj)
#pragma unroll
                        for (int n = 0; n < 2; ++n) *(f32x4*)(base + (off0 + (unsigned)((ai * 128 + m * 16) * 256 + bj * 128 + n * 4))) = acc[ai][bj][m][n];
        }
    }
};
struct EpiG2 {
    static constexpr bool PERM = true, AFTER_DRAIN = false;
    bf16_t* LW;
    __device__ __forceinline__ void operator()(const f32x4 (&acc)[2][2][4][2], const Unit& u, int wr, int wc, int fr, int fq) const {
        bf16_t* base = LW + (size_t)(u.pn >> 2) * MP * D;
        const unsigned off0 = (unsigned)(u.pm * 256 + wr * 64 + fr) * D + (u.pn & 3) * 256 + wc * 32 + 8 * fq;
#pragma unroll
        for (int ai = 0; ai < 2; ++ai)
#pragma unroll
            for (int m = 0; m < 4; ++m)
#pragma unroll
                for (int bj = 0; bj < 2; ++bj) { const f32x4 v0 = acc[ai][bj][m][0], v1 = acc[ai][bj][m][1];
                    u32x4 w; w.x = cvt_pk(v0[0], v0[1]); w.y = cvt_pk(v0[2], v0[3]); w.z = cvt_pk(v1[0], v1[1]); w.w = cvt_pk(v1[2], v1[3]);
                    *(u32x4*)(base + (off0 + (unsigned)((ai * 128 + m * 16) * D + bj * 128))) = w; }
    }
};
struct EpiQKV {
    static constexpr bool PERM = false, AFTER_DRAIN = false;
    bf16_t* QB; float* out; const float* qg; const float* kg; const float* rsq;
    __device__ __forceinline__ void operator()(const f32x4 (&acc)[2][2][4][2], const Unit& u, int wr, int wc, int fr, int fq) const {
        const int sec = u.pn >> 2, head = (u.pn & 3) * 4 + wc, row0 = u.pm * 256 + wr * 64 + fr;
        f32x4 gn[2][2];
#pragma unroll
        for (int bj = 0; bj < 2; ++bj)
#pragma unroll
            for (int n = 0; n < 2; ++n) { const int d = 32 * bj + 16 * n + 4 * fq;
                gn[bj][n] = sec == 0 ? *(const f32x4*)(qg + d) * 0.125f : (sec == 1 ? *(const f32x4*)(kg + d) : (f32x4){1.f, 1.f, 1.f, 1.f}); }
#pragma unroll
        for (int ai = 0; ai < 2; ++ai)
#pragma unroll
            for (int m = 0; m < 4; ++m) {
                const int row = row0 + ai * 128 + m * 16;
                const float rx = __builtin_amdgcn_rsqf(rsq[row] * (1.f / D) + RMS_EPS);
                float ss = 0.f;
#pragma unroll
                for (int bj = 0; bj < 2; ++bj)
#pragma unroll
                    for (int n = 0; n < 2; ++n) { const f32x4 x = acc[ai][bj][m][n]; ss += (x[0] * x[0] + x[1] * x[1]) + (x[2] * x[2] + x[3] * x[3]); }
                { const int ln = fq * 16 + fr; ss += shx(ss, 16, ln); ss += shx(ss, 32, ln); }
                const float rs = rx * (sec == 2 ? 1.f : __builtin_amdgcn_rsqf(ss * rx * rx * (1.f / 64.f) + RMS_EPS));
                if (row < MR) {
                    if (sec == 0) {
                        bf16_t* qp = QB + (size_t)row * D + head * 64 + 4 * fq;
#pragma unroll
                        for (int bj = 0; bj < 2; ++bj)
#pragma unroll
                            for (int n = 0; n < 2; ++n) { const f32x4 x = acc[ai][bj][m][n] * rs * gn[bj][n]; u32x2 w; w.x = cvt_pk(x[0], x[1]); w.y = cvt_pk(x[2], x[3]); *(u32x2*)(qp + 32 * bj + 16 * n) = w; }
                    } else {
                        int grp, b, t; row_bt(row, grp, b, t);
                        float* dp = grp == 0 ? out + (sec == 1 ? O_KP : O_VP) + (((size_t)b * NH + head) * TP + t) * HD
                                             : out + (sec == 1 ? O_KS : O_VS) + (((size_t)b * NH + head) * TS + t) * HD;
                        dp += 4 * fq;
#pragma unroll
                        for (int bj = 0; bj < 2; ++bj)
#pragma unroll
                            for (int n = 0; n < 2; ++n) *(f32x4*)(dp + 32 * bj + 16 * n) = acc[ai][bj][m][n] * rs * gn[bj][n];
                    }
                }
            }
    }
};
struct G1Order {
    static constexpr bool STREAM = false;
    int G, c;
    __device__ bool next(int i, Unit& u) const {
        const long L = (long)i * G + c; if (L >= 966) return false;
        int w = (int)L; { const int q = 966 / 8, r = 966 % 8, xcd = w % 8, off = w / 8; w = (xcd < r ? xcd * (q + 1) : r * (q + 1) + (xcd - r) * q) + off; }
        const int pm = w / 14, q = w % 14;
        if (q < 12) { u.pm = (q >> 2) * NTM + pm; u.pn = q; } else { u.pm = (q - 9) * NTM + pm; u.pn = q; }
        u.kb = 0; u.nt = 16; u.fl = 0; u.tl = 0;
        return true;
    }
    __device__ __forceinline__ void a_ready(const Unit&) const {}
    __device__ __forceinline__ void done(const Unit&) const {}
};

struct Job { const float* src; bf16_t* dst; const float* mu; int ld, Ksrc, koff, Kdst, rows, map, smode; };
__device__ __forceinline__ int srccol(int map, int n, int ld) {
    if (map == 0) return n < ld ? n : -1;
    if (map == 1) { const int pn = n >> 8, c = n & 255, bj = c >> 7, j = c & 127, hc = pn * 128 + j; return hc < DFF ? (bj ? DFF + hc : hc) : -1; }
    { const int t = n >> 8, c = n & 255, bj = c >> 7, wc = (c & 127) >> 5, i = c & 31; return t * 256 + 64 * wc + 32 * bj + i; }
}
__device__ __forceinline__ Job get_job(KP p, int j) {
    Job J; J.mu = nullptr; J.koff = 0; J.map = 0; J.smode = 0;
    unsigned char* ws = p->ws;
    if (j < 4) { J.src = p->in[8] + (size_t)j * D * 2 * DFF; J.dst = (bf16_t*)(ws + W_WIN + j * SZ_WIN1); J.ld = 2 * DFF; J.Ksrc = D; J.Kdst = D; J.rows = NIN; J.map = 1; J.mu = p->in[7] + (size_t)j * D; J.smode = 2; }
    else if (j < 8) { const int i = j - 4; J.src = p->in[9] + (size_t)i * DFF * D; J.dst = (bf16_t*)(ws + W_WOUT + i * SZ_WOUT1); J.ld = D; J.Ksrc = DFF; J.Kdst = DFFP; J.rows = D; }
    else if (j < 11) { const int g = j - 8; J.src = p->in[12] + (size_t)g * D * D; J.dst = (bf16_t*)(ws + W_WG1) + (size_t)g * D * D; J.ld = D; J.Ksrc = D; J.Kdst = D; J.rows = D; }
    else if (j < 17) { const int idx = j - 11, part = idx / 3, which = idx % 3;
        J.src = which == 0 ? p->in[14] : (which == 1 ? p->in[17] : p->in[19]); J.ld = which == 2 ? 128 : 64; J.rows = J.ld;
        J.mu = p->in[11] + (which == 0 ? 1 : (which == 1 ? 4 : 5)) * D; J.smode = part + 1;
        J.dst = (bf16_t*)(ws + W_WG1) + (size_t)(3072 + part * 256 + which * 64) * D; J.Ksrc = D; J.Kdst = D; }
    else if (j < 20) { const int which = j - 17; J.src = which == 0 ? p->in[15] : (which == 1 ? p->in[18] : p->in[20]); J.ld = D; J.rows = D;
        J.Ksrc = which == 2 ? 128 : 64; J.koff = which * 64; J.Kdst = 256; J.dst = (bf16_t*)(ws + W_WL2) + (size_t)which * D * 256; }
    else if (j == 20) { J.src = p->in[26]; J.dst = (bf16_t*)(ws + W_WO1); J.ld = D; J.Ksrc = D; J.Kdst = D; J.rows = D; }
    else if (j == 21) { J.src = p->in[27]; J.dst = (bf16_t*)(ws + W_WQKV); J.ld = 3 * D; J.Ksrc = D; J.Kdst = D; J.rows = 3 * D; J.map = 2; J.mu = p->in[10] + D; J.smode = 2; }
    else { J.src = p->in[30]; J.dst = (bf16_t*)(ws + W_WO2); J.ld = D; J.Ksrc = D; J.Kdst = D; J.rows = D; }
    return J;
}
__device__ __forceinline__ void convert_weights(KP p, LAS float* tl, int tid, int bid, int G) {
    int rot = 0;
    for (int j = 0; j < 23; ++j) {
        const Job J = get_job(p, j);
        const int nkt = J.Kdst >> 6, nnt = (J.rows + 255) >> 8, ntile = nnt * nkt;
        int first = bid - rot; if (first < 0) first += G;
        for (int t = first; t < ntile; t += G) {
            const int n0 = (t / nkt) << 8, k0 = (t % nkt) << 6;
            const bool inside = k0 >= J.koff && k0 < J.koff + J.Ksrc;
            if (inside) {
                const int nn = tid & 255, kh = tid >> 8;
                const int sc = (n0 + nn) < J.rows ? srccol(J.map, n0 + nn, J.ld) : -1;
                const float* sp = J.src + (size_t)(k0 - J.koff + kh) * J.ld + (sc >= 0 ? sc : 0);
                float v[32];
#pragma unroll
                for (int it = 0; it < 32; ++it) v[it] = sc >= 0 ? sp[(size_t)(2 * it) * J.ld] : 0.f;
                if (J.smode) {
#pragma unroll
                    for (int it = 0; it < 32; ++it) { const float m = J.mu[k0 - J.koff + kh + 2 * it]; v[it] *= J.smode == 1 ? 1.f - m : m; }
                }
#pragma unroll
                for (int it = 0; it < 32; ++it) tl[(kh + 2 * it) * 257 + nn] = v[it];
            }
            __syncthreads();
            {
                const int nn = tid >> 1, kh = (tid & 1) * 32;
                if (n0 + nn < J.rows) {
                    bf16_t* dp = J.dst + (size_t)(n0 + nn) * J.Kdst + k0 + kh;
#pragma unroll
                    for (int q = 0; q < 4; ++q) {
                        const unsigned z_ = (unsigned)tid >> 31;
                        u32x4 w = (u32x4){z_, z_, z_, z_};
                        if (inside) { float v[8];
#pragma unroll
                            for (int e = 0; e < 8; ++e) v[e] = tl[(kh + q * 8 + e) * 257 + nn];
                            w.x = cvt_pk(v[0], v[1]); w.y = cvt_pk(v[2], v[3]); w.z = cvt_pk(v[4], v[5]); w.w = cvt_pk(v[6], v[7]); }
                        *(u32x4*)(dp + q * 8) = w;
                    }
                }
            }
            __syncthreads();
        }
        rot = (rot + ntile) % G;
    }
}
__device__ __forceinline__ float row_rstd(const f32x4 (&v)[4], int lane) {
    float s = 0.f;
#pragma unroll
    for (int i = 0; i < 4; ++i) s += (v[i][0] * v[i][0] + v[i][1] * v[i][1]) + (v[i][2] * v[i][2] + v[i][3] * v[i][3]);
    s = wave_sum(s, lane);
    return __builtin_amdgcn_rsqf(s * (1.f / D) + RMS_EPS);
}

__device__ __forceinline__ void assemble_x(KP p, int tid, int bid, int G) {
    const int lane = tid & 63, gw = bid * 8 + (tid >> 6), nw = G * 8;
    float* X = (float*)(p->ws + W_X); bf16_t* XN = (bf16_t*)(p->ws + W_XN);
    for (int row = gw; row < MP; row += nw) {
        f32x4 v[4];
        const float* src = nullptr;
        if (row < MPR) { const int b = row / TP, t = row - b * TP; src = t < NMETA ? p->in[6] + (size_t)t * D : p->in[0] + ((size_t)b * SEQP + (t - NMETA)) * D; }
        else if (row < MR) src = p->in[1] + (size_t)(row - MPR) * D;
#pragma unroll
        for (int i = 0; i < 4; ++i) { const float zf = __uint_as_float((unsigned)tid >> 31); v[i] = src ? *(const f32x4*)(src + lane * 4 + 256 * i) : (f32x4){zf, zf, zf, zf}; }
        float ssq = 0.f;
#pragma unroll
        for (int i = 0; i < 4; ++i) ssq += (v[i][0] * v[i][0] + v[i][1] * v[i][1]) + (v[i][2] * v[i][2] + v[i][3] * v[i][3]);
        ssq = wave_sum(ssq, lane);
#pragma unroll
        for (int i = 0; i < 4; ++i) { const int c = lane * 4 + 256 * i; *(f32x4*)(X + (size_t)row * D + c) = v[i]; store_bf4(XN + (size_t)row * D + c, v[i]); }
        float* rsq = (float*)(p->ws + W_RSQ);
        if (lane < 5) rsq[(size_t)lane * MP + row] = lane == 0 ? ssq : 0.f;
    }    for (int i = gw * 64 + lane; i < 64 * 1024; i += nw * 64) ((unsigned*)(p->ws + W_SKF))[i] = 0u;
    for (int i = gw * 64 + lane; i < 65536; i += nw * 64) ((float*)(p->ws + W_SKP) + (size_t)276 * 65536)[i] = 0.f;
}
__device__ __forceinline__ void norm_phase(KP p, const float* g, int tid, int bid, int G, bool copy_y = false) {
    const int lane = tid & 63, gw = bid * 8 + (tid >> 6), nw = G * 8;
    const float* X = (const float*)(p->ws + W_X); bf16_t* XN = (bf16_t*)(p->ws + W_XN);
    for (int row = gw; row < MP; row += nw) {
        f32x4 v[4];
#pragma unroll
        for (int i = 0; i < 4; ++i) v[i] = *(const f32x4*)(X + (size_t)row * D + lane * 4 + 256 * i);
        const float rs = row_rstd(v, lane);
#pragma unroll
        for (int i = 0; i < 4; ++i) { const int c = lane * 4 + 256 * i; store_bf4(XN + (size_t)row * D + c, v[i] * rs * *(const f32x4*)(g + c)); }
        if (copy_y && row < MR) {
            float* dp = nullptr;
            if (row < MPR) { const int b = row / TP, t = row - b * TP; if (t >= NMETA) dp = p->out + O_YP + ((size_t)b * SEQP + (t - NMETA)) * D; }
            else dp = p->out + O_YS + (size_t)(row - MPR) * D;
            if (dp) {
#pragma unroll
                for (int i = 0; i < 4; ++i) *(f32x4*)(dp + lane * 4 + 256 * i) = v[i];
            }
        }
    }
}
__device__ __forceinline__ void mixprep_phase(KP p, int tid, int bid, int G) {
    const int lane = tid & 63, gw = bid * 8 + (tid >> 6), nw = G * 8;
    const float* X = (const float*)(p->ws + W_X); bf16_t* A = (bf16_t*)(p->ws + W_AALL);
    const float* g = p->in[10]; const float* mu = p->in[11];
    const int rb = (MR + nw - 1) / nw;
    f32x4 hl[4];
    for (int row = gw * rb, k = 0; k < rb && row < MR; ++row, ++k) {
        int grp, b, t; row_bt(row, grp, b, t);
        f32x4 v[4], pv[4];
#pragma unroll
        for (int i = 0; i < 4; ++i) v[i] = *(const f32x4*)(X + (size_t)row * D + lane * 4 + 256 * i);
        const float rs = row_rstd(v, lane);
        if (t > 0) {
            if (k == 0) {
#pragma unroll
                for (int i = 0; i < 4; ++i) pv[i] = *(const f32x4*)(X + (size_t)(row - 1) * D + lane * 4 + 256 * i);
                const float rp = row_rstd(pv, lane);
#pragma unroll
                for (int i = 0; i < 4; ++i) pv[i] = pv[i] * rp * *(const f32x4*)(g + lane * 4 + 256 * i);
            } else {
#pragma unroll
                for (int i = 0; i < 4; ++i) pv[i] = hl[i];
            }
        } else {
#pragma unroll
            for (int i = 0; i < 4; ++i) { const float zf = __uint_as_float((unsigned)tid >> 31); pv[i] = grp == 0 ? (f32x4){zf, zf, zf, zf} : *(const f32x4*)(p->in[3] + (size_t)b * D + lane * 4 + 256 * i); }
        }
        const bool last = t == (grp == 0 ? TP - 1 : TS - 1);
        float* sh = grp == 0 ? p->out + O_SHP + (size_t)b * D : p->out + O_SHS + (size_t)b * D;
#pragma unroll
        for (int i = 0; i < 4; ++i) {
            const int c = lane * 4 + 256 * i; const size_t o = (size_t)row * D + c;
            const f32x4 h = v[i] * rs * *(const f32x4*)(g + c), dx = pv[i] - h;
            store_bf4(A + o, h + dx * *(const f32x4*)(mu + c));
            store_bf4(A + (size_t)MP * D + o, h + dx * *(const f32x4*)(mu + 2 * D + c));
            store_bf4(A + (size_t)2 * MP * D + o, h + dx * *(const f32x4*)(mu + 3 * D + c));
            store_bf4(A + (size_t)3 * MP * D + o, h);
            store_bf4(A + (size_t)4 * MP * D + o, pv[i]);
            if (last) *(f32x4*)(sh + c) = h;
            hl[i] = h;
        }
    }
}
__device__ __forceinline__ void act_phase(KP p, int gtid, int nthr) {
    const float* L1 = (const float*)(p->ws + W_L1); bf16_t* A2 = (bf16_t*)(p->ws + W_A2);
    for (int i = gtid; i < MP * 64; i += nthr) {
        const int c = (i & 63) * 4;
        f32x4 v = *(const f32x4*)(L1 + (size_t)i * 4) + *(const f32x4*)(L1 + (size_t)MP * 256 + (size_t)i * 4);
        if (c < 64) {
#pragma unroll
            for (int j = 0; j < 4; ++j) v[j] = 1.f - 2.f * __builtin_amdgcn_rcpf(1.f + __expf(2.f * v[j]));
        } else if (c >= 128) {
#pragma unroll
            for (int j = 0; j < 4; ++j) v[j] = sigmoidf_(v[j]);
        }
        store_bf4(A2 + (size_t)i * 4, v);
    }
}

__device__ __forceinline__ float dpp_sum16(float x) {
    x += __builtin_bit_cast(float, __builtin_amdgcn_update_dpp(0, __builtin_bit_cast(int, x), 0xB1, 0xF, 0xF, true));
    x += __builtin_bit_cast(float, __builtin_amdgcn_update_dpp(0, __builtin_bit_cast(int, x), 0x4E, 0xF, 0xF, true));
    x += __builtin_bit_cast(float, __builtin_amdgcn_update_dpp(0, __builtin_bit_cast(int, x), 0x141, 0xF, 0xF, true));
    x += __builtin_bit_cast(float, __builtin_amdgcn_update_dpp(0, __builtin_bit_cast(int, x), 0x140, 0xF, 0xF, true));
    return x;
}
constexpr int SC_CH = 16, SC_STR = 400;
__device__ __forceinline__ void scan_phase(KP p, LAS float* buf, int tid, int bid, int G) {
    const int wid = tid >> 6, lane = tid & 63;
    const bf16_t* RKV = (const bf16_t*)(p->ws + W_RKV); const bf16_t* DEC = (const bf16_t*)(p->ws + W_DEC); const bf16_t* AA = (const bf16_t*)(p->ws + W_AA);
    bf16_t* SO = (bf16_t*)(p->ws + W_SO);
    const bool producer = wid >= 4;
    for (int u = bid; u < 768; u += G) {
        int bh, half, T, row0; const float* S0; float* Sout;
        if (u < 256) { bh = u >> 1; half = u & 1; T = TP; row0 = (bh >> 4) * TP; S0 = nullptr; Sout = p->out + O_SP + (size_t)bh * 4096; }
        else { const int v = u - 256; bh = v >> 1; half = v & 1; T = TS; row0 = MPR + (bh >> 4) * TS; S0 = p->in[2] + (size_t)bh * 4096; Sout = p->out + O_SS + (size_t)bh * 4096; }
        const int h = bh & 15, nchunk = T / SC_CH;
        if (producer) {
            const int t2 = tid - 256, pi = t2 >> 4, pj = t2 & 15, kc = h * 64 + 4 * pj;
            const f32x4 kkv = *(const f32x4*)(p->in[21] + kc), kav = *(const f32x4*)(p->in[22] + kc), w0v = *(const f32x4*)(p->in[13] + kc), a0v = *(const f32x4*)(p->in[16] + kc);
            u32x2 pr, pk, pvv, pa, pd;
#define SC_LOAD(c) do { const size_t o = (size_t)(row0 + (c) * SC_CH + pi) * D + kc; pr = *(const u32x2*)(RKV + o); pk = *(const u32x2*)(RKV + (size_t)MP * D + o); \
            pvv = *(const u32x2*)(RKV + (size_t)2 * MP * D + o); pa = *(const u32x2*)(AA + o); pd = *(const u32x2*)(DEC + o); } while (0)
#define SC_STORE(bi) do { LAS float* rec = buf + (bi) * (SC_CH * SC_STR) + pi * SC_STR; \
            const f32x4 r = (f32x4){bf_lo(pr.x), bf_hi(pr.x), bf_lo(pr.y), bf_hi(pr.y)}, k = (f32x4){bf_lo(pk.x), bf_hi(pk.x), bf_lo(pk.y), bf_hi(pk.y)}; \
            const f32x4 v = (f32x4){bf_lo(pvv.x), bf_hi(pvv.x), bf_lo(pvv.y), bf_hi(pvv.y)}; \
            f32x4 a = (f32x4){bf_lo(pa.x), bf_hi(pa.x), bf_lo(pa.y), bf_hi(pa.y)} + a0v; f32x4 w = (f32x4){bf_lo(pd.x), bf_hi(pd.x), bf_lo(pd.y), bf_hi(pd.y)} + w0v; \
            _Pragma("unroll") for (int j = 0; j < 4; ++j) { a[j] = sigmoidf_(a[j]); w[j] = __expf(-__expf(-softplusf_(-w[j]) - 0.5f)); } \
            const f32x4 q = k * kkv; float ss = (q[0] * q[0] + q[1] * q[1]) + (q[2] * q[2] + q[3] * q[3]); ss = dpp_sum16(ss); \
            const float inv = 1.f / fmaxf(sqrtf(ss), 1e-12f); const f32x4 nk = q * inv; \
            const f32x4 kp = k * (1.f + (a - 1.f) * kav), bb = nk * a; \
            float br = (bb[0] * r[0] + bb[1] * r[1]) + (bb[2] * r[2] + bb[3] * r[3]), kr = (kp[0] * r[0] + kp[1] * r[1]) + (kp[2] * r[2] + kp[3] * r[3]); \
            br = dpp_sum16(br); kr = dpp_sum16(kr); \
            *(LAS f32x4*)(rec + 4 * pj) = w; *(LAS f32x4*)(rec + 64 + 4 * pj) = nk; *(LAS f32x4*)(rec + 128 + 4 * pj) = bb; \
            *(LAS f32x4*)(rec + 192 + 4 * pj) = kp; *(LAS f32x4*)(rec + 256 + 4 * pj) = w * r; *(LAS f32x4*)(rec + 320 + 4 * pj) = v; \
            if (pj == 0) *(LAS f32x2*)(rec + 384) = (f32x2){br, kr}; } while (0)
            SC_LOAD(0); SC_STORE(0);
            if (nchunk > 1) SC_LOAD(1);
            __syncthreads();
            for (int c = 0; c < nchunk; ++c) {
                if (c + 1 < nchunk) { SC_STORE((c + 1) & 1); if (c + 2 < nchunk) SC_LOAD(c + 2); }
                __syncthreads();
            }
#undef SC_LOAD
#undef SC_STORE
        } else {
            const int rp = lane >> 4, kq = lane & 15, vA = half * 32 + wid * 8 + rp * 2;
            f32x4 sA = (f32x4){0.f, 0.f, 0.f, 0.f}, sB = sA;
            if (S0) { sA = *(const f32x4*)(S0 + vA * 64 + kq * 4); sB = *(const f32x4*)(S0 + (vA + 1) * 64 + kq * 4); }
            bf16_t* op = SO + (size_t)(row0 + kq) * D + h * 64 + vA;
            __syncthreads();
            for (int c = 0; c < nchunk; ++c) {
                const LAS float* cb = buf + (c & 1) * (SC_CH * SC_STR);
                float oA = 0.f, oB = 0.f;
#pragma unroll
                for (int i = 0; i < SC_CH; ++i) {
                    const LAS float* rec = cb + i * SC_STR;
                    const f32x4 wd = *(const LAS f32x4*)(rec + kq * 4), kk = *(const LAS f32x4*)(rec + 64 + kq * 4), bb = *(const LAS f32x4*)(rec + 128 + kq * 4),
                                kp = *(const LAS f32x4*)(rec + 192 + kq * 4), wr = *(const LAS f32x4*)(rec + 256 + kq * 4);
                    const f32x2 vv = *(const LAS f32x2*)(rec + 320 + vA), sc = *(const LAS f32x2*)(rec + 384);
                    const f32x2 t1A = sA.hi * kk.hi + sA.lo * kk.lo, t1B = sB.hi * kk.hi + sB.lo * kk.lo, t2A = sA.hi * wr.hi + sA.lo * wr.lo, t2B = sB.hi * wr.hi + sB.lo * wr.lo;
                    float d1A = t1A.x + t1A.y, d1B = t1B.x + t1B.y, d2A = t2A.x + t2A.y, d2B = t2B.x + t2B.y;
#define DPPR(ctl) "v_add_f32_dpp %0, %0, %0 " ctl " row_mask:0xf bank_mask:0xf bound_ctrl:1\n\tv_add_f32_dpp %1, %1, %1 " ctl " row_mask:0xf bank_mask:0xf bound_ctrl:1\n\t" \
                  "v_add_f32_dpp %2, %2, %2 " ctl " row_mask:0xf bank_mask:0xf bound_ctrl:1\n\tv_add_f32_dpp %3, %3, %3 " ctl " row_mask:0xf bank_mask:0xf bound_ctrl:1\n\t"
                    asm("s_nop 1\n\t" DPPR("quad_perm:[1,0,3,2]") DPPR("quad_perm:[2,3,0,1]") DPPR("row_half_mirror") DPPR("row_mirror") : "+v"(d1A), "+v"(d1B), "+v"(d2A), "+v"(d2B));
#undef DPPR
                    const float saA = -d1A, saB = -d1B;
                    const float tA = d2A + saA * sc.x + vv.x * sc.y, tB = d2B + saB * sc.x + vv.y * sc.y;
                    sA = sA * wd + bb * saA + kp * vv.x;
                    sB = sB * wd + bb * saB + kp * vv.y;
                    oA = kq == i ? tA : oA; oB = kq == i ? tB : oB;
                }
                *(unsigned*)(op + (size_t)c * SC_CH * D) = cvt_pk(oA, oB);
                __syncthreads();
            }
            *(f32x4*)(Sout + vA * 64 + kq * 4) = sA; *(f32x4*)(Sout + (vA + 1) * 64 + kq * 4) = sB;
        }
    }
}
__device__ __forceinline__ void post_phase(KP p, int tid, int bid, int G) {
    const int lane = tid & 63, gw = bid * 8 + (tid >> 6), nw = G * 8;
    const bf16_t* RKV = (const bf16_t*)(p->ws + W_RKV); const bf16_t* AA = (const bf16_t*)(p->ws + W_AA); const bf16_t* GG = (const bf16_t*)(p->ws + W_GG);
    const bf16_t* SO = (const bf16_t*)(p->ws + W_SO); bf16_t* OG = (bf16_t*)(p->ws + W_OG);
    const float* k_a = p->in[22]; const float* a0p = p->in[16]; const float* r_k = p->in[23]; const float* gnw = p->in[24]; const float* gnb = p->in[25];
    const int c0 = lane * 16;
    for (int row = gw; row < MR; row += nw) {
        const size_t o = (size_t)row * D + c0;
        float ov[16], rv[16], kv[16], vv[16], av[16], gv[16];
#pragma unroll
#define LD16(dst, ptr) do { const u32x4 a_ = *(const u32x4*)(ptr), b_ = *(const u32x4*)((ptr) + 8); \
        dst[0] = bf_lo(a_.x); dst[1] = bf_hi(a_.x); dst[2] = bf_lo(a_.y); dst[3] = bf_hi(a_.y); dst[4] = bf_lo(a_.z); dst[5] = bf_hi(a_.z); dst[6] = bf_lo(a_.w); dst[7] = bf_hi(a_.w); \
        dst[8] = bf_lo(b_.x); dst[9] = bf_hi(b_.x); dst[10] = bf_lo(b_.y); dst[11] = bf_hi(b_.y); dst[12] = bf_lo(b_.z); dst[13] = bf_hi(b_.z); dst[14] = bf_lo(b_.w); dst[15] = bf_hi(b_.w); } while (0)
        LD16(ov, SO + o); LD16(rv, RKV + o); LD16(kv, RKV + (size_t)MP * D + o); LD16(vv, RKV + (size_t)2 * MP * D + o); LD16(av, AA + o); LD16(gv, GG + o);
#undef LD16
        float sm = 0.f, rk = 0.f;
#pragma unroll
        for (int e = 0; e < 16; ++e) { sm += ov[e]; const float kp = kv[e] * (1.f + (sigmoidf_(a0p[c0 + e] + av[e]) - 1.f) * k_a[c0 + e]); rk += rv[e] * kp * r_k[c0 + e]; }
        sm += shx(sm, 1, lane); sm += shx(sm, 2, lane); rk += shx(rk, 1, lane); rk += shx(rk, 2, lane);
        const float mean = sm * (1.f / 64.f);
        float vs = 0.f;
#pragma unroll
        for (int e = 0; e < 16; ++e) { const float d = ov[e] - mean; vs += d * d; }
        vs += shx(vs, 1, lane); vs += shx(vs, 2, lane);
        const float rstd = __builtin_amdgcn_rsqf(vs * (1.f / 64.f) + GN_EPS);
        unsigned w[8];
#pragma unroll
        for (int e = 0; e < 16; e += 2) {
            const float y0 = ((ov[e] - mean) * rstd * gnw[c0 + e] + gnb[c0 + e] + rk * vv[e]) * gv[e];
            const float y1 = ((ov[e + 1] - mean) * rstd * gnw[c0 + e + 1] + gnb[c0 + e + 1] + rk * vv[e + 1]) * gv[e + 1];
            w[e >> 1] = cvt_pk(y0, y1);
        }
        *(u32x4*)(OG + o) = (u32x4){w[0], w[1], w[2], w[3]}; *(u32x4*)(OG + o + 8) = (u32x4){w[4], w[5], w[6], w[7]};
    }
}

__device__ __forceinline__ int crow(int r, int hi) { return (r & 3) + 8 * (r >> 2) + 4 * hi; }
__device__ __forceinline__ bf16x8 pack8(f32x4 a, f32x4 b) {
    u32x4 w; w.x = cvt_pk(a[0], a[1]); w.y = cvt_pk(a[2], a[3]); w.z = cvt_pk(b[0], b[1]); w.w = cvt_pk(b[2], b[3]);
    return __builtin_bit_cast(bf16x8, w);
}
__device__ __forceinline__ void attn_phase(KP p, int tid, int bid, int G) {
    const int lane = tid & 63, gw = bid * 8 + (tid >> 6), nw = G * 8;
    const bf16_t* QB = (const bf16_t*)(p->ws + W_QB); bf16_t* AO = (bf16_t*)(p->ws + W_OG);
    const int ql = lane & 31, hi = lane >> 5;
    constexpr int NU_P = BP * NH * 65;
    for (int u = gw; u < NU_P + BS * NH * 2; u += nw) {
        int bh, Q0, nq, npast, row_base, Tn; const float *kc, *vc, *kn, *vn;
        const int us = u < BS * NH * 2 ? NU_P + u : (u - BS * NH * 2);
        if (us < NU_P) { const int qbr = us / (BP * NH); bh = us - qbr * (BP * NH); Q0 = (64 - qbr) * 32; nq = min(32, TP - Q0); npast = 0; row_base = (bh >> 4) * TP; Tn = TP;
            kc = nullptr; vc = nullptr; kn = p->out + O_KP + (size_t)bh * TP * HD; vn = p->out + O_VP + (size_t)bh * TP * HD; }
        else { const int v = us - NU_P; bh = v >> 1; Q0 = (v & 1) * 32; nq = 32; npast = PAST; row_base = MPR + (bh >> 4) * TS; Tn = TS;
            kc = p->in[4] + (size_t)bh * PAST * HD; vc = p->in[5] + (size_t)bh * PAST * HD; kn = p->out + O_KS + (size_t)bh * TS * HD; vn = p->out + O_VS + (size_t)bh * TS * HD; }
        const int h = bh & 15, qpos0 = npast + Q0;
        bf16x8 qf[4];
        { const bf16_t* qp = QB + (size_t)(row_base + Q0 + min(ql, nq - 1)) * D + h * 64 + hi * 8;
#pragma unroll
          for (int s = 0; s < 4; ++s) qf[s] = *(const bf16x8*)(qp + 16 * s); }
        f32x16 o0, o1;
#pragma unroll
        for (int r = 0; r < 16; ++r) { o0[r] = 0.f; o1[r] = 0.f; }
        float carry = ql < nq ? 0.f : -1e30f;
        const int qpos = qpos0 + ql;
        f32x4 kc4[8];
#define ATT_TILE_PTRS(P0_, kb_, vb_, lim_) const bool inpast_ = (P0_) < npast; \
            const float* kb_ = inpast_ ? kc + (size_t)(P0_) * HD : kn + (size_t)((P0_) - npast) * HD; \
            const float* vb_ = inpast_ ? vc + (size_t)(P0_) * HD : vn + (size_t)((P0_) - npast) * HD; \
            const int lim_ = inpast_ ? 31 : min(31, Tn - 1 - ((P0_) - npast));
        { ATT_TILE_PTRS((qpos0 >> 5) * 32, kb0, vb0, lim0); (void)vb0;
          const float* kp = kb0 + (size_t)min(ql, lim0) * HD + hi * 8;
#pragma unroll
          for (int s = 0; s < 4; ++s) { kc4[2 * s] = *(const f32x4*)(kp + 16 * s); kc4[2 * s + 1] = *(const f32x4*)(kp + 16 * s + 4); } }
        for (int kt = qpos0 >> 5; kt >= 0; --kt) {
            const int P0 = kt * 32;
            ATT_TILE_PTRS(P0, kb, vb, lim); (void)kb;
            float x0[16], x1[16];
#pragma unroll
            for (int r = 0; r < 16; ++r) { const float* vp = vb + (size_t)min(crow(r, hi), lim) * HD + ql; x0[r] = vp[0]; x1[r] = vp[32]; }
            f32x4 kn4[8];
            { const int Pn = kt > 0 ? P0 - 32 : P0; ATT_TILE_PTRS(Pn, kbn, vbn, limn); (void)vbn;
              const float* kp = kbn + (size_t)min(ql, limn) * HD + hi * 8;
#pragma unroll
              for (int s = 0; s < 4; ++s) { kn4[2 * s] = *(const f32x4*)(kp + 16 * s); kn4[2 * s + 1] = *(const f32x4*)(kp + 16 * s + 4); } }
            f32x16 st;
#pragma unroll
            for (int r = 0; r < 16; ++r) st[r] = 0.f;
#pragma unroll
            for (int s = 0; s < 4; ++s) st = __builtin_amdgcn_mfma_f32_32x32x16_bf16(pack8(kc4[2 * s], kc4[2 * s + 1]), qf[s], st, 0, 0, 0);
            float L[16];
            float own[4];
#pragma unroll
            for (int g = 0; g < 4; ++g) { float sg = 0.f;
#pragma unroll
                for (int i = 0; i < 4; ++i) { const int r = 4 * g + i; const bool vis = (P0 + crow(r, hi)) < qpos; L[r] = vis ? -softplusf_(st[r]) : 0.f; sg += L[r]; }
                own[g] = sg; }
            float oth[4];
#pragma unroll
            for (int g = 0; g < 4; ++g) oth[g] = shx(own[g], 32, lane);
            float suf = carry;
            float A[16];
#pragma unroll
            for (int g = 3; g >= 0; --g) {
                float c = suf + (hi == 0 ? oth[g] : 0.f);
#pragma unroll
                for (int i = 3; i >= 0; --i) { const int r = 4 * g + i; c += L[r]; const bool vis = (P0 + crow(r, hi)) < qpos; A[r] = vis ? __expf(st[r] + c) : 0.f; }
                suf += own[g] + oth[g];
            }
            carry = suf;
            const bf16x8 pa0 = pack8((f32x4){A[0], A[1], A[2], A[3]}, (f32x4){A[4], A[5], A[6], A[7]});
            const bf16x8 pa1 = pack8((f32x4){A[8], A[9], A[10], A[11]}, (f32x4){A[12], A[13], A[14], A[15]});
            o0 = __builtin_amdgcn_mfma_f32_32x32x16_bf16(pa0, pack8((f32x4){x0[0], x0[1], x0[2], x0[3]}, (f32x4){x0[4], x0[5], x0[6], x0[7]}), o0, 0, 0, 0);
            o1 = __builtin_amdgcn_mfma_f32_32x32x16_bf16(pa0, pack8((f32x4){x1[0], x1[1], x1[2], x1[3]}, (f32x4){x1[4], x1[5], x1[6], x1[7]}), o1, 0, 0, 0);
            o0 = __builtin_amdgcn_mfma_f32_32x32x16_bf16(pa1, pack8((f32x4){x0[8], x0[9], x0[10], x0[11]}, (f32x4){x0[12], x0[13], x0[14], x0[15]}), o0, 0, 0, 0);
            o1 = __builtin_amdgcn_mfma_f32_32x32x16_bf16(pa1, pack8((f32x4){x1[8], x1[9], x1[10], x1[11]}, (f32x4){x1[12], x1[13], x1[14], x1[15]}), o1, 0, 0, 0);
#pragma unroll
            for (int e = 0; e < 8; ++e) kc4[e] = kn4[e];
            if (!__any(carry >= -104.f)) break;
        }
#undef ATT_TILE_PTRS
        bf16_t* op = AO + (size_t)(row_base + Q0) * D + h * 64 + ql;
#pragma unroll
        for (int r = 0; r < 16; ++r) { const int qr = crow(r, hi); if (qr < nq) { op[(size_t)qr * D] = (bf16_t)(cvt_pk(o0[r], 0.f) & 0xffffu); op[(size_t)qr * D + 32] = (bf16_t)(cvt_pk(o1[r], 0.f) & 0xffffu); } }
    }
}

template <int NS> __device__ __forceinline__ void fixup_phase(KP p, int ffn, int tid, int bid, int G) {
    float* X = (float*)(p->ws + W_X); bf16_t* XB = (bf16_t*)(p->ws + W_XN); const float* spl = (const float*)(p->ws + W_SKP);
    float* rsq = (float*)(p->ws + W_RSQ) + (size_t)(ffn == 1 ? 2 : (ffn == 2 ? 3 : (ffn == 4 ? 1 : 4))) * MP;
    const bool fold = ffn == 1 || ffn == 2 || ffn >= 4, fin = ffn == 3; const float scl = ffn >= 4 ? 1.0f : 0.5f;
    pg8::StaticOrder so; so.init(MP, D, 1, 0); so.nt0 = 0;
    const int ntail = so.nwg - G; if (ntail <= 0) return;
    const int wid = tid >> 6, lane = tid & 63, wr = wid >> 2, wc = wid & 3, fr = lane & 15, fq = lane >> 4;
    for (int B = bid; B < ntail * 32; B += G) {
        const int j = B >> 5, q = B & 31, n = q & 1, m = (q >> 1) & 3, bj = (q >> 3) & 1, ai = q >> 4;
        Unit u; so.next(G + j, u);
        f32x4 pv_[NS];
#pragma unroll
        for (int ch = 0; ch < NS; ++ch) pv_[ch] = *((const f32x4*)(spl + (size_t)(j * NS + ch) * 65536) + q * 512 + tid);
        f32x4 sum = pv_[0];
#pragma unroll
        for (int ch = 1; ch < NS; ++ch) sum += pv_[ch];
        const int row = u.pm * 256 + ai * 128 + wr * 64 + m * 16 + fr, col = u.pn * 256 + bj * 128 + wc * 32 + n * 16 + fq * 4;
        const size_t off = (size_t)row * D + col;
        const f32x4 x = *(const f32x4*)(X + off) + sum * scl;
        if (!fin) {
            *(f32x4*)(X + off) = x;
            if (fold) { store_bf4(XB + off, x); float ss = (x[0] * x[0] + x[1] * x[1]) + (x[2] * x[2] + x[3] * x[3]); ss += shx(ss, 16, lane); ss += shx(ss, 32, lane); if (fq == 0) unsafeAtomicAdd(rsq + row, ss); }
        } else if (row < MR) {
            float* dp = nullptr;
            if (row < MPR) { const int b = row / TP, t = row - b * TP; if (t >= NMETA) dp = p->out + O_YP + ((size_t)b * SEQP + (t - NMETA)) * D + col; }
            else dp = p->out + O_YS + (size_t)(row - MPR) * D + col;
            if (dp) *(f32x4*)dp = x;
        }
    }
}
#define XB_TMO      128
#define XB_XCNT(j)  (256  + 64 * (j))
#define XB_XSUB(j)  (1280 + 64 * (j))
#define XB_XGEN(j)  (2304 + 64 * (j))
#define XB_TOP      3328
#define XB_TOPGEN   3392
#define XCD_BAR_WORDS 3456
#define XB_SPIN_CAP (1u << 18)

__device__ __forceinline__ unsigned xb_ld(unsigned* p)              { return __hip_atomic_load(p, __ATOMIC_RELAXED, __HIP_MEMORY_SCOPE_AGENT); }
__device__ __forceinline__ unsigned xb_add(unsigned* p, unsigned v) { return __hip_atomic_fetch_add(p, v, __ATOMIC_RELAXED, __HIP_MEMORY_SCOPE_AGENT); }
__device__ __forceinline__ unsigned xb_xcc_id() { return (unsigned)__builtin_amdgcn_s_getreg((3 << 11) | 20) & 0xFu; }
#define XB_SPIN(cond, bar) do { unsigned _sp = 0; while (cond) { __builtin_amdgcn_s_sleep(1); \
    if ((++_sp & 255u) == 0u) { if (xb_ld(&(bar)[XB_TMO])) break; if (_sp > XB_SPIN_CAP) { atomicAdd(&(bar)[XB_TMO], 1u); break; } } } } while (0)

struct XcdBarrier {
    unsigned* bar; unsigned x;
    volatile LAS unsigned* st;
};

__device__ __forceinline__ XcdBarrier xcd_barrier_post(unsigned* bar, volatile LAS unsigned* st, bool xb_tid0) {
    XcdBarrier b; b.bar = bar; b.x = xb_xcc_id(); b.st = st;
    if (xb_tid0) (void)xb_add(&bar[XB_XCNT(b.x)], 1u);
    return b;
}
__device__ __forceinline__ void xcd_barrier_complete(unsigned* bar, unsigned x, unsigned& nloc, unsigned& nx) {
    const unsigned G = gridDim.x * gridDim.y * gridDim.z;
    unsigned sum, cnt, mine, sp = 0u;
    for (;;) {
        sum = 0u; cnt = 0u; mine = 0u;
#pragma unroll
        for (unsigned j = 0; j < 16; ++j) { const unsigned c = xb_ld(&bar[XB_XCNT(j)]); sum += c; cnt += (c > 0u) ? 1u : 0u; mine = (j == x) ? c : mine; }
        if (sum == G) break;
        __builtin_amdgcn_s_sleep(1);
        if ((++sp & 255u) == 0u) { if (xb_ld(&bar[XB_TMO])) break; if (sp > XB_SPIN_CAP) { atomicAdd(&bar[XB_TMO], 1u); break; } }
    }
    nloc = mine > 0u ? mine : 1u; nx = cnt > 0u ? cnt : 1u;
}

__device__ __forceinline__ void xcd_barrier(const XcdBarrier& b, bool xb_tid0) {
    asm volatile("s_waitcnt vmcnt(0)" ::: "memory");
    __syncthreads();
    if (xb_tid0) {
        unsigned* bar = b.bar;
        __builtin_amdgcn_s_waitcnt(0);
        unsigned nloc = b.st[0], nx = b.st[1];
        if (nloc == 0u) { xcd_barrier_complete(bar, b.x, nloc, nx); b.st[0] = nloc; b.st[1] = nx; }
        const unsigned old = xb_add(&bar[XB_XSUB(b.x)], 1u);
        const unsigned gen = old / nloc;
        if (old + 1u == (gen + 1u) * nloc) {
            __builtin_amdgcn_fence(__ATOMIC_RELEASE, "agent");
            asm volatile("s_waitcnt vmcnt(0)" ::: "memory");
            const unsigned og = xb_add(&bar[XB_TOP], 1u);
            const unsigned tg = og / nx;
            if (og + 1u == (tg + 1u) * nx) xb_add(&bar[XB_TOPGEN], 1u);
            else XB_SPIN(xb_ld(&bar[XB_TOPGEN]) == tg, bar);
            __builtin_amdgcn_fence(__ATOMIC_ACQUIRE, "agent");
            xb_add(&bar[XB_XGEN(b.x)], 1u);
            asm volatile("s_waitcnt vmcnt(0)" ::: "memory");
        } else {
            XB_SPIN(xb_ld(&bar[XB_XGEN(b.x)]) == gen, bar);
            __builtin_amdgcn_fence(__ATOMIC_ACQUIRE, "agent");
            asm volatile("s_waitcnt vmcnt(0)" ::: "memory");
        }
    }
    __syncthreads();
}
constexpr int NPHASE = 23;
#ifndef PHM
#define PHM 0xffff
#endif
#define EN(k) (((PHM) >> (k)) & 1)
constexpr int LDS_BYTES = 131072 + 8 * 576 * 4;
template <class Epi, class Sched>
__device__ __forceinline__ void run_gemm(LAS unsigned char* lds, int wb, const bf16_t* A, const bf16_t* Bt, int M, int N, int K, const Sched& S, const Epi& E, float* skp = nullptr, unsigned* skf = nullptr) {
    pg8::Gemm g{A, Bt, M, N, K, wb, skp, skf};
    pg8::gemm_phase<Epi, Sched, GP_ALIGN, GP_SP2>(lds, g, S, E);
}
__global__ void __launch_bounds__(512, 2) mega(Params p_unused) {
    LAS unsigned char* lds = (LAS unsigned char*)lds_raw;
    cg::grid_group grid = cg::this_grid();
    KP p = (KP)__builtin_amdgcn_kernarg_segment_ptr();
    const int ph_lo = p->ph_lo, ph_hi = p->ph_hi;
    const int wb = __builtin_amdgcn_readfirstlane((int)threadIdx.x) & ~63;
    { LAS unsigned* stw = (LAS unsigned*)(lds + 131072); if ((int)threadIdx.x < 2) stw[threadIdx.x] = 0u; __syncthreads(); }
    const XcdBarrier xbar = xcd_barrier_post((unsigned*)(p->ws + W_BAR), (volatile LAS unsigned*)(lds + 131072), threadIdx.x == 0);
    for (int pi_ = ph_lo; pi_ < ph_hi; ++pi_) {
        asm volatile("" ::: "v1","v2","v3","v4","v5","v6","v7","v8","v9","v10","v11","v12","v13","v14","v15","v16","v17","v18","v19","v20","v21","v22","v23","v24","v25","v26","v27","v28","v29","v30","v31","v32","v33","v34","v35","v36","v37","v38","v39","v40","v41","v42","v43","v44","v45","v46","v47","v48","v49","v50","v51","v52","v53","v54","v55","v56","v57","v58","v59","v60","v61","v62","v63","v64","v65","v66","v67","v68","v69","v70","v71","v72","v73","v74","v75","v76","v77","v78","v79","v80","v81","v82","v83","v84","v85","v86","v87","v88","v89","v90","v91","v92","v93","v94","v95","v96","v97","v98","v99","v100","v101","v102","v103","v104","v105","v106","v107","v108","v109","v110","v111","v112","v113","v114","v115","v116","v117","v118","v119","v120","v121","v122","v123","v124","v125","v126","v127","v128","v129","v130","v131","v132","v133","v134","v135","v136","v137","v138","v139","v140","v141","v142","v143","v144","v145","v146","v147","v148","v149","v150","v151","v152","v153","v154","v155","v156","v157","v158","v159","v160","v161","v162","v163","v164","v165","v166","v167","v168","v169","v170","v171","v172","v173","v174","v175","v176","v177","v178","v179","v180","v181","v182","v183","v184","v185","v186","v187","v188","v189","v190","v191","v192","v193","v194","v195","v196","v197","v198","v199","v200","v201","v202","v203","v204","v205","v206","v207","v208","v209","v210","v211","v212","v213","v214","v215","v216","v217","v218","v219","v220","v221","v222","v223","v224","v225","v226","v227","v228","v229","v230","v231","v232","v233","v234","v235","v236","v237","v238","v239","v240","v241","v242","v243","v244","v245","v246","v247","v248","v249");
        asm volatile("" : "+s"(p));
        const int phc = p->seq[pi_], ph = phc & 63; const bool dry = (phc & 64) != 0;
        int bid = blockIdx.x, G = gridDim.x;
        asm volatile("" : "+s"(bid), "+s"(G));
#define TID_HERE (wb + lane_now())
        int ffn = -1; bool ffn_in = false;
        if (ph == 1 || ph == 2) { ffn = 0; ffn_in = ph == 1; } else if (ph == 11 || ph == 12) { ffn = 1; ffn_in = ph == 11; }
        else if (ph == 14 || ph == 15) { ffn = 2; ffn_in = ph == 14; } else if (ph == 21 || ph == 22) { ffn = 3; ffn_in = ph == 21; }
        if (EN(0) && ph == 0) { { const int tid = TID_HERE; convert_weights(p, (LAS float*)lds, tid, bid, G); assemble_x(p, tid, bid, G); } }
        else if (EN(1) && ffn >= 0 && ffn_in) {
            pg8::StaticOrder S; S.init(MP, NIN, G, bid); S.nt0 = D / 64;
            unsigned char* ws = p->ws; EpiSwiGLU E{(bf16_t*)(ws + W_HB), (const float*)(ws + W_RSQ) + (size_t)(ffn == 0 ? 0 : (ffn == 1 ? 1 : (ffn == 2 ? 2 : 4))) * MP};
            run_gemm(lds, wb, (const bf16_t*)(ws + W_XN), (const bf16_t*)(ws + W_WIN + ffn * SZ_WIN1), MP, NIN, D, S, E);
        } else if (EN(2) && ffn >= 0) {
            TailSplitOrder S; S.init(MP, D, DFFP, G, bid, 11);
            unsigned char* ws = p->ws; const bool fold = (ffn == 1 || ffn == 2) && !dry;
            EpiRes E{(float*)(ws + W_X), dry ? 0.f : 0.5f, (ffn == 3 && !dry) ? p->out : nullptr, fold ? (bf16_t*)(ws + W_XN) : nullptr, (float*)(ws + W_RSQ) + (size_t)(ffn == 1 ? 2 : 3) * MP, (float*)(ws + W_SKP)};
            run_gemm(lds, wb, (const bf16_t*)(ws + W_HB), (const bf16_t*)(ws + W_WOUT + ffn * SZ_WOUT1), MP, D, DFFP, S, E, (float*)(ws + W_SKP), (unsigned*)(ws + W_SKF) + pi_ * 1024);
        }
        else if (ph >= 24 && ph < 28) { if (!dry) fixup_phase<11>(p, ph - 24, TID_HERE, bid, G); }
        else if (ph >= 28 && ph < 30) { if (!dry) fixup_phase<WO_NS>(p, ph - 24, TID_HERE, bid, G); }
        else if (EN(3) && ph == 3) mixprep_phase(p, TID_HERE, bid, G);
        else if (EN(4) && ph == 4) {
            G1Order S{G, bid};
            unsigned char* ws = p->ws; EpiG1 E{(bf16_t*)(ws + W_RKV), (float*)(ws + W_L1)};
            run_gemm(lds, wb, (const bf16_t*)(ws + W_AALL), (const bf16_t*)(ws + W_WG1), 5 * MP, 3584, D, S, E);
        }
        else if (EN(5) && ph == 5) act_phase(p, bid * 512 + TID_HERE, G * 512);
        else if (EN(6) && ph == 6) {
            G2Order S; S.init(G, bid);
            unsigned char* ws = p->ws; EpiG2 E{(bf16_t*)(ws + W_DEC)};
            run_gemm(lds, wb, (const bf16_t*)(ws + W_A2), (const bf16_t*)(ws + W_WL2), MP, 3072, 256, S, E);
        }
        else if (EN(7) && ph == 7) scan_phase(p, (LAS float*)lds, TID_HERE, bid, G);
        else if (EN(8) && ph == 8) post_phase(p, TID_HERE, bid, G);
        else if (EN(9) && (ph == 9 || ph == 19)) {
            TailSplitOrder S; S.init(MP, D, D, G, bid, WO_NS);
            unsigned char* ws = p->ws; EpiRes E{(float*)(ws + W_X), dry ? 0.f : 1.0f, nullptr, dry ? nullptr : (bf16_t*)(ws + W_XN), (float*)(ws + W_RSQ) + (size_t)(ph == 9 ? 1 : 4) * MP, (float*)(ws + W_SKP)};
            run_gemm(lds, wb, (const bf16_t*)(ws + W_OG), (const bf16_t*)(ws + (ph == 9 ? W_WO1 : W_WO2)), MP, D, D, S, E, (float*)(ws + W_SKP), (unsigned*)(ws + W_SKF) + pi_ * 1024);
        }
        else if (EN(11) && ph == 17) {
            pg8::StaticOrder S; S.init(MP, 3 * D, G, bid); S.nt0 = D / 64;
            unsigned char* ws = p->ws; EpiQKV E{(bf16_t*)(ws + W_QB), p->out, p->in[28], p->in[29], (const float*)(ws + W_RSQ) + (size_t)3 * MP};
            run_gemm(lds, wb, (const bf16_t*)(ws + W_XN), (const bf16_t*)(ws + W_WQKV), MP, 3 * D, D, S, E);
        }
        else if (EN(12) && ph == 18) attn_phase(p, TID_HERE, bid, G);
        if (pi_ + 1 < ph_hi) { if (pi_ < 0) grid.sync(); else xcd_barrier(xbar, (wb + lane_now()) == 0); }
    }
}

#ifndef ONE_LAUNCH
#define ONE_LAUNCH 1
#endif
extern "C" void kernel_launch(void* const* d_in, const int* in_sizes, int n_in, void* d_out, int out_size, void* d_ws, size_t ws_size, hipStream_t stream) {
    static int grid = 0;
    if (grid == 0) {
        if (n_in != 31 || (size_t)out_size != O_END || ws_size < W_END) { fprintf(stderr, "kernel_launch: unexpected sizes (n_in %d out %d ws %zu need %zu)\n", n_in, out_size, ws_size, (size_t)W_END); grid = -1; return; }
        int dev = 0, cus = 0, per_cu = 0;
        hipGetDevice(&dev); hipDeviceGetAttribute(&cus, hipDeviceAttributeMultiprocessorCount, dev);
        if (hipFuncSetAttribute((const void*)mega, hipFuncAttributeMaxDynamicSharedMemorySize, LDS_BYTES) != hipSuccess) { fprintf(stderr, "kernel_launch: hipFuncSetAttribute failed\n"); grid = -1; return; }
        hipOccupancyMaxActiveBlocksPerMultiprocessor(&per_cu, (const void*)mega, 512, LDS_BYTES);
        (void)hipGetLastError();
        if (per_cu < 1) per_cu = 1;
        grid = cus * per_cu;
    }
    if (grid < 0) return;
    Params p{};
    for (int i = 0; i < 31; ++i) p.in[i] = (const float*)d_in[i];
    p.out = (float*)d_out; p.ws = (unsigned char*)d_ws;
    int nseq = 0;
    for (int ph = 0; ph < NPHASE; ++ph) {
        if (ph == 10 || ph == 13 || ph == 16 || ph == 20) continue;
        p.seq[nseq++] = ph;
        if (ph == 2 || ph == 12 || ph == 15 || ph == 22) p.seq[nseq++] = 24 + (ph == 2 ? 0 : (ph == 12 ? 1 : (ph == 15 ? 2 : 3)));
        if (ph == 9 || ph == 19) p.seq[nseq++] = ph == 9 ? 28 : 29;
#ifdef REP_OF
        for (int r = 0; r < (REP_OF(ph)); ++r) p.seq[nseq++] = (ph | ((ph == 2 || ph == 9) ? 64 : 0));
#endif
    }
#if ONE_LAUNCH
    (void)hipMemsetAsync((unsigned char*)d_ws + W_BAR, 0, 16384, stream);
    p.ph_lo = 0; p.ph_hi = nseq;
    void* args[] = {&p};
    hipError_t e = hipLaunchCooperativeKernel((const void*)mega, dim3(grid), dim3(512), args, LDS_BYTES, stream);
    if (e != hipSuccess) fprintf(stderr, "cooperative launch failed: %s (grid %d)\n", hipGetErrorString(e), grid);
#else
    for (int ph = 0; ph < nseq; ++ph) { p.ph_lo = ph; p.ph_hi = ph + 1; hipLaunchKernelGGL(mega, dim3(grid), dim3(512), LDS_BYTES, stream, p); }
#endif
}
```
